# Optimizing an MI355X kernel written in HIP

```python
import jax, jax.numpy as jnp
from jax import lax
import numpy as np

D_MODEL = 1024
BATCH = 8
SEQ = 2048
DEPTH = 2

GRID_W = 64
CTX_LEN = 256
EPS = 1e-6
ROPE_BASE = 10000.0
Q_BLOCK = 128
NEG_INF = -1e30

A_HEADS = 4
A_NOPE = 128
A_ROPE = 64
A_V = 128
A_Q_RANK = 256
A_KV_RANK = 128
B_HEADS = 8
B_KV_HEADS = 2
B_HD = 64
WINDOW = 128
C_HEADS = 4
C_DK = 64
C_DV = 128
C_DECAY_RANK = 16
C_DECAY_TEMP = 16.0
C_CHUNK = 64
D_HEADS = 4
D_KV_HEADS = 2
D_HD = 128
N_BRANCH = 4
BRANCH_W = 512
D_FF = 4 * D_MODEL

A_COLS = A_Q_RANK + A_KV_RANK + A_ROPE
B_COLS = (B_HEADS + 2 * B_KV_HEADS) * B_HD
C_COLS = 2 * C_HEADS * C_DK + 2 * C_HEADS * C_DV + 2 * C_DECAY_RANK
D_COLS = (D_HEADS + 2 * D_KV_HEADS) * D_HD
GATE_COLS = N_BRANCH * D_MODEL
IN_SPLITS = (A_COLS, B_COLS, C_COLS, D_COLS, GATE_COLS)
IN_COLS = A_COLS + B_COLS + C_COLS + D_COLS + GATE_COLS

kernel_name = 'hybrid_parallel_mixer_flow_block'


def rmsnorm(x, w):
    xf = x.astype(jnp.float32)
    y = xf * lax.rsqrt(jnp.mean(xf * xf, axis=-1, keepdims=True) + EPS)
    return (y * w.astype(jnp.float32)).astype(x.dtype)


def modulate(h, shift, scale):
    return h * (1 + scale) + shift


def split_cols(t, sizes):
    return jnp.split(t, [int(s) for s in np.cumsum(sizes)[:-1]], axis=-1)


def to_heads(t, n, d):
    b, l, _ = t.shape
    return t.reshape(b, l, n, d).transpose(0, 2, 1, 3)


def from_heads(t):
    b, h, l, d = t.shape
    return t.transpose(0, 2, 1, 3).reshape(b, l, h * d)


def rope_1d(x, pos):
    half = x.shape[-1] // 2
    inv = ROPE_BASE ** (-jnp.arange(half, dtype=jnp.float32) / half)
    ang = pos.astype(jnp.float32)[:, None] * inv[None, :]
    cos = jnp.cos(ang).astype(x.dtype)
    sin = jnp.sin(ang).astype(x.dtype)
    x1, x2 = x[..., :half], x[..., half:]
    return jnp.concatenate([x1 * cos - x2 * sin, x1 * sin + x2 * cos], axis=-1)


def rope_2d(x, rows, cols):
    half = x.shape[-1] // 2
    return jnp.concatenate([rope_1d(x[..., :half], rows), rope_1d(x[..., half:], cols)], axis=-1)


def dense_block_attention(q, k, v, scale):
    b, hk, g, l, dk = q.shape
    nb = l // Q_BLOCK
    qb = q.reshape(b, hk, g, nb, Q_BLOCK, dk).transpose(3, 0, 1, 2, 4, 5)

    def one_block(qi):
        s = jnp.einsum('bhgqd,bhkd->bhgqk', qi, k).astype(jnp.float32) * scale
        p = jax.nn.softmax(s, axis=-1).astype(v.dtype)
        return jnp.einsum('bhgqk,bhkd->bhgqd', p, v)

    o = lax.map(one_block, qb)
    return o.transpose(1, 2, 3, 0, 4, 5).reshape(b, hk, g, l, v.shape[-1])


def mla_mixer(p_lat, p_ctx, q_norm_w, w_uq, kv_norm_w, w_ukv, rows, cols, need_ctx):
    def project(p, rope):
        c_q, c_kv, k_rope = split_cols(p, [A_Q_RANK, A_KV_RANK, A_ROPE])
        q = to_heads(rmsnorm(c_q, q_norm_w) @ w_uq, A_HEADS, A_NOPE + A_ROPE)
        kv = to_heads(rmsnorm(c_kv, kv_norm_w) @ w_ukv, A_HEADS, A_NOPE + A_V)
        q_nope, q_rope = q[..., :A_NOPE], q[..., A_NOPE:]
        k_nope, v = kv[..., :A_NOPE], kv[..., A_NOPE:]
        k_rope = k_rope[:, None]
        if rope:
            q_rope = rope_2d(q_rope, rows, cols)
            k_rope = rope_2d(k_rope, rows, cols)
        k_rope = jnp.broadcast_to(k_rope, k_nope.shape[:-1] + (A_ROPE,))
        q = jnp.concatenate([q_nope, q_rope], axis=-1)[:, :, None]
        k = jnp.concatenate([k_nope, k_rope], axis=-1)
        return q, k, v

    scale = (A_NOPE + A_ROPE) ** -0.5
    q, k, v = project(p_lat, True)
    qc, kc, vc = project(p_ctx, False)
    y = dense_block_attention(q, jnp.concatenate([kc, k], axis=2), jnp.concatenate([vc, v], axis=2), scale)
    y_lat = from_heads(y[:, :, 0])
    y_ctx = from_heads(dense_block_attention(qc, kc, vc, scale)[:, :, 0]) if need_ctx else None
    return y_lat, y_ctx


def window_sink_mixer(p_lat, p_ctx, sink, rows, cols, need_ctx):
    g = B_HEADS // B_KV_HEADS
    scale = B_HD ** -0.5

    def project(p, rope):
        q, k, v = split_cols(p, [B_HEADS * B_HD, B_KV_HEADS * B_HD, B_KV_HEADS * B_HD])
        q, k, v = to_heads(q, B_HEADS, B_HD), to_heads(k, B_KV_HEADS, B_HD), to_heads(v, B_KV_HEADS, B_HD)
        if rope:
            q, k = rope_2d(q, rows, cols), rope_2d(k, rows, cols)
        b, _, l, _ = q.shape
        return q.reshape(b, B_KV_HEADS, g, l, B_HD), k, v

    q, k, v = project(p_lat, True)
    qc, kc, vc = project(p_ctx, False)
    sink_f = sink.astype(jnp.float32).reshape(B_KV_HEADS, g)
    n_ctx = kc.shape[2]
    b, hk, _, t, d = q.shape
    nb = t // Q_BLOCK
    qb = q.reshape(b, hk, g, nb, Q_BLOCK, d)

    def bands(z):
        zp = jnp.pad(z, ((0, 0), (0, 0), (Q_BLOCK, Q_BLOCK), (0, 0)))
        return jnp.concatenate(
            [zp[:, :, j * Q_BLOCK: j * Q_BLOCK + t].reshape(b, hk, nb, Q_BLOCK, d) for j in range(3)], axis=3)

    kb, vb = bands(k), bands(v)
    qpos = jnp.arange(nb)[:, None] * Q_BLOCK + jnp.arange(Q_BLOCK)[None, :]
    kpos = jnp.arange(nb)[:, None] * Q_BLOCK - Q_BLOCK + jnp.arange(3 * Q_BLOCK)[None, :]
    valid = ((kpos[:, None, :] >= 0) & (kpos[:, None, :] < t)
             & (jnp.abs(qpos[:, :, None] - kpos[:, None, :]) <= WINDOW))
    s_loc = jnp.where(valid, jnp.einsum('bhgnqd,bhnkd->bhgnqk', qb, kb).astype(jnp.float32) * scale, NEG_INF)
    s_ctx = jnp.einsum('bhgnqd,bhcd->bhgnqc', qb, kc).astype(jnp.float32) * scale
    s_sink = jnp.broadcast_to(sink_f[None, :, :, None, None, None], s_loc.shape[:-1] + (1,))
    pr = jax.nn.softmax(jnp.concatenate([s_ctx, s_loc, s_sink], axis=-1), axis=-1).astype(v.dtype)
    o = (jnp.einsum('bhgnqc,bhcd->bhgnqd', pr[..., :n_ctx], vc)
         + jnp.einsum('bhgnqk,bhnkd->bhgnqd', pr[..., n_ctx:n_ctx + 3 * Q_BLOCK], vb))
    y_lat = from_heads(o.reshape(b, hk * g, t, d))
    if need_ctx:
        s = jnp.einsum('bhgqd,bhcd->bhgqc', qc, kc).astype(jnp.float32) * scale
        s_sink_c = jnp.broadcast_to(sink_f[None, :, :, None, None], s.shape[:-1] + (1,))
        pc = jax.nn.softmax(jnp.concatenate([s, s_sink_c], axis=-1), axis=-1)[..., :-1].astype(vc.dtype)
        oc = jnp.einsum('bhgqc,bhcd->bhgqd', pc, vc)
        y_ctx = from_heads(oc.reshape(b, hk * g, n_ctx, d))
    else:
        y_ctx = None
    return y_lat, y_ctx


def gla_chunk_scan(q, k, v, log_a, s0, with_out):
    b, h, t, dk = q.shape
    dv = v.shape[-1]
    n = t // C_CHUNK

    def chunks(z):
        return z.astype(jnp.float32).reshape(b, h, n, C_CHUNK, z.shape[-1]).transpose(2, 0, 1, 3, 4)

    lower_tri = jnp.tril(jnp.ones((C_CHUNK, C_CHUNK), dtype=bool))[:, :, None]

    def body(state, inp):
        qi, ki, vi, lai = inp
        cum = jnp.cumsum(lai, axis=2)
        last = cum[:, :, -1:, :]
        new_state = (jnp.exp(last[:, :, 0, :])[..., None] * state
                     + jnp.einsum('bhsd,bhse->bhde', ki * jnp.exp(last - cum), vi))
        if not with_out:
            return new_state, None
        o_inter = jnp.einsum('bhtd,bhde->bhte', qi * jnp.exp(cum), state)
        diff = cum[:, :, :, None, :] - cum[:, :, None, :, :]
        decay = jnp.exp(jnp.where(lower_tri, diff, -jnp.inf))
        scores = jnp.einsum('bhtd,bhsd,bhtsd->bhts', qi, ki, decay)
        return new_state, o_inter + jnp.einsum('bhts,bhse->bhte', scores, vi)

    state, o = lax.scan(body, s0, (chunks(q), chunks(k), chunks(v), chunks(log_a)))
    if with_out:
        o = o.transpose(1, 2, 0, 3, 4).reshape(b, h, t, dv)
    return state, o


def gla_mixer(p_lat, p_ctx, w_decay, b_decay, norm_w, need_ctx):
    def project(p):
        q, k, v, r, lr_f, lr_b = split_cols(
            p, [C_HEADS * C_DK, C_HEADS * C_DK, C_HEADS * C_DV, C_HEADS * C_DV, C_DECAY_RANK, C_DECAY_RANK])
        la_f = to_heads(jax.nn.log_sigmoid((lr_f @ w_decay[0] + b_decay[0]).astype(jnp.float32)) / C_DECAY_TEMP,
                        C_HEADS, C_DK)
        la_b = to_heads(jax.nn.log_sigmoid((lr_b @ w_decay[1] + b_decay[1]).astype(jnp.float32)) / C_DECAY_TEMP,
                        C_HEADS, C_DK)
        return (to_heads(q, C_HEADS, C_DK) * C_DK ** -0.5, to_heads(k, C_HEADS, C_DK),
                to_heads(v, C_HEADS, C_DV), r, la_f, la_b)

    q, k, v, r, la_f, la_b = project(p_lat)
    qc, kc, vc, rc, lac_f, lac_b = project(p_ctx)

    def flip(z):
        return z[:, :, ::-1]

    s0 = jnp.zeros((q.shape[0], C_HEADS, C_DK, C_DV), jnp.float32)
    s_cf, o_cf = gla_chunk_scan(qc, kc, vc, lac_f, s0, need_ctx)
    s_cb, o_cb = gla_chunk_scan(flip(qc), flip(kc), flip(vc), flip(lac_b), s0, need_ctx)
    _, o_f = gla_chunk_scan(q, k, v, la_f, s_cf, True)
    _, o_b = gla_chunk_scan(flip(q), flip(k), flip(v), flip(la_b), s_cb, True)

    def readout(o, gate):
        return from_heads(rmsnorm(o.astype(gate.dtype), norm_w)) * jax.nn.silu(gate)

    y_lat = readout(o_f + flip(o_b), r)
    y_ctx = readout(o_cf + flip(o_cb), rc) if need_ctx else None
    return y_lat, y_ctx


def qknorm_gqa_mixer(p_lat, p_ctx, q_norm_w, k_norm_w, rows, cols, need_ctx):
    g = D_HEADS // D_KV_HEADS
    scale = D_HD ** -0.5

    def project(p, rope):
        q, k, v = split_cols(p, [D_HEADS * D_HD, D_KV_HEADS * D_HD, D_KV_HEADS * D_HD])
        q = rmsnorm(to_heads(q, D_HEADS, D_HD), q_norm_w)
        k = rmsnorm(to_heads(k, D_KV_HEADS, D_HD), k_norm_w)
        v = to_heads(v, D_KV_HEADS, D_HD)
        if rope:
            q, k = rope_2d(q, rows, cols), rope_2d(k, rows, cols)
        b, _, l, _ = q.shape
        return q.reshape(b, D_KV_HEADS, g, l, D_HD), k, v

    q, k, v = project(p_lat, True)
    qc, kc, vc = project(p_ctx, False)
    b, _, _, t, _ = q.shape
    y = dense_block_attention(q, jnp.concatenate([kc, k], axis=2), jnp.concatenate([vc, v], axis=2), scale)
    y_lat = from_heads(y.reshape(b, D_HEADS, t, D_HD))
    if need_ctx:
        yc = dense_block_attention(qc, kc, vc, scale)
        y_ctx = from_heads(yc.reshape(b, D_HEADS, kc.shape[2], D_HD))
    else:
        y_ctx = None
    return y_lat, y_ctx


def gated_merge(ys, gate_logits, w_branch, w_o):
    b, l, _ = gate_logits.shape
    gates = jax.nn.sigmoid(gate_logits).reshape(b, l, N_BRANCH, D_MODEL)
    z = jnp.einsum('blnw,nwd->blnd', jnp.stack(ys, axis=2), w_branch)
    return jnp.einsum('blnd,blnd->bld', gates, z) @ w_o


def sqrelu_mlp(h, w1, w2):
    return jnp.square(jax.nn.relu(h @ w1)) @ w2


def setup_inputs(seed: int = 0) -> dict:
    key = jax.random.key(seed)
    ks = jax.random.split(key, 24)
    f32 = jnp.float32
    L, D = DEPTH, D_MODEL

    def nrm(k, shape, scale):
        return jax.random.normal(k, shape, f32) * scale

    def gain(k, shape):
        return 1.0 + 0.05 * jax.random.normal(k, shape, f32)

    return {
        'x': nrm(ks[0], (BATCH, SEQ, D), 1.0),
        'c': nrm(ks[1], (BATCH, D), 1.0),
        'ctx': nrm(ks[2], (BATCH, CTX_LEN, D), 1.0),
        'c_ctx': nrm(ks[3], (D,), 1.0),
        'ada_w': nrm(ks[4], (L, D, 6 * D), 0.5 * D ** -0.5),
        'ada_b': nrm(ks[5], (L, 6 * D), 0.01),
        'norm1_w': gain(ks[6], (L, D)),
        'norm2_w': gain(ks[7], (L, D)),
        'w_in': nrm(ks[8], (L, D, IN_COLS), D ** -0.5),
        'mla_q_norm_w': gain(ks[9], (L, A_Q_RANK)),
        'mla_w_uq': nrm(ks[10], (L, A_Q_RANK, A_HEADS * (A_NOPE + A_ROPE)), A_Q_RANK ** -0.5),
        'mla_kv_norm_w': gain(ks[11], (L, A_KV_RANK)),
        'mla_w_ukv': nrm(ks[12], (L, A_KV_RANK, A_HEADS * (A_NOPE + A_V)), A_KV_RANK ** -0.5),
        'swa_sink': nrm(ks[13], (L, B_HEADS), 1.0),
        'gla_w_decay': nrm(ks[14], (L, 2, C_DECAY_RANK, C_HEADS * C_DK), C_DECAY_RANK ** -0.5),
        'gla_b_decay': nrm(ks[15], (L, 2, C_HEADS * C_DK), 0.01),
        'gla_norm_w': gain(ks[16], (L, C_DV)),
        'gqa_q_norm_w': gain(ks[17], (L, D_HD)),
        'gqa_k_norm_w': gain(ks[18], (L, D_HD)),
        'w_branch': nrm(ks[19], (L, N_BRANCH, BRANCH_W, D), BRANCH_W ** -0.5),
        'w_o': nrm(ks[20], (L, D, D), D ** -0.5),
        'mlp_w1': nrm(ks[21], (L, D, D_FF), D ** -0.5),
        'mlp_w2': nrm(ks[22], (L, D_FF, D), D_FF ** -0.5),
        'final_norm_w': gain(ks[23], (D,)),
    }


def reference(x, c, ctx, c_ctx, ada_w, ada_b, norm1_w, norm2_w, w_in,
              mla_q_norm_w, mla_w_uq, mla_kv_norm_w, mla_w_ukv, swa_sink,
              gla_w_decay, gla_b_decay, gla_norm_w, gqa_q_norm_w, gqa_k_norm_w,
              w_branch, w_o, mlp_w1, mlp_w2, final_norm_w):
    t = x.shape[1]
    ROWS = t // GRID_W
    rows = jnp.repeat(jnp.arange(ROWS), GRID_W)
    cols = jnp.tile(jnp.arange(GRID_W), ROWS)
    xc = ctx
    sc = jax.nn.silu(c)
    scc = jax.nn.silu(c_ctx)
    for l in range(DEPTH):
        need_ctx = l < DEPTH - 1
        mod = jnp.split((sc @ ada_w[l] + ada_b[l])[:, None, :], 6, axis=-1)
        mod_c = jnp.split(scc @ ada_w[l] + ada_b[l], 6, axis=-1)
        h = modulate(rmsnorm(x, norm1_w[l]), mod[0], mod[1])
        hc = modulate(rmsnorm(xc, norm1_w[l]), mod_c[0], mod_c[1])
        p = split_cols(h @ w_in[l], IN_SPLITS)
        pc = split_cols(hc @ w_in[l], IN_SPLITS)
        ya, yca = mla_mixer(p[0], pc[0], mla_q_norm_w[l], mla_w_uq[l], mla_kv_norm_w[l], mla_w_ukv[l],
                            rows, cols, need_ctx)
        yb, ycb = window_sink_mixer(p[1], pc[1], swa_sink[l], rows, cols, need_ctx)
        yg, ycg = gla_mixer(p[2], pc[2], gla_w_decay[l], gla_b_decay[l], gla_norm_w[l], need_ctx)
        yd, ycd = qknorm_gqa_mixer(p[3], pc[3], gqa_q_norm_w[l], gqa_k_norm_w[l], rows, cols, need_ctx)
        x = x + mod[2] * gated_merge([ya, yb, yg, yd], p[4], w_branch[l], w_o[l])
        x = x + mod[5] * sqrelu_mlp(modulate(rmsnorm(x, norm2_w[l]), mod[3], mod[4]), mlp_w1[l], mlp_w2[l])
        if need_ctx:
            xc = xc + mod_c[2] * gated_merge([yca, ycb, ycg, ycd], pc[4], w_branch[l], w_o[l])
            xc = xc + mod_c[5] * sqrelu_mlp(modulate(rmsnorm(xc, norm2_w[l]), mod_c[3], mod_c[4]),
                                            mlp_w1[l], mlp_w2[l])
    return rmsnorm(x, final_norm_w)
```

```cpp
#include <hip/hip_runtime.h>
#include <hip/hip_cooperative_groups.h>
#include <cstdio>
#include <cstdint>
namespace cg = cooperative_groups;

#define LAS __attribute__((address_space(3)))
typedef unsigned short bf16;
typedef short bf16x8 __attribute__((ext_vector_type(8)));
typedef float f32x4 __attribute__((ext_vector_type(4)));
typedef float f32x16 __attribute__((ext_vector_type(16)));
typedef unsigned u32x4 __attribute__((ext_vector_type(4)));
typedef unsigned u32x2 __attribute__((ext_vector_type(2)));

constexpr int DM = 1024, NB = 8, SEQ = 2048, CTXL = 256, GB = 4, NGRP = 2;
constexpr int MG_ROWS = GB * (SEQ + CTXL);
constexpr int LAT_ROWS = GB * SEQ;
constexpr int KEYS = CTXL + SEQ;
constexpr int IN_COLS = 7904, PC = 3840;
constexpr int WIN_N = 7936;
constexpr float EPS = 1e-6f;
constexpr int PC_CQ = 0, PC_CKV = 256, PC_KR = 384, PC_QB = 448, PC_KB = 960, PC_VB = 1088, PC_QC = 1216, PC_KC = 1472, PC_VC = 1728, PC_RC = 2240,
              PC_LRF = 2752, PC_QD = 2784, PC_KD = 3296, PC_VD = 3552, PC_GATE = 3808;
constexpr size_t MiB = 1u << 20;
constexpr size_t WS_CTL = 0, CTL_BYTES = 1 * MiB;
constexpr size_t WS_MOD = 1 * MiB;
constexpr size_t WS_WT = 2 * MiB;
constexpr size_t WT_WIN = 0, WT_WMLA = WT_WIN + (size_t)WIN_N * 1024 * 2, WT_WB = WT_WMLA + (size_t)1792 * 384 * 2, WT_WO = WT_WB + (size_t)4096 * 512 * 2,
                 WT_W1 = WT_WO + (size_t)1024 * 1024 * 2, WT_W2 = WT_W1 + (size_t)4096 * 1024 * 2, WT_END = WT_W2 + (size_t)1024 * 4096 * 2;
static_assert(WT_END <= 40 * MiB, "weights");
constexpr size_t WS_XC1 = 42 * MiB;
constexpr size_t WS_H = 50 * MiB;
constexpr size_t WS_MG = 68 * MiB;
constexpr size_t WS_Y = 86 * MiB;
constexpr size_t WS_P = 122 * MiB;
constexpr size_t WS_CN = WS_P + (size_t)MG_ROWS * PC * 2;
constexpr size_t WS_QA = WS_CN + (size_t)MG_ROWS * 384 * 2;
constexpr size_t WS_KA = WS_QA + (size_t)MG_ROWS * 768 * 2;
constexpr size_t WS_VTA = WS_KA + (size_t)GB * 4 * KEYS * 192 * 2;
constexpr size_t WS_VTB = WS_VTA + (size_t)GB * 4 * 128 * KEYS * 2;
constexpr size_t WS_VTC = WS_VTB + (size_t)GB * 2 * 64 * KEYS * 2;
constexpr size_t WS_VTD = WS_VTC + (size_t)GB * 4 * 128 * KEYS * 2;
constexpr size_t WS_END = WS_VTD + (size_t)GB * 2 * 128 * KEYS * 2;
constexpr size_t WS_Z = WS_P;
static_assert(WS_Z + (size_t)MG_ROWS * 4096 * 2 <= WS_QA, "Z overlay must stay inside P|CN");
static_assert(WS_END <= 248 * MiB, "workspace");
constexpr int LDS_BYTES = 147456;

__device__ __forceinline__ unsigned f2bf(float f) { unsigned u = __builtin_bit_cast(unsigned, f); return (u + 0x7fffu + ((u >> 16) & 1u)) >> 16; }
__device__ __forceinline__ unsigned pk2(float lo, float hi) { return f2bf(lo) | (f2bf(hi) << 16); }
__device__ __forceinline__ float bf2f(unsigned short b) { return __builtin_bit_cast(float, (unsigned)b << 16); }
__device__ __forceinline__ float bflo(unsigned w) { return __builtin_bit_cast(float, w << 16); }
__device__ __forceinline__ float bfhi(unsigned w) { return __builtin_bit_cast(float, w & 0xffff0000u); }
__device__ __forceinline__ float wave_sum(float v) {
#pragma unroll
    for (int o = 1; o < 64; o <<= 1) v += __shfl_xor(v, o);
    return v;
}
__device__ __forceinline__ int tidx() { int t = threadIdx.x; asm volatile("" : "+v"(t)); return t; }
__device__ __forceinline__ float sigmoidf_(float x) { return 1.f / (1.f + __expf(-x)); }
__device__ __forceinline__ float siluf_(float x) { return x / (1.f + __expf(-x)); }

namespace pg8 {
constexpr int BM = 256, BK = 64, HALF = 128, HTB = HALF * BK * 2, STAGE_BYTES = 8 * HTB, NXCD = 8, WGM = 8;
__host__ __device__ __forceinline__ int lds_byte(int r, int c) { const int st = (r >> 4) * 2 + (c >> 5), rr = r & 15, cc = c & 31, ob = rr * 64 + cc * 2; return st * 1024 + (ob ^ (((ob >> 9) & 1) << 5)); }
__host__ __device__ __forceinline__ void stage_rc(int b, int& R, int& C) { const int st = b / 1024, sb = b % 1024, swz = sb ^ (((sb >> 9) & 1) << 5); R = (st >> 1) * 16 + swz / 64; C = (st & 1) * 32 + (swz % 64) / 2; }
__host__ __device__ __forceinline__ int perm32(int rho) { const int n = rho >> 4, i = rho & 15; return 8 * (i >> 2) + 4 * n + (i & 3); }

struct Unit { int pm, pn; };
struct Gemm { const bf16* A; const bf16* Bt; int lda, ldb, K; int adiv, amul; };

struct StaticOrder {
    int nM, nN, nwg, G, c;
    __device__ void init(int nM_, int nN_, int G_, int c_) { nM = nM_; nN = nN_; nwg = nM * nN; G = G_; c = c_; }
    __device__ bool next(int i, Unit& u) const {
        const long L = (long)i * G + c; if (L >= nwg) return false;
        int wgid = (int)L; { const int q = nwg / NXCD, r = nwg % NXCD, xcd = wgid % NXCD, off = wgid / NXCD; wgid = (xcd < r ? xcd * (q + 1) : r * (q + 1) + (xcd - r) * q) + off; }
        const int nig = WGM * nN, gid = wgid / nig, fm = gid * WGM, gsz = (nM - fm) < WGM ? (nM - fm) : WGM;
        u.pm = fm + ((wgid % nig) % gsz); u.pn = (wgid % nig) / gsz; return true;
    }
};
template <class Epi>
__device__ __forceinline__ void gemm_phase(LAS unsigned char* lds, const Gemm g, const StaticOrder& S, const Epi& E) {
    const int tid = tidx(), wid = __builtin_amdgcn_readfirstlane(tid >> 6), lane = tid & 63, wr = wid >> 2, wc = wid & 3, fr = lane & 15, fq = lane >> 4;
    const int K = g.K, nt = K / BK;
    unsigned voffA[2], voffB[2];
#pragma unroll
    for (int i = 0; i < 2; ++i) { int R, C; stage_rc(tid * 16 + i * 8192, R, C); const int Rb = (R & ~31) + perm32(R & 31);
        voffA[i] = (unsigned)(R * g.lda + C) * 2u; voffB[i] = (unsigned)(Rb * g.ldb + C) * 2u; }
    const size_t kstep = (size_t)(BK * 2);
    const size_t hstepA = (size_t)HALF * g.lda * 2, hstepB = (size_t)HALF * g.ldb * 2;
    const size_t tstepA = 2 * hstepA, tstepB = 2 * hstepB;
    const unsigned ldsw = (unsigned)wid * 1024u;
    const int aoff = lds_byte(wr * 64 + fr, fq * 8), boff = lds_byte(wc * 32 + fr, fq * 8);
#define PG8_SA(b, h) (((b) * 2 + (h)) * HTB)
#define PG8_SB(b, h) ((4 + (b) * 2 + (h)) * HTB)
#define PG8_STAGE(bufoff, gbase, voff) do { _Pragma("unroll") for (int _i = 0; _i < 2; ++_i) \
        __builtin_amdgcn_global_load_lds((const unsigned*)((const char*)(gbase) + (voff)[_i]), (LAS unsigned*)(lds + (bufoff) + ldsw + _i * 8192), 16, 0, 0); } while (0)
#define PG8_LDA(dst, b, h) do { _Pragma("unroll") for (int m = 0; m < 4; ++m) _Pragma("unroll") for (int k = 0; k < 2; ++k) dst[m][k] = *(const LAS bf16x8*)(lds + PG8_SA(b, h) + aoff + m * 2048 + k * 1024); } while (0)
#define PG8_LDB(dst, b, h) do { _Pragma("unroll") for (int n = 0; n < 2; ++n) _Pragma("unroll") for (int k = 0; k < 2; ++k) dst[n][k] = *(const LAS bf16x8*)(lds + PG8_SB(b, h) + boff + n * 2048 + k * 1024); } while (0)
#define PG8_MMA(ai, bj, At, Bt) do { __builtin_amdgcn_s_setprio(1); _Pragma("unroll") for (int m = 0; m < 4; ++m) _Pragma("unroll") for (int n = 0; n < 2; ++n) _Pragma("unroll") for (int k = 0; k < 2; ++k) \
        acc[ai][bj][m][n] = __builtin_amdgcn_mfma_f32_16x16x32_bf16(Bt[n][k], At[m][k], acc[ai][bj][m][n], 0, 0, 0); __builtin_amdgcn_s_setprio(0); } while (0)
#define PG8_WAIT_V(n) asm volatile("s_waitcnt vmcnt(" #n ")" ::: "memory")
#define PG8_WAIT_L(n) asm volatile("s_waitcnt lgkmcnt(" #n ")" ::: "memory")
#define PG8_BAR __builtin_amdgcn_s_barrier()
#define PG8_SCHED __builtin_amdgcn_sched_barrier(0)
#define PG8_AOFF(u) ((size_t)(g.adiv ? ((u).pn / g.adiv) * g.amul * 2 : 0))
    Unit cur, nxt; int ui = 0;
    if (!S.next(0, cur)) return;
    f32x4 acc[2][2][4][2];
#pragma unroll
    for (int a = 0; a < 2; ++a)
#pragma unroll
        for (int b = 0; b < 2; ++b)
#pragma unroll
            for (int m = 0; m < 4; ++m)
#pragma unroll
                for (int n = 0; n < 2; ++n) acc[a][b][m][n] = (f32x4){0.f, 0.f, 0.f, 0.f};
    bf16x8 At[4][2], B0[2][2], B1[2][2];
    const char* cA = (const char*)g.A + (size_t)cur.pm * tstepA + PG8_AOFF(cur); const char* cB = (const char*)g.Bt + (size_t)cur.pn * tstepB;
    PG8_STAGE(PG8_SB(0, 0), cB, voffB); PG8_STAGE(PG8_SB(0, 1), cB + hstepB, voffB); PG8_STAGE(PG8_SA(0, 0), cA, voffA); PG8_STAGE(PG8_SA(0, 1), cA + hstepA, voffA);
    if (wr == 1) PG8_BAR;
    PG8_WAIT_V(2); PG8_BAR;
    PG8_STAGE(PG8_SB(1, 0), cB + kstep, voffB); PG8_STAGE(PG8_SA(1, 0), cA + kstep, voffA); PG8_STAGE(PG8_SB(1, 1), cB + hstepB + kstep, voffB);
    PG8_WAIT_V(6); PG8_BAR;
    for (;;) {
        const bool has_next = S.next(ui + 1, nxt);
        const char* nA = has_next ? (const char*)g.A + (size_t)nxt.pm * tstepA + PG8_AOFF(nxt) : cA; const char* nB = has_next ? (const char*)g.Bt + (size_t)nxt.pn * tstepB : cB;
#pragma unroll 1
        for (int t = 0; t < nt; t += 2) {
            const bool last = (t == nt - 2);
            const char* a1 = cA + (size_t)(t + 1) * kstep;
            const char* a2 = last ? nA : cA + (size_t)(t + 2) * kstep; const char* b2 = last ? nB : cB + (size_t)(t + 2) * kstep;
            const char* a3 = a2 + kstep; const char* b3 = b2 + kstep;
            PG8_LDB(B0, 0, 0); PG8_LDB(B1, 0, 1); PG8_SCHED; PG8_LDA(At, 0, 0); PG8_STAGE(PG8_SA(1, 1), a1 + hstepA, voffA);
            PG8_WAIT_V(8); PG8_WAIT_L(0); PG8_BAR; PG8_MMA(0, 0, At, B0); PG8_MMA(0, 1, At, B1); PG8_BAR; PG8_SCHED;
            PG8_LDA(At, 0, 1); PG8_STAGE(PG8_SB(0, 0), b2, voffB); PG8_STAGE(PG8_SB(0, 1), b2 + hstepB, voffB); PG8_STAGE(PG8_SA(0, 0), a2, voffA);
            PG8_WAIT_V(8); PG8_WAIT_L(0); PG8_BAR; PG8_MMA(1, 0, At, B0); PG8_MMA(1, 1, At, B1); PG8_BAR; PG8_SCHED;
            PG8_LDB(B0, 1, 0); PG8_LDB(B1, 1, 1); PG8_SCHED; PG8_LDA(At, 1, 0); PG8_STAGE(PG8_SA(0, 1), a2 + hstepA, voffA);
            PG8_WAIT_V(8); PG8_WAIT_L(0); PG8_BAR; PG8_MMA(0, 0, At, B0); PG8_MMA(0, 1, At, B1); PG8_BAR; PG8_SCHED;
            PG8_LDA(At, 1, 1); PG8_STAGE(PG8_SB(1, 0), b3, voffB); PG8_STAGE(PG8_SB(1, 1), b3 + hstepB, voffB); PG8_STAGE(PG8_SA(1, 0), a3, voffA);
            PG8_WAIT_V(8); PG8_WAIT_L(0); PG8_BAR; PG8_MMA(1, 0, At, B0); PG8_MMA(1, 1, At, B1); PG8_BAR; PG8_SCHED;
        }
        if (wr == 0) PG8_BAR;
        E(acc, cur, wr, wc, fr, fq);
        if (!has_next) break;
#pragma unroll
        for (int a = 0; a < 2; ++a)
#pragma unroll
            for (int b = 0; b < 2; ++b)
#pragma unroll
                for (int m = 0; m < 4; ++m)
#pragma unroll
                    for (int n = 0; n < 2; ++n) acc[a][b][m][n] = (f32x4){0.f, 0.f, 0.f, 0.f};
        cur = nxt; cA = nA; cB = nB; ++ui;
        if (wr == 1) PG8_BAR;
    }
    PG8_WAIT_V(0);
    PG8_BAR;
#undef PG8_SA
#undef PG8_SB
#undef PG8_STAGE
#undef PG8_LDA
#undef PG8_LDB
#undef PG8_MMA
#undef PG8_WAIT_V
#undef PG8_WAIT_L
#undef PG8_BAR
#undef PG8_SCHED
#undef PG8_AOFF
}
}

struct Args {
    const float* in[24];
    float* out; unsigned char* ws;
    int ph_lo, ph_hi;
};
enum { I_X = 0, I_C, I_CTX, I_CCTX, I_ADAW, I_ADAB, I_N1W, I_N2W, I_WIN, I_MQNW, I_MWUQ, I_MKVNW, I_MWUKV, I_SINK, I_GWD, I_GBD, I_GNW, I_QNW, I_KNW, I_WBR, I_WO, I_W1, I_W2, I_FNW };

struct Ctx {
    const Args* a; unsigned char* ws; int l, g;
};
__device__ __forceinline__ const float* xrow_src(const Args& a, int l, int g, int r) {
    if (r < LAT_ROWS) { const size_t gr = (size_t)(g * GB) * SEQ + r; return (l == 0 ? a.in[I_X] : a.out) + gr * DM; }
    const size_t cr = (size_t)(g * GB) * CTXL + (r - LAT_ROWS); return (l == 0 ? a.in[I_CTX] : (const float*)(a.ws + WS_XC1)) + cr * DM;
}
__device__ __forceinline__ float* xrow_dst(const Args& a, int g, int r) {
    if (r < LAT_ROWS) { const size_t gr = (size_t)(g * GB) * SEQ + r; return a.out + gr * DM; }
    const size_t cr = (size_t)(g * GB) * CTXL + (r - LAT_ROWS); return (float*)(a.ws + WS_XC1) + cr * DM;
}
__device__ __forceinline__ int row_bi(int g, int r) { return r < LAT_ROWS ? g * GB + (r >> 11) : 8; }
__device__ __forceinline__ void row_blk(int r, int& bl, int& kap) { if (r < LAT_ROWS) { bl = r >> 11; kap = CTXL + (r & 2047); } else { bl = (r - LAT_ROWS) >> 8; kap = (r - LAT_ROWS) & 255; } }

using pg8::Unit;
__device__ __forceinline__ u32x4 pack8(const f32x4 v0, const f32x4 v1) { u32x4 w; w.x = pk2(v0[0], v0[1]); w.y = pk2(v0[2], v0[3]); w.z = pk2(v1[0], v1[1]); w.w = pk2(v1[2], v1[3]); return w; }

template <int ACT> struct EpiStore {
    bf16* O; int ldc;
    __device__ __forceinline__ void operator()(const f32x4 (&acc)[2][2][4][2], const Unit& u, int wr, int wc, int fr, int fq) const {
        const int row0 = u.pm * 256 + wr * 64 + fr, col0 = u.pn * 256 + wc * 32 + 8 * fq;
#pragma unroll
        for (int ai = 0; ai < 2; ++ai)
#pragma unroll
            for (int m = 0; m < 4; ++m) { bf16* rowp = O + (size_t)(row0 + ai * 128 + m * 16) * ldc + col0;
#pragma unroll
                for (int bj = 0; bj < 2; ++bj) { f32x4 v0 = acc[ai][bj][m][0], v1 = acc[ai][bj][m][1];
                    if (ACT == 1) {
#pragma unroll
                        for (int j = 0; j < 4; ++j) { const float a = fmaxf(v0[j], 0.f), b = fmaxf(v1[j], 0.f); v0[j] = a * a; v1[j] = b * b; } }
                    *(u32x4*)(rowp + bj * 128) = pack8(v0, v1); } }
    }
};
__device__ __forceinline__ void store_vt(const f32x4 (&acc)[2][2][4][2], int bj, bf16* vt, int nheads, int dv, int colbase  , int pm, int wr, int fr, int fq) {
    int bl, kap0; row_blk(pm * 256, bl, kap0);
    const int c0 = colbase + 8 * fq, head = c0 / dv, e0 = c0 - head * dv;
    bf16* vp = vt + ((size_t)(bl * nheads + head) * dv + e0) * KEYS + kap0 + wr * 64 + fr;
#pragma unroll
    for (int ai = 0; ai < 2; ++ai)
#pragma unroll
        for (int m = 0; m < 4; ++m)
#pragma unroll
            for (int n = 0; n < 2; ++n)
#pragma unroll
                for (int j = 0; j < 4; ++j) vp[(size_t)(4 * n + j) * KEYS + ai * 128 + m * 16] = (bf16)f2bf(acc[ai][bj][m][n][j]);
}
struct EpiInProj {
    bf16* P; bf16 *vtb, *vtc, *vtd;
    __device__ __forceinline__ void operator()(const f32x4 (&acc)[2][2][4][2], const Unit& u, int wr, int wc, int fr, int fq) const {
        const int row0 = u.pm * 256 + wr * 64 + fr;
#pragma unroll
        for (int bj = 0; bj < 2; ++bj) {
            const int cg = u.pn * 256 + bj * 128 + wc * 32;
            if (cg >= PC_VB && cg < PC_QC) store_vt(acc, bj, vtb, 2, 64, cg - PC_VB, u.pm, wr, fr, fq);
            else if (cg >= PC_VC && cg < PC_RC) store_vt(acc, bj, vtc, 4, 128, cg - PC_VC, u.pm, wr, fr, fq);
            else if (cg >= PC_VD && cg < PC_GATE) store_vt(acc, bj, vtd, 2, 128, cg - PC_VD, u.pm, wr, fr, fq);
            else {
#pragma unroll
                for (int ai = 0; ai < 2; ++ai)
#pragma unroll
                    for (int m = 0; m < 4; ++m) *(u32x4*)(P + (size_t)(row0 + ai * 128 + m * 16) * PC + cg + 8 * fq) = pack8(acc[ai][bj][m][0], acc[ai][bj][m][1]);
            }
        }
    }
};
struct EpiMla {
    bf16 *QA, *KA, *vta;
    __device__ __forceinline__ void operator()(const f32x4 (&acc)[2][2][4][2], const Unit& u, int wr, int wc, int fr, int fq) const {
        const int row0 = u.pm * 256 + wr * 64 + fr;
        int bl, kap0; row_blk(u.pm * 256, bl, kap0);
#pragma unroll
        for (int bj = 0; bj < 2; ++bj) {
            const int cg = u.pn * 256 + bj * 128 + wc * 32;
            if (cg < 768) {
#pragma unroll
                for (int ai = 0; ai < 2; ++ai)
#pragma unroll
                    for (int m = 0; m < 4; ++m) *(u32x4*)(QA + (size_t)(row0 + ai * 128 + m * 16) * 768 + cg + 8 * fq) = pack8(acc[ai][bj][m][0], acc[ai][bj][m][1]);
            } else if (cg < 1280) {
                const int c = cg - 768 + 8 * fq, head = c >> 7, j0 = c & 127;
#pragma unroll
                for (int ai = 0; ai < 2; ++ai)
#pragma unroll
                    for (int m = 0; m < 4; ++m) { const int kap = kap0 + ai * 128 + wr * 64 + m * 16 + fr;
                        *(u32x4*)(KA + ((size_t)(bl * 4 + head) * KEYS + kap) * 192 + j0) = pack8(acc[ai][bj][m][0], acc[ai][bj][m][1]); }
            } else store_vt(acc, bj, vta, 4, 128, cg - 1280, u.pm, wr, fr, fq);
        }
    }
};
struct EpiMerge {
    const bf16* Z; bf16* MGo;
    __device__ __forceinline__ void operator()(const f32x4 (&acc)[2][2][4][2], const Unit& u, int wr, int wc, int fr, int fq) const {
        const int row0 = u.pm * 256 + wr * 64 + fr, d0 = u.pn * 64 + wc * 16 + fq * 4;
#pragma unroll
        for (int ai = 0; ai < 2; ++ai)
#pragma unroll
            for (int m = 0; m < 4; ++m) { const size_t row = (size_t)(row0 + ai * 128 + m * 16); float o[4] = {0.f, 0.f, 0.f, 0.f};
#pragma unroll
                for (int bj = 0; bj < 2; ++bj)
#pragma unroll
                    for (int n = 0; n < 2; ++n) { const int nb = 2 * bj + n; const u32x2 z = *(const u32x2*)(Z + row * 4096 + nb * 1024 + d0);
                        const f32x4 a = acc[ai][bj][m][n];
                        o[0] += sigmoidf_(a[0]) * bflo(z.x); o[1] += sigmoidf_(a[1]) * bfhi(z.x); o[2] += sigmoidf_(a[2]) * bflo(z.y); o[3] += sigmoidf_(a[3]) * bfhi(z.y); }
                u32x2 w; w.x = pk2(o[0], o[1]); w.y = pk2(o[2], o[3]); *(u32x2*)(MGo + row * 1024 + d0) = w; }
    }
};
struct EpiResid {
    const Args* a; int l, g, chunk; bool from_dst;
    __device__ __forceinline__ void operator()(const f32x4 (&acc)[2][2][4][2], const Unit& u, int wr, int wc, int fr, int fq) const {
        const int rt = u.pm * 256; const int bi = row_bi(g, rt);
        const float* src = from_dst ? (const float*)xrow_dst(*a, g, rt) : xrow_src(*a, l, g, rt); float* dst = xrow_dst(*a, g, rt);
        const float* mod = (const float*)(a->ws + WS_MOD) + ((size_t)(l * 9 + bi) * 6 + chunk) * 1024;
        const int rl0 = wr * 64 + fr;
#pragma unroll
        for (int bj = 0; bj < 2; ++bj) { const int c0 = u.pn * 256 + bj * 128 + wc * 32 + 8 * fq;
            const f32x4 g0 = *(const f32x4*)(mod + c0), g1 = *(const f32x4*)(mod + c0 + 4);
#pragma unroll
            for (int ai = 0; ai < 2; ++ai)
#pragma unroll
                for (int m = 0; m < 4; ++m) { const size_t off = (size_t)(rl0 + ai * 128 + m * 16) * DM + c0;
                    const f32x4 x0 = *(const f32x4*)(src + off), x1 = *(const f32x4*)(src + off + 4);
                    *(f32x4*)(dst + off) = x0 + g0 * acc[ai][bj][m][0]; *(f32x4*)(dst + off + 4) = x1 + g1 * acc[ai][bj][m][1]; } }
    }
};

__device__ __forceinline__ float wfetch(const Args& a, int kind, int l, int n, int k) {
    switch (kind) {
    case 0: {
        int src;
        if (n < PC_GATE) src = n; else if (n < PC) return 0.f;
        else { const int t = n - PC, tg = t >> 8, c = t & 255; const int nb = 2 * (c >> 7) + ((c >> 2) & 1), dd = 16 * ((c >> 5) & 3) + 4 * ((c >> 3) & 3) + (c & 3); src = PC_GATE + nb * 1024 + 64 * tg + dd; }
        return a.in[I_WIN][((size_t)l * 1024 + k) * IN_COLS + src]; }
    case 1: {
        if (n < 768) return k < 256 ? a.in[I_MWUQ][((size_t)l * 256 + k) * 768 + n] : 0.f;
        if (k < 256) return 0.f;
        const int m = n - 768; const int src = m < 512 ? (m >> 7) * 256 + (m & 127) : ((m - 512) >> 7) * 256 + 128 + ((m - 512) & 127);
        return a.in[I_MWUKV][((size_t)l * 128 + (k - 256)) * 1024 + src]; }
    case 2: { const int nb = n >> 10, d = n & 1023; return a.in[I_WBR][(((size_t)l * 4 + nb) * 512 + k) * 1024 + d]; }
    case 3: return a.in[I_WO][((size_t)l * 1024 + k) * 1024 + n];
    case 4: return a.in[I_W1][((size_t)l * 1024 + k) * 4096 + n];
    default: return a.in[I_W2][((size_t)l * 4096 + k) * 1024 + n];
    }
}
__device__ __forceinline__ void transpose_item(const Args& a, int kind, int l, int K, bf16* WT, int item, int nblk, LAS float* scr, int lane) {
    const int kb = item / nblk, nb = item % nblk, k0 = 64 * kb, n0 = 32 * nb;
#pragma unroll 8
    for (int i = 0; i < 32; ++i) { const int kk = 2 * i + (lane >> 5); scr[kk * 33 + (lane & 31)] = wfetch(a, kind, l, n0 + (lane & 31), k0 + kk); }
    asm volatile("s_waitcnt lgkmcnt(0)" ::: "memory");
    const int c = lane & 7;
#pragma unroll
    for (int j = 0; j < 4; ++j) { const int n = (lane >> 3) + 8 * j; const LAS float* s = scr + (8 * c) * 33 + n;
        u32x4 o; o.x = pk2(s[0 * 33], s[1 * 33]); o.y = pk2(s[2 * 33], s[3 * 33]); o.z = pk2(s[4 * 33], s[5 * 33]); o.w = pk2(s[6 * 33], s[7 * 33]);
        *(u32x4*)(WT + (size_t)(n0 + n) * K + k0 + 8 * c) = o; }
    asm volatile("s_waitcnt lgkmcnt(0)" ::: "memory");
}
__device__ __forceinline__ void prep_weights(const Args& a, int l, LAS unsigned char* lds) {
    const int tid = tidx(), lane = tid & 63, wave = tid >> 6;
    LAS float* scr = (LAS float*)(lds + wave * 8704);
    unsigned char* wt = a.ws + WS_WT;
    constexpr int I0 = 16 * (WIN_N / 32), I1 = 6 * (1792 / 32), I2 = 8 * (4096 / 32), I3 = 16 * (1024 / 32), I4 = 16 * (4096 / 32), I5 = 64 * (1024 / 32);
    const int gw = blockIdx.x * 8 + wave, NGW = gridDim.x * 8;
    for (int it = gw; it < I0 + I1 + I2 + I3 + I4 + I5; it += NGW) {
        int r = it;
        if (r < I0) { transpose_item(a, 0, l, 1024, (bf16*)(wt + WT_WIN), r, WIN_N / 32, scr, lane); continue; } r -= I0;
        if (r < I1) { transpose_item(a, 1, l, 384, (bf16*)(wt + WT_WMLA), r, 1792 / 32, scr, lane); continue; } r -= I1;
        if (r < I2) { transpose_item(a, 2, l, 512, (bf16*)(wt + WT_WB), r, 4096 / 32, scr, lane); continue; } r -= I2;
        if (r < I3) { transpose_item(a, 3, l, 1024, (bf16*)(wt + WT_WO), r, 1024 / 32, scr, lane); continue; } r -= I3;
        if (r < I4) { transpose_item(a, 4, l, 1024, (bf16*)(wt + WT_W1), r, 4096 / 32, scr, lane); continue; } r -= I4;
        transpose_item(a, 5, l, 4096, (bf16*)(wt + WT_W2), r, 1024 / 32, scr, lane);
    }
}
__device__ __forceinline__ void prep_mods(const Args& a, LAS unsigned char* lds) {
    const int tid = tidx(), lane = tid & 63, wave = tid >> 6;
    LAS float* sc = (LAS float*)(lds + 73728);
    LAS float* red = (LAS float*)(lds + 73728 + 36864);
    for (int i = tid; i < 9 * 1024; i += 512) { const int bi = i >> 10, k = i & 1023; const float v = bi < 8 ? a.in[I_C][bi * 1024 + k] : a.in[I_CCTX][k]; sc[i] = siluf_(v); }
    __syncthreads();
    for (int item = blockIdx.x; item < 2 * 96; item += gridDim.x) {
        const int l = item / 96, n = (item % 96) * 64 + lane;
        float acc[9];
#pragma unroll
        for (int b = 0; b < 9; ++b) acc[b] = 0.f;
        const float* w = a.in[I_ADAW] + ((size_t)l * 1024 + wave * 128) * 6144 + n;
#pragma unroll 8
        for (int k = 0; k < 128; ++k) { const float wv = w[(size_t)k * 6144];
#pragma unroll
            for (int b = 0; b < 9; ++b) acc[b] += sc[b * 1024 + wave * 128 + k] * wv; }
#pragma unroll
        for (int b = 0; b < 9; ++b) red[(wave * 9 + b) * 64 + lane] = acc[b];
        __syncthreads();
        if (wave == 0) {
            const float bias = a.in[I_ADAB][l * 6144 + n];
#pragma unroll
            for (int b = 0; b < 9; ++b) { float s = bias;
#pragma unroll
                for (int w8 = 0; w8 < 8; ++w8) s += red[(w8 * 9 + b) * 64 + lane];
                ((float*)(a.ws + WS_MOD))[((size_t)l * 9 + b) * 6144 + n] = s; }
        }
        __syncthreads();
    }
}

__device__ __forceinline__ void norm_mod_rows(const Args& a, int l, int g, int nrows, int which  ) {
    const int tid = tidx(), lane = tid & 63, gw = blockIdx.x * 8 + (tid >> 6), NGW = gridDim.x * 8;
    const float* nw = a.in[which ? I_N2W : I_N1W] + l * DM;
    bf16* H = (bf16*)(a.ws + WS_H);
    for (int r = gw; r < nrows; r += NGW) {
        const float* xr = which ? (const float*)xrow_dst(a, g, r) : xrow_src(a, l, g, r);
        const float* mod = (const float*)(a.ws + WS_MOD) + ((size_t)(l * 9 + row_bi(g, r)) * 6 + (which ? 3 : 0)) * 1024;
        f32x4 v[4]; float s = 0.f;
#pragma unroll
        for (int j = 0; j < 4; ++j) { v[j] = *(const f32x4*)(xr + 4 * lane + 256 * j); s += (v[j][0] * v[j][0] + v[j][1] * v[j][1]) + (v[j][2] * v[j][2] + v[j][3] * v[j][3]); }
        const float rstd = rsqrtf(wave_sum(s) * (1.f / DM) + EPS);
#pragma unroll
        for (int j = 0; j < 4; ++j) { const int c = 4 * lane + 256 * j; const f32x4 w = *(const f32x4*)(nw + c), sh = *(const f32x4*)(mod + c), sc = *(const f32x4*)(mod + 1024 + c);
            f32x4 y;
#pragma unroll
            for (int e = 0; e < 4; ++e) y[e] = v[j][e] * rstd * w[e] * (1.f + sc[e]) + sh[e];
            u32x2 o; o.x = pk2(y[0], y[1]); o.y = pk2(y[2], y[3]); *(u32x2*)(H + (size_t)r * DM + c) = o; }
    }
}
__device__ __forceinline__ void final_norm_rows(const Args& a) {
    const int tid = tidx(), lane = tid & 63, gw = blockIdx.x * 8 + (tid >> 6), NGW = gridDim.x * 8;
    const float* nw = a.in[I_FNW];
    for (int r = gw; r < NB * SEQ; r += NGW) {
        float* xr = a.out + (size_t)r * DM;
        f32x4 v[4]; float s = 0.f;
#pragma unroll
        for (int j = 0; j < 4; ++j) { v[j] = *(const f32x4*)(xr + 4 * lane + 256 * j); s += (v[j][0] * v[j][0] + v[j][1] * v[j][1]) + (v[j][2] * v[j][2] + v[j][3] * v[j][3]); }
        const float rstd = rsqrtf(wave_sum(s) * (1.f / DM) + EPS);
#pragma unroll
        for (int j = 0; j < 4; ++j) { const int c = 4 * lane + 256 * j; const f32x4 w = *(const f32x4*)(nw + c); *(f32x4*)(xr + c) = v[j] * rstd * w; }
    }
}
__device__ __forceinline__ void rope_pair(float& x1, float& x2, int pos, int i, int quarter) {
    const float inv = exp2f(-(float)i * (13.287712379549449f / (float)quarter));
    const float ang = (float)pos * inv; const float s = __sinf(ang), c = __cosf(ang);
    const float a = x1 * c - x2 * s, b = x1 * s + x2 * c; x1 = a; x2 = b;
}
__device__ __forceinline__ void post_rows(const Args& a, int l) {
    const int tid = tidx(), lane = tid & 63, gw = blockIdx.x * 8 + (tid >> 6), NGW = gridDim.x * 8;
    bf16* P = (bf16*)(a.ws + WS_P); bf16* CN = (bf16*)(a.ws + WS_CN); bf16* KA = (bf16*)(a.ws + WS_KA);
    const float* qnw = a.in[I_MQNW] + l * 256; const float* kvnw = a.in[I_MKVNW] + l * 128; const float* knw = a.in[I_KNW] + l * 128;
    for (int r = gw; r < MG_ROWS; r += NGW) {
        bf16* pr = P + (size_t)r * PC;
        const bool lat = r < LAT_ROWS; const int t = r & 2047, rowp = t >> 6, colp = t & 63;
        int bl, kap; row_blk(r, bl, kap);
        {
            const u32x2 w = *(const u32x2*)(pr + PC_CQ + 4 * lane); float x[4] = {bflo(w.x), bfhi(w.x), bflo(w.y), bfhi(w.y)};
            const float rstd = rsqrtf(wave_sum(x[0] * x[0] + x[1] * x[1] + x[2] * x[2] + x[3] * x[3]) * (1.f / 256.f) + EPS);
            const f32x4 nw = *(const f32x4*)(qnw + 4 * lane);
            u32x2 o; o.x = pk2(x[0] * rstd * nw[0], x[1] * rstd * nw[1]); o.y = pk2(x[2] * rstd * nw[2], x[3] * rstd * nw[3]);
            *(u32x2*)(CN + (size_t)r * 384 + 4 * lane) = o; }
        {
            const unsigned w = *(const unsigned*)(pr + PC_CKV + 2 * lane); const float x0 = bflo(w), x1 = bfhi(w);
            const float rstd = rsqrtf(wave_sum(x0 * x0 + x1 * x1) * (1.f / 128.f) + EPS);
            *(unsigned*)(CN + (size_t)r * 384 + 256 + 2 * lane) = pk2(x0 * rstd * kvnw[2 * lane], x1 * rstd * kvnw[2 * lane + 1]); }
        if (lane < 32) {
            const int part = lane >> 4, i = lane & 15, d1 = 32 * part + i, d2 = d1 + 16;
            float x1 = bf2f(pr[PC_KR + d1]), x2 = bf2f(pr[PC_KR + d2]);
            if (lat) rope_pair(x1, x2, part ? colp : rowp, i, 16);
            const bf16 o1 = (bf16)f2bf(x1), o2 = (bf16)f2bf(x2);
#pragma unroll
            for (int h = 0; h < 4; ++h) { bf16* kd = KA + ((size_t)(bl * 4 + h) * KEYS + kap) * 192 + 128; kd[d1] = o1; kd[d2] = o2; }
        }
        if (lat) {
            const int hh = lane >> 5, part = (lane >> 4) & 1, i = lane & 15, d1 = 64 * hh + 32 * part + i, d2 = d1 + 16;
            float x1 = bf2f(pr[PC_KB + d1]), x2 = bf2f(pr[PC_KB + d2]);
            rope_pair(x1, x2, part ? colp : rowp, i, 16);
            pr[PC_KB + d1] = (bf16)f2bf(x1); pr[PC_KB + d2] = (bf16)f2bf(x2);
        }
        {
            const int hh = lane >> 5, i = lane & 31; bf16* kd = pr + PC_KD + 128 * hh;
            float x0 = bf2f(kd[i]), x1 = bf2f(kd[32 + i]), x2 = bf2f(kd[64 + i]), x3 = bf2f(kd[96 + i]);
            float ss = x0 * x0 + x1 * x1 + x2 * x2 + x3 * x3;
#pragma unroll
            for (int o = 1; o < 32; o <<= 1) ss += __shfl_xor(ss, o);
            const float rstd = rsqrtf(ss * (1.f / 128.f) + EPS);
            x0 *= rstd * knw[i]; x1 *= rstd * knw[32 + i]; x2 *= rstd * knw[64 + i]; x3 *= rstd * knw[96 + i];
            if (lat) { rope_pair(x0, x1, rowp, i, 32); rope_pair(x2, x3, colp, i, 32); }
            kd[i] = (bf16)f2bf(x0); kd[32 + i] = (bf16)f2bf(x1); kd[64 + i] = (bf16)f2bf(x2); kd[96 + i] = (bf16)f2bf(x3);
        }
    }
}
__device__ __forceinline__ void comb_rows(const Args& a, int l, int nrows) {
    const int tid = tidx(), lane = tid & 63, gw = blockIdx.x * 8 + (tid >> 6), NGW = gridDim.x * 8;
    const bf16* P = (const bf16*)(a.ws + WS_P); bf16* Y = (bf16*)(a.ws + WS_Y); const bf16* OB = (const bf16*)(a.ws + WS_MG);
    const float* gnw = a.in[I_GNW] + l * 128;
    for (int r = gw; r < nrows; r += NGW) {
#pragma unroll
        for (int h = 0; h < 4; ++h) {
            const int e = 2 * lane;
            const unsigned wf = *(const unsigned*)(Y + (size_t)r * 2048 + 1024 + 128 * h + e), wb = *(const unsigned*)(OB + (size_t)r * 512 + 128 * h + e), wr_ = *(const unsigned*)(P + (size_t)r * PC + PC_RC + 128 * h + e);
            const float o0 = bflo(wf) + bflo(wb), o1 = bfhi(wf) + bfhi(wb);
            const float rstd = rsqrtf(wave_sum(o0 * o0 + o1 * o1) * (1.f / 128.f) + EPS);
            *(unsigned*)(Y + (size_t)r * 2048 + 1024 + 128 * h + e) = pk2(o0 * rstd * gnw[e] * siluf_(bflo(wr_)), o1 * rstd * gnw[e + 1] * siluf_(bfhi(wr_)));
        }
    }
}

struct AttnArgs {
    const bf16* Q; int qpitch;
    const bf16* Kc; const bf16* Kl; int kpitch;
    const bf16* Vt;
    bf16* O; int opitch;
    int qpos0, ntile, band_first;
    float sink_l2; const float* qnw;
};
template <int DK, int DV, int MODE>
__device__ __forceinline__ void attn_unit(LAS unsigned char* lds, const AttnArgs& A) {
    constexpr int KS = DK * 2 + 16, VS = 272, NS = DK / 16, NDT = DV / 32, NKC = DK / 32, NVC = DV / 32, KCH = DK / 8;
    constexpr int VT_OFF = 128 * KS;
    const int tid = tidx(), lane = tid & 63, wave = __builtin_amdgcn_readfirstlane(tid >> 6);
    const int qg = wave & 3, kp = wave >> 2, r = lane & 31, h = lane >> 5;
    const bool lat = A.qpos0 >= 0;
    bf16x8 qf[NS];
    {
        float qv[NS][8];
        const bf16* qrow = A.Q + (size_t)(32 * qg + r) * A.qpitch + 8 * h;
#pragma unroll
        for (int s = 0; s < NS; ++s) { const u32x4 w = *(const u32x4*)(qrow + 16 * s);
            qv[s][0] = bflo(w.x); qv[s][1] = bfhi(w.x); qv[s][2] = bflo(w.y); qv[s][3] = bfhi(w.y); qv[s][4] = bflo(w.z); qv[s][5] = bfhi(w.z); qv[s][6] = bflo(w.w); qv[s][7] = bfhi(w.w); }
        if (MODE == 2) {
            float ss = 0.f;
#pragma unroll
            for (int s = 0; s < NS; ++s)
#pragma unroll
                for (int j = 0; j < 8; ++j) ss += qv[s][j] * qv[s][j];
            ss += __shfl_xor(ss, 32);
            const float rstd = rsqrtf(ss * (1.f / 128.f) + EPS);
#pragma unroll
            for (int s = 0; s < NS; ++s)
#pragma unroll
                for (int j = 0; j < 8; ++j) qv[s][j] *= rstd * A.qnw[16 * s + 8 * h + j];
        }
        if (lat) {
            const int pos = A.qpos0 + 32 * qg + r, rowp = pos >> 6, colp = pos & 63;
#pragma unroll
            for (int j = 0; j < 8; ++j) {
                if (MODE == 0) { rope_pair(qv[8][j], qv[9][j], rowp, 8 * h + j, 16); rope_pair(qv[10][j], qv[11][j], colp, 8 * h + j, 16); }
                if (MODE == 1) { rope_pair(qv[0][j], qv[1][j], rowp, 8 * h + j, 16); rope_pair(qv[2][j], qv[3][j], colp, 8 * h + j, 16); }
                if (MODE == 2) { rope_pair(qv[0][j], qv[2][j], rowp, 8 * h + j, 32); rope_pair(qv[1][j], qv[3][j], rowp, 16 + 8 * h + j, 32);
                                 rope_pair(qv[4][j], qv[6][j], colp, 8 * h + j, 32); rope_pair(qv[5][j], qv[7][j], colp, 16 + 8 * h + j, 32); }
            }
        }
        const float c = (MODE == 0 ? 0.07216878364870322f : MODE == 1 ? 0.125f : 0.08838834764831845f) * 1.4426950408889634f;
#pragma unroll
        for (int s = 0; s < NS; ++s) { u32x4 w; w.x = pk2(qv[s][0] * c, qv[s][1] * c); w.y = pk2(qv[s][2] * c, qv[s][3] * c); w.z = pk2(qv[s][4] * c, qv[s][5] * c); w.w = pk2(qv[s][6] * c, qv[s][7] * c);
            qf[s] = __builtin_bit_cast(bf16x8, w); }
    }
    float m_run = -INFINITY, l_run = 0.f;
    f32x16 acc[NDT];
#pragma unroll
    for (int d = 0; d < NDT; ++d)
#pragma unroll
        for (int i = 0; i < 16; ++i) acc[d][i] = 0.f;
    u32x4 kreg[NKC], vreg[NVC];
#define ATT_K0(i) ((MODE == 1 && lat && (i) >= 2) ? CTXL + 128 * (A.band_first + (i) - 2) : 128 * (i))
#define ATT_LOAD(i) do { const int k0_ = ATT_K0(i); const bf16* kb_ = ((k0_ < CTXL) ? A.Kc + (size_t)k0_ * A.kpitch : A.Kl + (size_t)(k0_ - CTXL) * A.kpitch) + (size_t)(tid >> 3) * A.kpitch + 8 * (tid & 7); \
        _Pragma("unroll") for (int p_ = 0; p_ < 2; ++p_) _Pragma("unroll") for (int c_ = 0; c_ < KCH / 8; ++c_) kreg[p_ * (KCH / 8) + c_] = *(const u32x4*)(kb_ + (size_t)(64 * p_) * A.kpitch + 64 * c_); \
        const bf16* vb_ = A.Vt + (size_t)(tid >> 4) * KEYS + k0_ + 8 * (tid & 15); \
        _Pragma("unroll") for (int p_ = 0; p_ < NVC; ++p_) vreg[p_] = *(const u32x4*)(vb_ + (size_t)(32 * p_) * KEYS); } while (0)
    ATT_LOAD(0);
    for (int it = 0; it < A.ntile; ++it) {
        __syncthreads();
        {
            LAS unsigned char* kw_ = lds + (tid >> 3) * KS + (tid & 7) * 16;
#pragma unroll
            for (int p_ = 0; p_ < 2; ++p_)
#pragma unroll
                for (int c_ = 0; c_ < KCH / 8; ++c_) *(LAS u32x4*)(kw_ + 64 * p_ * KS + 128 * c_) = kreg[p_ * (KCH / 8) + c_];
            LAS unsigned char* vw_ = lds + VT_OFF + (tid >> 4) * VS + (tid & 15) * 16;
#pragma unroll
            for (int p_ = 0; p_ < NVC; ++p_) *(LAS u32x4*)(vw_ + 32 * p_ * VS) = vreg[p_];
        }
        __syncthreads();
        if (it + 1 < A.ntile) ATT_LOAD(it + 1);
        f32x16 st0, st1;
#pragma unroll
        for (int i = 0; i < 16; ++i) { st0[i] = 0.f; st1[i] = 0.f; }
        const LAS unsigned char* kb = lds + (64 * kp + r) * KS + 16 * h;
#pragma unroll
        for (int s = 0; s < NS; ++s) {
            const bf16x8 k0f = *(const LAS bf16x8*)(kb + 32 * s), k1f = *(const LAS bf16x8*)(kb + 32 * KS + 32 * s);
            st0 = __builtin_amdgcn_mfma_f32_32x32x16_bf16(k0f, qf[s], st0, 0, 0, 0);
            st1 = __builtin_amdgcn_mfma_f32_32x32x16_bf16(k1f, qf[s], st1, 0, 0, 0);
        }
        if (MODE == 1 && lat && it >= 2) {
            const int qpos = A.qpos0 + 32 * qg + r, kb0 = ATT_K0(it) - CTXL + 64 * kp + 4 * h;
#pragma unroll
            for (int i = 0; i < 16; ++i) { const int kpos = kb0 + (i & 3) + 8 * (i >> 2); const int d0 = qpos - kpos, d1 = d0 - 32;
                if (d0 > 128 || d0 < -128) st0[i] = -INFINITY;
                if (d1 > 128 || d1 < -128) st1[i] = -INFINITY; }
        }
        float mt = fmaxf(st0[0], st1[0]);
#pragma unroll
        for (int i = 1; i < 16; ++i) mt = fmaxf(mt, fmaxf(st0[i], st1[i]));
        mt = fmaxf(mt, __shfl_xor(mt, 32));
        const float mnew = fmaxf(m_run, mt);
        const float alpha = __builtin_amdgcn_exp2f(m_run - mnew);
        m_run = mnew;
        float ps = 0.f;
#pragma unroll
        for (int i = 0; i < 16; ++i) { st0[i] = __builtin_amdgcn_exp2f(st0[i] - mnew); st1[i] = __builtin_amdgcn_exp2f(st1[i] - mnew); ps += st0[i] + st1[i]; }
        l_run = l_run * alpha + ps;
#pragma unroll
        for (int d = 0; d < NDT; ++d)
#pragma unroll
            for (int i = 0; i < 16; ++i) acc[d][i] *= alpha;
        bf16x8 pf[2][2];
#pragma unroll
        for (int u = 0; u < 2; ++u) {
            u32x4 w0, w1;
            w0.x = pk2(st0[8 * u + 0], st0[8 * u + 1]); w0.y = pk2(st0[8 * u + 2], st0[8 * u + 3]); w0.z = pk2(st0[8 * u + 4], st0[8 * u + 5]); w0.w = pk2(st0[8 * u + 6], st0[8 * u + 7]);
            w1.x = pk2(st1[8 * u + 0], st1[8 * u + 1]); w1.y = pk2(st1[8 * u + 2], st1[8 * u + 3]); w1.z = pk2(st1[8 * u + 4], st1[8 * u + 5]); w1.w = pk2(st1[8 * u + 6], st1[8 * u + 7]);
            pf[0][u] = __builtin_bit_cast(bf16x8, w0); pf[1][u] = __builtin_bit_cast(bf16x8, w1);
        }
        const LAS unsigned char* vb = lds + VT_OFF + r * VS + (64 * kp + 4 * h) * 2;
#pragma unroll
        for (int kt = 0; kt < 2; ++kt)
#pragma unroll
            for (int u = 0; u < 2; ++u)
#pragma unroll
                for (int d = 0; d < NDT; ++d) {
                    const LAS unsigned char* p = vb + d * 32 * VS + (32 * kt + 16 * u) * 2;
                    const u32x2 lo = *(const LAS u32x2*)p, hi = *(const LAS u32x2*)(p + 16);
                    u32x4 w; w.x = lo.x; w.y = lo.y; w.z = hi.x; w.w = hi.y;
                    acc[d] = __builtin_amdgcn_mfma_f32_32x32x16_bf16(__builtin_bit_cast(bf16x8, w), pf[kt][u], acc[d], 0, 0, 0);
                }
    }
#undef ATT_LOAD
#undef ATT_K0
    l_run += __shfl_xor(l_run, 32);
    __syncthreads();
    LAS float* mb = (LAS float*)lds + (size_t)qg * (NDT * 16 + 2) * 64 + lane;
    if (kp == 1) {
        mb[0] = m_run; mb[64] = l_run;
#pragma unroll
        for (int d = 0; d < NDT; ++d)
#pragma unroll
            for (int i = 0; i < 16; ++i) mb[(2 + d * 16 + i) * 64] = acc[d][i];
    }
    __syncthreads();
    if (kp == 0) {
        const float m1 = mb[0], l1 = mb[64];
        const float M = fmaxf(m_run, m1), a0 = __builtin_amdgcn_exp2f(m_run - M), a1 = __builtin_amdgcn_exp2f(m1 - M);
        float L = l_run * a0 + l1 * a1;
        if (MODE == 1) L += __builtin_amdgcn_exp2f(A.sink_l2 - M);
        const float inv = 1.f / L;
        bf16* orow = A.O + (size_t)(32 * qg + r) * A.opitch + 4 * h;
#pragma unroll
        for (int d = 0; d < NDT; ++d)
#pragma unroll
            for (int i4 = 0; i4 < 4; ++i4) {
                float o[4];
#pragma unroll
                for (int j = 0; j < 4; ++j) o[j] = (acc[d][4 * i4 + j] * a0 + mb[(2 + d * 16 + 4 * i4 + j) * 64] * a1) * inv;
                u32x2 w; w.x = pk2(o[0], o[1]); w.y = pk2(o[2], o[3]);
                *(u32x2*)(orow + 32 * d + 8 * i4) = w;
            }
    }
    __syncthreads();
}

struct GlaArgs { const bf16* P; const bf16* VtC; bf16* Y; bf16* OB; const float* wd; const float* bd; int bl, h, dir, need_ctx; };
__device__ __forceinline__ float logsigmoidf_(float x) { return fminf(x, 0.f) - log1pf(__expf(-fabsf(x))); }
__device__ __forceinline__ void gla_unit(LAS unsigned char* lds, const GlaArgs& G) {
    constexpr int RS = 144;
    constexpr int O_RQ = 0, O_RK = 9216, O_VT = 18432, O_LR = 36864, O_WD = 38912, O_BD = 43008, O_GT = 43264, O_DL = 45312, O_QT = 45568, O_KT = 54784, O_KH = 64000, O_AT = 73216, O_ST = 82432, O_END = 100864;
    const int tid = tidx(), lane = tid & 63, wave = __builtin_amdgcn_readfirstlane(tid >> 6), r = lane & 31, hh = lane >> 5;
    const int bl = G.bl, h = G.h, dir = G.dir;
    __syncthreads();
    for (int i = tid; i < 1024; i += 512) ((LAS float*)(lds + O_WD))[i] = G.wd[(size_t)(i >> 6) * 256 + 64 * h + (i & 63)];
    if (tid < 64) ((LAS float*)(lds + O_BD))[tid] = G.bd[64 * h + tid];
    for (int i = tid; i < 128 * RS / 4; i += 512) ((LAS unsigned*)(lds + O_ST))[i] = 0u;
    f32x16 sacc;
#pragma unroll
    for (int i = 0; i < 16; ++i) sacc[i] = 0.f;
    u32x4 rq, rk, rv0, rv1, rl;
#define GLA_ROWS(c, row0, kap0, isctx) do { const int cc_ = (c); if (cc_ < 4) { const int ch_ = dir ? 3 - cc_ : cc_; row0 = LAT_ROWS + bl * CTXL + 64 * ch_; kap0 = 64 * ch_; isctx = 1; } \
        else { const int ch_ = dir ? 35 - cc_ : cc_ - 4; row0 = bl * SEQ + 64 * ch_; kap0 = CTXL + 64 * ch_; isctx = 0; } } while (0)
#define GLA_LOAD(c) do { int row0_, kap0_, ic_; GLA_ROWS(c, row0_, kap0_, ic_); (void)ic_; const bf16* pr_ = G.P + (size_t)(row0_ + (tid >> 3)) * PC + 8 * (tid & 7); \
        rq = *(const u32x4*)(pr_ + PC_QC + 64 * h); rk = *(const u32x4*)(pr_ + PC_KC + 64 * h); \
        const bf16* vp_ = G.VtC + ((size_t)(bl * 4 + h) * 128 + (tid >> 3)) * KEYS + kap0_ + 8 * (tid & 7); rv0 = *(const u32x4*)vp_; rv1 = *(const u32x4*)(vp_ + (size_t)64 * KEYS); \
        if (tid < 128) rl = *(const u32x4*)(G.P + (size_t)(row0_ + (tid >> 1)) * PC + PC_LRF + 16 * dir + 8 * (tid & 1)); } while (0)
    GLA_LOAD(0);
    for (int c = 0; c < 36; ++c) {
        int row0, kap0, isctx; GLA_ROWS(c, row0, kap0, isctx);
        __syncthreads();
        *(LAS u32x4*)(lds + O_RQ + (tid >> 3) * RS + (tid & 7) * 16) = rq; *(LAS u32x4*)(lds + O_RK + (tid >> 3) * RS + (tid & 7) * 16) = rk;
        *(LAS u32x4*)(lds + O_VT + (tid >> 3) * RS + (tid & 7) * 16) = rv0; *(LAS u32x4*)(lds + O_VT + (64 + (tid >> 3)) * RS + (tid & 7) * 16) = rv1;
        if (tid < 128) *(LAS u32x4*)(lds + O_LR + (tid >> 1) * 32 + (tid & 1) * 16) = rl;
        __syncthreads();
        if (c + 1 < 36) GLA_LOAD(c + 1);
        const int d = lane;
        float la[8];
        {
            float wdv[16];
#pragma unroll
            for (int q = 0; q < 16; ++q) wdv[q] = ((const LAS float*)(lds + O_WD))[q * 64 + d];
            const float bdv = ((const LAS float*)(lds + O_BD))[d];
#pragma unroll
            for (int i = 0; i < 8; ++i) { const LAS unsigned* lr = (const LAS unsigned*)(lds + O_LR + (8 * wave + i) * 32); float x = bdv;
#pragma unroll
                for (int q = 0; q < 8; ++q) { const unsigned w = lr[q]; x += bflo(w) * wdv[2 * q] + bfhi(w) * wdv[2 * q + 1]; }
                la[i] = logsigmoidf_(x) * (1.f / 16.f); }
        }
        float cum[8];
        if (dir == 0) { float s = 0.f;
#pragma unroll
            for (int i = 0; i < 8; ++i) { s += la[i]; cum[i] = s; }
            ((LAS float*)(lds + O_GT))[wave * 64 + d] = s; }
        else { float s = 0.f;
#pragma unroll
            for (int i = 7; i >= 0; --i) { s += la[i]; cum[i] = s; }
            ((LAS float*)(lds + O_GT))[wave * 64 + d] = s; }
        __syncthreads();
        float pre = 0.f, tot = 0.f;
#pragma unroll
        for (int w8 = 0; w8 < 8; ++w8) { const float gt = ((const LAS float*)(lds + O_GT))[w8 * 64 + d]; tot += gt; if (dir == 0 ? (w8 < wave) : (w8 > wave)) pre += gt; }
        if (wave == 0) ((LAS float*)(lds + O_DL))[d] = __expf(tot);
        {
            unsigned kh[4];
#pragma unroll
            for (int i = 0; i < 8; ++i) { const int s = 8 * wave + i; const float cm = cum[i] + pre;
                const float qv = bf2f(*(const LAS bf16*)(lds + O_RQ + s * RS + 2 * d)), kv = bf2f(*(const LAS bf16*)(lds + O_RK + s * RS + 2 * d));
                *(LAS bf16*)(lds + O_QT + s * RS + 2 * d) = (bf16)f2bf(qv * 0.125f * __expf(cm));
                *(LAS bf16*)(lds + O_KT + s * RS + 2 * d) = (bf16)f2bf(kv * __expf(-cm));
                const unsigned khv = f2bf(kv * __expf(tot - cm));
                if (i & 1) kh[i >> 1] |= khv << 16; else kh[i >> 1] = khv; }
            u32x4 w; w.x = kh[0]; w.y = kh[1]; w.z = kh[2]; w.w = kh[3];
            *(LAS u32x4*)(lds + O_KH + d * RS + 16 * wave) = w;
        }
        __syncthreads();
        if (wave < 4) {
            const int ss = wave & 1, tt = wave >> 1;
            f32x16 sc;
#pragma unroll
            for (int i = 0; i < 16; ++i) sc[i] = 0.f;
#pragma unroll
            for (int kk = 0; kk < 4; ++kk) { const bf16x8 af = *(const LAS bf16x8*)(lds + O_KT + (32 * ss + r) * RS + (16 * kk + 8 * hh) * 2), bfr = *(const LAS bf16x8*)(lds + O_QT + (32 * tt + r) * RS + (16 * kk + 8 * hh) * 2);
                sc = __builtin_amdgcn_mfma_f32_32x32x16_bf16(af, bfr, sc, 0, 0, 0); }
            const int t = 32 * tt + r;
#pragma unroll
            for (int i4 = 0; i4 < 4; ++i4) { float v[4];
#pragma unroll
                for (int j = 0; j < 4; ++j) { const int s = 32 * ss + 8 * i4 + 4 * hh + j; const bool keep = dir == 0 ? (s <= t) : (s >= t); v[j] = keep ? sc[4 * i4 + j] : 0.f; }
                u32x2 w; w.x = pk2(v[0], v[1]); w.y = pk2(v[2], v[3]); *(LAS u32x2*)(lds + O_AT + t * RS + (32 * ss + 8 * i4 + 4 * hh) * 2) = w; }
        }
        __syncthreads();
        const int et = wave >> 1;
        {
            const int tt = wave & 1;
            f32x16 oc;
#pragma unroll
            for (int i = 0; i < 16; ++i) oc[i] = 0.f;
#pragma unroll
            for (int kk = 0; kk < 4; ++kk) { const bf16x8 af = *(const LAS bf16x8*)(lds + O_ST + (32 * et + r) * RS + (16 * kk + 8 * hh) * 2), bfr = *(const LAS bf16x8*)(lds + O_QT + (32 * tt + r) * RS + (16 * kk + 8 * hh) * 2);
                oc = __builtin_amdgcn_mfma_f32_32x32x16_bf16(af, bfr, oc, 0, 0, 0); }
#pragma unroll
            for (int kk = 0; kk < 4; ++kk) { const bf16x8 af = *(const LAS bf16x8*)(lds + O_VT + (32 * et + r) * RS + (16 * kk + 8 * hh) * 2), bfr = *(const LAS bf16x8*)(lds + O_AT + (32 * tt + r) * RS + (16 * kk + 8 * hh) * 2);
                oc = __builtin_amdgcn_mfma_f32_32x32x16_bf16(af, bfr, oc, 0, 0, 0); }
            if (!isctx || G.need_ctx) {
                const int row = row0 + 32 * tt + r;
                bf16* op = dir ? G.OB + (size_t)row * 512 + 128 * h : G.Y + (size_t)row * 2048 + 1024 + 128 * h;
#pragma unroll
                for (int i4 = 0; i4 < 4; ++i4) { u32x2 w; w.x = pk2(oc[4 * i4], oc[4 * i4 + 1]); w.y = pk2(oc[4 * i4 + 2], oc[4 * i4 + 3]); *(u32x2*)(op + 32 * et + 8 * i4 + 4 * hh) = w; }
            }
        }
        {
            const int dt = wave & 1;
            const float dl = ((const LAS float*)(lds + O_DL))[32 * dt + r];
#pragma unroll
            for (int i = 0; i < 16; ++i) sacc[i] *= dl;
#pragma unroll
            for (int kk = 0; kk < 4; ++kk) { const bf16x8 af = *(const LAS bf16x8*)(lds + O_VT + (32 * et + r) * RS + (16 * kk + 8 * hh) * 2), bfr = *(const LAS bf16x8*)(lds + O_KH + (32 * dt + r) * RS + (16 * kk + 8 * hh) * 2);
                sacc = __builtin_amdgcn_mfma_f32_32x32x16_bf16(af, bfr, sacc, 0, 0, 0); }
            __syncthreads();
#pragma unroll
            for (int i = 0; i < 16; ++i) { const int e = 32 * et + (i & 3) + 8 * (i >> 2) + 4 * hh; *(LAS bf16*)(lds + O_ST + e * RS + (32 * dt + r) * 2) = (bf16)f2bf(sacc[i]); }
        }
    }
#undef GLA_LOAD
#undef GLA_ROWS
    __syncthreads();
}

__device__ __forceinline__ void attn_phase(const Args& a, int l, int g, LAS unsigned char* lds) {
    unsigned char* ws = a.ws;
    const bf16* P = (const bf16*)(ws + WS_P); const bf16* QA = (const bf16*)(ws + WS_QA); const bf16* KA = (const bf16*)(ws + WS_KA);
    bf16* Y = (bf16*)(ws + WS_Y);
    const int need_ctx = (l == 0);
    const int N_GLA = 32, N_A = 256, N_D = 256, N_B = 512, N_AC = need_ctx ? 32 : 0, N_DC = N_AC, N_BC = need_ctx ? 64 : 0;
    const int total = N_GLA + N_A + N_D + N_B + N_AC + N_DC + N_BC;
    unsigned* ctr = (unsigned*)(ws + WS_CTL) + (l * 2 + g) * 64;
    volatile LAS int* slot = (volatile LAS int*)(lds + LDS_BYTES - 16);
    for (;;) {
        __syncthreads();
        if (threadIdx.x == 0) *slot = (int)__hip_atomic_fetch_add(ctr, 1u, __ATOMIC_RELAXED, __HIP_MEMORY_SCOPE_AGENT);
        __syncthreads();
        int idx = *slot;
        idx = __builtin_amdgcn_readfirstlane(idx);
        if (idx >= total) break;
        if (idx < N_GLA) {
            GlaArgs G; G.P = P; G.VtC = (const bf16*)(ws + WS_VTC); G.Y = Y; G.OB = (bf16*)(ws + WS_MG);
            G.bl = idx >> 3; G.h = (idx >> 1) & 3; G.dir = idx & 1; G.need_ctx = need_ctx;
            G.wd = a.in[I_GWD] + ((size_t)l * 2 + G.dir) * 16 * 256; G.bd = a.in[I_GBD] + ((size_t)l * 2 + G.dir) * 256;
            gla_unit(lds, G); continue; }
        idx -= N_GLA;
        AttnArgs A; A.sink_l2 = 0.f; A.qnw = nullptr; A.band_first = 0;
        if (idx < N_A || (idx >= N_A + N_D + N_B && idx < N_A + N_D + N_B + N_AC)) {
            int bl, h, row, ctxq;
            if (idx < N_A) { bl = idx >> 6; h = (idx >> 4) & 3; const int qb = idx & 15; row = bl * SEQ + 128 * qb; A.qpos0 = 128 * qb; A.ntile = 18; ctxq = 0; }
            else { const int j = idx - (N_A + N_D + N_B); bl = j >> 3; h = (j >> 1) & 3; const int qb = j & 1; row = LAT_ROWS + bl * CTXL + 128 * qb; A.qpos0 = -1; A.ntile = 2; ctxq = 1; }
            (void)ctxq;
            A.Q = QA + (size_t)row * 768 + 192 * h; A.qpitch = 768;
            A.Kc = KA + (size_t)(bl * 4 + h) * KEYS * 192; A.Kl = A.Kc + (size_t)CTXL * 192; A.kpitch = 192;
            A.Vt = (const bf16*)(ws + WS_VTA) + (size_t)(bl * 4 + h) * 128 * KEYS;
            A.O = Y + (size_t)row * 2048 + 128 * h; A.opitch = 2048;
            attn_unit<192, 128, 0>(lds, A); continue; }
        if ((idx >= N_A && idx < N_A + N_D) || (idx >= N_A + N_D + N_B + N_AC && idx < N_A + N_D + N_B + N_AC + N_DC)) {
            int bl, h, row;
            if (idx < N_A + N_D) { const int j = idx - N_A; bl = j >> 6; h = (j >> 4) & 3; const int qb = j & 15; row = bl * SEQ + 128 * qb; A.qpos0 = 128 * qb; A.ntile = 18; }
            else { const int j = idx - (N_A + N_D + N_B + N_AC); bl = j >> 3; h = (j >> 1) & 3; const int qb = j & 1; row = LAT_ROWS + bl * CTXL + 128 * qb; A.qpos0 = -1; A.ntile = 2; }
            const int kvh = h >> 1;
            A.Q = P + (size_t)row * PC + PC_QD + 128 * h; A.qpitch = PC;
            A.Kc = P + (size_t)(LAT_ROWS + bl * CTXL) * PC + PC_KD + 128 * kvh; A.Kl = P + (size_t)(bl * SEQ) * PC + PC_KD + 128 * kvh; A.kpitch = PC;
            A.Vt = (const bf16*)(ws + WS_VTD) + (size_t)(bl * 2 + kvh) * 128 * KEYS;
            A.O = Y + (size_t)row * 2048 + 1536 + 128 * h; A.opitch = 2048; A.qnw = a.in[I_QNW] + l * 128;
            attn_unit<128, 128, 2>(lds, A); continue; }
        {
            int bl, h, row;
            if (idx < N_A + N_D + N_B) { const int j = idx - (N_A + N_D); bl = j >> 7; h = (j >> 4) & 7; const int qb = j & 15; row = bl * SEQ + 128 * qb; A.qpos0 = 128 * qb;
                const int first = qb >= 1 ? qb - 1 : 0, last = qb + 1 < 16 ? qb + 1 : 15; A.band_first = first; A.ntile = 2 + (last - first + 1); }
            else { const int j = idx - (N_A + N_D + N_B + N_AC + N_DC); bl = j >> 4; h = (j >> 1) & 7; const int qb = j & 1; row = LAT_ROWS + bl * CTXL + 128 * qb; A.qpos0 = -1; A.ntile = 2; }
            const int kvh = h >> 2;
            A.Q = P + (size_t)row * PC + PC_QB + 64 * h; A.qpitch = PC;
            A.Kc = P + (size_t)(LAT_ROWS + bl * CTXL) * PC + PC_KB + 64 * kvh; A.Kl = P + (size_t)(bl * SEQ) * PC + PC_KB + 64 * kvh; A.kpitch = PC;
            A.Vt = (const bf16*)(ws + WS_VTB) + (size_t)(bl * 2 + kvh) * 64 * KEYS;
            A.O = Y + (size_t)row * 2048 + 512 + 64 * h; A.opitch = 2048; A.sink_l2 = a.in[I_SINK][l * 8 + h] * 1.4426950408889634f;
            attn_unit<64, 64, 1>(lds, A); }
    }
}

constexpr int N_PHASES = 50;
template <bool COOP>
__global__ void __launch_bounds__(512, 2) mk_fwd(Args args) {
    extern __shared__ __attribute__((aligned(16))) unsigned char lds_raw[];
    LAS unsigned char* lds = (LAS unsigned char*)lds_raw;
    unsigned char* ws = args.ws; unsigned char* wt = ws + WS_WT;
    const int G = gridDim.x, bx = blockIdx.x;
    for (int p = args.ph_lo; p < args.ph_hi; ++p) {
        if (COOP) { if (p > args.ph_lo) cg::this_grid().sync(); }
        if (p == 0) { prep_weights(args, 0, lds); prep_mods(args, lds); continue; }
        if (p == N_PHASES - 1) { final_norm_rows(args); continue; }
        const int q = p - 1, lg = q / 12, k = q - lg * 12, l = lg >> 1, g = lg & 1;
        const int nM = (l == 1) ? 32 : 36;
        pg8::StaticOrder S;
        switch (k) {
        case 0: if (l == 1 && g == 0) prep_weights(args, 1, lds); norm_mod_rows(args, l, g, MG_ROWS, 0); break;
        case 1: { pg8::Gemm gm{(const bf16*)(ws + WS_H), (const bf16*)(wt + WT_WIN), 1024, 1024, 1024, 0, 0}; S.init(36, 15, G, bx);
            EpiInProj E{(bf16*)(ws + WS_P), (bf16*)(ws + WS_VTB), (bf16*)(ws + WS_VTC), (bf16*)(ws + WS_VTD)}; pg8::gemm_phase(lds, gm, S, E); break; }
        case 2: post_rows(args, l); break;
        case 3: { pg8::Gemm gm{(const bf16*)(ws + WS_CN), (const bf16*)(wt + WT_WMLA), 384, 384, 384, 0, 0}; S.init(36, 7, G, bx);
            EpiMla E{(bf16*)(ws + WS_QA), (bf16*)(ws + WS_KA), (bf16*)(ws + WS_VTA)}; pg8::gemm_phase(lds, gm, S, E); break; }
        case 4: attn_phase(args, l, g, lds); break;
        case 5: comb_rows(args, l, nM * 256); break;
        case 6: { pg8::Gemm gm{(const bf16*)(ws + WS_Y), (const bf16*)(wt + WT_WB), 2048, 512, 512, 4, 512}; S.init(nM, 16, G, bx);
            EpiStore<0> E{(bf16*)(ws + WS_Z), 4096}; pg8::gemm_phase(lds, gm, S, E); break; }
        case 7: { pg8::Gemm gm{(const bf16*)(ws + WS_H), (const bf16*)(wt + WT_WIN) + (size_t)PC * 1024, 1024, 1024, 1024, 0, 0}; S.init(nM, 16, G, bx);
            EpiMerge E{(const bf16*)(ws + WS_Z), (bf16*)(ws + WS_MG)}; pg8::gemm_phase(lds, gm, S, E); break; }
        case 8: { pg8::Gemm gm{(const bf16*)(ws + WS_MG), (const bf16*)(wt + WT_WO), 1024, 1024, 1024, 0, 0}; S.init(nM, 4, G, bx);
            EpiResid E{&args, l, g, 2, false}; pg8::gemm_phase(lds, gm, S, E); break; }
        case 9: norm_mod_rows(args, l, g, nM * 256, 1); break;
        case 10: { pg8::Gemm gm{(const bf16*)(ws + WS_H), (const bf16*)(wt + WT_W1), 1024, 1024, 1024, 0, 0}; S.init(nM, 16, G, bx);
            EpiStore<1> E{(bf16*)(ws + WS_Z), 4096}; pg8::gemm_phase(lds, gm, S, E); break; }
        default: { pg8::Gemm gm{(const bf16*)(ws + WS_Z), (const bf16*)(wt + WT_W2), 4096, 4096, 4096, 0, 0}; S.init(nM, 4, G, bx);
            EpiResid E{&args, l, g, 5, true}; pg8::gemm_phase(lds, gm, S, E); break; }
        }
    }
}

#ifndef MK_PER_PHASE
#define MK_PER_PHASE 1
#endif
extern "C" void kernel_launch(void* const* d_in, const int* in_sizes, int n_in, void* d_out, int out_size, void* d_ws, size_t ws_size, hipStream_t stream) {
    static int grid = 0;
    if (grid == 0) {
        if (n_in != 24 || out_size != NB * SEQ * DM || ws_size < WS_END) { fprintf(stderr, "kernel_launch: unexpected shapes (n_in %d out %d ws %zu)\n", n_in, out_size, ws_size); grid = -1; return; }
        int dev = 0, cus = 0, per_cu = 0;
        hipGetDevice(&dev); hipDeviceGetAttribute(&cus, hipDeviceAttributeMultiprocessorCount, dev);
        hipFuncSetAttribute((const void*)mk_fwd<true>, hipFuncAttributeMaxDynamicSharedMemorySize, LDS_BYTES);
        hipFuncSetAttribute((const void*)mk_fwd<false>, hipFuncAttributeMaxDynamicSharedMemorySize, LDS_BYTES);
        hipOccupancyMaxActiveBlocksPerMultiprocessor(&per_cu, (const void*)mk_fwd<true>, 512, LDS_BYTES);
        if (per_cu < 1) { fprintf(stderr, "kernel_launch: occupancy query says %d blocks per CU\n", per_cu); per_cu = 1; }
        (void)hipGetLastError();
        grid = cus;
    }
    if (grid < 0) return;
    hipMemsetAsync((char*)d_ws + WS_CTL, 0, 4096, stream);
    Args a{};
    for (int i = 0; i < 24; ++i) a.in[i] = (const float*)d_in[i];
    a.out = (float*)d_out; a.ws = (unsigned char*)d_ws;
#if MK_PER_PHASE
    for (int p = 0; p < N_PHASES; ++p) { a.ph_lo = p; a.ph_hi = p + 1; hipLaunchKernelGGL(mk_fwd<false>, dim3(grid), dim3(512), LDS_BYTES, stream, a); }
#else
    a.ph_lo = 0; a.ph_hi = N_PHASES;
    void* kargs[] = {&a};
    hipError_t e = hipLaunchCooperativeKernel((const void*)mk_fwd<true>, dim3(grid), dim3(512), kargs, LDS_BYTES, stream);
    if (e != hipSuccess) fprintf(stderr, "cooperative launch failed: %s (grid %d)\n", hipGetErrorString(e), grid);
#endif
}
```

```cpp
#include <hip/hip_runtime.h>
#include <hip/hip_cooperative_groups.h>
#include <cstdio>
#include <cstdint>
namespace cg = cooperative_groups;

#define LAS __attribute__((address_space(3)))
typedef unsigned short bf16;
typedef short bf16x8 __attribute__((ext_vector_type(8)));
typedef float f32x4 __attribute__((ext_vector_type(4)));
typedef float f32x16 __attribute__((ext_vector_type(16)));
typedef unsigned u32x4 __attribute__((ext_vector_type(4)));
typedef unsigned u32x2 __attribute__((ext_vector_type(2)));

constexpr int DM = 1024, NB = 8, SEQ = 2048, CTXL = 256, GB = 4, NGRP = 2;
constexpr int MG_ROWS = GB * (SEQ + CTXL);
constexpr int LAT_ROWS = GB * SEQ;
constexpr int KEYS = CTXL + SEQ;
constexpr int IN_COLS = 7904, PC = 3840;
constexpr int WIN_N = 7936;
constexpr float EPS = 1e-6f;
constexpr int PC_CQ = 0, PC_CKV = 256, PC_KR = 384, PC_QB = 448, PC_KB = 960, PC_VB = 1088, PC_QC = 1216, PC_KC = 1472, PC_VC = 1728, PC_RC = 2240,
              PC_LRF = 2752, PC_QD = 2784, PC_KD = 3296, PC_VD = 3552, PC_GATE = 3808;
constexpr size_t MiB = 1u << 20;
constexpr size_t WS_CTL = 0, CTL_BYTES = 1 * MiB;
constexpr size_t WS_MOD = 1 * MiB;
constexpr size_t WS_WT = 2 * MiB;
constexpr size_t WT_WIN = 0, WT_WMLA = WT_WIN + (size_t)WIN_N * 1024 * 2, WT_WB = WT_WMLA + (size_t)1792 * 384 * 2, WT_WO = WT_WB + (size_t)4096 * 512 * 2,
                 WT_W1 = WT_WO + (size_t)1024 * 1024 * 2, WT_W2 = WT_W1 + (size_t)4096 * 1024 * 2, WT_END = WT_W2 + (size_t)1024 * 4096 * 2;
static_assert(WT_END <= 40 * MiB, "weights");
constexpr size_t WS_XC1 = 42 * MiB;
constexpr size_t WS_H = 50 * MiB;
constexpr size_t WS_MG = 68 * MiB;
constexpr size_t WS_Y = 86 * MiB;
constexpr size_t WS_P = 122 * MiB;
constexpr size_t WS_CN = WS_P + (size_t)MG_ROWS * PC * 2;
constexpr size_t WS_QA = WS_CN + (size_t)MG_ROWS * 384 * 2;
constexpr size_t WS_KA = WS_QA + (size_t)MG_ROWS * 768 * 2;
constexpr size_t WS_VTA = WS_KA + (size_t)GB * 4 * KEYS * 192 * 2;
constexpr size_t WS_VTB = WS_VTA + (size_t)GB * 4 * 128 * KEYS * 2;
constexpr size_t WS_VTC = WS_VTB + (size_t)GB * 2 * 64 * KEYS * 2;
constexpr size_t WS_VTD = WS_VTC + (size_t)GB * 4 * 128 * KEYS * 2;
constexpr size_t WS_END = WS_VTD + (size_t)GB * 2 * 128 * KEYS * 2;
constexpr size_t WS_Z = WS_P;
static_assert(WS_Z + (size_t)MG_ROWS * 4096 * 2 <= WS_QA, "Z overlay must stay inside P|CN");
static_assert(WS_END <= 248 * MiB, "workspace");
constexpr int LDS_BYTES = 147456;

__device__ __forceinline__ unsigned f2bf(float f) { unsigned u = __builtin_bit_cast(unsigned, f); return (u + 0x7fffu + ((u >> 16) & 1u)) >> 16; }
__device__ __forceinline__ unsigned pk2(float lo, float hi) { return f2bf(lo) | (f2bf(hi) << 16); }
__device__ __forceinline__ float bf2f(unsigned short b) { return __builtin_bit_cast(float, (unsigned)b << 16); }
__device__ __forceinline__ float bflo(unsigned w) { return __builtin_bit_cast(float, w << 16); }
__device__ __forceinline__ float bfhi(unsigned w) { return __builtin_bit_cast(float, w & 0xffff0000u); }
__device__ __forceinline__ float wave_sum(float v) {
#pragma unroll
    for (int o = 1; o < 64; o <<= 1) v += __shfl_xor(v, o);
    return v;
}
__device__ __forceinline__ int tidx() { int t = threadIdx.x; asm volatile("" : "+v"(t)); return t; }
__device__ __forceinline__ float sigmoidf_(float x) { return 1.f / (1.f + __expf(-x)); }
__device__ __forceinline__ float siluf_(float x) { return x / (1.f + __expf(-x)); }

namespace pg8 {
constexpr int BM = 256, BK = 64, HALF = 128, HTB = HALF * BK * 2, STAGE_BYTES = 8 * HTB, NXCD = 8, WGM = 8;
__host__ __device__ __forceinline__ int lds_byte(int r, int c) { const int st = (r >> 4) * 2 + (c >> 5), rr = r & 15, cc = c & 31, ob = rr * 64 + cc * 2; return st * 1024 + (ob ^ (((ob >> 9) & 1) << 5)); }
__host__ __device__ __forceinline__ void stage_rc(int b, int& R, int& C) { const int st = b / 1024, sb = b % 1024, swz = sb ^ (((sb >> 9) & 1) << 5); R = (st >> 1) * 16 + swz / 64; C = (st & 1) * 32 + (swz % 64) / 2; }
__host__ __device__ __forceinline__ int perm32(int rho) { const int n = rho >> 4, i = rho & 15; return 8 * (i >> 2) + 4 * n + (i & 3); }

struct Unit { int pm, pn; };
struct Gemm { const bf16* A; const bf16* Bt; int lda, ldb, K; int adiv, amul; };

struct StaticOrder {
    int nM, nN, nwg, G, c;
    __device__ void init(int nM_, int nN_, int G_, int c_) { nM = nM_; nN = nN_; nwg = nM * nN; G = G_; c = c_; }
    __device__ bool next(int i, Unit& u) const {
        const long L = (long)i * G + c; if (L >= nwg) return false;
        int wgid = (int)L; { const int q = nwg / NXCD, r = nwg % NXCD, xcd = wgid % NXCD, off = wgid / NXCD; wgid = (xcd < r ? xcd * (q + 1) : r * (q + 1) + (xcd - r) * q) + off; }
        const int nig = WGM * nN, gid = wgid / nig, fm = gid * WGM, gsz = (nM - fm) < WGM ? (nM - fm) : WGM;
        u.pm = fm + ((wgid % nig) % gsz); u.pn = (wgid % nig) / gsz; return true;
    }
};
template <class Epi>
__device__ __forceinline__ void gemm_phase(LAS unsigned char* lds, const Gemm g, const StaticOrder& S, const Epi& E) {
    const int tid = tidx(), wid = __builtin_amdgcn_readfirstlane(tid >> 6), lane = tid & 63, wr = wid >> 2, wc = wid & 3, fr = lane & 15, fq = lane >> 4;
    const int K = g.K, nt = K / BK;
    unsigned voffA[2], voffB[2];
#pragma unroll
    for (int i = 0; i < 2; ++i) { int R, C; stage_rc(tid * 16 + i * 8192, R, C); const int Rb = (R & ~31) + perm32(R & 31);
        voffA[i] = (unsigned)(R * g.lda + C) * 2u; voffB[i] = (unsigned)(Rb * g.ldb + C) * 2u; }
    const size_t kstep = (size_t)(BK * 2);
    const size_t hstepA = (size_t)HALF * g.lda * 2, hstepB = (size_t)HALF * g.ldb * 2;
    const size_t tstepA = 2 * hstepA, tstepB = 2 * hstepB;
    const unsigned ldsw = (unsigned)wid * 1024u;
    const int aoff = lds_byte(wr * 64 + fr, fq * 8), boff = lds_byte(wc * 32 + fr, fq * 8);
#define PG8_SA(b, h) (((b) * 2 + (h)) * HTB)
#define PG8_SB(b, h) ((4 + (b) * 2 + (h)) * HTB)
#define PG8_STAGE(bufoff, gbase, voff) do { _Pragma("unroll") for (int _i = 0; _i < 2; ++_i) \
        __builtin_amdgcn_global_load_lds((const unsigned*)((const char*)(gbase) + (voff)[_i]), (LAS unsigned*)(lds + (bufoff) + ldsw + _i * 8192), 16, 0, 0); } while (0)
#define PG8_LDA(dst, b, h) do { _Pragma("unroll") for (int m = 0; m < 4; ++m) _Pragma("unroll") for (int k = 0; k < 2; ++k) dst[m][k] = *(const LAS bf16x8*)(lds + PG8_SA(b, h) + aoff + m * 2048 + k * 1024); } while (0)
#define PG8_LDB(dst, b, h) do { _Pragma("unroll") for (int n = 0; n < 2; ++n) _Pragma("unroll") for (int k = 0; k < 2; ++k) dst[n][k] = *(const LAS bf16x8*)(lds + PG8_SB(b, h) + boff + n * 2048 + k * 1024); } while (0)
#define PG8_MMA(ai, bj, At, Bt) do { __builtin_amdgcn_s_setprio(1); _Pragma("unroll") for (int m = 0; m < 4; ++m) _Pragma("unroll") for (int n = 0; n < 2; ++n) _Pragma("unroll") for (int k = 0; k < 2; ++k) \
        acc[ai][bj][m][n] = __builtin_amdgcn_mfma_f32_16x16x32_bf16(Bt[n][k], At[m][k], acc[ai][bj][m][n], 0, 0, 0); __builtin_amdgcn_s_setprio(0); } while (0)
#define PG8_WAIT_V(n) asm volatile("s_waitcnt vmcnt(" #n ")" ::: "memory")
#define PG8_WAIT_L(n) asm volatile("s_waitcnt lgkmcnt(" #n ")" ::: "memory")
#define PG8_BAR __builtin_amdgcn_s_barrier()
#define PG8_SCHED __builtin_amdgcn_sched_barrier(0)
#define PG8_AOFF(u) ((size_t)(g.adiv ? ((u).pn / g.adiv) * g.amul * 2 : 0))
    Unit cur, nxt; int ui = 0;
    if (!S.next(0, cur)) return;
    f32x4 acc[2][2][4][2];
#pragma unroll
    for (int a = 0; a < 2; ++a)
#pragma unroll
        for (int b = 0; b < 2; ++b)
#pragma unroll
            for (int m = 0; m < 4; ++m)
#pragma unroll
                for (int n = 0; n < 2; ++n) acc[a][b][m][n] = (f32x4){0.f, 0.f, 0.f, 0.f};
    bf16x8 At[4][2], B0[2][2], B1[2][2];
    const char* cA = (const char*)g.A + (size_t)cur.pm * tstepA + PG8_AOFF(cur); const char* cB = (const char*)g.Bt + (size_t)cur.pn * tstepB;
    PG8_STAGE(PG8_SB(0, 0), cB, voffB); PG8_STAGE(PG8_SB(0, 1), cB + hstepB, voffB); PG8_STAGE(PG8_SA(0, 0), cA, voffA); PG8_STAGE(PG8_SA(0, 1), cA + hstepA, voffA);
    if (wr == 1) PG8_BAR;
    PG8_WAIT_V(2); PG8_BAR;
    PG8_STAGE(PG8_SB(1, 0), cB + kstep, voffB); PG8_STAGE(PG8_SA(1, 0), cA + kstep, voffA); PG8_STAGE(PG8_SB(1, 1), cB + hstepB + kstep, voffB);
    PG8_WAIT_V(6); PG8_BAR;
    for (;;) {
        const bool has_next = S.next(ui + 1, nxt);
        const char* nA = has_next ? (const char*)g.A + (size_t)nxt.pm * tstepA + PG8_AOFF(nxt) : cA; const char* nB = has_next ? (const char*)g.Bt + (size_t)nxt.pn * tstepB : cB;
#pragma unroll 1
        for (int t = 0; t < nt; t += 2) {
            const bool last = (t == nt - 2);
            const char* a1 = cA + (size_t)(t + 1) * kstep;
            const char* a2 = last ? nA : cA + (size_t)(t + 2) * kstep; const char* b2 = last ? nB : cB + (size_t)(t + 2) * kstep;
            const char* a3 = a2 + kstep; const char* b3 = b2 + kstep;
            PG8_LDB(B0, 0, 0); PG8_LDB(B1, 0, 1); PG8_SCHED; PG8_LDA(At, 0, 0); PG8_STAGE(PG8_SA(1, 1), a1 + hstepA, voffA);
            PG8_WAIT_V(8); PG8_WAIT_L(0); PG8_BAR; PG8_MMA(0, 0, At, B0); PG8_MMA(0, 1, At, B1); PG8_BAR; PG8_SCHED;
            PG8_LDA(At, 0, 1); PG8_STAGE(PG8_SB(0, 0), b2, voffB); PG8_STAGE(PG8_SB(0, 1), b2 + hstepB, voffB); PG8_STAGE(PG8_SA(0, 0), a2, voffA);
            PG8_WAIT_V(8); PG8_WAIT_L(0); PG8_BAR; PG8_MMA(1, 0, At, B0); PG8_MMA(1, 1, At, B1); PG8_BAR; PG8_SCHED;
            PG8_LDB(B0, 1, 0); PG8_LDB(B1, 1, 1); PG8_SCHED; PG8_LDA(At, 1, 0); PG8_STAGE(PG8_SA(0, 1), a2 + hstepA, voffA);
            PG8_WAIT_V(8); PG8_WAIT_L(0); PG8_BAR; PG8_MMA(0, 0, At, B0); PG8_MMA(0, 1, At, B1); PG8_BAR; PG8_SCHED;
            PG8_LDA(At, 1, 1); PG8_STAGE(PG8_SB(1, 0), b3, voffB); PG8_STAGE(PG8_SB(1, 1), b3 + hstepB, voffB); PG8_STAGE(PG8_SA(1, 0), a3, voffA);
            PG8_WAIT_V(8); PG8_WAIT_L(0); PG8_BAR; PG8_MMA(1, 0, At, B0); PG8_MMA(1, 1, At, B1); PG8_BAR; PG8_SCHED;
        }
        if (wr == 0) PG8_BAR;
        E(acc, cur, wr, wc, fr, fq);
        if (!has_next) break;
#pragma unroll
        for (int a = 0; a < 2; ++a)
#pragma unroll
            for (int b = 0; b < 2; ++b)
#pragma unroll
                for (int m = 0; m < 4; ++m)
#pragma unroll
                    for (int n = 0; n < 2; ++n) acc[a][b][m][n] = (f32x4){0.f, 0.f, 0.f, 0.f};
        cur = nxt; cA = nA; cB = nB; ++ui;
        if (wr == 1) PG8_BAR;
    }
    PG8_WAIT_V(0);
    PG8_BAR;
#undef PG8_SA
#undef PG8_SB
#undef PG8_STAGE
#undef PG8_LDA
#undef PG8_LDB
#undef PG8_MMA
#undef PG8_WAIT_V
#undef PG8_WAIT_L
#undef PG8_BAR
#undef PG8_SCHED
#undef PG8_AOFF
}
}

struct Args {
    const float* in[24];
    float* out; unsigned char* ws;
    int ph_lo, ph_hi;
};
enum { I_X = 0, I_C, I_CTX, I_CCTX, I_ADAW, I_ADAB, I_N1W, I_N2W, I_WIN, I_MQNW, I_MWUQ, I_MKVNW, I_MWUKV, I_SINK, I_GWD, I_GBD, I_GNW, I_QNW, I_KNW, I_WBR, I_WO, I_W1, I_W2, I_FNW };

struct Ctx {
    const Args* a; unsigned char* ws; int l, g;
};
__device__ __forceinline__ const float* xrow_src(const Args& a, int l, int g, int r) {
    if (r < LAT_ROWS) { const size_t gr = (size_t)(g * GB) * SEQ + r; return (l == 0 ? a.in[I_X] : a.out) + gr * DM; }
    const size_t cr = (size_t)(g * GB) * CTXL + (r - LAT_ROWS); return (l == 0 ? a.in[I_CTX] : (const float*)(a.ws + WS_XC1)) + cr * DM;
}
__device__ __forceinline__ float* xrow_dst(const Args& a, int g, int r) {
    if (r < LAT_ROWS) { const size_t gr = (size_t)(g * GB) * SEQ + r; return a.out + gr * DM; }
    const size_t cr = (size_t)(g * GB) * CTXL + (r - LAT_ROWS); return (float*)(a.ws + WS_XC1) + cr * DM;
}
__device__ __forceinline__ int row_bi(int g, int r) { return r < LAT_ROWS ? g * GB + (r >> 11) : 8; }
__device__ __forceinline__ void row_blk(int r, int& bl, int& kap) { if (r < LAT_ROWS) { bl = r >> 11; kap = CTXL + (r & 2047); } else { bl = (r - LAT_ROWS) >> 8; kap = (r - LAT_ROWS) & 255; } }

using pg8::Unit;
__device__ __forceinline__ u32x4 pack8(const f32x4 v0, const f32x4 v1) { u32x4 w; w.x = pk2(v0[0], v0[1]); w.y = pk2(v0[2], v0[3]); w.z = pk2(v1[0], v1[1]); w.w = pk2(v1[2], v1[3]); return w; }

template <int ACT> struct EpiStore {
    bf16* O; int ldc;
    __device__ __forceinline__ void operator()(const f32x4 (&acc)[2][2][4][2], const Unit& u, int wr, int wc, int fr, int fq) const {
        const int row0 = u.pm * 256 + wr * 64 + fr, col0 = u.pn * 256 + wc * 32 + 8 * fq;
#pragma unroll
        for (int ai = 0; ai < 2; ++ai)
#pragma unroll
            for (int m = 0; m < 4; ++m) { bf16* rowp = O + (size_t)(row0 + ai * 128 + m * 16) * ldc + col0;
#pragma unroll
                for (int bj = 0; bj < 2; ++bj) { f32x4 v0 = acc[ai][bj][m][0], v1 = acc[ai][bj][m][1];
                    if (ACT == 1) {
#pragma unroll
                        for (int j = 0; j < 4; ++j) { const float a = fmaxf(v0[j], 0.f), b = fmaxf(v1[j], 0.f); v0[j] = a * a; v1[j] = b * b; } }
                    *(u32x4*)(rowp + bj * 128) = pack8(v0, v1); } }
    }
};
__device__ __forceinline__ void store_vt(const f32x4 (&acc)[2][2][4][2], int bj, bf16* vt, int nheads, int dv, int colbase  , int pm, int wr, int fr, int fq) {
    int bl, kap0; row_blk(pm * 256, bl, kap0);
    const int c0 = colbase + 8 * fq, head = c0 / dv, e0 = c0 - head * dv;
    bf16* vp = vt + ((size_t)(bl * nheads + head) * dv + e0) * KEYS + kap0 + wr * 64 + fr;
#pragma unroll
    for (int ai = 0; ai < 2; ++ai)
#pragma unroll
        for (int m = 0; m < 4; ++m)
#pragma unroll
            for (int n = 0; n < 2; ++n)
#pragma unroll
                for (int j = 0; j < 4; ++j) vp[(size_t)(4 * n + j) * KEYS + ai * 128 + m * 16] = (bf16)f2bf(acc[ai][bj][m][n][j]);
}
struct EpiInProj {
    bf16* P; bf16 *vtb, *vtc, *vtd;
    __device__ __forceinline__ void operator()(const f32x4 (&acc)[2][2][4][2], const Unit& u, int wr, int wc, int fr, int fq) const {
        const int row0 = u.pm * 256 + wr * 64 + fr;
#pragma unroll
        for (int bj = 0; bj < 2; ++bj) {
            const int cg = u.pn * 256 + bj * 128 + wc * 32;
            if (cg >= PC_VB && cg < PC_QC) store_vt(acc, bj, vtb, 2, 64, cg - PC_VB, u.pm, wr, fr, fq);
            else if (cg >= PC_VC && cg < PC_RC) store_vt(acc, bj, vtc, 4, 128, cg - PC_VC, u.pm, wr, fr, fq);
            else if (cg >= PC_VD && cg < PC_GATE) store_vt(acc, bj, vtd, 2, 128, cg - PC_VD, u.pm, wr, fr, fq);
            else {
#pragma unroll
                for (int ai = 0; ai < 2; ++ai)
#pragma unroll
                    for (int m = 0; m < 4; ++m) *(u32x4*)(P + (size_t)(row0 + ai * 128 + m * 16) * PC + cg + 8 * fq) = pack8(acc[ai][bj][m][0], acc[ai][bj][m][1]);
            }
        }
    }
};
struct EpiMla {
    bf16 *QA, *KA, *vta;
    __device__ __forceinline__ void operator()(const f32x4 (&acc)[2][2][4][2], const Unit& u, int wr, int wc, int fr, int fq) const {
        const int row0 = u.pm * 256 + wr * 64 + fr;
        int bl, kap0; row_blk(u.pm * 256, bl, kap0);
#pragma unroll
        for (int bj = 0; bj < 2; ++bj) {
            const int cg = u.pn * 256 + bj * 128 + wc * 32;
            if (cg < 768) {
#pragma unroll
                for (int ai = 0; ai < 2; ++ai)
#pragma unroll
                    for (int m = 0; m < 4; ++m) *(u32x4*)(QA + (size_t)(row0 + ai * 128 + m * 16) * 768 + cg + 8 * fq) = pack8(acc[ai][bj][m][0], acc[ai][bj][m][1]);
            } else if (cg < 1280) {
                const int c = cg - 768 + 8 * fq, head = c >> 7, j0 = c & 127;
#pragma unroll
                for (int ai = 0; ai < 2; ++ai)
#pragma unroll
                    for (int m = 0; m < 4; ++m) { const int kap = kap0 + ai * 128 + wr * 64 + m * 16 + fr;
                        *(u32x4*)(KA + ((size_t)(bl * 4 + head) * KEYS + kap) * 192 + j0) = pack8(acc[ai][bj][m][0], acc[ai][bj][m][1]); }
            } else store_vt(acc, bj, vta, 4, 128, cg - 1280, u.pm, wr, fr, fq);
        }
    }
};
struct EpiMerge {
    const bf16* Z; bf16* MGo;
    __device__ __forceinline__ void operator()(const f32x4 (&acc)[2][2][4][2], const Unit& u, int wr, int wc, int fr, int fq) const {
        const int row0 = u.pm * 256 + wr * 64 + fr, d0 = u.pn * 64 + wc * 16 + fq * 4;
#pragma unroll
        for (int ai = 0; ai < 2; ++ai)
#pragma unroll
            for (int m = 0; m < 4; ++m) { const size_t row = (size_t)(row0 + ai * 128 + m * 16); float o[4] = {0.f, 0.f, 0.f, 0.f};
#pragma unroll
                for (int bj = 0; bj < 2; ++bj)
#pragma unroll
                    for (int n = 0; n < 2; ++n) { const int nb = 2 * bj + n; const u32x2 z = *(const u32x2*)(Z + row * 4096 + nb * 1024 + d0);
                        const f32x4 a = acc[ai][bj][m][n];
                        o[0] += sigmoidf_(a[0]) * bflo(z.x); o[1] += sigmoidf_(a[1]) * bfhi(z.x); o[2] += sigmoidf_(a[2]) * bflo(z.y); o[3] += sigmoidf_(a[3]) * bfhi(z.y); }
                u32x2 w; w.x = pk2(o[0], o[1]); w.y = pk2(o[2], o[3]); *(u32x2*)(MGo + row * 1024 + d0) = w; }
    }
};
struct EpiResid {
    const Args* a; int l, g, chunk; bool from_dst;
    __device__ __forceinline__ void operator()(const f32x4 (&acc)[2][2][4][2], const Unit& u, int wr, int wc, int fr, int fq) const {
        const int rt = u.pm * 256; const int bi = row_bi(g, rt);
        const float* src = from_dst ? (const float*)xrow_dst(*a, g, rt) : xrow_src(*a, l, g, rt); float* dst = xrow_dst(*a, g, rt);
        const float* mod = (const float*)(a->ws + WS_MOD) + ((size_t)(l * 9 + bi) * 6 + chunk) * 1024;
        const int rl0 = wr * 64 + fr;
#pragma unroll
        for (int bj = 0; bj < 2; ++bj) { const int c0 = u.pn * 256 + bj * 128 + wc * 32 + 8 * fq;
            const f32x4 g0 = *(const f32x4*)(mod + c0), g1 = *(const f32x4*)(mod + c0 + 4);
#pragma unroll
            for (int ai = 0; ai < 2; ++ai)
#pragma unroll
                for (int m = 0; m < 4; ++m) { const size_t off = (size_t)(rl0 + ai * 128 + m * 16) * DM + c0;
                    const f32x4 x0 = *(const f32x4*)(src + off), x1 = *(const f32x4*)(src + off + 4);
                    *(f32x4*)(dst + off) = x0 + g0 * acc[ai][bj][m][0]; *(f32x4*)(dst + off + 4) = x1 + g1 * acc[ai][bj][m][1]; } }
    }
};

__device__ __forceinline__ float wfetch(const Args& a, int kind, int l, int n, int k) {
    switch (kind) {
    case 0: {
        int src;
        if (n < PC_GATE) src = n; else if (n < PC) return 0.f;
        else { const int t = n - PC, tg = t >> 8, c = t & 255; const int nb = 2 * (c >> 7) + ((c >> 2) & 1), dd = 16 * ((c >> 5) & 3) + 4 * ((c >> 3) & 3) + (c & 3); src = PC_GATE + nb * 1024 + 64 * tg + dd; }
        return a.in[I_WIN][((size_t)l * 1024 + k) * IN_COLS + src]; }
    case 1: {
        if (n < 768) return k < 256 ? a.in[I_MWUQ][((size_t)l * 256 + k) * 768 + n] : 0.f;
        if (k < 256) return 0.f;
        const int m = n - 768; const int src = m < 512 ? (m >> 7) * 256 + (m & 127) : ((m - 512) >> 7) * 256 + 128 + ((m - 512) & 127);
        return a.in[I_MWUKV][((size_t)l * 128 + (k - 256)) * 1024 + src]; }
    case 2: { const int nb = n >> 10, d = n & 1023; return a.in[I_WBR][(((size_t)l * 4 + nb) * 512 + k) * 1024 + d]; }
    case 3: return a.in[I_WO][((size_t)l * 1024 + k) * 1024 + n];
    case 4: return a.in[I_W1][((size_t)l * 1024 + k) * 4096 + n];
    default: return a.in[I_W2][((size_t)l * 4096 + k) * 1024 + n];
    }
}
__device__ __forceinline__ void transpose_item(const Args& a, int kind, int l, int K, bf16* WT, int item, int nblk, LAS float* scr, int lane) {
    const int kb = item / nblk, nb = item % nblk, k0 = 64 * kb, n0 = 32 * nb;
#pragma unroll 8
    for (int i = 0; i < 32; ++i) { const int kk = 2 * i + (lane >> 5); scr[kk * 33 + (lane & 31)] = wfetch(a, kind, l, n0 + (lane & 31), k0 + kk); }
    asm volatile("s_waitcnt lgkmcnt(0)" ::: "memory");
    const int c = lane & 7;
#pragma unroll
    for (int j = 0; j < 4; ++j) { const int n = (lane >> 3) + 8 * j; const LAS float* s = scr + (8 * c) * 33 + n;
        u32x4 o; o.x = pk2(s[0 * 33], s[1 * 33]); o.y = pk2(s[2 * 33], s[3 * 33]); o.z = pk2(s[4 * 33], s[5 * 33]); o.w = pk2(s[6 * 33], s[7 * 33]);
        *(u32x4*)(WT + (size_t)(n0 + n) * K + k0 + 8 * c) = o; }
    asm volatile("s_waitcnt lgkmcnt(0)" ::: "memory");
}
__device__ __forceinline__ void prep_weights(const Args& a, int l, LAS unsigned char* lds) {
    const int tid = tidx(), lane = tid & 63, wave = tid >> 6;
    LAS float* scr = (LAS float*)(lds + wave * 8704);
    unsigned char* wt = a.ws + WS_WT;
    constexpr int I0 = 16 * (WIN_N / 32), I1 = 6 * (1792 / 32), I2 = 8 * (4096 / 32), I3 = 16 * (1024 / 32), I4 = 16 * (4096 / 32), I5 = 64 * (1024 / 32);
    const int gw = blockIdx.x * 8 + wave, NGW = gridDim.x * 8;
    for (int it = gw; it < I0 + I1 + I2 + I3 + I4 + I5; it += NGW) {
        int r = it;
        if (r < I0) { transpose_item(a, 0, l, 1024, (bf16*)(wt + WT_WIN), r, WIN_N / 32, scr, lane); continue; } r -= I0;
        if (r < I1) { transpose_item(a, 1, l, 384, (bf16*)(wt + WT_WMLA), r, 1792 / 32, scr, lane); continue; } r -= I1;
        if (r < I2) { transpose_item(a, 2, l, 512, (bf16*)(wt + WT_WB), r, 4096 / 32, scr, lane); continue; } r -= I2;
        if (r < I3) { transpose_item(a, 3, l, 1024, (bf16*)(wt + WT_WO), r, 1024 / 32, scr, lane); continue; } r -= I3;
        if (r < I4) { transpose_item(a, 4, l, 1024, (bf16*)(wt + WT_W1), r, 4096 / 32, scr, lane); continue; } r -= I4;
        transpose_item(a, 5, l, 4096, (bf16*)(wt + WT_W2), r, 1024 / 32, scr, lane);
    }
}
__device__ __forceinline__ void prep_mods(const Args& a, LAS unsigned char* lds) {
    const int tid = tidx(), lane = tid & 63, wave = tid >> 6;
    LAS float* sc = (LAS float*)(lds + 73728);
    LAS float* red = (LAS float*)(lds + 73728 + 36864);
    for (int i = tid; i < 9 * 1024; i += 512) { const int bi = i >> 10, k = i & 1023; const float v = bi < 8 ? a.in[I_C][bi * 1024 + k] : a.in[I_CCTX][k]; sc[i] = siluf_(v); }
    __syncthreads();
    for (int item = blockIdx.x; item < 2 * 96; item += gridDim.x) {
        const int l = item / 96, n = (item % 96) * 64 + lane;
        float acc[9];
#pragma unroll
        for (int b = 0; b < 9; ++b) acc[b] = 0.f;
        const float* w = a.in[I_ADAW] + ((size_t)l * 1024 + wave * 128) * 6144 + n;
#pragma unroll 8
        for (int k = 0; k < 128; ++k) { const float wv = w[(size_t)k * 6144];
#pragma unroll
            for (int b = 0; b < 9; ++b) acc[b] += sc[b * 1024 + wave * 128 + k] * wv; }
#pragma unroll
        for (int b = 0; b < 9; ++b) red[(wave * 9 + b) * 64 + lane] = acc[b];
        __syncthreads();
        if (wave == 0) {
            const float bias = a.in[I_ADAB][l * 6144 + n];
#pragma unroll
            for (int b = 0; b < 9; ++b) { float s = bias;
#pragma unroll
                for (int w8 = 0; w8 < 8; ++w8) s += red[(w8 * 9 + b) * 64 + lane];
                ((float*)(a.ws + WS_MOD))[((size_t)l * 9 + b) * 6144 + n] = s; }
        }
        __syncthreads();
    }
}

__device__ __forceinline__ void norm_mod_rows(const Args& a, int l, int g, int nrows, int which  ) {
    const int tid = tidx(), lane = tid & 63, gw = blockIdx.x * 8 + (tid >> 6), NGW = gridDim.x * 8;
    const float* nw = a.in[which ? I_N2W : I_N1W] + l * DM;
    bf16* H = (bf16*)(a.ws + WS_H);
    for (int r = gw; r < nrows; r += NGW) {
        const float* xr = which ? (const float*)xrow_dst(a, g, r) : xrow_src(a, l, g, r);
        const float* mod = (const float*)(a.ws + WS_MOD) + ((size_t)(l * 9 + row_bi(g, r)) * 6 + (which ? 3 : 0)) * 1024;
        f32x4 v[4]; float s = 0.f;
#pragma unroll
        for (int j = 0; j < 4; ++j) { v[j] = *(const f32x4*)(xr + 4 * lane + 256 * j); s += (v[j][0] * v[j][0] + v[j][1] * v[j][1]) + (v[j][2] * v[j][2] + v[j][3] * v[j][3]); }
        const float rstd = rsqrtf(wave_sum(s) * (1.f / DM) + EPS);
#pragma unroll
        for (int j = 0; j < 4; ++j) { const int c = 4 * lane + 256 * j; const f32x4 w = *(const f32x4*)(nw + c), sh = *(const f32x4*)(mod + c), sc = *(const f32x4*)(mod + 1024 + c);
            f32x4 y;
#pragma unroll
            for (int e = 0; e < 4; ++e) y[e] = v[j][e] * rstd * w[e] * (1.f + sc[e]) + sh[e];
            u32x2 o; o.x = pk2(y[0], y[1]); o.y = pk2(y[2], y[3]); *(u32x2*)(H + (size_t)r * DM + c) = o; }
    }
}
__device__ __forceinline__ void final_norm_rows(const Args& a) {
    const int tid = tidx(), lane = tid & 63, gw = blockIdx.x * 8 + (tid >> 6), NGW = gridDim.x * 8;
    const float* nw = a.in[I_FNW];
    for (int r = gw; r < NB * SEQ; r += NGW) {
        float* xr = a.out + (size_t)r * DM;
        f32x4 v[4]; float s = 0.f;
#pragma unroll
        for (int j = 0; j < 4; ++j) { v[j] = *(const f32x4*)(xr + 4 * lane + 256 * j); s += (v[j][0] * v[j][0] + v[j][1] * v[j][1]) + (v[j][2] * v[j][2] + v[j][3] * v[j][3]); }
        const float rstd = rsqrtf(wave_sum(s) * (1.f / DM) + EPS);
#pragma unroll
        for (int j = 0; j < 4; ++j) { const int c = 4 * lane + 256 * j; const f32x4 w = *(const f32x4*)(nw + c); *(f32x4*)(xr + c) = v[j] * rstd * w; }
    }
}
__device__ __forceinline__ void rope_pair(float& x1, float& x2, int pos, int i, int quarter) {
    const float inv = exp2f(-(float)i * (13.287712379549449f / (float)quarter));
    const float ang = (float)pos * inv; const float s = __sinf(ang), c = __cosf(ang);
    const float a = x1 * c - x2 * s, b = x1 * s + x2 * c; x1 = a; x2 = b;
}
__device__ __forceinline__ void post_rows(const Args& a, int l) {
    const int tid = tidx(), lane = tid & 63, gw = blockIdx.x * 8 + (tid >> 6), NGW = gridDim.x * 8;
    bf16* P = (bf16*)(a.ws + WS_P); bf16* CN = (bf16*)(a.ws + WS_CN); bf16* KA = (bf16*)(a.ws + WS_KA);
    const float* qnw = a.in[I_MQNW] + l * 256; const float* kvnw = a.in[I_MKVNW] + l * 128; const float* knw = a.in[I_KNW] + l * 128;
    for (int r = gw; r < MG_ROWS; r += NGW) {
        bf16* pr = P + (size_t)r * PC;
        const bool lat = r < LAT_ROWS; const int t = r & 2047, rowp = t >> 6, colp = t & 63;
        int bl, kap; row_blk(r, bl, kap);
        {
            const u32x2 w = *(const u32x2*)(pr + PC_CQ + 4 * lane); float x[4] = {bflo(w.x), bfhi(w.x), bflo(w.y), bfhi(w.y)};
            const float rstd = rsqrtf(wave_sum(x[0] * x[0] + x[1] * x[1] + x[2] * x[2] + x[3] * x[3]) * (1.f / 256.f) + EPS);
            const f32x4 nw = *(const f32x4*)(qnw + 4 * lane);
            u32x2 o; o.x = pk2(x[0] * rstd * nw[0], x[1] * rstd * nw[1]); o.y = pk2(x[2] * rstd * nw[2], x[3] * rstd * nw[3]);
            *(u32x2*)(CN + (size_t)r * 384 + 4 * lane) = o; }
        {
            const unsigned w = *(const unsigned*)(pr + PC_CKV + 2 * lane); const float x0 = bflo(w), x1 = bfhi(w);
            const float rstd = rsqrtf(wave_sum(x0 * x0 + x1 * x1) * (1.f / 128.f) + EPS);
            *(unsigned*)(CN + (size_t)r * 384 + 256 + 2 * lane) = pk2(x0 * rstd * kvnw[2 * lane], x1 * rstd * kvnw[2 * lane + 1]); }
        if (lane < 32) {
            const int part = lane >> 4, i = lane & 15, d1 = 32 * part + i, d2 = d1 + 16;
            float x1 = bf2f(pr[PC_KR + d1]), x2 = bf2f(pr[PC_KR + d2]);
            if (lat) rope_pair(x1, x2, part ? colp : rowp, i, 16);
            const bf16 o1 = (bf16)f2bf(x1), o2 = (bf16)f2bf(x2);
#pragma unroll
            for (int h = 0; h < 4; ++h) { bf16* kd = KA + ((size_t)(bl * 4 + h) * KEYS + kap) * 192 + 128; kd[d1] = o1; kd[d2] = o2; }
        }
        if (lat) {
            const int hh = lane >> 5, part = (lane >> 4) & 1, i = lane & 15, d1 = 64 * hh + 32 * part + i, d2 = d1 + 16;
            float x1 = bf2f(pr[PC_KB + d1]), x2 = bf2f(pr[PC_KB + d2]);
            rope_pair(x1, x2, part ? colp : rowp, i, 16);
            pr[PC_KB + d1] = (bf16)f2bf(x1); pr[PC_KB + d2] = (bf16)f2bf(x2);
        }
        {
            const int hh = lane >> 5, i = lane & 31; bf16* kd = pr + PC_KD + 128 * hh;
            float x0 = bf2f(kd[i]), x1 = bf2f(kd[32 + i]), x2 = bf2f(kd[64 + i]), x3 = bf2f(kd[96 + i]);
            float ss = x0 * x0 + x1 * x1 + x2 * x2 + x3 * x3;
#pragma unroll
            for (int o = 1; o < 32; o <<= 1) ss += __shfl_xor(ss, o);
            const float rstd = rsqrtf(ss * (1.f / 128.f) + EPS);
            x0 *= rstd * knw[i]; x1 *= rstd * knw[32 + i]; x2 *= rstd * knw[64 + i]; x3 *= rstd * knw[96 + i];
            if (lat) { rope_pair(x0, x1, rowp, i, 32); rope_pair(x2, x3, colp, i, 32); }
            kd[i] = (bf16)f2bf(x0); kd[32 + i] = (bf16)f2bf(x1); kd[64 + i] = (bf16)f2bf(x2); kd[96 + i] = (bf16)f2bf(x3);
        }
    }
}
__device__ __forceinline__ void comb_rows(const Args& a, int l, int nrows) {
    const int tid = tidx(), lane = tid & 63, gw = blockIdx.x * 8 + (tid >> 6), NGW = gridDim.x * 8;
    const bf16* P = (const bf16*)(a.ws + WS_P); bf16* Y = (bf16*)(a.ws + WS_Y); const bf16* OB = (const bf16*)(a.ws + WS_MG);
    const float* gnw = a.in[I_GNW] + l * 128;
    for (int r = gw; r < nrows; r += NGW) {
#pragma unroll
        for (int h = 0; h < 4; ++h) {
            const int e = 2 * lane;
            const unsigned wf = *(const unsigned*)(Y + (size_t)r * 2048 + 1024 + 128 * h + e), wb = *(const unsigned*)(OB + (size_t)r * 512 + 128 * h + e), wr_ = *(const unsigned*)(P + (size_t)r * PC + PC_RC + 128 * h + e);
            const float o0 = bflo(wf) + bflo(wb), o1 = bfhi(wf) + bfhi(wb);
            const float rstd = rsqrtf(wave_sum(o0 * o0 + o1 * o1) * (1.f / 128.f) + EPS);
            *(unsigned*)(Y + (size_t)r * 2048 + 1024 + 128 * h + e) = pk2(o0 * rstd * gnw[e] * siluf_(bflo(wr_)), o1 * rstd * gnw[e + 1] * siluf_(bfhi(wr_)));
        }
    }
}

struct AttnArgs {
    const bf16* Q; int qpitch;
    const bf16* Kc; const bf16* Kl; int kpitch;
    const bf16* Vt;
    bf16* O; int opitch;
    int qpos0, ntile, band_first;
    float sink_l2; const float* qnw;
};
template <int DK, int DV, int MODE>
__device__ __forceinline__ void attn_unit(LAS unsigned char* lds, const AttnArgs& A) {
    constexpr int KS = DK * 2 + 16, VS = 272, NS = DK / 16, NDT = DV / 32, NKC = DK / 32, NVC = DV / 32, KCH = DK / 8;
    constexpr int VT_OFF = 128 * KS;
    const int tid = tidx(), lane = tid & 63, wave = __builtin_amdgcn_readfirstlane(tid >> 6);
    const int qg = wave & 3, kp = wave >> 2, r = lane & 31, h = lane >> 5;
    const bool lat = A.qpos0 >= 0;
    bf16x8 qf[NS];
    {
        float qv[NS][8];
        const bf16* qrow = A.Q + (size_t)(32 * qg + r) * A.qpitch + 8 * h;
#pragma unroll
        for (int s = 0; s < NS; ++s) { const u32x4 w = *(const u32x4*)(qrow + 16 * s);
            qv[s][0] = bflo(w.x); qv[s][1] = bfhi(w.x); qv[s][2] = bflo(w.y); qv[s][3] = bfhi(w.y); qv[s][4] = bflo(w.z); qv[s][5] = bfhi(w.z); qv[s][6] = bflo(w.w); qv[s][7] = bfhi(w.w); }
        if (MODE == 2) {
            float ss = 0.f;
#pragma unroll
            for (int s = 0; s < NS; ++s)
#pragma unroll
                for (int j = 0; j < 8; ++j) ss += qv[s][j] * qv[s][j];
            ss += __shfl_xor(ss, 32);
            const float rstd = rsqrtf(ss * (1.f / 128.f) + EPS);
#pragma unroll
            for (int s = 0; s < NS; ++s)
#pragma unroll
                for (int j = 0; j < 8; ++j) qv[s][j] *= rstd * A.qnw[16 * s + 8 * h + j];
        }
        if (lat) {
            const int pos = A.qpos0 + 32 * qg + r, rowp = pos >> 6, colp = pos & 63;
#pragma unroll
            for (int j = 0; j < 8; ++j) {
                if (MODE == 0) { rope_pair(qv[8][j], qv[9][j], rowp, 8 * h + j, 16); rope_pair(qv[10][j], qv[11][j], colp, 8 * h + j, 16); }
                if (MODE == 1) { rope_pair(qv[0][j], qv[1][j], rowp, 8 * h + j, 16); rope_pair(qv[2][j], qv[3][j], colp, 8 * h + j, 16); }
                if (MODE == 2) { rope_pair(qv[0][j], qv[2][j], rowp, 8 * h + j, 32); rope_pair(qv[1][j], qv[3][j], rowp, 16 + 8 * h + j, 32);
                                 rope_pair(qv[4][j], qv[6][j], colp, 8 * h + j, 32); rope_pair(qv[5][j], qv[7][j], colp, 16 + 8 * h + j, 32); }
            }
        }
        const float c = (MODE == 0 ? 0.07216878364870322f : MODE == 1 ? 0.125f : 0.08838834764831845f) * 1.4426950408889634f;
#pragma unroll
        for (int s = 0; s < NS; ++s) { u32x4 w; w.x = pk2(qv[s][0] * c, qv[s][1] * c); w.y = pk2(qv[s][2] * c, qv[s][3] * c); w.z = pk2(qv[s][4] * c, qv[s][5] * c); w.w = pk2(qv[s][6] * c, qv[s][7] * c);
            qf[s] = __builtin_bit_cast(bf16x8, w); }
    }
    float m_run = -INFINITY, l_run = 0.f;
    f32x16 acc[NDT];
#pragma unroll
    for (int d = 0; d < NDT; ++d)
#pragma unroll
        for (int i = 0; i < 16; ++i) acc[d][i] = 0.f;
    u32x4 kreg[NKC], vreg[NVC];
#define ATT_K0(i) ((MODE == 1 && lat && (i) >= 2) ? CTXL + 128 * (A.band_first + (i) - 2) : 128 * (i))
#define ATT_LOAD(i) do { const int k0_ = ATT_K0(i); const bf16* kb_ = ((k0_ < CTXL) ? A.Kc + (size_t)k0_ * A.kpitch : A.Kl + (size_t)(k0_ - CTXL) * A.kpitch) + (size_t)(tid >> 3) * A.kpitch + 8 * (tid & 7); \
        _Pragma("unroll") for (int p_ = 0; p_ < 2; ++p_) _Pragma("unroll") for (int c_ = 0; c_ < KCH / 8; ++c_) kreg[p_ * (KCH / 8) + c_] = *(const u32x4*)(kb_ + (size_t)(64 * p_) * A.kpitch + 64 * c_); \
        const bf16* vb_ = A.Vt + (size_t)(tid >> 4) * KEYS + k0_ + 8 * (tid & 15); \
        _Pragma("unroll") for (int p_ = 0; p_ < NVC; ++p_) vreg[p_] = *(const u32x4*)(vb_ + (size_t)(32 * p_) * KEYS); } while (0)
    ATT_LOAD(0);
    for (int it = 0; it < A.ntile; ++it) {
        __syncthreads();
        {
            LAS unsigned char* kw_ = lds + (tid >> 3) * KS + (tid & 7) * 16;
#pragma unroll
            for (int p_ = 0; p_ < 2; ++p_)
#pragma unroll
                for (int c_ = 0; c_ < KCH / 8; ++c_) *(LAS u32x4*)(kw_ + 64 * p_ * KS + 128 * c_) = kreg[p_ * (KCH / 8) + c_];
            LAS unsigned char* vw_ = lds + VT_OFF + (tid >> 4) * VS + (tid & 15) * 16;
#pragma unroll
            for (int p_ = 0; p_ < NVC; ++p_) *(LAS u32x4*)(vw_ + 32 * p_ * VS) = vreg[p_];
        }
        __syncthreads();
        if (it + 1 < A.ntile) ATT_LOAD(it + 1);
        f32x16 st0, st1;
#pragma unroll
        for (int i = 0; i < 16; ++i) { st0[i] = 0.f; st1[i] = 0.f; }
        const LAS unsigned char* kb = lds + (64 * kp + r) * KS + 16 * h;
#pragma unroll
        for (int s = 0; s < NS; ++s) {
            const bf16x8 k0f = *(const LAS bf16x8*)(kb + 32 * s), k1f = *(const LAS bf16x8*)(kb + 32 * KS + 32 * s);
            st0 = __builtin_amdgcn_mfma_f32_32x32x16_bf16(k0f, qf[s], st0, 0, 0, 0);
            st1 = __builtin_amdgcn_mfma_f32_32x32x16_bf16(k1f, qf[s], st1, 0, 0, 0);
        }
        if (MODE == 1 && lat && it >= 2) {
            const int qpos = A.qpos0 + 32 * qg + r, kb0 = ATT_K0(it) - CTXL + 64 * kp + 4 * h;
#pragma unroll
            for (int i = 0; i < 16; ++i) { const int kpos = kb0 + (i & 3) + 8 * (i >> 2); const int d0 = qpos - kpos, d1 = d0 - 32;
                if (d0 > 128 || d0 < -128) st0[i] = -INFINITY;
                if (d1 > 128 || d1 < -128) st1[i] = -INFINITY; }
        }
        float mt = fmaxf(st0[0], st1[0]);
#pragma unroll
        for (int i = 1; i < 16; ++i) mt = fmaxf(mt, fmaxf(st0[i], st1[i]));
        mt = fmaxf(mt, __shfl_xor(mt, 32));
        const float mnew = fmaxf(m_run, mt);
        const float alpha = __builtin_amdgcn_exp2f(m_run - mnew);
        m_run = mnew;
        float ps = 0.f;
#pragma unroll
        for (int i = 0; i < 16; ++i) { st0[i] = __builtin_amdgcn_exp2f(st0[i] - mnew); st1[i] = __builtin_amdgcn_exp2f(st1[i] - mnew); ps += st0[i] + st1[i]; }
        l_run = l_run * alpha + ps;
#pragma unroll
        for (int d = 0; d < NDT; ++d)
#pragma unroll
            for (int i = 0; i < 16; ++i) acc[d][i] *= alpha;
        bf16x8 pf[2][2];
#pragma unroll
        for (int u = 0; u < 2; ++u) {
            u32x4 w0, w1;
            w0.x = pk2(st0[8 * u + 0], st0[8 * u + 1]); w0.y = pk2(st0[8 * u + 2], st0[8 * u + 3]); w0.z = pk2(st0[8 * u + 4], st0[8 * u + 5]); w0.w = pk2(st0[8 * u + 6], st0[8 * u + 7]);
            w1.x = pk2(st1[8 * u + 0], st1[8 * u + 1]); w1.y = pk2(st1[8 * u + 2], st1[8 * u + 3]); w1.z = pk2(st1[8 * u + 4], st1[8 * u + 5]); w1.w = pk2(st1[8 * u + 6], st1[8 * u + 7]);
            pf[0][u] = __builtin_bit_cast(bf16x8, w0); pf[1][u] = __builtin_bit_cast(bf16x8, w1);
        }
        const LAS unsigned char* vb = lds + VT_OFF + r * VS + (64 * kp + 4 * h) * 2;
#pragma unroll
        for (int kt = 0; kt < 2; ++kt)
#pragma unroll
            for (int u = 0; u < 2; ++u)
#pragma unroll
                for (int d = 0; d < NDT; ++d) {
                    const LAS unsigned char* p = vb + d * 32 * VS + (32 * kt + 16 * u) * 2;
                    const u32x2 lo = *(const LAS u32x2*)p, hi = *(const LAS u32x2*)(p + 16);
                    u32x4 w; w.x = lo.x; w.y = lo.y; w.z = hi.x; w.w = hi.y;
                    acc[d] = __builtin_amdgcn_mfma_f32_32x32x16_bf16(__builtin_bit_cast(bf16x8, w), pf[kt][u], acc[d], 0, 0, 0);
                }
    }
#undef ATT_LOAD
#undef ATT_K0
    l_run += __shfl_xor(l_run, 32);
    __syncthreads();
    LAS float* mb = (LAS float*)lds + (size_t)qg * (NDT * 16 + 2) * 64 + lane;
    if (kp == 1) {
        mb[0] = m_run; mb[64] = l_run;
#pragma unroll
        for (int d = 0; d < NDT; ++d)
#pragma unroll
            for (int i = 0; i < 16; ++i) mb[(2 + d * 16 + i) * 64] = acc[d][i];
    }
    __syncthreads();
    if (kp == 0) {
        const float m1 = mb[0], l1 = mb[64];
        const float M = fmaxf(m_run, m1), a0 = __builtin_amdgcn_exp2f(m_run - M), a1 = __builtin_amdgcn_exp2f(m1 - M);
        float L = l_run * a0 + l1 * a1;
        if (MODE == 1) L += __builtin_amdgcn_exp2f(A.sink_l2 - M);
        const float inv = 1.f / L;
        bf16* orow = A.O + (size_t)(32 * qg + r) * A.opitch + 4 * h;
#pragma unroll
        for (int d = 0; d < NDT; ++d)
#pragma unroll
            for (int i4 = 0; i4 < 4; ++i4) {
                float o[4];
#pragma unroll
                for (int j = 0; j < 4; ++j) o[j] = (acc[d][4 * i4 + j] * a0 + mb[(2 + d * 16 + 4 * i4 + j) * 64] * a1) * inv;
                u32x2 w; w.x = pk2(o[0], o[1]); w.y = pk2(o[2], o[3]);
                *(u32x2*)(orow + 32 * d + 8 * i4) = w;
            }
    }
    __syncthreads();
}

struct GlaArgs { const bf16* P; const bf16* VtC; bf16* Y; bf16* OB; const float* wd; const float* bd; int bl, h, dir, need_ctx; };
__device__ __forceinline__ float logsigmoidf_(float x) { return fminf(x, 0.f) - log1pf(__expf(-fabsf(x))); }
__device__ __forceinline__ void gla_unit(LAS unsigned char* lds, const GlaArgs& G) {
    constexpr int RS = 144;
    constexpr int O_RQ = 0, O_RK = 9216, O_VT = 18432, O_LR = 36864, O_WD = 38912, O_BD = 43008, O_GT = 43264, O_DL = 45312, O_QT = 45568, O_KT = 54784, O_KH = 64000, O_AT = 73216, O_ST = 82432, O_END = 100864;
    const int tid = tidx(), lane = tid & 63, wave = __builtin_amdgcn_readfirstlane(tid >> 6), r = lane & 31, hh = lane >> 5;
    const int bl = G.bl, h = G.h, dir = G.dir;
    __syncthreads();
    for (int i = tid; i < 1024; i += 512) ((LAS float*)(lds + O_WD))[i] = G.wd[(size_t)(i >> 6) * 256 + 64 * h + (i & 63)];
    if (tid < 64) ((LAS float*)(lds + O_BD))[tid] = G.bd[64 * h + tid];
    for (int i = tid; i < 128 * RS / 4; i += 512) ((LAS unsigned*)(lds + O_ST))[i] = 0u;
    f32x16 sacc;
#pragma unroll
    for (int i = 0; i < 16; ++i) sacc[i] = 0.f;
    u32x4 rq, rk, rv0, rv1, rl;
#define GLA_ROWS(c, row0, kap0, isctx) do { const int cc_ = (c); if (cc_ < 4) { const int ch_ = dir ? 3 - cc_ : cc_; row0 = LAT_ROWS + bl * CTXL + 64 * ch_; kap0 = 64 * ch_; isctx = 1; } \
        else { const int ch_ = dir ? 35 - cc_ : cc_ - 4; row0 = bl * SEQ + 64 * ch_; kap0 = CTXL + 64 * ch_; isctx = 0; } } while (0)
#define GLA_LOAD(c) do { int row0_, kap0_, ic_; GLA_ROWS(c, row0_, kap0_, ic_); (void)ic_; const bf16* pr_ = G.P + (size_t)(row0_ + (tid >> 3)) * PC + 8 * (tid & 7); \
        rq = *(const u32x4*)(pr_ + PC_QC + 64 * h); rk = *(const u32x4*)(pr_ + PC_KC + 64 * h); \
        const bf16* vp_ = G.VtC + ((size_t)(bl * 4 + h) * 128 + (tid >> 3)) * KEYS + kap0_ + 8 * (tid & 7); rv0 = *(const u32x4*)vp_; rv1 = *(const u32x4*)(vp_ + (size_t)64 * KEYS); \
        if (tid < 128) rl = *(const u32x4*)(G.P + (size_t)(row0_ + (tid >> 1)) * PC + PC_LRF + 16 * dir + 8 * (tid & 1)); } while (0)
    GLA_LOAD(0);
    for (int c = 0; c < 36; ++c) {
        int row0, kap0, isctx; GLA_ROWS(c, row0, kap0, isctx);
        __syncthreads();
        *(LAS u32x4*)(lds + O_RQ + (tid >> 3) * RS + (tid & 7) * 16) = rq; *(LAS u32x4*)(lds + O_RK + (tid >> 3) * RS + (tid & 7) * 16) = rk;
        *(LAS u32x4*)(lds + O_VT + (tid >> 3) * RS + (tid & 7) * 16) = rv0; *(LAS u32x4*)(lds + O_VT + (64 + (tid >> 3)) * RS + (tid & 7) * 16) = rv1;
        if (tid < 128) *(LAS u32x4*)(lds + O_LR + (tid >> 1) * 32 + (tid & 1) * 16) = rl;
        __syncthreads();
        if (c + 1 < 36) GLA_LOAD(c + 1);
        const int d = lane;
        float la[8];
        {
            float wdv[16];
#pragma unroll
            for (int q = 0; q < 16; ++q) wdv[q] = ((const LAS float*)(lds + O_WD))[q * 64 + d];
            const float bdv = ((const LAS float*)(lds + O_BD))[d];
#pragma unroll
            for (int i = 0; i < 8; ++i) { const LAS unsigned* lr = (const LAS unsigned*)(lds + O_LR + (8 * wave + i) * 32); float x = bdv;
#pragma unroll
                for (int q = 0; q < 8; ++q) { const unsigned w = lr[q]; x += bflo(w) * wdv[2 * q] + bfhi(w) * wdv[2 * q + 1]; }
                la[i] = logsigmoidf_(x) * (1.f / 16.f); }
        }
        float cum[8];
        if (dir == 0) { float s = 0.f;
#pragma unroll
            for (int i = 0; i < 8; ++i) { s += la[i]; cum[i] = s; }
            ((LAS float*)(lds + O_GT))[wave * 64 + d] = s; }
        else { float s = 0.f;
#pragma unroll
            for (int i = 7; i >= 0; --i) { s += la[i]; cum[i] = s; }
            ((LAS float*)(lds + O_GT))[wave * 64 + d] = s; }
        __syncthreads();
        float pre = 0.f, tot = 0.f;
#pragma unroll
        for (int w8 = 0; w8 < 8; ++w8) { const float gt = ((const LAS float*)(lds + O_GT))[w8 * 64 + d]; tot += gt; if (dir == 0 ? (w8 < wave) : (w8 > wave)) pre += gt; }
        if (wave == 0) ((LAS float*)(lds + O_DL))[d] = __expf(tot);
        {
            unsigned kh[4];
#pragma unroll
            for (int i = 0; i < 8; ++i) { const int s = 8 * wave + i; const float cm = cum[i] + pre;
                const float qv = bf2f(*(const LAS bf16*)(lds + O_RQ + s * RS + 2 * d)), kv = bf2f(*(const LAS bf16*)(lds + O_RK + s * RS + 2 * d));
                *(LAS bf16*)(lds + O_QT + s * RS + 2 * d) = (bf16)f2bf(qv * 0.125f * __expf(cm));
                *(LAS bf16*)(lds + O_KT + s * RS + 2 * d) = (bf16)f2bf(kv * __expf(-cm));
                const unsigned khv = f2bf(kv * __expf(tot - cm));
                if (i & 1) kh[i >> 1] |= khv << 16; else kh[i >> 1] = khv; }
            u32x4 w; w.x = kh[0]; w.y = kh[1]; w.z = kh[2]; w.w = kh[3];
            *(LAS u32x4*)(lds + O_KH + d * RS + 16 * wave) = w;
        }
        __syncthreads();
        if (wave < 4) {
            const int ss = wave & 1, tt = wave >> 1;
            f32x16 sc;
#pragma unroll
            for (int i = 0; i < 16; ++i) sc[i] = 0.f;
#pragma unroll
            for (int kk = 0; kk < 4; ++kk) { const bf16x8 af = *(const LAS bf16x8*)(lds + O_KT + (32 * ss + r) * RS + (16 * kk + 8 * hh) * 2), bfr = *(const LAS bf16x8*)(lds + O_QT + (32 * tt + r) * RS + (16 * kk + 8 * hh) * 2);
                sc = __builtin_amdgcn_mfma_f32_32x32x16_bf16(af, bfr, sc, 0, 0, 0); }
            const int t = 32 * tt + r;
#pragma unroll
            for (int i4 = 0; i4 < 4; ++i4) { float v[4];
#pragma unroll
                for (int j = 0; j < 4; ++j) { const int s = 32 * ss + 8 * i4 + 4 * hh + j; const bool keep = dir == 0 ? (s <= t) : (s >= t); v[j] = keep ? sc[4 * i4 + j] : 0.f; }
                u32x2 w; w.x = pk2(v[0], v[1]); w.y = pk2(v[2], v[3]); *(LAS u32x2*)(lds + O_AT + t * RS + (32 * ss + 8 * i4 + 4 * hh) * 2) = w; }
        }
        __syncthreads();
        const int et = wave >> 1;
        {
            const int tt = wave & 1;
            f32x16 oc;
#pragma unroll
            for (int i = 0; i < 16; ++i) oc[i] = 0.f;
#pragma unroll
            for (int kk = 0; kk < 4; ++kk) { const bf16x8 af = *(const LAS bf16x8*)(lds + O_ST + (32 * et + r) * RS + (16 * kk + 8 * hh) * 2), bfr = *(const LAS bf16x8*)(lds + O_QT + (32 * tt + r) * RS + (16 * kk + 8 * hh) * 2);
                oc = __builtin_amdgcn_mfma_f32_32x32x16_bf16(af, bfr, oc, 0, 0, 0); }
#pragma unroll
            for (int kk = 0; kk < 4; ++kk) { const bf16x8 af = *(const LAS bf16x8*)(lds + O_VT + (32 * et + r) * RS + (16 * kk + 8 * hh) * 2), bfr = *(const LAS bf16x8*)(lds + O_AT + (32 * tt + r) * RS + (16 * kk + 8 * hh) * 2);
                oc = __builtin_amdgcn_mfma_f32_32x32x16_bf16(af, bfr, oc, 0, 0, 0); }
            if (!isctx || G.need_ctx) {
                const int row = row0 + 32 * tt + r;
                bf16* op = dir ? G.OB + (size_t)row * 512 + 128 * h : G.Y + (size_t)row * 2048 + 1024 + 128 * h;
#pragma unroll
                for (int i4 = 0; i4 < 4; ++i4) { u32x2 w; w.x = pk2(oc[4 * i4], oc[4 * i4 + 1]); w.y = pk2(oc[4 * i4 + 2], oc[4 * i4 + 3]); *(u32x2*)(op + 32 * et + 8 * i4 + 4 * hh) = w; }
            }
        }
        {
            const int dt = wave & 1;
            const float dl = ((const LAS float*)(lds + O_DL))[32 * dt + r];
#pragma unroll
            for (int i = 0; i < 16; ++i) sacc[i] *= dl;
#pragma unroll
            for (int kk = 0; kk < 4; ++kk) { const bf16x8 af = *(const LAS bf16x8*)(lds + O_VT + (32 * et + r) * RS + (16 * kk + 8 * hh) * 2), bfr = *(const LAS bf16x8*)(lds + O_KH + (32 * dt + r) * RS + (16 * kk + 8 * hh) * 2);
                sacc = __builtin_amdgcn_mfma_f32_32x32x16_bf16(af, bfr, sacc, 0, 0, 0); }
            __syncthreads();
#pragma unroll
            for (int i = 0; i < 16; ++i) { const int e = 32 * et + (i & 3) + 8 * (i >> 2) + 4 * hh; *(LAS bf16*)(lds + O_ST + e * RS + (32 * dt + r) * 2) = (bf16)f2bf(sacc[i]); }
        }
    }
#undef GLA_LOAD
#undef GLA_ROWS
    __syncthreads();
}

__device__ __forceinline__ void attn_phase(const Args& a, int l, int g, LAS unsigned char* lds) {
    unsigned char* ws = a.ws;
    const bf16* P = (const bf16*)(ws + WS_P); const bf16* QA = (const bf16*)(ws + WS_QA); const bf16* KA = (const bf16*)(ws + WS_KA);
    bf16* Y = (bf16*)(ws + WS_Y);
    const int need_ctx = (l == 0);
    const int N_GLA = 32, N_A = 256, N_D = 256, N_B = 512, N_AC = need_ctx ? 32 : 0, N_DC = N_AC, N_BC = need_ctx ? 64 : 0;
    const int total = N_GLA + N_A + N_D + N_B + N_AC + N_DC + N_BC;
    unsigned* ctr = (unsigned*)(ws + WS_CTL) + (l * 2 + g) * 64;
    volatile LAS int* slot = (volatile LAS int*)(lds + LDS_BYTES - 16);
    for (;;) {
        __syncthreads();
        if (threadIdx.x == 0) *slot = (int)__hip_atomic_fetch_add(ctr, 1u, __ATOMIC_RELAXED, __HIP_MEMORY_SCOPE_AGENT);
        __syncthreads();
        int idx = *slot;
        idx = __builtin_amdgcn_readfirstlane(idx);
        if (idx >= total) break;
        if (idx < N_GLA) {
            GlaArgs G; G.P = P; G.VtC = (const bf16*)(ws + WS_VTC); G.Y = Y; G.OB = (bf16*)(ws + WS_MG);
            G.bl = idx >> 3; G.h = (idx >> 1) & 3; G.dir = idx & 1; G.need_ctx = need_ctx;
            G.wd = a.in[I_GWD] + ((size_t)l * 2 + G.dir) * 16 * 256; G.bd = a.in[I_GBD] + ((size_t)l * 2 + G.dir) * 256;
            gla_unit(lds, G); continue; }
        idx -= N_GLA;
        AttnArgs A; A.sink_l2 = 0.f; A.qnw = nullptr; A.band_first = 0;
        if (idx < N_A || (idx >= N_A + N_D + N_B && idx < N_A + N_D + N_B + N_AC)) {
            int bl, h, row, ctxq;
            if (idx < N_A) { bl = idx >> 6; h = (idx >> 4) & 3; const int qb = idx & 15; row = bl * SEQ + 128 * qb; A.qpos0 = 128 * qb; A.ntile = 18; ctxq = 0; }
            else { const int j = idx - (N_A + N_D + N_B); bl = j >> 3; h = (j >> 1) & 3; const int qb = j & 1; row = LAT_ROWS + bl * CTXL + 128 * qb; A.qpos0 = -1; A.ntile = 2; ctxq = 1; }
            (void)ctxq;
            A.Q = QA + (size_t)row * 768 + 192 * h; A.qpitch = 768;
            A.Kc = KA + (size_t)(bl * 4 + h) * KEYS * 192; A.Kl = A.Kc + (size_t)CTXL * 192; A.kpitch = 192;
            A.Vt = (const bf16*)(ws + WS_VTA) + (size_t)(bl * 4 + h) * 128 * KEYS;
            A.O = Y + (size_t)row * 2048 + 128 * h; A.opitch = 2048;
            attn_unit<192, 128, 0>(lds, A); continue; }
        if ((idx >= N_A && idx < N_A + N_D) || (idx >= N_A + N_D + N_B + N_AC && idx < N_A + N_D + N_B + N_AC + N_DC)) {
            int bl, h, row;
            if (idx < N_A + N_D) { const int j = idx - N_A; bl = j >> 6; h = (j >> 4) & 3; const int qb = j & 15; row = bl * SEQ + 128 * qb; A.qpos0 = 128 * qb; A.ntile = 18; }
            else { const int j = idx - (N_A + N_D + N_B + N_AC); bl = j >> 3; h = (j >> 1) & 3; const int qb = j & 1; row = LAT_ROWS + bl * CTXL + 128 * qb; A.qpos0 = -1; A.ntile = 2; }
            const int kvh = h >> 1;
            A.Q = P + (size_t)row * PC + PC_QD + 128 * h; A.qpitch = PC;
            A.Kc = P + (size_t)(LAT_ROWS + bl * CTXL) * PC + PC_KD + 128 * kvh; A.Kl = P + (size_t)(bl * SEQ) * PC + PC_KD + 128 * kvh; A.kpitch = PC;
            A.Vt = (const bf16*)(ws + WS_VTD) + (size_t)(bl * 2 + kvh) * 128 * KEYS;
            A.O = Y + (size_t)row * 2048 + 1536 + 128 * h; A.opitch = 2048; A.qnw = a.in[I_QNW] + l * 128;
            attn_unit<128, 128, 2>(lds, A); continue; }
        {
            int bl, h, row;
            if (idx < N_A + N_D + N_B) { const int j = idx - (N_A + N_D); bl = j >> 7; h = (j >> 4) & 7; const int qb = j & 15; row = bl * SEQ + 128 * qb; A.qpos0 = 128 * qb;
                const int first = qb >= 1 ? qb - 1 : 0, last = qb + 1 < 16 ? qb + 1 : 15; A.band_first = first; A.ntile = 2 + (last - first + 1); }
            else { const int j = idx - (N_A + N_D + N_B + N_AC + N_DC); bl = j >> 4; h = (j >> 1) & 7; const int qb = j & 1; row = LAT_ROWS + bl * CTXL + 128 * qb; A.qpos0 = -1; A.ntile = 2; }
            const int kvh = h >> 2;
            A.Q = P + (size_t)row * PC + PC_QB + 64 * h; A.qpitch = PC;
            A.Kc = P + (size_t)(LAT_ROWS + bl * CTXL) * PC + PC_KB + 64 * kvh; A.Kl = P + (size_t)(bl * SEQ) * PC + PC_KB + 64 * kvh; A.kpitch = PC;
            A.Vt = (const bf16*)(ws + WS_VTB) + (size_t)(bl * 2 + kvh) * 64 * KEYS;
            A.O = Y + (size_t)row * 2048 + 512 + 64 * h; A.opitch = 2048; A.sink_l2 = a.in[I_SINK][l * 8 + h] * 1.4426950408889634f;
            attn_unit<64, 64, 1>(lds, A); }
    }
}

constexpr int N_PHASES = 50;
template <bool COOP>
__global__ void __launch_bounds__(512, 2) mk_fwd(Args args) {
    extern __shared__ __attribute__((aligned(16))) unsigned char lds_raw[];
    LAS unsigned char* lds = (LAS unsigned char*)lds_raw;
    unsigned char* ws = args.ws; unsigned char* wt = ws + WS_WT;
    const int G = gridDim.x, bx = blockIdx.x;
    for (int p = args.ph_lo; p < args.ph_hi; ++p) {
        if (COOP) { if (p > args.ph_lo) cg::this_grid().sync(); }
        if (p == 0) { prep_weights(args, 0, lds); prep_mods(args, lds); continue; }
        if (p == N_PHASES - 1) { final_norm_rows(args); continue; }
        const int q = p - 1, lg = q / 12, k = q - lg * 12, l = lg >> 1, g = lg & 1;
        const int nM = (l == 1) ? 32 : 36;
        pg8::StaticOrder S;
        switch (k) {
        case 0: if (l == 1 && g == 0) prep_weights(args, 1, lds); norm_mod_rows(args, l, g, MG_ROWS, 0); break;
        case 1: { pg8::Gemm gm{(const bf16*)(ws + WS_H), (const bf16*)(wt + WT_WIN), 1024, 1024, 1024, 0, 0}; S.init(36, 15, G, bx);
            EpiInProj E{(bf16*)(ws + WS_P), (bf16*)(ws + WS_VTB), (bf16*)(ws + WS_VTC), (bf16*)(ws + WS_VTD)}; pg8::gemm_phase(lds, gm, S, E); break; }
        case 2: post_rows(args, l); break;
        case 3: { pg8::Gemm gm{(const bf16*)(ws + WS_CN), (const bf16*)(wt + WT_WMLA), 384, 384, 384, 0, 0}; S.init(36, 7, G, bx);
            EpiMla E{(bf16*)(ws + WS_QA), (bf16*)(ws + WS_KA), (bf16*)(ws + WS_VTA)}; pg8::gemm_phase(lds, gm, S, E); break; }
        case 4: attn_phase(args, l, g, lds); break;
        case 5: comb_rows(args, l, nM * 256); break;
        case 6: { pg8::Gemm gm{(const bf16*)(ws + WS_Y), (const bf16*)(wt + WT_WB), 2048, 512, 512, 4, 512}; S.init(nM, 16, G, bx);
            EpiStore<0> E{(bf16*)(ws + WS_Z), 4096}; pg8::gemm_phase(lds, gm, S, E); break; }
        case 7: { pg8::Gemm gm{(const bf16*)(ws + WS_H), (const bf16*)(wt + WT_WIN) + (size_t)PC * 1024, 1024, 1024, 1024, 0, 0}; S.init(nM, 16, G, bx);
            EpiMerge E{(const bf16*)(ws + WS_Z), (bf16*)(ws + WS_MG)}; pg8::gemm_phase(lds, gm, S, E); break; }
        case 8: { pg8::Gemm gm{(const bf16*)(ws + WS_MG), (const bf16*)(wt + WT_WO), 1024, 1024, 1024, 0, 0}; S.init(nM, 4, G, bx);
            EpiResid E{&args, l, g, 2, false}; pg8::gemm_phase(lds, gm, S, E); break; }
        case 9: norm_mod_rows(args, l, g, nM * 256, 1); break;
        case 10: { pg8::Gemm gm{(const bf16*)(ws + WS_H), (const bf16*)(wt + WT_W1), 1024, 1024, 1024, 0, 0}; S.init(nM, 16, G, bx);
            EpiStore<1> E{(bf16*)(ws + WS_Z), 4096}; pg8::gemm_phase(lds, gm, S, E); break; }
        default: { pg8::Gemm gm{(const bf16*)(ws + WS_Z), (const bf16*)(wt + WT_W2), 4096, 4096, 4096, 0, 0}; S.init(nM, 4, G, bx);
            EpiResid E{&args, l, g, 5, true}; pg8::gemm_phase(lds, gm, S, E); break; }
        }
    }
}

#ifndef MK_PER_PHASE
#define MK_PER_PHASE 0
#endif
extern "C" void kernel_launch(void* const* d_in, const int* in_sizes, int n_in, void* d_out, int out_size, void* d_ws, size_t ws_size, hipStream_t stream) {
    static int grid = 0;
    if (grid == 0) {
        if (n_in != 24 || out_size != NB * SEQ * DM || ws_size < WS_END) { fprintf(stderr, "kernel_launch: unexpected shapes (n_in %d out %d ws %zu)\n", n_in, out_size, ws_size); grid = -1; return; }
        int dev = 0, cus = 0, per_cu = 0;
        hipGetDevice(&dev); hipDeviceGetAttribute(&cus, hipDeviceAttributeMultiprocessorCount, dev);
        hipFuncSetAttribute((const void*)mk_fwd<true>, hipFuncAttributeMaxDynamicSharedMemorySize, LDS_BYTES);
        hipFuncSetAttribute((const void*)mk_fwd<false>, hipFuncAttributeMaxDynamicSharedMemorySize, LDS_BYTES);
        hipOccupancyMaxActiveBlocksPerMultiprocessor(&per_cu, (const void*)mk_fwd<true>, 512, LDS_BYTES);
        if (per_cu < 1) { fprintf(stderr, "kernel_launch: occupancy query says %d blocks per CU\n", per_cu); per_cu = 1; }
        (void)hipGetLastError();
        grid = cus;
    }
    if (grid < 0) return;
    hipMemsetAsync((char*)d_ws + WS_CTL, 0, 4096, stream);
    Args a{};
    for (int i = 0; i < 24; ++i) a.in[i] = (const float*)d_in[i];
    a.out = (float*)d_out; a.ws = (unsigned char*)d_ws;
#if MK_PER_PHASE
    for (int p = 0; p < N_PHASES; ++p) { a.ph_lo = p; a.ph_hi = p + 1; hipLaunchKernelGGL(mk_fwd<false>, dim3(grid), dim3(512), LDS_BYTES, stream, a); }
#else
    a.ph_lo = 0; a.ph_hi = N_PHASES;
    void* kargs[] = {&a};
    hipError_t e = hipLaunchCooperativeKernel((const void*)mk_fwd<true>, dim3(grid), dim3(512), kargs, LDS_BYTES, stream);
    if (e != hipSuccess) fprintf(stderr, "cooperative launch failed: %s (grid %d)\n", hipGetErrorString(e), grid);
#endif
}
```

```cpp
#include <hip/hip_runtime.h>
#include <hip/hip_cooperative_groups.h>
#include <cstdio>
#include <cstdint>
namespace cg = cooperative_groups;

#define LAS __attribute__((address_space(3)))
typedef unsigned short bf16;
typedef short bf16x8 __attribute__((ext_vector_type(8)));
typedef float f32x4 __attribute__((ext_vector_type(4)));
typedef float f32x16 __attribute__((ext_vector_type(16)));
typedef unsigned u32x4 __attribute__((ext_vector_type(4)));
typedef unsigned u32x2 __attribute__((ext_vector_type(2)));

constexpr int DM = 1024, NB = 8, SEQ = 2048, CTXL = 256, GB = 4, NGRP = 2;
constexpr int MG_ROWS = GB * (SEQ + CTXL);
constexpr int LAT_ROWS = GB * SEQ;
constexpr int KEYS = CTXL + SEQ;
constexpr int IN_COLS = 7904, PC = 3840;
constexpr int WIN_N = 7936;
constexpr float EPS = 1e-6f;
constexpr int PC_CQ = 0, PC_CKV = 256, PC_KR = 384, PC_QB = 448, PC_KB = 960, PC_VB = 1088, PC_QC = 1216, PC_KC = 1472, PC_VC = 1728, PC_RC = 2240,
              PC_LRF = 2752, PC_QD = 2784, PC_KD = 3296, PC_VD = 3552, PC_GATE = 3808;
constexpr size_t MiB = 1u << 20;
constexpr size_t WS_CTL = 0, CTL_BYTES = 1 * MiB;
constexpr size_t WS_MOD = 1 * MiB;
constexpr size_t WS_WT = 2 * MiB;
constexpr size_t WT_WIN = 0, WT_WMLA = WT_WIN + (size_t)WIN_N * 1024 * 2, WT_WB = WT_WMLA + (size_t)1792 * 384 * 2, WT_WO = WT_WB + (size_t)4096 * 512 * 2,
                 WT_W1 = WT_WO + (size_t)1024 * 1024 * 2, WT_W2 = WT_W1 + (size_t)4096 * 1024 * 2, WT_END = WT_W2 + (size_t)1024 * 4096 * 2;
static_assert(WT_END <= 40 * MiB, "weights");
constexpr size_t WS_XC1 = 42 * MiB;
constexpr size_t WS_H = 50 * MiB;
constexpr size_t WS_MG = 68 * MiB;
constexpr size_t WS_Y = 86 * MiB;
constexpr size_t WS_P = 122 * MiB;
constexpr size_t WS_CN = WS_P + (size_t)MG_ROWS * PC * 2;
constexpr size_t WS_QA = WS_CN + (size_t)MG_ROWS * 384 * 2;
constexpr size_t WS_KA = WS_QA + (size_t)MG_ROWS * 768 * 2;
constexpr size_t WS_VTA = WS_KA + (size_t)GB * 4 * KEYS * 192 * 2;
constexpr size_t WS_VTB = WS_VTA + (size_t)GB * 4 * 128 * KEYS * 2;
constexpr size_t WS_VTC = WS_VTB + (size_t)GB * 2 * 64 * KEYS * 2;
constexpr size_t WS_VTD = WS_VTC + (size_t)GB * 4 * 128 * KEYS * 2;
constexpr size_t WS_END = WS_VTD + (size_t)GB * 2 * 128 * KEYS * 2;
constexpr size_t WS_Z = WS_P;
static_assert(WS_Z + (size_t)MG_ROWS * 4096 * 2 <= WS_QA, "Z overlay must stay inside P|CN");
static_assert(WS_END <= 248 * MiB, "workspace");
constexpr int LDS_BYTES = 147456;

__device__ __forceinline__ unsigned f2bf(float f) { unsigned u = __builtin_bit_cast(unsigned, f); return (u + 0x7fffu + ((u >> 16) & 1u)) >> 16; }
__device__ __forceinline__ unsigned pk2(float lo, float hi) { return f2bf(lo) | (f2bf(hi) << 16); }
__device__ __forceinline__ float bf2f(unsigned short b) { return __builtin_bit_cast(float, (unsigned)b << 16); }
__device__ __forceinline__ float bflo(unsigned w) { return __builtin_bit_cast(float, w << 16); }
__device__ __forceinline__ float bfhi(unsigned w) { return __builtin_bit_cast(float, w & 0xffff0000u); }
__device__ __forceinline__ float wave_sum(float v) {
#pragma unroll
    for (int o = 1; o < 64; o <<= 1) v += __shfl_xor(v, o);
    return v;
}
__device__ __forceinline__ int tidx() { int t = threadIdx.x; asm volatile("" : "+v"(t)); return t; }
__device__ __forceinline__ float sigmoidf_(float x) { return 1.f / (1.f + __expf(-x)); }
__device__ __forceinline__ float siluf_(float x) { return x / (1.f + __expf(-x)); }

namespace pg8 {
constexpr int BM = 256, BK = 64, HALF = 128, HTB = HALF * BK * 2, STAGE_BYTES = 8 * HTB, NXCD = 8, WGM = 8;
__host__ __device__ __forceinline__ int lds_byte(int r, int c) { const int st = (r >> 4) * 2 + (c >> 5), rr = r & 15, cc = c & 31, ob = rr * 64 + cc * 2; return st * 1024 + (ob ^ (((ob >> 9) & 1) << 5)); }
__host__ __device__ __forceinline__ void stage_rc(int b, int& R, int& C) { const int st = b / 1024, sb = b % 1024, swz = sb ^ (((sb >> 9) & 1) << 5); R = (st >> 1) * 16 + swz / 64; C = (st & 1) * 32 + (swz % 64) / 2; }
__host__ __device__ __forceinline__ int perm32(int rho) { const int n = rho >> 4, i = rho & 15; return 8 * (i >> 2) + 4 * n + (i & 3); }

struct Unit { int pm, pn; };
struct Gemm { const bf16* A; const bf16* Bt; int lda, ldb, K; int adiv, amul; };

struct StaticOrder {
    int nM, nN, nwg, G, c;
    __device__ void init(int nM_, int nN_, int G_, int c_) { nM = nM_; nN = nN_; nwg = nM * nN; G = G_; c = c_; }
    __device__ bool next(int i, Unit& u) const {
        const long L = (long)i * G + c; if (L >= nwg) return false;
        int wgid = (int)L; { const int q = nwg / NXCD, r = nwg % NXCD, xcd = wgid % NXCD, off = wgid / NXCD; wgid = (xcd < r ? xcd * (q + 1) : r * (q + 1) + (xcd - r) * q) + off; }
        const int nig = WGM * nN, gid = wgid / nig, fm = gid * WGM, gsz = (nM - fm) < WGM ? (nM - fm) : WGM;
        u.pm = fm + ((wgid % nig) % gsz); u.pn = (wgid % nig) / gsz; return true;
    }
};
template <class Epi>
__device__ __forceinline__ void gemm_phase(LAS unsigned char* lds, const Gemm g, const StaticOrder& S, const Epi& E) {
    const int tid = tidx(), wid = __builtin_amdgcn_readfirstlane(tid >> 6), lane = tid & 63, wr = wid >> 2, wc = wid & 3, fr = lane & 15, fq = lane >> 4;
    const int K = g.K, nt = K / BK;
    unsigned voffA[2], voffB[2];
#pragma unroll
    for (int i = 0; i < 2; ++i) { int R, C; stage_rc(tid * 16 + i * 8192, R, C); const int Rb = (R & ~31) + perm32(R & 31);
        voffA[i] = (unsigned)(R * g.lda + C) * 2u; voffB[i] = (unsigned)(Rb * g.ldb + C) * 2u; }
    const size_t kstep = (size_t)(BK * 2);
    const size_t hstepA = (size_t)HALF * g.lda * 2, hstepB = (size_t)HALF * g.ldb * 2;
    const size_t tstepA = 2 * hstepA, tstepB = 2 * hstepB;
    const unsigned ldsw = (unsigned)wid * 1024u;
    const int aoff = lds_byte(wr * 64 + fr, fq * 8), boff = lds_byte(wc * 32 + fr, fq * 8);
#define PG8_SA(b, h) (((b) * 2 + (h)) * HTB)
#define PG8_SB(b, h) ((4 + (b) * 2 + (h)) * HTB)
#define PG8_STAGE(bufoff, gbase, voff) do { _Pragma("unroll") for (int _i = 0; _i < 2; ++_i) \
        __builtin_amdgcn_global_load_lds((const unsigned*)((const char*)(gbase) + (voff)[_i]), (LAS unsigned*)(lds + (bufoff) + ldsw + _i * 8192), 16, 0, 0); } while (0)
#define PG8_LDA(dst, b, h) do { _Pragma("unroll") for (int m = 0; m < 4; ++m) _Pragma("unroll") for (int k = 0; k < 2; ++k) dst[m][k] = *(const LAS bf16x8*)(lds + PG8_SA(b, h) + aoff + m * 2048 + k * 1024); } while (0)
#define PG8_LDB(dst, b, h) do { _Pragma("unroll") for (int n = 0; n < 2; ++n) _Pragma("unroll") for (int k = 0; k < 2; ++k) dst[n][k] = *(const LAS bf16x8*)(lds + PG8_SB(b, h) + boff + n * 2048 + k * 1024); } while (0)
#define PG8_MMA(ai, bj, At, Bt) do { __builtin_amdgcn_s_setprio(1); _Pragma("unroll") for (int m = 0; m < 4; ++m) _Pragma("unroll") for (int n = 0; n < 2; ++n) _Pragma("unroll") for (int k = 0; k < 2; ++k) \
        acc[ai][bj][m][n] = __builtin_amdgcn_mfma_f32_16x16x32_bf16(Bt[n][k], At[m][k], acc[ai][bj][m][n], 0, 0, 0); __builtin_amdgcn_s_setprio(0); } while (0)
#define PG8_WAIT_V(n) asm volatile("s_waitcnt vmcnt(" #n ")" ::: "memory")
#define PG8_WAIT_L(n) asm volatile("s_waitcnt lgkmcnt(" #n ")" ::: "memory")
#define PG8_BAR __builtin_amdgcn_s_barrier()
#define PG8_SCHED __builtin_amdgcn_sched_barrier(0)
#define PG8_AOFF(u) ((size_t)(g.adiv ? ((u).pn / g.adiv) * g.amul * 2 : 0))
    Unit cur, nxt; int ui = 0;
    if (!S.next(0, cur)) return;
    f32x4 acc[2][2][4][2];
#pragma unroll
    for (int a = 0; a < 2; ++a)
#pragma unroll
        for (int b = 0; b < 2; ++b)
#pragma unroll
            for (int m = 0; m < 4; ++m)
#pragma unroll
                for (int n = 0; n < 2; ++n) acc[a][b][m][n] = (f32x4){0.f, 0.f, 0.f, 0.f};
    bf16x8 At[4][2], B0[2][2], B1[2][2];
    const char* cA = (const char*)g.A + (size_t)cur.pm * tstepA + PG8_AOFF(cur); const char* cB = (const char*)g.Bt + (size_t)cur.pn * tstepB;
    PG8_STAGE(PG8_SB(0, 0), cB, voffB); PG8_STAGE(PG8_SB(0, 1), cB + hstepB, voffB); PG8_STAGE(PG8_SA(0, 0), cA, voffA); PG8_STAGE(PG8_SA(0, 1), cA + hstepA, voffA);
    if (wr == 1) PG8_BAR;
    PG8_WAIT_V(2); PG8_BAR;
    PG8_STAGE(PG8_SB(1, 0), cB + kstep, voffB); PG8_STAGE(PG8_SA(1, 0), cA + kstep, voffA); PG8_STAGE(PG8_SB(1, 1), cB + hstepB + kstep, voffB);
    PG8_WAIT_V(6); PG8_BAR;
    for (;;) {
        const bool has_next = S.next(ui + 1, nxt);
        const char* nA = has_next ? (const char*)g.A + (size_t)nxt.pm * tstepA + PG8_AOFF(nxt) : cA; const char* nB = has_next ? (const char*)g.Bt + (size_t)nxt.pn * tstepB : cB;
#pragma unroll 1
        for (int t = 0; t < nt; t += 2) {
            const bool last = (t == nt - 2);
            const char* a1 = cA + (size_t)(t + 1) * kstep;
            const char* a2 = last ? nA : cA + (size_t)(t + 2) * kstep; const char* b2 = last ? nB : cB + (size_t)(t + 2) * kstep;
            const char* a3 = a2 + kstep; const char* b3 = b2 + kstep;
            PG8_LDB(B0, 0, 0); PG8_LDB(B1, 0, 1); PG8_SCHED; PG8_LDA(At, 0, 0); PG8_STAGE(PG8_SA(1, 1), a1 + hstepA, voffA);
            PG8_WAIT_V(8); PG8_WAIT_L(0); PG8_BAR; PG8_MMA(0, 0, At, B0); PG8_MMA(0, 1, At, B1); PG8_BAR; PG8_SCHED;
            PG8_LDA(At, 0, 1); PG8_STAGE(PG8_SB(0, 0), b2, voffB); PG8_STAGE(PG8_SB(0, 1), b2 + hstepB, voffB); PG8_STAGE(PG8_SA(0, 0), a2, voffA);
            PG8_WAIT_V(8); PG8_WAIT_L(0); PG8_BAR; PG8_MMA(1, 0, At, B0); PG8_MMA(1, 1, At, B1); PG8_BAR; PG8_SCHED;
            PG8_LDB(B0, 1, 0); PG8_LDB(B1, 1, 1); PG8_SCHED; PG8_LDA(At, 1, 0); PG8_STAGE(PG8_SA(0, 1), a2 + hstepA, voffA);
            PG8_WAIT_V(8); PG8_WAIT_L(0); PG8_BAR; PG8_MMA(0, 0, At, B0); PG8_MMA(0, 1, At, B1); PG8_BAR; PG8_SCHED;
            PG8_LDA(At, 1, 1); PG8_STAGE(PG8_SB(1, 0), b3, voffB); PG8_STAGE(PG8_SB(1, 1), b3 + hstepB, voffB); PG8_STAGE(PG8_SA(1, 0), a3, voffA);
            PG8_WAIT_V(8); PG8_WAIT_L(0); PG8_BAR; PG8_MMA(1, 0, At, B0); PG8_MMA(1, 1, At, B1); PG8_BAR; PG8_SCHED;
        }
        if (wr == 0) PG8_BAR;
        E(acc, cur, wr, wc, fr, fq);
        if (!has_next) break;
#pragma unroll
        for (int a = 0; a < 2; ++a)
#pragma unroll
            for (int b = 0; b < 2; ++b)
#pragma unroll
                for (int m = 0; m < 4; ++m)
#pragma unroll
                    for (int n = 0; n < 2; ++n) acc[a][b][m][n] = (f32x4){0.f, 0.f, 0.f, 0.f};
        cur = nxt; cA = nA; cB = nB; ++ui;
        if (wr == 1) PG8_BAR;
    }
    PG8_WAIT_V(0);
    PG8_BAR;
#undef PG8_SA
#undef PG8_SB
#undef PG8_STAGE
#undef PG8_LDA
#undef PG8_LDB
#undef PG8_MMA
#undef PG8_WAIT_V
#undef PG8_WAIT_L
#undef PG8_BAR
#undef PG8_SCHED
#undef PG8_AOFF
}
}

struct Args {
    const float* in[24];
    float* out; unsigned char* ws;
    int ph_lo, ph_hi;
};
enum { I_X = 0, I_C, I_CTX, I_CCTX, I_ADAW, I_ADAB, I_N1W, I_N2W, I_WIN, I_MQNW, I_MWUQ, I_MKVNW, I_MWUKV, I_SINK, I_GWD, I_GBD, I_GNW, I_QNW, I_KNW, I_WBR, I_WO, I_W1, I_W2, I_FNW };

struct Ctx {
    const Args* a; unsigned char* ws; int l, g;
};
__device__ __forceinline__ const float* xrow_src(const Args& a, int l, int g, int r) {
    if (r < LAT_ROWS) { const size_t gr = (size_t)(g * GB) * SEQ + r; return (l == 0 ? a.in[I_X] : a.out) + gr * DM; }
    const size_t cr = (size_t)(g * GB) * CTXL + (r - LAT_ROWS); return (l == 0 ? a.in[I_CTX] : (const float*)(a.ws + WS_XC1)) + cr * DM;
}
__device__ __forceinline__ float* xrow_dst(const Args& a, int g, int r) {
    if (r < LAT_ROWS) { const size_t gr = (size_t)(g * GB) * SEQ + r; return a.out + gr * DM; }
    const size_t cr = (size_t)(g * GB) * CTXL + (r - LAT_ROWS); return (float*)(a.ws + WS_XC1) + cr * DM;
}
__device__ __forceinline__ int row_bi(int g, int r) { return r < LAT_ROWS ? g * GB + (r >> 11) : 8; }
__device__ __forceinline__ void row_blk(int r, int& bl, int& kap) { if (r < LAT_ROWS) { bl = r >> 11; kap = CTXL + (r & 2047); } else { bl = (r - LAT_ROWS) >> 8; kap = (r - LAT_ROWS) & 255; } }

using pg8::Unit;
__device__ __forceinline__ u32x4 pack8(const f32x4 v0, const f32x4 v1) { u32x4 w; w.x = pk2(v0[0], v0[1]); w.y = pk2(v0[2], v0[3]); w.z = pk2(v1[0], v1[1]); w.w = pk2(v1[2], v1[3]); return w; }

template <int ACT> struct EpiStore {
    bf16* O; int ldc;
    __device__ __forceinline__ void operator()(const f32x4 (&acc)[2][2][4][2], const Unit& u, int wr, int wc, int fr, int fq) const {
        const int row0 = u.pm * 256 + wr * 64 + fr, col0 = u.pn * 256 + wc * 32 + 8 * fq;
#pragma unroll
        for (int ai = 0; ai < 2; ++ai)
#pragma unroll
            for (int m = 0; m < 4; ++m) { bf16* rowp = O + (size_t)(row0 + ai * 128 + m * 16) * ldc + col0;
#pragma unroll
                for (int bj = 0; bj < 2; ++bj) { f32x4 v0 = acc[ai][bj][m][0], v1 = acc[ai][bj][m][1];
                    if (ACT == 1) {
#pragma unroll
                        for (int j = 0; j < 4; ++j) { const float a = fmaxf(v0[j], 0.f), b = fmaxf(v1[j], 0.f); v0[j] = a * a; v1[j] = b * b; } }
                    *(u32x4*)(rowp + bj * 128) = pack8(v0, v1); } }
    }
};
__device__ __forceinline__ void store_vt(const f32x4 (&acc)[2][2][4][2], int bj, bf16* vt, int nheads, int dv, int colbase  , int pm, int wr, int fr, int fq) {
    int bl, kap0; row_blk(pm * 256, bl, kap0);
    const int c0 = colbase + 8 * fq, head = c0 / dv, e0 = c0 - head * dv;
    bf16* vp = vt + ((size_t)(bl * nheads + head) * dv + e0) * KEYS + kap0 + wr * 64 + fr;
#pragma unroll
    for (int ai = 0; ai < 2; ++ai)
#pragma unroll
        for (int m = 0; m < 4; ++m)
#pragma unroll
            for (int n = 0; n < 2; ++n)
#pragma unroll
                for (int j = 0; j < 4; ++j) vp[(size_t)(4 * n + j) * KEYS + ai * 128 + m * 16] = (bf16)f2bf(acc[ai][bj][m][n][j]);
}
struct EpiInProj {
    bf16* P; bf16 *vtb, *vtc, *vtd;
    __device__ __forceinline__ void operator()(const f32x4 (&acc)[2][2][4][2], const Unit& u, int wr, int wc, int fr, int fq) const {
        const int row0 = u.pm * 256 + wr * 64 + fr;
#pragma unroll
        for (int bj = 0; bj < 2; ++bj) {
            const int cg = u.pn * 256 + bj * 128 + wc * 32;
            if (cg >= PC_VB && cg < PC_QC) store_vt(acc, bj, vtb, 2, 64, cg - PC_VB, u.pm, wr, fr, fq);
            else if (cg >= PC_VC && cg < PC_RC) store_vt(acc, bj, vtc, 4, 128, cg - PC_VC, u.pm, wr, fr, fq);
            else if (cg >= PC_VD && cg < PC_GATE) store_vt(acc, bj, vtd, 2, 128, cg - PC_VD, u.pm, wr, fr, fq);
            else {
#pragma unroll
                for (int ai = 0; ai < 2; ++ai)
#pragma unroll
                    for (int m = 0; m < 4; ++m) *(u32x4*)(P + (size_t)(row0 + ai * 128 + m * 16) * PC + cg + 8 * fq) = pack8(acc[ai][bj][m][0], acc[ai][bj][m][1]);
            }
        }
    }
};
struct EpiMla {
    bf16 *QA, *KA, *vta;
    __device__ __forceinline__ void operator()(const f32x4 (&acc)[2][2][4][2], const Unit& u, int wr, int wc, int fr, int fq) const {
        const int row0 = u.pm * 256 + wr * 64 + fr;
        int bl, kap0; row_blk(u.pm * 256, bl, kap0);
#pragma unroll
        for (int bj = 0; bj < 2; ++bj) {
            const int cg = u.pn * 256 + bj * 128 + wc * 32;
            if (cg < 768) {
#pragma unroll
                for (int ai = 0; ai < 2; ++ai)
#pragma unroll
                    for (int m = 0; m < 4; ++m) *(u32x4*)(QA + (size_t)(row0 + ai * 128 + m * 16) * 768 + cg + 8 * fq) = pack8(acc[ai][bj][m][0], acc[ai][bj][m][1]);
            } else if (cg < 1280) {
                const int c = cg - 768 + 8 * fq, head = c >> 7, j0 = c & 127;
#pragma unroll
                for (int ai = 0; ai < 2; ++ai)
#pragma unroll
                    for (int m = 0; m < 4; ++m) { const int kap = kap0 + ai * 128 + wr * 64 + m * 16 + fr;
                        *(u32x4*)(KA + ((size_t)(bl * 4 + head) * KEYS + kap) * 192 + j0) = pack8(acc[ai][bj][m][0], acc[ai][bj][m][1]); }
            } else store_vt(acc, bj, vta, 4, 128, cg - 1280, u.pm, wr, fr, fq);
        }
    }
};
struct EpiMerge {
    const bf16* Z; bf16* MGo;
    __device__ __forceinline__ void operator()(const f32x4 (&acc)[2][2][4][2], const Unit& u, int wr, int wc, int fr, int fq) const {
        const int row0 = u.pm * 256 + wr * 64 + fr, d0 = u.pn * 64 + wc * 16 + fq * 4;
#pragma unroll
        for (int ai = 0; ai < 2; ++ai)
#pragma unroll
            for (int m = 0; m < 4; ++m) { const size_t row = (size_t)(row0 + ai * 128 + m * 16); float o[4] = {0.f, 0.f, 0.f, 0.f};
#pragma unroll
                for (int bj = 0; bj < 2; ++bj)
#pragma unroll
                    for (int n = 0; n < 2; ++n) { const int nb = 2 * bj + n; const u32x2 z = *(const u32x2*)(Z + row * 4096 + nb * 1024 + d0);
                        const f32x4 a = acc[ai][bj][m][n];
                        o[0] += sigmoidf_(a[0]) * bflo(z.x); o[1] += sigmoidf_(a[1]) * bfhi(z.x); o[2] += sigmoidf_(a[2]) * bflo(z.y); o[3] += sigmoidf_(a[3]) * bfhi(z.y); }
                u32x2 w; w.x = pk2(o[0], o[1]); w.y = pk2(o[2], o[3]); *(u32x2*)(MGo + row * 1024 + d0) = w; }
    }
};
struct EpiResid {
    const Args* a; int l, g, chunk; bool from_dst;
    __device__ __forceinline__ void operator()(const f32x4 (&acc)[2][2][4][2], const Unit& u, int wr, int wc, int fr, int fq) const {
        const int rt = u.pm * 256; const int bi = row_bi(g, rt);
        const float* src = from_dst ? (const float*)xrow_dst(*a, g, rt) : xrow_src(*a, l, g, rt); float* dst = xrow_dst(*a, g, rt);
        const float* mod = (const float*)(a->ws + WS_MOD) + ((size_t)(l * 9 + bi) * 6 + chunk) * 1024;
        const int rl0 = wr * 64 + fr;
#pragma unroll
        for (int bj = 0; bj < 2; ++bj) { const int c0 = u.pn * 256 + bj * 128 + wc * 32 + 8 * fq;
            const f32x4 g0 = *(const f32x4*)(mod + c0), g1 = *(const f32x4*)(mod + c0 + 4);
#pragma unroll
            for (int ai = 0; ai < 2; ++ai)
#pragma unroll
                for (int m = 0; m < 4; ++m) { const size_t off = (size_t)(rl0 + ai * 128 + m * 16) * DM + c0;
                    const f32x4 x0 = *(const f32x4*)(src + off), x1 = *(const f32x4*)(src + off + 4);
                    *(f32x4*)(dst + off) = x0 + g0 * acc[ai][bj][m][0]; *(f32x4*)(dst + off + 4) = x1 + g1 * acc[ai][bj][m][1]; } }
    }
};

__device__ __forceinline__ float wfetch(const Args& a, int kind, int l, int n, int k) {
    switch (kind) {
    case 0: {
        int src;
        if (n < PC_GATE) src = n; else if (n < PC) return 0.f;
        else { const int t = n - PC, tg = t >> 8, c = t & 255; const int nb = 2 * (c >> 7) + ((c >> 2) & 1), dd = 16 * ((c >> 5) & 3) + 4 * ((c >> 3) & 3) + (c & 3); src = PC_GATE + nb * 1024 + 64 * tg + dd; }
        return a.in[I_WIN][((size_t)l * 1024 + k) * IN_COLS + src]; }
    case 1: {
        if (n < 768) return k < 256 ? a.in[I_MWUQ][((size_t)l * 256 + k) * 768 + n] : 0.f;
        if (k < 256) return 0.f;
        const int m = n - 768; const int src = m < 512 ? (m >> 7) * 256 + (m & 127) : ((m - 512) >> 7) * 256 + 128 + ((m - 512) & 127);
        return a.in[I_MWUKV][((size_t)l * 128 + (k - 256)) * 1024 + src]; }
    case 2: { const int nb = n >> 10, d = n & 1023; return a.in[I_WBR][(((size_t)l * 4 + nb) * 512 + k) * 1024 + d]; }
    case 3: return a.in[I_WO][((size_t)l * 1024 + k) * 1024 + n];
    case 4: return a.in[I_W1][((size_t)l * 1024 + k) * 4096 + n];
    default: return a.in[I_W2][((size_t)l * 4096 + k) * 1024 + n];
    }
}
__device__ __forceinline__ void transpose_item(const Args& a, int kind, int l, int K, bf16* WT, int item, int nblk, LAS float* scr, int lane) {
    const int kb = item / nblk, nb = item % nblk, k0 = 64 * kb, n0 = 32 * nb;
#pragma unroll 8
    for (int i = 0; i < 32; ++i) { const int kk = 2 * i + (lane >> 5); scr[kk * 33 + (lane & 31)] = wfetch(a, kind, l, n0 + (lane & 31), k0 + kk); }
    asm volatile("s_waitcnt lgkmcnt(0)" ::: "memory");
    const int c = lane & 7;
#pragma unroll
    for (int j = 0; j < 4; ++j) { const int n = (lane >> 3) + 8 * j; const LAS float* s = scr + (8 * c) * 33 + n;
        u32x4 o; o.x = pk2(s[0 * 33], s[1 * 33]); o.y = pk2(s[2 * 33], s[3 * 33]); o.z = pk2(s[4 * 33], s[5 * 33]); o.w = pk2(s[6 * 33], s[7 * 33]);
        *(u32x4*)(WT + (size_t)(n0 + n) * K + k0 + 8 * c) = o; }
    asm volatile("s_waitcnt lgkmcnt(0)" ::: "memory");
}
__device__ __forceinline__ void prep_weights(const Args& a, int l, LAS unsigned char* lds) {
    const int tid = tidx(), lane = tid & 63, wave = tid >> 6;
    LAS float* scr = (LAS float*)(lds + wave * 8704);
    unsigned char* wt = a.ws + WS_WT;
    constexpr int I0 = 16 * (WIN_N / 32), I1 = 6 * (1792 / 32), I2 = 8 * (4096 / 32), I3 = 16 * (1024 / 32), I4 = 16 * (4096 / 32), I5 = 64 * (1024 / 32);
    const int gw = blockIdx.x * 8 + wave, NGW = gridDim.x * 8;
    for (int it = gw; it < I0 + I1 + I2 + I3 + I4 + I5; it += NGW) {
        int r = it;
        if (r < I0) { transpose_item(a, 0, l, 1024, (bf16*)(wt + WT_WIN), r, WIN_N / 32, scr, lane); continue; } r -= I0;
        if (r < I1) { transpose_item(a, 1, l, 384, (bf16*)(wt + WT_WMLA), r, 1792 / 32, scr, lane); continue; } r -= I1;
        if (r < I2) { transpose_item(a, 2, l, 512, (bf16*)(wt + WT_WB), r, 4096 / 32, scr, lane); continue; } r -= I2;
        if (r < I3) { transpose_item(a, 3, l, 1024, (bf16*)(wt + WT_WO), r, 1024 / 32, scr, lane); continue; } r -= I3;
        if (r < I4) { transpose_item(a, 4, l, 1024, (bf16*)(wt + WT_W1), r, 4096 / 32, scr, lane); continue; } r -= I4;
        transpose_item(a, 5, l, 4096, (bf16*)(wt + WT_W2), r, 1024 / 32, scr, lane);
    }
}
__device__ __forceinline__ void prep_mods(const Args& a, LAS unsigned char* lds) {
    const int tid = tidx(), lane = tid & 63, wave = tid >> 6;
    LAS float* sc = (LAS float*)(lds + 73728);
    LAS float* red = (LAS float*)(lds + 73728 + 36864);
    for (int i = tid; i < 9 * 1024; i += 512) { const int bi = i >> 10, k = i & 1023; const float v = bi < 8 ? a.in[I_C][bi * 1024 + k] : a.in[I_CCTX][k]; sc[i] = siluf_(v); }
    __syncthreads();
    for (int item = blockIdx.x; item < 2 * 96; item += gridDim.x) {
        const int l = item / 96, n = (item % 96) * 64 + lane;
        float acc[9];
#pragma unroll
        for (int b = 0; b < 9; ++b) acc[b] = 0.f;
        const float* w = a.in[I_ADAW] + ((size_t)l * 1024 + wave * 128) * 6144 + n;
#pragma unroll 8
        for (int k = 0; k < 128; ++k) { const float wv = w[(size_t)k * 6144];
#pragma unroll
            for (int b = 0; b < 9; ++b) acc[b] += sc[b * 1024 + wave * 128 + k] * wv; }
#pragma unroll
        for (int b = 0; b < 9; ++b) red[(wave * 9 + b) * 64 + lane] = acc[b];
        __syncthreads();
        if (wave == 0) {
            const float bias = a.in[I_ADAB][l * 6144 + n];
#pragma unroll
            for (int b = 0; b < 9; ++b) { float s = bias;
#pragma unroll
                for (int w8 = 0; w8 < 8; ++w8) s += red[(w8 * 9 + b) * 64 + lane];
                ((float*)(a.ws + WS_MOD))[((size_t)l * 9 + b) * 6144 + n] = s; }
        }
        __syncthreads();
    }
}

__device__ __forceinline__ void norm_mod_rows(const Args& a, int l, int g, int nrows, int which  ) {
    const int tid = tidx(), lane = tid & 63, gw = blockIdx.x * 8 + (tid >> 6), NGW = gridDim.x * 8;
    const float* nw = a.in[which ? I_N2W : I_N1W] + l * DM;
    bf16* H = (bf16*)(a.ws + WS_H);
    for (int r = gw; r < nrows; r += NGW) {
        const float* xr = which ? (const float*)xrow_dst(a, g, r) : xrow_src(a, l, g, r);
        const float* mod = (const float*)(a.ws + WS_MOD) + ((size_t)(l * 9 + row_bi(g, r)) * 6 + (which ? 3 : 0)) * 1024;
        f32x4 v[4]; float s = 0.f;
#pragma unroll
        for (int j = 0; j < 4; ++j) { v[j] = *(const f32x4*)(xr + 4 * lane + 256 * j); s += (v[j][0] * v[j][0] + v[j][1] * v[j][1]) + (v[j][2] * v[j][2] + v[j][3] * v[j][3]); }
        const float rstd = rsqrtf(wave_sum(s) * (1.f / DM) + EPS);
#pragma unroll
        for (int j = 0; j < 4; ++j) { const int c = 4 * lane + 256 * j; const f32x4 w = *(const f32x4*)(nw + c), sh = *(const f32x4*)(mod + c), sc = *(const f32x4*)(mod + 1024 + c);
            f32x4 y;
#pragma unroll
            for (int e = 0; e < 4; ++e) y[e] = v[j][e] * rstd * w[e] * (1.f + sc[e]) + sh[e];
            u32x2 o; o.x = pk2(y[0], y[1]); o.y = pk2(y[2], y[3]); *(u32x2*)(H + (size_t)r * DM + c) = o; }
    }
}
__device__ __forceinline__ void final_norm_rows(const Args& a) {
    const int tid = tidx(), lane = tid & 63, gw = blockIdx.x * 8 + (tid >> 6), NGW = gridDim.x * 8;
    const float* nw = a.in[I_FNW];
    for (int r = gw; r < NB * SEQ; r += NGW) {
        float* xr = a.out + (size_t)r * DM;
        f32x4 v[4]; float s = 0.f;
#pragma unroll
        for (int j = 0; j < 4; ++j) { v[j] = *(const f32x4*)(xr + 4 * lane + 256 * j); s += (v[j][0] * v[j][0] + v[j][1] * v[j][1]) + (v[j][2] * v[j][2] + v[j][3] * v[j][3]); }
        const float rstd = rsqrtf(wave_sum(s) * (1.f / DM) + EPS);
#pragma unroll
        for (int j = 0; j < 4; ++j) { const int c = 4 * lane + 256 * j; const f32x4 w = *(const f32x4*)(nw + c); *(f32x4*)(xr + c) = v[j] * rstd * w; }
    }
}
__device__ __forceinline__ void rope_pair(float& x1, float& x2, int pos, int i, int quarter) {
    const float inv = exp2f(-(float)i * (13.287712379549449f / (float)quarter));
    const float ang = (float)pos * inv; const float s = __sinf(ang), c = __cosf(ang);
    const float a = x1 * c - x2 * s, b = x1 * s + x2 * c; x1 = a; x2 = b;
}
__device__ __forceinline__ void post_rows(const Args& a, int l) {
    const int tid = tidx(), lane = tid & 63, gw = blockIdx.x * 8 + (tid >> 6), NGW = gridDim.x * 8;
    bf16* P = (bf16*)(a.ws + WS_P); bf16* CN = (bf16*)(a.ws + WS_CN); bf16* KA = (bf16*)(a.ws + WS_KA);
    const float* qnw = a.in[I_MQNW] + l * 256; const float* kvnw = a.in[I_MKVNW] + l * 128; const float* knw = a.in[I_KNW] + l * 128;
    for (int r = gw; r < MG_ROWS; r += NGW) {
        bf16* pr = P + (size_t)r * PC;
        const bool lat = r < LAT_ROWS; const int t = r & 2047, rowp = t >> 6, colp = t & 63;
        int bl, kap; row_blk(r, bl, kap);
        {
            const u32x2 w = *(const u32x2*)(pr + PC_CQ + 4 * lane); float x[4] = {bflo(w.x), bfhi(w.x), bflo(w.y), bfhi(w.y)};
            const float rstd = rsqrtf(wave_sum(x[0] * x[0] + x[1] * x[1] + x[2] * x[2] + x[3] * x[3]) * (1.f / 256.f) + EPS);
            const f32x4 nw = *(const f32x4*)(qnw + 4 * lane);
            u32x2 o; o.x = pk2(x[0] * rstd * nw[0], x[1] * rstd * nw[1]); o.y = pk2(x[2] * rstd * nw[2], x[3] * rstd * nw[3]);
            *(u32x2*)(CN + (size_t)r * 384 + 4 * lane) = o; }
        {
            const unsigned w = *(const unsigned*)(pr + PC_CKV + 2 * lane); const float x0 = bflo(w), x1 = bfhi(w);
            const float rstd = rsqrtf(wave_sum(x0 * x0 + x1 * x1) * (1.f / 128.f) + EPS);
            *(unsigned*)(CN + (size_t)r * 384 + 256 + 2 * lane) = pk2(x0 * rstd * kvnw[2 * lane], x1 * rstd * kvnw[2 * lane + 1]); }
        if (lane < 32) {
            const int part = lane >> 4, i = lane & 15, d1 = 32 * part + i, d2 = d1 + 16;
            float x1 = bf2f(pr[PC_KR + d1]), x2 = bf2f(pr[PC_KR + d2]);
            if (lat) rope_pair(x1, x2, part ? colp : rowp, i, 16);
            const bf16 o1 = (bf16)f2bf(x1), o2 = (bf16)f2bf(x2);
#pragma unroll
            for (int h = 0; h < 4; ++h) { bf16* kd = KA + ((size_t)(bl * 4 + h) * KEYS + kap) * 192 + 128; kd[d1] = o1; kd[d2] = o2; }
        }
        if (lat) {
            const int hh = lane >> 5, part = (lane >> 4) & 1, i = lane & 15, d1 = 64 * hh + 32 * part + i, d2 = d1 + 16;
            float x1 = bf2f(pr[PC_KB + d1]), x2 = bf2f(pr[PC_KB + d2]);
            rope_pair(x1, x2, part ? colp : rowp, i, 16);
            pr[PC_KB + d1] = (bf16)f2bf(x1); pr[PC_KB + d2] = (bf16)f2bf(x2);
        }
        {
            const int hh = lane >> 5, i = lane & 31; bf16* kd = pr + PC_KD + 128 * hh;
            float x0 = bf2f(kd[i]), x1 = bf2f(kd[32 + i]), x2 = bf2f(kd[64 + i]), x3 = bf2f(kd[96 + i]);
            float ss = x0 * x0 + x1 * x1 + x2 * x2 + x3 * x3;
#pragma unroll
            for (int o = 1; o < 32; o <<= 1) ss += __shfl_xor(ss, o);
            const float rstd = rsqrtf(ss * (1.f / 128.f) + EPS);
            x0 *= rstd * knw[i]; x1 *= rstd * knw[32 + i]; x2 *= rstd * knw[64 + i]; x3 *= rstd * knw[96 + i];
            if (lat) { rope_pair(x0, x1, rowp, i, 32); rope_pair(x2, x3, colp, i, 32); }
            kd[i] = (bf16)f2bf(x0); kd[32 + i] = (bf16)f2bf(x1); kd[64 + i] = (bf16)f2bf(x2); kd[96 + i] = (bf16)f2bf(x3);
        }
    }
}
__device__ __forceinline__ void comb_rows(const Args& a, int l, int nrows) {
    const int tid = tidx(), lane = tid & 63, gw = blockIdx.x * 8 + (tid >> 6), NGW = gridDim.x * 8;
    const bf16* P = (const bf16*)(a.ws + WS_P); bf16* Y = (bf16*)(a.ws + WS_Y); const bf16* OB = (const bf16*)(a.ws + WS_MG);
    const float* gnw = a.in[I_GNW] + l * 128;
    for (int r = gw; r < nrows; r += NGW) {
#pragma unroll
        for (int h = 0; h < 4; ++h) {
            const int e = 2 * lane;
            const unsigned wf = *(const unsigned*)(Y + (size_t)r * 2048 + 1024 + 128 * h + e), wb = *(const unsigned*)(OB + (size_t)r * 512 + 128 * h + e), wr_ = *(const unsigned*)(P + (size_t)r * PC + PC_RC + 128 * h + e);
            const float o0 = bflo(wf) + bflo(wb), o1 = bfhi(wf) + bfhi(wb);
            const float rstd = rsqrtf(wave_sum(o0 * o0 + o1 * o1) * (1.f / 128.f) + EPS);
            *(unsigned*)(Y + (size_t)r * 2048 + 1024 + 128 * h + e) = pk2(o0 * rstd * gnw[e] * siluf_(bflo(wr_)), o1 * rstd * gnw[e + 1] * siluf_(bfhi(wr_)));
        }
    }
}

struct AttnArgs {
    const bf16* Q; int qpitch;
    const bf16* Kc; const bf16* Kl; int kpitch;
    const bf16* Vt;
    bf16* O; int opitch;
    int qpos0, ntile, band_first;
    float sink_l2; const float* qnw;
};
template <int DK, int DV, int MODE>
__device__ __forceinline__ void attn_unit(LAS unsigned char* lds, const AttnArgs& A) {
    constexpr int KS = DK * 2 + 16, VS = 272, NS = DK / 16, NDT = DV / 32, NKC = DK / 32, NVC = DV / 32, KCH = DK / 8;
    constexpr int VT_OFF = 128 * KS;
    const int tid = tidx(), lane = tid & 63, wave = __builtin_amdgcn_readfirstlane(tid >> 6);
    const int qg = wave & 3, kp = wave >> 2, r = lane & 31, h = lane >> 5;
    const bool lat = A.qpos0 >= 0;
    bf16x8 qf[NS];
    {
        float qv[NS][8];
        const bf16* qrow = A.Q + (size_t)(32 * qg + r) * A.qpitch + 8 * h;
#pragma unroll
        for (int s = 0; s < NS; ++s) { const u32x4 w = *(const u32x4*)(qrow + 16 * s);
            qv[s][0] = bflo(w.x); qv[s][1] = bfhi(w.x); qv[s][2] = bflo(w.y); qv[s][3] = bfhi(w.y); qv[s][4] = bflo(w.z); qv[s][5] = bfhi(w.z); qv[s][6] = bflo(w.w); qv[s][7] = bfhi(w.w); }
        if (MODE == 2) {
            float ss = 0.f;
#pragma unroll
            for (int s = 0; s < NS; ++s)
#pragma unroll
                for (int j = 0; j < 8; ++j) ss += qv[s][j] * qv[s][j];
            ss += __shfl_xor(ss, 32);
            const float rstd = rsqrtf(ss * (1.f / 128.f) + EPS);
#pragma unroll
            for (int s = 0; s < NS; ++s)
#pragma unroll
                for (int j = 0; j < 8; ++j) qv[s][j] *= rstd * A.qnw[16 * s + 8 * h + j];
        }
        if (lat) {
            const int pos = A.qpos0 + 32 * qg + r, rowp = pos >> 6, colp = pos & 63;
#pragma unroll
            for (int j = 0; j < 8; ++j) {
                if (MODE == 0) { rope_pair(qv[8][j], qv[9][j], rowp, 8 * h + j, 16); rope_pair(qv[10][j], qv[11][j], colp, 8 * h + j, 16); }
                if (MODE == 1) { rope_pair(qv[0][j], qv[1][j], rowp, 8 * h + j, 16); rope_pair(qv[2][j], qv[3][j], colp, 8 * h + j, 16); }
                if (MODE == 2) { rope_pair(qv[0][j], qv[2][j], rowp, 8 * h + j, 32); rope_pair(qv[1][j], qv[3][j], rowp, 16 + 8 * h + j, 32);
                                 rope_pair(qv[4][j], qv[6][j], colp, 8 * h + j, 32); rope_pair(qv[5][j], qv[7][j], colp, 16 + 8 * h + j, 32); }
            }
        }
        const float c = (MODE == 0 ? 0.07216878364870322f : MODE == 1 ? 0.125f : 0.08838834764831845f) * 1.4426950408889634f;
#pragma unroll
        for (int s = 0; s < NS; ++s) { u32x4 w; w.x = pk2(qv[s][0] * c, qv[s][1] * c); w.y = pk2(qv[s][2] * c, qv[s][3] * c); w.z = pk2(qv[s][4] * c, qv[s][5] * c); w.w = pk2(qv[s][6] * c, qv[s][7] * c);
            qf[s] = __builtin_bit_cast(bf16x8, w); }
    }
    float m_run = -INFINITY, l_run = 0.f;
    f32x16 acc[NDT];
#pragma unroll
    for (int d = 0; d < NDT; ++d)
#pragma unroll
        for (int i = 0; i < 16; ++i) acc[d][i] = 0.f;
    u32x4 kreg[NKC], vreg[NVC];
#define ATT_K0(i) ((MODE == 1 && lat && (i) >= 2) ? CTXL + 128 * (A.band_first + (i) - 2) : 128 * (i))
#define ATT_LOAD(i) do { const int k0_ = ATT_K0(i); const bf16* kb_ = ((k0_ < CTXL) ? A.Kc + (size_t)k0_ * A.kpitch : A.Kl + (size_t)(k0_ - CTXL) * A.kpitch) + (size_t)(tid >> 3) * A.kpitch + 8 * (tid & 7); \
        _Pragma("unroll") for (int p_ = 0; p_ < 2; ++p_) _Pragma("unroll") for (int c_ = 0; c_ < KCH / 8; ++c_) kreg[p_ * (KCH / 8) + c_] = *(const u32x4*)(kb_ + (size_t)(64 * p_) * A.kpitch + 64 * c_); \
        const bf16* vb_ = A.Vt + (size_t)(tid >> 4) * KEYS + k0_ + 8 * (tid & 15); \
        _Pragma("unroll") for (int p_ = 0; p_ < NVC; ++p_) vreg[p_] = *(const u32x4*)(vb_ + (size_t)(32 * p_) * KEYS); } while (0)
    ATT_LOAD(0);
    for (int it = 0; it < A.ntile; ++it) {
        __syncthreads();
        {
            LAS unsigned char* kw_ = lds + (tid >> 3) * KS + (tid & 7) * 16;
#pragma unroll
            for (int p_ = 0; p_ < 2; ++p_)
#pragma unroll
                for (int c_ = 0; c_ < KCH / 8; ++c_) *(LAS u32x4*)(kw_ + 64 * p_ * KS + 128 * c_) = kreg[p_ * (KCH / 8) + c_];
            LAS unsigned char* vw_ = lds + VT_OFF + (tid >> 4) * VS + (tid & 15) * 16;
#pragma unroll
            for (int p_ = 0; p_ < NVC; ++p_) *(LAS u32x4*)(vw_ + 32 * p_ * VS) = vreg[p_];
        }
        __syncthreads();
        if (it + 1 < A.ntile) ATT_LOAD(it + 1);
        f32x16 st0, st1;
#pragma unroll
        for (int i = 0; i < 16; ++i) { st0[i] = 0.f; st1[i] = 0.f; }
        const LAS unsigned char* kb = lds + (64 * kp + r) * KS + 16 * h;
#pragma unroll
        for (int s = 0; s < NS; ++s) {
            const bf16x8 k0f = *(const LAS bf16x8*)(kb + 32 * s), k1f = *(const LAS bf16x8*)(kb + 32 * KS + 32 * s);
            st0 = __builtin_amdgcn_mfma_f32_32x32x16_bf16(k0f, qf[s], st0, 0, 0, 0);
            st1 = __builtin_amdgcn_mfma_f32_32x32x16_bf16(k1f, qf[s], st1, 0, 0, 0);
        }
        if (MODE == 1 && lat && it >= 2) {
            const int qpos = A.qpos0 + 32 * qg + r, kb0 = ATT_K0(it) - CTXL + 64 * kp + 4 * h;
#pragma unroll
            for (int i = 0; i < 16; ++i) { const int kpos = kb0 + (i & 3) + 8 * (i >> 2); const int d0 = qpos - kpos, d1 = d0 - 32;
                if (d0 > 128 || d0 < -128) st0[i] = -INFINITY;
                if (d1 > 128 || d1 < -128) st1[i] = -INFINITY; }
        }
        float mt = fmaxf(st0[0], st1[0]);
#pragma unroll
        for (int i = 1; i < 16; ++i) mt = fmaxf(mt, fmaxf(st0[i], st1[i]));
        mt = fmaxf(mt, __shfl_xor(mt, 32));
        const float mnew = fmaxf(m_run, mt);
        const float alpha = __builtin_amdgcn_exp2f(m_run - mnew);
        m_run = mnew;
        float ps = 0.f;
#pragma unroll
        for (int i = 0; i < 16; ++i) { st0[i] = __builtin_amdgcn_exp2f(st0[i] - mnew); st1[i] = __builtin_amdgcn_exp2f(st1[i] - mnew); ps += st0[i] + st1[i]; }
        l_run = l_run * alpha + ps;
#pragma unroll
        for (int d = 0; d < NDT; ++d)
#pragma unroll
            for (int i = 0; i < 16; ++i) acc[d][i] *= alpha;
        bf16x8 pf[2][2];
#pragma unroll
        for (int u = 0; u < 2; ++u) {
            u32x4 w0, w1;
            w0.x = pk2(st0[8 * u + 0], st0[8 * u + 1]); w0.y = pk2(st0[8 * u + 2], st0[8 * u + 3]); w0.z = pk2(st0[8 * u + 4], st0[8 * u + 5]); w0.w = pk2(st0[8 * u + 6], st0[8 * u + 7]);
            w1.x = pk2(st1[8 * u + 0], st1[8 * u + 1]); w1.y = pk2(st1[8 * u + 2], st1[8 * u + 3]); w1.z = pk2(st1[8 * u + 4], st1[8 * u + 5]); w1.w = pk2(st1[8 * u + 6], st1[8 * u + 7]);
            pf[0][u] = __builtin_bit_cast(bf16x8, w0); pf[1][u] = __builtin_bit_cast(bf16x8, w1);
        }
        const LAS unsigned char* vb = lds + VT_OFF + r * VS + (64 * kp + 4 * h) * 2;
#pragma unroll
        for (int kt = 0; kt < 2; ++kt)
#pragma unroll
            for (int u = 0; u < 2; ++u)
#pragma unroll
                for (int d = 0; d < NDT; ++d) {
                    const LAS unsigned char* p = vb + d * 32 * VS + (32 * kt + 16 * u) * 2;
                    const u32x2 lo = *(const LAS u32x2*)p, hi = *(const LAS u32x2*)(p + 16);
                    u32x4 w; w.x = lo.x; w.y = lo.y; w.z = hi.x; w.w = hi.y;
                    acc[d] = __builtin_amdgcn_mfma_f32_32x32x16_bf16(__builtin_bit_cast(bf16x8, w), pf[kt][u], acc[d], 0, 0, 0);
                }
    }
#undef ATT_LOAD
#undef ATT_K0
    l_run += __shfl_xor(l_run, 32);
    __syncthreads();
    LAS float* mb = (LAS float*)lds + (size_t)qg * (NDT * 16 + 2) * 64 + lane;
    if (kp == 1) {
        mb[0] = m_run; mb[64] = l_run;
#pragma unroll
        for (int d = 0; d < NDT; ++d)
#pragma unroll
            for (int i = 0; i < 16; ++i) mb[(2 + d * 16 + i) * 64] = acc[d][i];
    }
    __syncthreads();
    if (kp == 0) {
        const float m1 = mb[0], l1 = mb[64];
        const float M = fmaxf(m_run, m1), a0 = __builtin_amdgcn_exp2f(m_run - M), a1 = __builtin_amdgcn_exp2f(m1 - M);
        float L = l_run * a0 + l1 * a1;
        if (MODE == 1) L += __builtin_amdgcn_exp2f(A.sink_l2 - M);
        const float inv = 1.f / L;
        bf16* orow = A.O + (size_t)(32 * qg + r) * A.opitch + 4 * h;
#pragma unroll
        for (int d = 0; d < NDT; ++d)
#pragma unroll
            for (int i4 = 0; i4 < 4; ++i4) {
                float o[4];
#pragma unroll
                for (int j = 0; j < 4; ++j) o[j] = (acc[d][4 * i4 + j] * a0 + mb[(2 + d * 16 + 4 * i4 + j) * 64] * a1) * inv;
                u32x2 w; w.x = pk2(o[0], o[1]); w.y = pk2(o[2], o[3]);
                *(u32x2*)(orow + 32 * d + 8 * i4) = w;
            }
    }
    __syncthreads();
}

struct GlaArgs { const bf16* P; const bf16* VtC; bf16* Y; bf16* OB; const float* wd; const float* bd; int bl, h, dir, need_ctx; };
__device__ __forceinline__ float logsigmoidf_(float x) { return fminf(x, 0.f) - log1pf(__expf(-fabsf(x))); }
__device__ __forceinline__ void gla_unit(LAS unsigned char* lds, const GlaArgs& G) {
    constexpr int RS = 144;
    constexpr int O_RQ = 0, O_RK = 9216, O_VT = 18432, O_LR = 36864, O_WD = 38912, O_BD = 43008, O_GT = 43264, O_DL = 45312, O_QT = 45568, O_KT = 54784, O_KH = 64000, O_AT = 73216, O_ST = 82432, O_END = 100864;
    const int tid = tidx(), lane = tid & 63, wave = __builtin_amdgcn_readfirstlane(tid >> 6), r = lane & 31, hh = lane >> 5;
    const int bl = G.bl, h = G.h, dir = G.dir;
    __syncthreads();
    for (int i = tid; i < 1024; i += 512) ((LAS float*)(lds + O_WD))[i] = G.wd[(size_t)(i >> 6) * 256 + 64 * h + (i & 63)];
    if (tid < 64) ((LAS float*)(lds + O_BD))[tid] = G.bd[64 * h + tid];
    for (int i = tid; i < 128 * RS / 4; i += 512) ((LAS unsigned*)(lds + O_ST))[i] = 0u;
    f32x16 sacc;
#pragma unroll
    for (int i = 0; i < 16; ++i) sacc[i] = 0.f;
    u32x4 rq, rk, rv0, rv1, rl;
#define GLA_ROWS(c, row0, kap0, isctx) do { const int cc_ = (c); if (cc_ < 4) { const int ch_ = dir ? 3 - cc_ : cc_; row0 = LAT_ROWS + bl * CTXL + 64 * ch_; kap0 = 64 * ch_; isctx = 1; } \
        else { const int ch_ = dir ? 35 - cc_ : cc_ - 4; row0 = bl * SEQ + 64 * ch_; kap0 = CTXL + 64 * ch_; isctx = 0; } } while (0)
#define GLA_LOAD(c) do { int row0_, kap0_, ic_; GLA_ROWS(c, row0_, kap0_, ic_); (void)ic_; const bf16* pr_ = G.P + (size_t)(row0_ + (tid >> 3)) * PC + 8 * (tid & 7); \
        rq = *(const u32x4*)(pr_ + PC_QC + 64 * h); rk = *(const u32x4*)(pr_ + PC_KC + 64 * h); \
        const bf16* vp_ = G.VtC + ((size_t)(bl * 4 + h) * 128 + (tid >> 3)) * KEYS + kap0_ + 8 * (tid & 7); rv0 = *(const u32x4*)vp_; rv1 = *(const u32x4*)(vp_ + (size_t)64 * KEYS); \
        if (tid < 128) rl = *(const u32x4*)(G.P + (size_t)(row0_ + (tid >> 1)) * PC + PC_LRF + 16 * dir + 8 * (tid & 1)); } while (0)
    GLA_LOAD(0);
    for (int c = 0; c < 36; ++c) {
        int row0, kap0, isctx; GLA_ROWS(c, row0, kap0, isctx);
        __syncthreads();
        *(LAS u32x4*)(lds + O_RQ + (tid >> 3) * RS + (tid & 7) * 16) = rq; *(LAS u32x4*)(lds + O_RK + (tid >> 3) * RS + (tid & 7) * 16) = rk;
        *(LAS u32x4*)(lds + O_VT + (tid >> 3) * RS + (tid & 7) * 16) = rv0; *(LAS u32x4*)(lds + O_VT + (64 + (tid >> 3)) * RS + (tid & 7) * 16) = rv1;
        if (tid < 128) *(LAS u32x4*)(lds + O_LR + (tid >> 1) * 32 + (tid & 1) * 16) = rl;
        __syncthreads();
        if (c + 1 < 36) GLA_LOAD(c + 1);
        const int d = lane;
        float la[8];
        {
            float wdv[16];
#pragma unroll
            for (int q = 0; q < 16; ++q) wdv[q] = ((const LAS float*)(lds + O_WD))[q * 64 + d];
            const float bdv = ((const LAS float*)(lds + O_BD))[d];
#pragma unroll
            for (int i = 0; i < 8; ++i) { const LAS unsigned* lr = (const LAS unsigned*)(lds + O_LR + (8 * wave + i) * 32); float x = bdv;
#pragma unroll
                for (int q = 0; q < 8; ++q) { const unsigned w = lr[q]; x += bflo(w) * wdv[2 * q] + bfhi(w) * wdv[2 * q + 1]; }
                la[i] = logsigmoidf_(x) * (1.f / 16.f); }
        }
        float cum[8];
        if (dir == 0) { float s = 0.f;
#pragma unroll
            for (int i = 0; i < 8; ++i) { s += la[i]; cum[i] = s; }
            ((LAS float*)(lds + O_GT))[wave * 64 + d] = s; }
        else { float s = 0.f;
#pragma unroll
            for (int i = 7; i >= 0; --i) { s += la[i]; cum[i] = s; }
            ((LAS float*)(lds + O_GT))[wave * 64 + d] = s; }
        __syncthreads();
        float pre = 0.f, tot = 0.f;
#pragma unroll
        for (int w8 = 0; w8 < 8; ++w8) { const float gt = ((const LAS float*)(lds + O_GT))[w8 * 64 + d]; tot += gt; if (dir == 0 ? (w8 < wave) : (w8 > wave)) pre += gt; }
        if (wave == 0) ((LAS float*)(lds + O_DL))[d] = __expf(tot);
        {
            unsigned kh[4];
#pragma unroll
            for (int i = 0; i < 8; ++i) { const int s = 8 * wave + i; const float cm = cum[i] + pre;
                const float qv = bf2f(*(const LAS bf16*)(lds + O_RQ + s * RS + 2 * d)), kv = bf2f(*(const LAS bf16*)(lds + O_RK + s * RS + 2 * d));
                *(LAS bf16*)(lds + O_QT + s * RS + 2 * d) = (bf16)f2bf(qv * 0.125f * __expf(cm));
                *(LAS bf16*)(lds + O_KT + s * RS + 2 * d) = (bf16)f2bf(kv * __expf(-cm));
                const unsigned khv = f2bf(kv * __expf(tot - cm));
                if (i & 1) kh[i >> 1] |= khv << 16; else kh[i >> 1] = khv; }
            u32x4 w; w.x = kh[0]; w.y = kh[1]; w.z = kh[2]; w.w = kh[3];
            *(LAS u32x4*)(lds + O_KH + d * RS + 16 * wave) = w;
        }
        __syncthreads();
        if (wave < 4) {
            const int ss = wave & 1, tt = wave >> 1;
            f32x16 sc;
#pragma unroll
            for (int i = 0; i < 16; ++i) sc[i] = 0.f;
#pragma unroll
            for (int kk = 0; kk < 4; ++kk) { const bf16x8 af = *(const LAS bf16x8*)(lds + O_KT + (32 * ss + r) * RS + (16 * kk + 8 * hh) * 2), bfr = *(const LAS bf16x8*)(lds + O_QT + (32 * tt + r) * RS + (16 * kk + 8 * hh) * 2);
                sc = __builtin_amdgcn_mfma_f32_32x32x16_bf16(af, bfr, sc, 0, 0, 0); }
            const int t = 32 * tt + r;
#pragma unroll
            for (int i4 = 0; i4 < 4; ++i4) { float v[4];
#pragma unroll
                for (int j = 0; j < 4; ++j) { const int s = 32 * ss + 8 * i4 + 4 * hh + j; const bool keep = dir == 0 ? (s <= t) : (s >= t); v[j] = keep ? sc[4 * i4 + j] : 0.f; }
                u32x2 w; w.x = pk2(v[0], v[1]); w.y = pk2(v[2], v[3]); *(LAS u32x2*)(lds + O_AT + t * RS + (32 * ss + 8 * i4 + 4 * hh) * 2) = w; }
        }
        __syncthreads();
        const int et = wave >> 1;
        {
            const int tt = wave & 1;
            f32x16 oc;
#pragma unroll
            for (int i = 0; i < 16; ++i) oc[i] = 0.f;
#pragma unroll
            for (int kk = 0; kk < 4; ++kk) { const bf16x8 af = *(const LAS bf16x8*)(lds + O_ST + (32 * et + r) * RS + (16 * kk + 8 * hh) * 2), bfr = *(const LAS bf16x8*)(lds + O_QT + (32 * tt + r) * RS + (16 * kk + 8 * hh) * 2);
                oc = __builtin_amdgcn_mfma_f32_32x32x16_bf16(af, bfr, oc, 0, 0, 0); }
#pragma unroll
            for (int kk = 0; kk < 4; ++kk) { const bf16x8 af = *(const LAS bf16x8*)(lds + O_VT + (32 * et + r) * RS + (16 * kk + 8 * hh) * 2), bfr = *(const LAS bf16x8*)(lds + O_AT + (32 * tt + r) * RS + (16 * kk + 8 * hh) * 2);
                oc = __builtin_amdgcn_mfma_f32_32x32x16_bf16(af, bfr, oc, 0, 0, 0); }
            if (!isctx || G.need_ctx) {
                const int row = row0 + 32 * tt + r;
                bf16* op = dir ? G.OB + (size_t)row * 512 + 128 * h : G.Y + (size_t)row * 2048 + 1024 + 128 * h;
#pragma unroll
                for (int i4 = 0; i4 < 4; ++i4) { u32x2 w; w.x = pk2(oc[4 * i4], oc[4 * i4 + 1]); w.y = pk2(oc[4 * i4 + 2], oc[4 * i4 + 3]); *(u32x2*)(op + 32 * et + 8 * i4 + 4 * hh) = w; }
            }
        }
        {
            const int dt = wave & 1;
            const float dl = ((const LAS float*)(lds + O_DL))[32 * dt + r];
#pragma unroll
            for (int i = 0; i < 16; ++i) sacc[i] *= dl;
#pragma unroll
            for (int kk = 0; kk < 4; ++kk) { const bf16x8 af = *(const LAS bf16x8*)(lds + O_VT + (32 * et + r) * RS + (16 * kk + 8 * hh) * 2), bfr = *(const LAS bf16x8*)(lds + O_KH + (32 * dt + r) * RS + (16 * kk + 8 * hh) * 2);
                sacc = __builtin_amdgcn_mfma_f32_32x32x16_bf16(af, bfr, sacc, 0, 0, 0); }
            __syncthreads();
#pragma unroll
            for (int i = 0; i < 16; ++i) { const int e = 32 * et + (i & 3) + 8 * (i >> 2) + 4 * hh; *(LAS bf16*)(lds + O_ST + e * RS + (32 * dt + r) * 2) = (bf16)f2bf(sacc[i]); }
        }
    }
#undef GLA_LOAD
#undef GLA_ROWS
    __syncthreads();
}

__device__ __forceinline__ void attn_phase(const Args& a, int l, int g, LAS unsigned char* lds) {
    unsigned char* ws = a.ws;
    const bf16* P = (const bf16*)(ws + WS_P); const bf16* QA = (const bf16*)(ws + WS_QA); const bf16* KA = (const bf16*)(ws + WS_KA);
    bf16* Y = (bf16*)(ws + WS_Y);
    const int need_ctx = (l == 0);
    const int N_GLA = 32, N_A = 256, N_D = 256, N_B = 512, N_AC = need_ctx ? 32 : 0, N_DC = N_AC, N_BC = need_ctx ? 64 : 0;
    const int total = N_GLA + N_A + N_D + N_B + N_AC + N_DC + N_BC;
    unsigned* ctr = (unsigned*)(ws + WS_CTL) + (l * 2 + g) * 64;
    volatile LAS int* slot = (volatile LAS int*)(lds + LDS_BYTES - 16);
    for (;;) {
        __syncthreads();
        if (threadIdx.x == 0) *slot = (int)__hip_atomic_fetch_add(ctr, 1u, __ATOMIC_RELAXED, __HIP_MEMORY_SCOPE_AGENT);
        __syncthreads();
        int idx = *slot;
        idx = __builtin_amdgcn_readfirstlane(idx);
        if (idx >= total) break;
        if (idx < N_GLA) {
            GlaArgs G; G.P = P; G.VtC = (const bf16*)(ws + WS_VTC); G.Y = Y; G.OB = (bf16*)(ws + WS_MG);
            G.bl = idx >> 3; G.h = (idx >> 1) & 3; G.dir = idx & 1; G.need_ctx = need_ctx;
            G.wd = a.in[I_GWD] + ((size_t)l * 2 + G.dir) * 16 * 256; G.bd = a.in[I_GBD] + ((size_t)l * 2 + G.dir) * 256;
            gla_unit(lds, G); continue; }
        idx -= N_GLA;
        AttnArgs A; A.sink_l2 = 0.f; A.qnw = nullptr; A.band_first = 0;
        if (idx < N_A || (idx >= N_A + N_D + N_B && idx < N_A + N_D + N_B + N_AC)) {
            int bl, h, row, ctxq;
            if (idx < N_A) { bl = idx >> 6; h = (idx >> 4) & 3; const int qb = idx & 15; row = bl * SEQ + 128 * qb; A.qpos0 = 128 * qb; A.ntile = 18; ctxq = 0; }
            else { const int j = idx - (N_A + N_D + N_B); bl = j >> 3; h = (j >> 1) & 3; const int qb = j & 1; row = LAT_ROWS + bl * CTXL + 128 * qb; A.qpos0 = -1; A.ntile = 2; ctxq = 1; }
            (void)ctxq;
            A.Q = QA + (size_t)row * 768 + 192 * h; A.qpitch = 768;
            A.Kc = KA + (size_t)(bl * 4 + h) * KEYS * 192; A.Kl = A.Kc + (size_t)CTXL * 192; A.kpitch = 192;
            A.Vt = (const bf16*)(ws + WS_VTA) + (size_t)(bl * 4 + h) * 128 * KEYS;
            A.O = Y + (size_t)row * 2048 + 128 * h; A.opitch = 2048;
            attn_unit<192, 128, 0>(lds, A); continue; }
        if ((idx >= N_A && idx < N_A + N_D) || (idx >= N_A + N_D + N_B + N_AC && idx < N_A + N_D + N_B + N_AC + N_DC)) {
            int bl, h, row;
            if (idx < N_A + N_D) { const int j = idx - N_A; bl = j >> 6; h = (j >> 4) & 3; const int qb = j & 15; row = bl * SEQ + 128 * qb; A.qpos0 = 128 * qb; A.ntile = 18; }
            else { const int j = idx - (N_A + N_D + N_B + N_AC); bl = j >> 3; h = (j >> 1) & 3; const int qb = j & 1; row = LAT_ROWS + bl * CTXL + 128 * qb; A.qpos0 = -1; A.ntile = 2; }
            const int kvh = h >> 1;
            A.Q = P + (size_t)row * PC + PC_QD + 128 * h; A.qpitch = PC;
            A.Kc = P + (size_t)(LAT_ROWS + bl * CTXL) * PC + PC_KD + 128 * kvh; A.Kl = P + (size_t)(bl * SEQ) * PC + PC_KD + 128 * kvh; A.kpitch = PC;
            A.Vt = (const bf16*)(ws + WS_VTD) + (size_t)(bl * 2 + kvh) * 128 * KEYS;
            A.O = Y + (size_t)row * 2048 + 1536 + 128 * h; A.opitch = 2048; A.qnw = a.in[I_QNW] + l * 128;
            attn_unit<128, 128, 2>(lds, A); continue; }
        {
            int bl, h, row;
            if (idx < N_A + N_D + N_B) { const int j = idx - (N_A + N_D); bl = j >> 7; h = (j >> 4) & 7; const int qb = j & 15; row = bl * SEQ + 128 * qb; A.qpos0 = 128 * qb;
                const int first = qb >= 1 ? qb - 1 : 0, last = qb + 1 < 16 ? qb + 1 : 15; A.band_first = first; A.ntile = 2 + (last - first + 1); }
            else { const int j = idx - (N_A + N_D + N_B + N_AC + N_DC); bl = j >> 4; h = (j >> 1) & 7; const int qb = j & 1; row = LAT_ROWS + bl * CTXL + 128 * qb; A.qpos0 = -1; A.ntile = 2; }
            const int kvh = h >> 2;
            A.Q = P + (size_t)row * PC + PC_QB + 64 * h; A.qpitch = PC;
            A.Kc = P + (size_t)(LAT_ROWS + bl * CTXL) * PC + PC_KB + 64 * kvh; A.Kl = P + (size_t)(bl * SEQ) * PC + PC_KB + 64 * kvh; A.kpitch = PC;
            A.Vt = (const bf16*)(ws + WS_VTB) + (size_t)(bl * 2 + kvh) * 64 * KEYS;
            A.O = Y + (size_t)row * 2048 + 512 + 64 * h; A.opitch = 2048; A.sink_l2 = a.in[I_SINK][l * 8 + h] * 1.4426950408889634f;
            attn_unit<64, 64, 1>(lds, A); }
    }
}


#define XB_TMO      128
#define XB_XCNT(j)  (256  + 64 * (j))
#define XB_XSUB(j)  (1280 + 64 * (j))
#define XB_XGEN(j)  (2304 + 64 * (j))
#define XB_TOP      3328
#define XB_TOPGEN   3392
#define XCD_BAR_WORDS 3456
#define XB_SPIN_CAP (1u << 22)
__device__ __forceinline__ unsigned xb_ld(unsigned* p)              { return __hip_atomic_load(p, __ATOMIC_RELAXED, __HIP_MEMORY_SCOPE_AGENT); }
__device__ __forceinline__ unsigned xb_add(unsigned* p, unsigned v) { return __hip_atomic_fetch_add(p, v, __ATOMIC_RELAXED, __HIP_MEMORY_SCOPE_AGENT); }
__device__ __forceinline__ unsigned xb_xcc_id() { return (unsigned)__builtin_amdgcn_s_getreg((3 << 11) | 20) & 0xFu; }
#define XB_SPIN(cond, bar) do { unsigned _sp = 0; while (cond) { __builtin_amdgcn_s_sleep(1); \
    if ((++_sp & 255u) == 0u) { if (xb_ld(&(bar)[XB_TMO])) break; if (_sp > XB_SPIN_CAP) { atomicAdd(&(bar)[XB_TMO], 1u); break; } } } } while (0)
struct XcdBarrier { unsigned* bar; unsigned x; volatile LAS unsigned* st; };
__device__ __forceinline__ XcdBarrier xcd_barrier_post(unsigned* bar, volatile LAS unsigned* st) {
    XcdBarrier b; b.bar = bar; b.x = xb_xcc_id(); b.st = st;
    if (threadIdx.x == 0) (void)xb_add(&bar[XB_XCNT(b.x)], 1u);
    return b;
}
__device__ __forceinline__ void xcd_barrier_complete(unsigned* bar, unsigned x, unsigned& nloc, unsigned& nx) {
    const unsigned G = gridDim.x * gridDim.y * gridDim.z;
    unsigned sum, cnt, mine, sp = 0u;
    for (;;) {
        sum = 0u; cnt = 0u; mine = 0u;
#pragma unroll
        for (unsigned j = 0; j < 16; ++j) { const unsigned c = xb_ld(&bar[XB_XCNT(j)]); sum += c; cnt += (c > 0u) ? 1u : 0u; mine = (j == x) ? c : mine; }
        if (sum == G) break;
        __builtin_amdgcn_s_sleep(1);
        if ((++sp & 255u) == 0u) { if (xb_ld(&bar[XB_TMO])) break; if (sp > XB_SPIN_CAP) { atomicAdd(&bar[XB_TMO], 1u); break; } }
    }
    nloc = mine > 0u ? mine : 1u; nx = cnt > 0u ? cnt : 1u;
}
__device__ __forceinline__ void xcd_barrier(const XcdBarrier& b) {
    asm volatile("s_waitcnt vmcnt(0)" ::: "memory");
    __syncthreads();
    if (threadIdx.x == 0) {
        unsigned* bar = b.bar;
        __builtin_amdgcn_s_waitcnt(0);
        unsigned nloc = b.st[0], nx = b.st[1];
        if (nloc == 0u) { xcd_barrier_complete(bar, b.x, nloc, nx); b.st[0] = nloc; b.st[1] = nx; }
        const unsigned old = xb_add(&bar[XB_XSUB(b.x)], 1u);
        const unsigned gen = old / nloc;
        if (old + 1u == (gen + 1u) * nloc) {
            __builtin_amdgcn_fence(__ATOMIC_RELEASE, "agent");
            asm volatile("s_waitcnt vmcnt(0)" ::: "memory");
            const unsigned og = xb_add(&bar[XB_TOP], 1u);
            const unsigned tg = og / nx;
            if (og + 1u == (tg + 1u) * nx) xb_add(&bar[XB_TOPGEN], 1u);
            else XB_SPIN(xb_ld(&bar[XB_TOPGEN]) == tg, bar);
            __builtin_amdgcn_fence(__ATOMIC_ACQUIRE, "agent");
            xb_add(&bar[XB_XGEN(b.x)], 1u);
            asm volatile("s_waitcnt vmcnt(0)" ::: "memory");
        } else {
            XB_SPIN(xb_ld(&bar[XB_XGEN(b.x)]) == gen, bar);
            __builtin_amdgcn_fence(__ATOMIC_ACQUIRE, "agent");
            asm volatile("s_waitcnt vmcnt(0)" ::: "memory");
        }
    }
    __syncthreads();
}
constexpr int CW_BAR = 4096;

#ifndef MK_CG_FIRST
#define MK_CG_FIRST 1
#endif
constexpr int N_PHASES = 50;
template <bool COOP>
__global__ void __launch_bounds__(512, 2) mk_fwd(Args args) {
    extern __shared__ __attribute__((aligned(16))) unsigned char lds_raw[];
    LAS unsigned char* lds = (LAS unsigned char*)lds_raw;
    unsigned char* ws = args.ws; unsigned char* wt = ws + WS_WT;
    const int G = gridDim.x, bx = blockIdx.x;
    volatile LAS unsigned* misc = (volatile LAS unsigned*)(lds + LDS_BYTES - 32);
    XcdBarrier bar; bar.bar = nullptr; bar.x = 0; bar.st = misc;
    if (COOP) { if (threadIdx.x < 2) misc[threadIdx.x] = 0u; __syncthreads(); bar = xcd_barrier_post((unsigned*)(ws + WS_CTL) + CW_BAR, misc); }
    for (int p = args.ph_lo; p < args.ph_hi; ++p) {
        if (COOP) { if (p == args.ph_lo + 1 && MK_CG_FIRST) cg::this_grid().sync(); else if (p > args.ph_lo) xcd_barrier(bar); }
        if (p == 0) { prep_weights(args, 0, lds); prep_mods(args, lds); continue; }
        if (p == N_PHASES - 1) { final_norm_rows(args); continue; }
        const int q = p - 1, lg = q / 12, k = q - lg * 12, l = lg >> 1, g = lg & 1;
        const int nM = (l == 1) ? 32 : 36;
        pg8::StaticOrder S;
        switch (k) {
        case 0: if (l == 1 && g == 0) prep_weights(args, 1, lds); norm_mod_rows(args, l, g, MG_ROWS, 0); break;
        case 1: { pg8::Gemm gm{(const bf16*)(ws + WS_H), (const bf16*)(wt + WT_WIN), 1024, 1024, 1024, 0, 0}; S.init(36, 15, G, bx);
            EpiInProj E{(bf16*)(ws + WS_P), (bf16*)(ws + WS_VTB), (bf16*)(ws + WS_VTC), (bf16*)(ws + WS_VTD)}; pg8::gemm_phase(lds, gm, S, E); break; }
        case 2: post_rows(args, l); break;
        case 3: { pg8::Gemm gm{(const bf16*)(ws + WS_CN), (const bf16*)(wt + WT_WMLA), 384, 384, 384, 0, 0}; S.init(36, 7, G, bx);
            EpiMla E{(bf16*)(ws + WS_QA), (bf16*)(ws + WS_KA), (bf16*)(ws + WS_VTA)}; pg8::gemm_phase(lds, gm, S, E); break; }
        case 4: attn_phase(args, l, g, lds); break;
        case 5: comb_rows(args, l, nM * 256); break;
        case 6: { pg8::Gemm gm{(const bf16*)(ws + WS_Y), (const bf16*)(wt + WT_WB), 2048, 512, 512, 4, 512}; S.init(nM, 16, G, bx);
            EpiStore<0> E{(bf16*)(ws + WS_Z), 4096}; pg8::gemm_phase(lds, gm, S, E); break; }
        case 7: { pg8::Gemm gm{(const bf16*)(ws + WS_H), (const bf16*)(wt + WT_WIN) + (size_t)PC * 1024, 1024, 1024, 1024, 0, 0}; S.init(nM, 16, G, bx);
            EpiMerge E{(const bf16*)(ws + WS_Z), (bf16*)(ws + WS_MG)}; pg8::gemm_phase(lds, gm, S, E); break; }
        case 8: { pg8::Gemm gm{(const bf16*)(ws + WS_MG), (const bf16*)(wt + WT_WO), 1024, 1024, 1024, 0, 0}; S.init(nM, 4, G, bx);
            EpiResid E{&args, l, g, 2, false}; pg8::gemm_phase(lds, gm, S, E); break; }
        case 9: norm_mod_rows(args, l, g, nM * 256, 1); break;
        case 10: { pg8::Gemm gm{(const bf16*)(ws + WS_H), (const bf16*)(wt + WT_W1), 1024, 1024, 1024, 0, 0}; S.init(nM, 16, G, bx);
            EpiStore<1> E{(bf16*)(ws + WS_Z), 4096}; pg8::gemm_phase(lds, gm, S, E); break; }
        default: { pg8::Gemm gm{(const bf16*)(ws + WS_Z), (const bf16*)(wt + WT_W2), 4096, 4096, 4096, 0, 0}; S.init(nM, 4, G, bx);
            EpiResid E{&args, l, g, 5, true}; pg8::gemm_phase(lds, gm, S, E); break; }
        }
    }
}

#ifndef MK_PER_PHASE
#define MK_PER_PHASE 0
#endif
extern "C" void kernel_launch(void* const* d_in, const int* in_sizes, int n_in, void* d_out, int out_size, void* d_ws, size_t ws_size, hipStream_t stream) {
    static int grid = 0;
    if (grid == 0) {
        if (n_in != 24 || out_size != NB * SEQ * DM || ws_size < WS_END) { fprintf(stderr, "kernel_launch: unexpected shapes (n_in %d out %d ws %zu)\n", n_in, out_size, ws_size); grid = -1; return; }
        int dev = 0, cus = 0, per_cu = 0;
        hipGetDevice(&dev); hipDeviceGetAttribute(&cus, hipDeviceAttributeMultiprocessorCount, dev);
        hipFuncSetAttribute((const void*)mk_fwd<true>, hipFuncAttributeMaxDynamicSharedMemorySize, LDS_BYTES);
        hipFuncSetAttribute((const void*)mk_fwd<false>, hipFuncAttributeMaxDynamicSharedMemorySize, LDS_BYTES);
        hipOccupancyMaxActiveBlocksPerMultiprocessor(&per_cu, (const void*)mk_fwd<true>, 512, LDS_BYTES);
        if (per_cu < 1) { fprintf(stderr, "kernel_launch: occupancy query says %d blocks per CU\n", per_cu); per_cu = 1; }
        (void)hipGetLastError();
        grid = cus;
    }
    if (grid < 0) return;
    hipMemsetAsync((char*)d_ws + WS_CTL, 0, 32768, stream);
    Args a{};
    for (int i = 0; i < 24; ++i) a.in[i] = (const float*)d_in[i];
    a.out = (float*)d_out; a.ws = (unsigned char*)d_ws;
#if MK_PER_PHASE
    for (int p = 0; p < N_PHASES; ++p) { a.ph_lo = p; a.ph_hi = p + 1; hipLaunchKernelGGL(mk_fwd<false>, dim3(grid), dim3(512), LDS_BYTES, stream, a); }
#else
    a.ph_lo = 0; a.ph_hi = N_PHASES;
    void* kargs[] = {&a};
    hipError_t e = hipLaunchCooperativeKernel((const void*)mk_fwd<true>, dim3(grid), dim3(512), kargs, LDS_BYTES, stream);
    if (e != hipSuccess) fprintf(stderr, "cooperative launch failed: %s (grid %d)\n", hipGetErrorString(e), grid);
#endif
}
```

```cpp
#include <hip/hip_runtime.h>
#include <hip/hip_cooperative_groups.h>
#include <cstdio>
#include <cstdint>
namespace cg = cooperative_groups;

#define LAS __attribute__((address_space(3)))
typedef unsigned short bf16;
typedef short bf16x8 __attribute__((ext_vector_type(8)));
typedef float f32x4 __attribute__((ext_vector_type(4)));
typedef float f32x16 __attribute__((ext_vector_type(16)));
typedef unsigned u32x4 __attribute__((ext_vector_type(4)));
typedef unsigned u32x2 __attribute__((ext_vector_type(2)));

constexpr int DM = 1024, NB = 8, SEQ = 2048, CTXL = 256, GB = 4, NGRP = 2;
constexpr int MG_ROWS = GB * (SEQ + CTXL);
constexpr int LAT_ROWS = GB * SEQ;
constexpr int KEYS = CTXL + SEQ;
constexpr int IN_COLS = 7904, PC = 3840;
constexpr int WIN_N = 7936;
constexpr float EPS = 1e-6f;
constexpr int PC_CQ = 0, PC_CKV = 256, PC_KR = 384, PC_QB = 448, PC_KB = 960, PC_VB = 1088, PC_QC = 1216, PC_KC = 1472, PC_VC = 1728, PC_RC = 2240,
              PC_LRF = 2752, PC_QD = 2784, PC_KD = 3296, PC_VD = 3552, PC_GATE = 3808;
constexpr size_t MiB = 1u << 20;
constexpr size_t WS_CTL = 0, CTL_BYTES = 1 * MiB;
constexpr size_t WS_MOD = 1 * MiB;
constexpr size_t WS_WT = 2 * MiB;
constexpr size_t WT_WIN = 0, WT_WMLA = WT_WIN + (size_t)WIN_N * 1024 * 2, WT_WB = WT_WMLA + (size_t)1792 * 384 * 2, WT_WO = WT_WB + (size_t)4096 * 512 * 2,
                 WT_W1 = WT_WO + (size_t)1024 * 1024 * 2, WT_W2 = WT_W1 + (size_t)4096 * 1024 * 2, WT_END = WT_W2 + (size_t)1024 * 4096 * 2;
static_assert(WT_END <= 40 * MiB, "weights");
constexpr size_t WS_XC1 = 42 * MiB;
constexpr size_t WS_H = 50 * MiB;
constexpr size_t WS_MG = 68 * MiB;
constexpr size_t WS_Y = 86 * MiB;
constexpr size_t WS_P = 122 * MiB;
constexpr size_t WS_CN = WS_P + (size_t)MG_ROWS * PC * 2;
constexpr size_t WS_QA = WS_CN + (size_t)MG_ROWS * 384 * 2;
constexpr size_t WS_KA = WS_QA + (size_t)MG_ROWS * 768 * 2;
constexpr size_t WS_VTA = WS_KA + (size_t)GB * 4 * KEYS * 192 * 2;
constexpr size_t WS_VTB = WS_VTA + (size_t)GB * 4 * 128 * KEYS * 2;
constexpr size_t WS_VTC = WS_VTB + (size_t)GB * 2 * 64 * KEYS * 2;
constexpr size_t WS_VTD = WS_VTC + (size_t)GB * 4 * 128 * KEYS * 2;
constexpr size_t WS_END = WS_VTD + (size_t)GB * 2 * 128 * KEYS * 2;
constexpr size_t WS_Z = WS_P;
static_assert(WS_Z + (size_t)MG_ROWS * 4096 * 2 <= WS_QA, "Z overlay must stay inside P|CN");
static_assert(WS_END <= 248 * MiB, "workspace");
constexpr int LDS_BYTES = 147456;

__device__ __forceinline__ unsigned f2bf(float f) { unsigned u = __builtin_bit_cast(unsigned, f); return (u + 0x7fffu + ((u >> 16) & 1u)) >> 16; }
typedef float f32x2_t __attribute__((ext_vector_type(2))); typedef __bf16 bf16x2_t __attribute__((ext_vector_type(2)));
__device__ __forceinline__ unsigned pk2(float lo, float hi) { f32x2_t v = {lo, hi}; bf16x2_t b = __builtin_convertvector(v, bf16x2_t); return __builtin_bit_cast(unsigned, b); }
__device__ __forceinline__ float bf2f(unsigned short b) { return __builtin_bit_cast(float, (unsigned)b << 16); }
__device__ __forceinline__ float bflo(unsigned w) { return __builtin_bit_cast(float, w << 16); }
__device__ __forceinline__ float bfhi(unsigned w) { return __builtin_bit_cast(float, w & 0xffff0000u); }
__device__ __forceinline__ float wave_sum(float v) {
#pragma unroll
    for (int o = 1; o < 64; o <<= 1) v += __shfl_xor(v, o);
    return v;
}
__device__ __forceinline__ int tidx() { int t = threadIdx.x; asm volatile("" : "+v"(t)); return t; }
__device__ __forceinline__ float sigmoidf_(float x) { return 1.f / (1.f + __expf(-x)); }
__device__ __forceinline__ float siluf_(float x) { return x / (1.f + __expf(-x)); }

namespace pg8 {
constexpr int BM = 256, BK = 64, HALF = 128, HTB = HALF * BK * 2, STAGE_BYTES = 8 * HTB, NXCD = 8, WGM = 8;
__host__ __device__ __forceinline__ int lds_byte(int r, int c) { const int st = (r >> 4) * 2 + (c >> 5), rr = r & 15, cc = c & 31, ob = rr * 64 + cc * 2; return st * 1024 + (ob ^ (((ob >> 9) & 1) << 5)); }
__host__ __device__ __forceinline__ void stage_rc(int b, int& R, int& C) { const int st = b / 1024, sb = b % 1024, swz = sb ^ (((sb >> 9) & 1) << 5); R = (st >> 1) * 16 + swz / 64; C = (st & 1) * 32 + (swz % 64) / 2; }
__host__ __device__ __forceinline__ int perm32(int rho) { const int n = rho >> 4, i = rho & 15; return 8 * (i >> 2) + 4 * n + (i & 3); }

struct Unit { int pm, pn; };
struct Gemm { const bf16* A; const bf16* Bt; int lda, ldb, K; int adiv, amul; };

struct StaticOrder {
    int nM, nN, nwg, G, c;
    __device__ void init(int nM_, int nN_, int G_, int c_) { nM = nM_; nN = nN_; nwg = nM * nN; G = G_; c = c_; }
    __device__ bool next(int i, Unit& u) const {
        const long L = (long)i * G + c; if (L >= nwg) return false;
        int wgid = (int)L; { const int q = nwg / NXCD, r = nwg % NXCD, xcd = wgid % NXCD, off = wgid / NXCD; wgid = (xcd < r ? xcd * (q + 1) : r * (q + 1) + (xcd - r) * q) + off; }
        const int nig = WGM * nN, gid = wgid / nig, fm = gid * WGM, gsz = (nM - fm) < WGM ? (nM - fm) : WGM;
        u.pm = fm + ((wgid % nig) % gsz); u.pn = (wgid % nig) / gsz; return true;
    }
};
template <class Epi>
__device__ __forceinline__ void gemm_phase(LAS unsigned char* lds, const Gemm g, const StaticOrder& S, const Epi& E) {
    const int tid = tidx(), wid = __builtin_amdgcn_readfirstlane(tid >> 6), lane = tid & 63, wr = wid >> 2, wc = wid & 3, fr = lane & 15, fq = lane >> 4;
    const int K = g.K, nt = K / BK;
    unsigned voffA[2], voffB[2];
#pragma unroll
    for (int i = 0; i < 2; ++i) { int R, C; stage_rc(tid * 16 + i * 8192, R, C); const int Rb = (R & ~31) + perm32(R & 31);
        voffA[i] = (unsigned)(R * g.lda + C) * 2u; voffB[i] = (unsigned)(Rb * g.ldb + C) * 2u; }
    const size_t kstep = (size_t)(BK * 2);
    const size_t hstepA = (size_t)HALF * g.lda * 2, hstepB = (size_t)HALF * g.ldb * 2;
    const size_t tstepA = 2 * hstepA, tstepB = 2 * hstepB;
    const unsigned ldsw = (unsigned)wid * 1024u;
    const int aoff = lds_byte(wr * 64 + fr, fq * 8), boff = lds_byte(wc * 32 + fr, fq * 8);
#define PG8_SA(b, h) (((b) * 2 + (h)) * HTB)
#define PG8_SB(b, h) ((4 + (b) * 2 + (h)) * HTB)
#define PG8_STAGE(bufoff, gbase, voff) do { _Pragma("unroll") for (int _i = 0; _i < 2; ++_i) \
        __builtin_amdgcn_global_load_lds((const unsigned*)((const char*)(gbase) + (voff)[_i]), (LAS unsigned*)(lds + (bufoff) + ldsw + _i * 8192), 16, 0, 0); } while (0)
#define PG8_LDA(dst, b, h) do { _Pragma("unroll") for (int m = 0; m < 4; ++m) _Pragma("unroll") for (int k = 0; k < 2; ++k) dst[m][k] = *(const LAS bf16x8*)(lds + PG8_SA(b, h) + aoff + m * 2048 + k * 1024); } while (0)
#define PG8_LDB(dst, b, h) do { _Pragma("unroll") for (int n = 0; n < 2; ++n) _Pragma("unroll") for (int k = 0; k < 2; ++k) dst[n][k] = *(const LAS bf16x8*)(lds + PG8_SB(b, h) + boff + n * 2048 + k * 1024); } while (0)
#define PG8_MMA(ai, bj, At, Bt) do { __builtin_amdgcn_s_setprio(1); _Pragma("unroll") for (int m = 0; m < 4; ++m) _Pragma("unroll") for (int n = 0; n < 2; ++n) _Pragma("unroll") for (int k = 0; k < 2; ++k) \
        acc[ai][bj][m][n] = __builtin_amdgcn_mfma_f32_16x16x32_bf16(Bt[n][k], At[m][k], acc[ai][bj][m][n], 0, 0, 0); __builtin_amdgcn_s_setprio(0); } while (0)
#define PG8_WAIT_V(n) asm volatile("s_waitcnt vmcnt(" #n ")" ::: "memory")
#define PG8_WAIT_L(n) asm volatile("s_waitcnt lgkmcnt(" #n ")" ::: "memory")
#define PG8_BAR __builtin_amdgcn_s_barrier()
#define PG8_SCHED __builtin_amdgcn_sched_barrier(0)
#define PG8_AOFF(u) ((size_t)(g.adiv ? ((u).pn / g.adiv) * g.amul * 2 : 0))
    Unit cur, nxt; int ui = 0;
    if (!S.next(0, cur)) return;
    f32x4 acc[2][2][4][2];
#pragma unroll
    for (int a = 0; a < 2; ++a)
#pragma unroll
        for (int b = 0; b < 2; ++b)
#pragma unroll
            for (int m = 0; m < 4; ++m)
#pragma unroll
                for (int n = 0; n < 2; ++n) acc[a][b][m][n] = (f32x4){0.f, 0.f, 0.f, 0.f};
    bf16x8 At[4][2], B0[2][2], B1[2][2];
    const char* cA = (const char*)g.A + (size_t)cur.pm * tstepA + PG8_AOFF(cur); const char* cB = (const char*)g.Bt + (size_t)cur.pn * tstepB;
    PG8_STAGE(PG8_SB(0, 0), cB, voffB); PG8_STAGE(PG8_SB(0, 1), cB + hstepB, voffB); PG8_STAGE(PG8_SA(0, 0), cA, voffA); PG8_STAGE(PG8_SA(0, 1), cA + hstepA, voffA);
    if (wr == 1) PG8_BAR;
    PG8_WAIT_V(2); PG8_BAR;
    PG8_STAGE(PG8_SB(1, 0), cB + kstep, voffB); PG8_STAGE(PG8_SA(1, 0), cA + kstep, voffA); PG8_STAGE(PG8_SB(1, 1), cB + hstepB + kstep, voffB);
    PG8_WAIT_V(6); PG8_BAR;
    for (;;) {
        const bool has_next = S.next(ui + 1, nxt);
        const char* nA = has_next ? (const char*)g.A + (size_t)nxt.pm * tstepA + PG8_AOFF(nxt) : cA; const char* nB = has_next ? (const char*)g.Bt + (size_t)nxt.pn * tstepB : cB;
#pragma unroll 1
        for (int t = 0; t < nt; t += 2) {
            const bool last = (t == nt - 2);
            const char* a1 = cA + (size_t)(t + 1) * kstep;
            const char* a2 = last ? nA : cA + (size_t)(t + 2) * kstep; const char* b2 = last ? nB : cB + (size_t)(t + 2) * kstep;
            const char* a3 = a2 + kstep; const char* b3 = b2 + kstep;
            PG8_LDB(B0, 0, 0); PG8_LDB(B1, 0, 1); PG8_SCHED; PG8_LDA(At, 0, 0); PG8_STAGE(PG8_SA(1, 1), a1 + hstepA, voffA);
            PG8_WAIT_V(8); PG8_WAIT_L(0); PG8_BAR; PG8_MMA(0, 0, At, B0); PG8_MMA(0, 1, At, B1); PG8_BAR; PG8_SCHED;
            PG8_LDA(At, 0, 1); PG8_STAGE(PG8_SB(0, 0), b2, voffB); PG8_STAGE(PG8_SB(0, 1), b2 + hstepB, voffB); PG8_STAGE(PG8_SA(0, 0), a2, voffA);
            PG8_WAIT_V(8); PG8_WAIT_L(0); PG8_BAR; PG8_MMA(1, 0, At, B0); PG8_MMA(1, 1, At, B1); PG8_BAR; PG8_SCHED;
            PG8_LDB(B0, 1, 0); PG8_LDB(B1, 1, 1); PG8_SCHED; PG8_LDA(At, 1, 0); PG8_STAGE(PG8_SA(0, 1), a2 + hstepA, voffA);
            PG8_WAIT_V(8); PG8_WAIT_L(0); PG8_BAR; PG8_MMA(0, 0, At, B0); PG8_MMA(0, 1, At, B1); PG8_BAR; PG8_SCHED;
            PG8_LDA(At, 1, 1); PG8_STAGE(PG8_SB(1, 0), b3, voffB); PG8_STAGE(PG8_SB(1, 1), b3 + hstepB, voffB); PG8_STAGE(PG8_SA(1, 0), a3, voffA);
            PG8_WAIT_V(8); PG8_WAIT_L(0); PG8_BAR; PG8_MMA(1, 0, At, B0); PG8_MMA(1, 1, At, B1); PG8_BAR; PG8_SCHED;
        }
        if (wr == 0) PG8_BAR;
        E(acc, cur, wr, wc, fr, fq);
        if (!has_next) break;
#pragma unroll
        for (int a = 0; a < 2; ++a)
#pragma unroll
            for (int b = 0; b < 2; ++b)
#pragma unroll
                for (int m = 0; m < 4; ++m)
#pragma unroll
                    for (int n = 0; n < 2; ++n) acc[a][b][m][n] = (f32x4){0.f, 0.f, 0.f, 0.f};
        cur = nxt; cA = nA; cB = nB; ++ui;
        if (wr == 1) PG8_BAR;
    }
    PG8_WAIT_V(0);
    PG8_BAR;
#undef PG8_SA
#undef PG8_SB
#undef PG8_STAGE
#undef PG8_LDA
#undef PG8_LDB
#undef PG8_MMA
#undef PG8_WAIT_V
#undef PG8_WAIT_L
#undef PG8_BAR
#undef PG8_SCHED
#undef PG8_AOFF
}
}

struct Args {
    const float* in[24];
    float* out; unsigned char* ws;
    int ph_lo, ph_hi;
};
enum { I_X = 0, I_C, I_CTX, I_CCTX, I_ADAW, I_ADAB, I_N1W, I_N2W, I_WIN, I_MQNW, I_MWUQ, I_MKVNW, I_MWUKV, I_SINK, I_GWD, I_GBD, I_GNW, I_QNW, I_KNW, I_WBR, I_WO, I_W1, I_W2, I_FNW };

struct Ctx {
    const Args* a; unsigned char* ws; int l, g;
};
__device__ __forceinline__ const float* xrow_src(const Args& a, int l, int g, int r) {
    if (r < LAT_ROWS) { const size_t gr = (size_t)(g * GB) * SEQ + r; return (l == 0 ? a.in[I_X] : a.out) + gr * DM; }
    const size_t cr = (size_t)(g * GB) * CTXL + (r - LAT_ROWS); return (l == 0 ? a.in[I_CTX] : (const float*)(a.ws + WS_XC1)) + cr * DM;
}
__device__ __forceinline__ float* xrow_dst(const Args& a, int g, int r) {
    if (r < LAT_ROWS) { const size_t gr = (size_t)(g * GB) * SEQ + r; return a.out + gr * DM; }
    const size_t cr = (size_t)(g * GB) * CTXL + (r - LAT_ROWS); return (float*)(a.ws + WS_XC1) + cr * DM;
}
__device__ __forceinline__ int row_bi(int g, int r) { return r < LAT_ROWS ? g * GB + (r >> 11) : 8; }
__device__ __forceinline__ void row_blk(int r, int& bl, int& kap) { if (r < LAT_ROWS) { bl = r >> 11; kap = CTXL + (r & 2047); } else { bl = (r - LAT_ROWS) >> 8; kap = (r - LAT_ROWS) & 255; } }

using pg8::Unit;
__device__ __forceinline__ u32x4 pack8(const f32x4 v0, const f32x4 v1) { u32x4 w; w.x = pk2(v0[0], v0[1]); w.y = pk2(v0[2], v0[3]); w.z = pk2(v1[0], v1[1]); w.w = pk2(v1[2], v1[3]); return w; }

template <int ACT> struct EpiStore {
    bf16* O; int ldc;
    __device__ __forceinline__ void operator()(const f32x4 (&acc)[2][2][4][2], const Unit& u, int wr, int wc, int fr, int fq) const {
        const int row0 = u.pm * 256 + wr * 64 + fr, col0 = u.pn * 256 + wc * 32 + 8 * fq;
#pragma unroll
        for (int ai = 0; ai < 2; ++ai)
#pragma unroll
            for (int m = 0; m < 4; ++m) { bf16* rowp = O + (size_t)(row0 + ai * 128 + m * 16) * ldc + col0;
#pragma unroll
                for (int bj = 0; bj < 2; ++bj) { f32x4 v0 = acc[ai][bj][m][0], v1 = acc[ai][bj][m][1];
                    if (ACT == 1) {
#pragma unroll
                        for (int j = 0; j < 4; ++j) { const float a = fmaxf(v0[j], 0.f), b = fmaxf(v1[j], 0.f); v0[j] = a * a; v1[j] = b * b; } }
                    *(u32x4*)(rowp + bj * 128) = pack8(v0, v1); } }
    }
};
__device__ __forceinline__ void store_vt(const f32x4 (&acc)[2][2][4][2], int bj, bf16* vt, int nheads, int dv, int colbase  , int pm, int wr, int fr, int fq) {
    int bl, kap0; row_blk(pm * 256, bl, kap0);
    const int c0 = colbase + 8 * fq, head = c0 / dv, e0 = c0 - head * dv;
    bf16* vp = vt + ((size_t)(bl * nheads + head) * dv + e0) * KEYS + kap0 + wr * 64 + fr;
#pragma unroll
    for (int ai = 0; ai < 2; ++ai)
#pragma unroll
        for (int m = 0; m < 4; ++m)
#pragma unroll
            for (int n = 0; n < 2; ++n)
#pragma unroll
                for (int j = 0; j < 4; ++j) vp[(size_t)(4 * n + j) * KEYS + ai * 128 + m * 16] = (bf16)f2bf(acc[ai][bj][m][n][j]);
}
struct EpiInProj {
    bf16* P; bf16 *vtb, *vtc, *vtd;
    __device__ __forceinline__ void operator()(const f32x4 (&acc)[2][2][4][2], const Unit& u, int wr, int wc, int fr, int fq) const {
        const int row0 = u.pm * 256 + wr * 64 + fr;
#pragma unroll
        for (int bj = 0; bj < 2; ++bj) {
            const int cg = u.pn * 256 + bj * 128 + wc * 32;
            if (cg >= PC_VB && cg < PC_QC) store_vt(acc, bj, vtb, 2, 64, cg - PC_VB, u.pm, wr, fr, fq);
            else if (cg >= PC_VC && cg < PC_RC) store_vt(acc, bj, vtc, 4, 128, cg - PC_VC, u.pm, wr, fr, fq);
            else if (cg >= PC_VD && cg < PC_GATE) store_vt(acc, bj, vtd, 2, 128, cg - PC_VD, u.pm, wr, fr, fq);
            else {
#pragma unroll
                for (int ai = 0; ai < 2; ++ai)
#pragma unroll
                    for (int m = 0; m < 4; ++m) *(u32x4*)(P + (size_t)(row0 + ai * 128 + m * 16) * PC + cg + 8 * fq) = pack8(acc[ai][bj][m][0], acc[ai][bj][m][1]);
            }
        }
    }
};
struct EpiMla {
    bf16 *QA, *KA, *vta;
    __device__ __forceinline__ void operator()(const f32x4 (&acc)[2][2][4][2], const Unit& u, int wr, int wc, int fr, int fq) const {
        const int row0 = u.pm * 256 + wr * 64 + fr;
        int bl, kap0; row_blk(u.pm * 256, bl, kap0);
#pragma unroll
        for (int bj = 0; bj < 2; ++bj) {
            const int cg = u.pn * 256 + bj * 128 + wc * 32;
            if (cg < 768) {
#pragma unroll
                for (int ai = 0; ai < 2; ++ai)
#pragma unroll
                    for (int m = 0; m < 4; ++m) *(u32x4*)(QA + (size_t)(row0 + ai * 128 + m * 16) * 768 + cg + 8 * fq) = pack8(acc[ai][bj][m][0], acc[ai][bj][m][1]);
            } else if (cg < 1280) {
                const int c = cg - 768 + 8 * fq, head = c >> 7, j0 = c & 127;
#pragma unroll
                for (int ai = 0; ai < 2; ++ai)
#pragma unroll
                    for (int m = 0; m < 4; ++m) { const int kap = kap0 + ai * 128 + wr * 64 + m * 16 + fr;
                        *(u32x4*)(KA + ((size_t)(bl * 4 + head) * KEYS + kap) * 192 + j0) = pack8(acc[ai][bj][m][0], acc[ai][bj][m][1]); }
            } else store_vt(acc, bj, vta, 4, 128, cg - 1280, u.pm, wr, fr, fq);
        }
    }
};
struct EpiMerge {
    const bf16* Z; bf16* MGo;
    __device__ __forceinline__ void operator()(const f32x4 (&acc)[2][2][4][2], const Unit& u, int wr, int wc, int fr, int fq) const {
        const int row0 = u.pm * 256 + wr * 64 + fr, d0 = u.pn * 64 + wc * 16 + fq * 4;
#pragma unroll
        for (int ai = 0; ai < 2; ++ai)
#pragma unroll
            for (int m = 0; m < 4; ++m) { const size_t row = (size_t)(row0 + ai * 128 + m * 16); float o[4] = {0.f, 0.f, 0.f, 0.f};
#pragma unroll
                for (int bj = 0; bj < 2; ++bj)
#pragma unroll
                    for (int n = 0; n < 2; ++n) { const int nb = 2 * bj + n; const u32x2 z = *(const u32x2*)(Z + row * 4096 + nb * 1024 + d0);
                        const f32x4 a = acc[ai][bj][m][n];
                        o[0] += sigmoidf_(a[0]) * bflo(z.x); o[1] += sigmoidf_(a[1]) * bfhi(z.x); o[2] += sigmoidf_(a[2]) * bflo(z.y); o[3] += sigmoidf_(a[3]) * bfhi(z.y); }
                u32x2 w; w.x = pk2(o[0], o[1]); w.y = pk2(o[2], o[3]); *(u32x2*)(MGo + row * 1024 + d0) = w; }
    }
};
struct EpiResid {
    const Args* a; int l, g, chunk; bool from_dst;
    __device__ __forceinline__ void operator()(const f32x4 (&acc)[2][2][4][2], const Unit& u, int wr, int wc, int fr, int fq) const {
        const int rt = u.pm * 256; const int bi = row_bi(g, rt);
        const float* src = from_dst ? (const float*)xrow_dst(*a, g, rt) : xrow_src(*a, l, g, rt); float* dst = xrow_dst(*a, g, rt);
        const float* mod = (const float*)(a->ws + WS_MOD) + ((size_t)(l * 9 + bi) * 6 + chunk) * 1024;
        const int rl0 = wr * 64 + fr;
#pragma unroll
        for (int bj = 0; bj < 2; ++bj) { const int c0 = u.pn * 256 + bj * 128 + wc * 32 + 8 * fq;
            const f32x4 g0 = *(const f32x4*)(mod + c0), g1 = *(const f32x4*)(mod + c0 + 4);
#pragma unroll
            for (int ai = 0; ai < 2; ++ai)
#pragma unroll
                for (int m = 0; m < 4; ++m) { const size_t off = (size_t)(rl0 + ai * 128 + m * 16) * DM + c0;
                    const f32x4 x0 = *(const f32x4*)(src + off), x1 = *(const f32x4*)(src + off + 4);
                    *(f32x4*)(dst + off) = x0 + g0 * acc[ai][bj][m][0]; *(f32x4*)(dst + off + 4) = x1 + g1 * acc[ai][bj][m][1]; } }
    }
};

__device__ __forceinline__ float wfetch(const Args& a, int kind, int l, int n, int k) {
    switch (kind) {
    case 0: {
        int src;
        if (n < PC_GATE) src = n; else if (n < PC) return 0.f;
        else { const int t = n - PC, tg = t >> 8, c = t & 255; const int nb = 2 * (c >> 7) + ((c >> 2) & 1), dd = 16 * ((c >> 5) & 3) + 4 * ((c >> 3) & 3) + (c & 3); src = PC_GATE + nb * 1024 + 64 * tg + dd; }
        return a.in[I_WIN][((size_t)l * 1024 + k) * IN_COLS + src]; }
    case 1: {
        if (n < 768) return k < 256 ? a.in[I_MWUQ][((size_t)l * 256 + k) * 768 + n] : 0.f;
        if (k < 256) return 0.f;
        const int m = n - 768; const int src = m < 512 ? (m >> 7) * 256 + (m & 127) : ((m - 512) >> 7) * 256 + 128 + ((m - 512) & 127);
        return a.in[I_MWUKV][((size_t)l * 128 + (k - 256)) * 1024 + src]; }
    case 2: { const int nb = n >> 10, d = n & 1023; return a.in[I_WBR][(((size_t)l * 4 + nb) * 512 + k) * 1024 + d]; }
    case 3: return a.in[I_WO][((size_t)l * 1024 + k) * 1024 + n];
    case 4: return a.in[I_W1][((size_t)l * 1024 + k) * 4096 + n];
    default: return a.in[I_W2][((size_t)l * 4096 + k) * 1024 + n];
    }
}
__device__ __forceinline__ void transpose_item(const Args& a, int kind, int l, int K, bf16* WT, int item, int nblk, LAS float* scr, int lane) {
    const int kb = item / nblk, nb = item % nblk, k0 = 64 * kb, n0 = 32 * nb;
#pragma unroll 8
    for (int i = 0; i < 32; ++i) { const int kk = 2 * i + (lane >> 5); scr[kk * 33 + (lane & 31)] = wfetch(a, kind, l, n0 + (lane & 31), k0 + kk); }
    asm volatile("s_waitcnt lgkmcnt(0)" ::: "memory");
    const int c = lane & 7;
#pragma unroll
    for (int j = 0; j < 4; ++j) { const int n = (lane >> 3) + 8 * j; const LAS float* s = scr + (8 * c) * 33 + n;
        u32x4 o; o.x = pk2(s[0 * 33], s[1 * 33]); o.y = pk2(s[2 * 33], s[3 * 33]); o.z = pk2(s[4 * 33], s[5 * 33]); o.w = pk2(s[6 * 33], s[7 * 33]);
        *(u32x4*)(WT + (size_t)(n0 + n) * K + k0 + 8 * c) = o; }
    asm volatile("s_waitcnt lgkmcnt(0)" ::: "memory");
}
__device__ __forceinline__ void prep_weights(const Args& a, int l, LAS unsigned char* lds) {
    const int tid = tidx(), lane = tid & 63, wave = tid >> 6;
    LAS float* scr = (LAS float*)(lds + wave * 8704);
    unsigned char* wt = a.ws + WS_WT;
    constexpr int I0 = 16 * (WIN_N / 32), I1 = 6 * (1792 / 32), I2 = 8 * (4096 / 32), I3 = 16 * (1024 / 32), I4 = 16 * (4096 / 32), I5 = 64 * (1024 / 32);
    const int gw = blockIdx.x * 8 + wave, NGW = gridDim.x * 8;
    for (int it = gw; it < I0 + I1 + I2 + I3 + I4 + I5; it += NGW) {
        int r = it;
        if (r < I0) { transpose_item(a, 0, l, 1024, (bf16*)(wt + WT_WIN), r, WIN_N / 32, scr, lane); continue; } r -= I0;
        if (r < I1) { transpose_item(a, 1, l, 384, (bf16*)(wt + WT_WMLA), r, 1792 / 32, scr, lane); continue; } r -= I1;
        if (r < I2) { transpose_item(a, 2, l, 512, (bf16*)(wt + WT_WB), r, 4096 / 32, scr, lane); continue; } r -= I2;
        if (r < I3) { transpose_item(a, 3, l, 1024, (bf16*)(wt + WT_WO), r, 1024 / 32, scr, lane); continue; } r -= I3;
        if (r < I4) { transpose_item(a, 4, l, 1024, (bf16*)(wt + WT_W1), r, 4096 / 32, scr, lane); continue; } r -= I4;
        transpose_item(a, 5, l, 4096, (bf16*)(wt + WT_W2), r, 1024 / 32, scr, lane);
    }
}
__device__ __forceinline__ void prep_mods(const Args& a, LAS unsigned char* lds) {
    const int tid = tidx(), lane = tid & 63, wave = tid >> 6;
    LAS float* sc = (LAS float*)(lds + 73728);
    LAS float* red = (LAS float*)(lds + 73728 + 36864);
    for (int i = tid; i < 9 * 1024; i += 512) { const int bi = i >> 10, k = i & 1023; const float v = bi < 8 ? a.in[I_C][bi * 1024 + k] : a.in[I_CCTX][k]; sc[i] = siluf_(v); }
    __syncthreads();
    for (int item = blockIdx.x; item < 2 * 96; item += gridDim.x) {
        const int l = item / 96, n = (item % 96) * 64 + lane;
        float acc[9];
#pragma unroll
        for (int b = 0; b < 9; ++b) acc[b] = 0.f;
        const float* w = a.in[I_ADAW] + ((size_t)l * 1024 + wave * 128) * 6144 + n;
#pragma unroll 8
        for (int k = 0; k < 128; ++k) { const float wv = w[(size_t)k * 6144];
#pragma unroll
            for (int b = 0; b < 9; ++b) acc[b] += sc[b * 1024 + wave * 128 + k] * wv; }
#pragma unroll
        for (int b = 0; b < 9; ++b) red[(wave * 9 + b) * 64 + lane] = acc[b];
        __syncthreads();
        if (wave == 0) {
            const float bias = a.in[I_ADAB][l * 6144 + n];
#pragma unroll
            for (int b = 0; b < 9; ++b) { float s = bias;
#pragma unroll
                for (int w8 = 0; w8 < 8; ++w8) s += red[(w8 * 9 + b) * 64 + lane];
                ((float*)(a.ws + WS_MOD))[((size_t)l * 9 + b) * 6144 + n] = s; }
        }
        __syncthreads();
    }
}

__device__ __forceinline__ void norm_mod_rows(const Args& a, int l, int g, int nrows, int which  ) {
    const int tid = tidx(), lane = tid & 63, gw = blockIdx.x * 8 + (tid >> 6), NGW = gridDim.x * 8;
    const float* nw = a.in[which ? I_N2W : I_N1W] + l * DM;
    bf16* H = (bf16*)(a.ws + WS_H);
    for (int r = gw; r < nrows; r += NGW) {
        const float* xr = which ? (const float*)xrow_dst(a, g, r) : xrow_src(a, l, g, r);
        const float* mod = (const float*)(a.ws + WS_MOD) + ((size_t)(l * 9 + row_bi(g, r)) * 6 + (which ? 3 : 0)) * 1024;
        f32x4 v[4]; float s = 0.f;
#pragma unroll
        for (int j = 0; j < 4; ++j) { v[j] = *(const f32x4*)(xr + 4 * lane + 256 * j); s += (v[j][0] * v[j][0] + v[j][1] * v[j][1]) + (v[j][2] * v[j][2] + v[j][3] * v[j][3]); }
        const float rstd = rsqrtf(wave_sum(s) * (1.f / DM) + EPS);
#pragma unroll
        for (int j = 0; j < 4; ++j) { const int c = 4 * lane + 256 * j; const f32x4 w = *(const f32x4*)(nw + c), sh = *(const f32x4*)(mod + c), sc = *(const f32x4*)(mod + 1024 + c);
            f32x4 y;
#pragma unroll
            for (int e = 0; e < 4; ++e) y[e] = v[j][e] * rstd * w[e] * (1.f + sc[e]) + sh[e];
            u32x2 o; o.x = pk2(y[0], y[1]); o.y = pk2(y[2], y[3]); *(u32x2*)(H + (size_t)r * DM + c) = o; }
    }
}
__device__ __forceinline__ void final_norm_rows(const Args& a) {
    const int tid = tidx(), lane = tid & 63, gw = blockIdx.x * 8 + (tid >> 6), NGW = gridDim.x * 8;
    const float* nw = a.in[I_FNW];
    for (int r = gw; r < NB * SEQ; r += NGW) {
        float* xr = a.out + (size_t)r * DM;
        f32x4 v[4]; float s = 0.f;
#pragma unroll
        for (int j = 0; j < 4; ++j) { v[j] = *(const f32x4*)(xr + 4 * lane + 256 * j); s += (v[j][0] * v[j][0] + v[j][1] * v[j][1]) + (v[j][2] * v[j][2] + v[j][3] * v[j][3]); }
        const float rstd = rsqrtf(wave_sum(s) * (1.f / DM) + EPS);
#pragma unroll
        for (int j = 0; j < 4; ++j) { const int c = 4 * lane + 256 * j; const f32x4 w = *(const f32x4*)(nw + c); *(f32x4*)(xr + c) = v[j] * rstd * w; }
    }
}
__device__ __forceinline__ void rope_pair(float& x1, float& x2, int pos, int i, int quarter) {
    const float inv = exp2f(-(float)i * (13.287712379549449f / (float)quarter));
    const float ang = (float)pos * inv; const float s = __sinf(ang), c = __cosf(ang);
    const float a = x1 * c - x2 * s, b = x1 * s + x2 * c; x1 = a; x2 = b;
}
__device__ __forceinline__ void post_rows(const Args& a, int l) {
    const int tid = tidx(), lane = tid & 63, gw = blockIdx.x * 8 + (tid >> 6), NGW = gridDim.x * 8;
    bf16* P = (bf16*)(a.ws + WS_P); bf16* CN = (bf16*)(a.ws + WS_CN); bf16* KA = (bf16*)(a.ws + WS_KA);
    const float* qnw = a.in[I_MQNW] + l * 256; const float* kvnw = a.in[I_MKVNW] + l * 128; const float* knw = a.in[I_KNW] + l * 128;
    for (int r = gw; r < MG_ROWS; r += NGW) {
        bf16* pr = P + (size_t)r * PC;
        const bool lat = r < LAT_ROWS; const int t = r & 2047, rowp = t >> 6, colp = t & 63;
        int bl, kap; row_blk(r, bl, kap);
        {
            const u32x2 w = *(const u32x2*)(pr + PC_CQ + 4 * lane); float x[4] = {bflo(w.x), bfhi(w.x), bflo(w.y), bfhi(w.y)};
            const float rstd = rsqrtf(wave_sum(x[0] * x[0] + x[1] * x[1] + x[2] * x[2] + x[3] * x[3]) * (1.f / 256.f) + EPS);
            const f32x4 nw = *(const f32x4*)(qnw + 4 * lane);
            u32x2 o; o.x = pk2(x[0] * rstd * nw[0], x[1] * rstd * nw[1]); o.y = pk2(x[2] * rstd * nw[2], x[3] * rstd * nw[3]);
            *(u32x2*)(CN + (size_t)r * 384 + 4 * lane) = o; }
        {
            const unsigned w = *(const unsigned*)(pr + PC_CKV + 2 * lane); const float x0 = bflo(w), x1 = bfhi(w);
            const float rstd = rsqrtf(wave_sum(x0 * x0 + x1 * x1) * (1.f / 128.f) + EPS);
            *(unsigned*)(CN + (size_t)r * 384 + 256 + 2 * lane) = pk2(x0 * rstd * kvnw[2 * lane], x1 * rstd * kvnw[2 * lane + 1]); }
        if (lane < 32) {
            const int part = lane >> 4, i = lane & 15, d1 = 32 * part + i, d2 = d1 + 16;
            float x1 = bf2f(pr[PC_KR + d1]), x2 = bf2f(pr[PC_KR + d2]);
            if (lat) rope_pair(x1, x2, part ? colp : rowp, i, 16);
            const bf16 o1 = (bf16)f2bf(x1), o2 = (bf16)f2bf(x2);
#pragma unroll
            for (int h = 0; h < 4; ++h) { bf16* kd = KA + ((size_t)(bl * 4 + h) * KEYS + kap) * 192 + 128; kd[d1] = o1; kd[d2] = o2; }
        }
        if (lat) {
            const int hh = lane >> 5, part = (lane >> 4) & 1, i = lane & 15, d1 = 64 * hh + 32 * part + i, d2 = d1 + 16;
            float x1 = bf2f(pr[PC_KB + d1]), x2 = bf2f(pr[PC_KB + d2]);
            rope_pair(x1, x2, part ? colp : rowp, i, 16);
            pr[PC_KB + d1] = (bf16)f2bf(x1); pr[PC_KB + d2] = (bf16)f2bf(x2);
        }
        {
            const int hh = lane >> 5, i = lane & 31; bf16* kd = pr + PC_KD + 128 * hh;
            float x0 = bf2f(kd[i]), x1 = bf2f(kd[32 + i]), x2 = bf2f(kd[64 + i]), x3 = bf2f(kd[96 + i]);
            float ss = x0 * x0 + x1 * x1 + x2 * x2 + x3 * x3;
#pragma unroll
            for (int o = 1; o < 32; o <<= 1) ss += __shfl_xor(ss, o);
            const float rstd = rsqrtf(ss * (1.f / 128.f) + EPS);
            x0 *= rstd * knw[i]; x1 *= rstd * knw[32 + i]; x2 *= rstd * knw[64 + i]; x3 *= rstd * knw[96 + i];
            if (lat) { rope_pair(x0, x1, rowp, i, 32); rope_pair(x2, x3, colp, i, 32); }
            kd[i] = (bf16)f2bf(x0); kd[32 + i] = (bf16)f2bf(x1); kd[64 + i] = (bf16)f2bf(x2); kd[96 + i] = (bf16)f2bf(x3);
        }
    }
}
__device__ __forceinline__ void comb_rows(const Args& a, int l, int nrows) {
    const int tid = tidx(), lane = tid & 63, gw = blockIdx.x * 8 + (tid >> 6), NGW = gridDim.x * 8;
    const bf16* P = (const bf16*)(a.ws + WS_P); bf16* Y = (bf16*)(a.ws + WS_Y); const bf16* OB = (const bf16*)(a.ws + WS_MG);
    const float* gnw = a.in[I_GNW] + l * 128;
    for (int r = gw; r < nrows; r += NGW) {
#pragma unroll
        for (int h = 0; h < 4; ++h) {
            const int e = 2 * lane;
            const unsigned wf = *(const unsigned*)(Y + (size_t)r * 2048 + 1024 + 128 * h + e), wb = *(const unsigned*)(OB + (size_t)r * 512 + 128 * h + e), wr_ = *(const unsigned*)(P + (size_t)r * PC + PC_RC + 128 * h + e);
            const float o0 = bflo(wf) + bflo(wb), o1 = bfhi(wf) + bfhi(wb);
            const float rstd = rsqrtf(wave_sum(o0 * o0 + o1 * o1) * (1.f / 128.f) + EPS);
            *(unsigned*)(Y + (size_t)r * 2048 + 1024 + 128 * h + e) = pk2(o0 * rstd * gnw[e] * siluf_(bflo(wr_)), o1 * rstd * gnw[e + 1] * siluf_(bfhi(wr_)));
        }
    }
}

struct AttnArgs {
    const bf16* Q; int qpitch;
    const bf16* Kc; const bf16* Kl; int kpitch;
    const bf16* Vt;
    bf16* O; int opitch;
    int qpos0, ntile, band_first;
    float sink_l2; const float* qnw;
};
template <int DK, int DV, int MODE>
__device__ __forceinline__ void attn_unit(LAS unsigned char* lds, const AttnArgs& A) {
    constexpr int KS = DK * 2 + 16, VS = 272, NS = DK / 16, NDT = DV / 32, NKC = DK / 32, NVC = DV / 32, KCH = DK / 8;
    constexpr int VT_OFF = 128 * KS;
    const int tid = tidx(), lane = tid & 63, wave = __builtin_amdgcn_readfirstlane(tid >> 6);
    const int qg = wave & 3, kp = wave >> 2, r = lane & 31, h = lane >> 5;
    const bool lat = A.qpos0 >= 0;
    bf16x8 qf[NS];
    {
        float qv[NS][8];
        const bf16* qrow = A.Q + (size_t)(32 * qg + r) * A.qpitch + 8 * h;
#pragma unroll
        for (int s = 0; s < NS; ++s) { const u32x4 w = *(const u32x4*)(qrow + 16 * s);
            qv[s][0] = bflo(w.x); qv[s][1] = bfhi(w.x); qv[s][2] = bflo(w.y); qv[s][3] = bfhi(w.y); qv[s][4] = bflo(w.z); qv[s][5] = bfhi(w.z); qv[s][6] = bflo(w.w); qv[s][7] = bfhi(w.w); }
        if (MODE == 2) {
            float ss = 0.f;
#pragma unroll
            for (int s = 0; s < NS; ++s)
#pragma unroll
                for (int j = 0; j < 8; ++j) ss += qv[s][j] * qv[s][j];
            ss += __shfl_xor(ss, 32);
            const float rstd = rsqrtf(ss * (1.f / 128.f) + EPS);
#pragma unroll
            for (int s = 0; s < NS; ++s)
#pragma unroll
                for (int j = 0; j < 8; ++j) qv[s][j] *= rstd * A.qnw[16 * s + 8 * h + j];
        }
        if (lat) {
            const int pos = A.qpos0 + 32 * qg + r, rowp = pos >> 6, colp = pos & 63;
#pragma unroll
            for (int j = 0; j < 8; ++j) {
                if (MODE == 0) { rope_pair(qv[8][j], qv[9][j], rowp, 8 * h + j, 16); rope_pair(qv[10][j], qv[11][j], colp, 8 * h + j, 16); }
                if (MODE == 1) { rope_pair(qv[0][j], qv[1][j], rowp, 8 * h + j, 16); rope_pair(qv[2][j], qv[3][j], colp, 8 * h + j, 16); }
                if (MODE == 2) { rope_pair(qv[0][j], qv[2][j], rowp, 8 * h + j, 32); rope_pair(qv[1][j], qv[3][j], rowp, 16 + 8 * h + j, 32);
                                 rope_pair(qv[4][j], qv[6][j], colp, 8 * h + j, 32); rope_pair(qv[5][j], qv[7][j], colp, 16 + 8 * h + j, 32); }
            }
        }
        const float c = (MODE == 0 ? 0.07216878364870322f : MODE == 1 ? 0.125f : 0.08838834764831845f) * 1.4426950408889634f;
#pragma unroll
        for (int s = 0; s < NS; ++s) { u32x4 w; w.x = pk2(qv[s][0] * c, qv[s][1] * c); w.y = pk2(qv[s][2] * c, qv[s][3] * c); w.z = pk2(qv[s][4] * c, qv[s][5] * c); w.w = pk2(qv[s][6] * c, qv[s][7] * c);
            qf[s] = __builtin_bit_cast(bf16x8, w); }
    }
    float m_run = -INFINITY, l_run = 0.f;
    f32x16 acc[NDT];
#pragma unroll
    for (int d = 0; d < NDT; ++d)
#pragma unroll
        for (int i = 0; i < 16; ++i) acc[d][i] = 0.f;
    u32x4 kreg[NKC], vreg[NVC];
#define ATT_K0(i) ((MODE == 1 && lat && (i) >= 2) ? CTXL + 128 * (A.band_first + (i) - 2) : 128 * (i))
#define ATT_LOAD(i) do { const int k0_ = ATT_K0(i); const bf16* kb_ = ((k0_ < CTXL) ? A.Kc + (size_t)k0_ * A.kpitch : A.Kl + (size_t)(k0_ - CTXL) * A.kpitch) + (size_t)(tid >> 3) * A.kpitch + 8 * (tid & 7); \
        _Pragma("unroll") for (int p_ = 0; p_ < 2; ++p_) _Pragma("unroll") for (int c_ = 0; c_ < KCH / 8; ++c_) kreg[p_ * (KCH / 8) + c_] = *(const u32x4*)(kb_ + (size_t)(64 * p_) * A.kpitch + 64 * c_); \
        const bf16* vb_ = A.Vt + (size_t)(tid >> 4) * KEYS + k0_ + 8 * (tid & 15); \
        _Pragma("unroll") for (int p_ = 0; p_ < NVC; ++p_) vreg[p_] = *(const u32x4*)(vb_ + (size_t)(32 * p_) * KEYS); } while (0)
    ATT_LOAD(0);
    for (int it = 0; it < A.ntile; ++it) {
        __syncthreads();
        {
            LAS unsigned char* kw_ = lds + (tid >> 3) * KS + (tid & 7) * 16;
#pragma unroll
            for (int p_ = 0; p_ < 2; ++p_)
#pragma unroll
                for (int c_ = 0; c_ < KCH / 8; ++c_) *(LAS u32x4*)(kw_ + 64 * p_ * KS + 128 * c_) = kreg[p_ * (KCH / 8) + c_];
            LAS unsigned char* vw_ = lds + VT_OFF + (tid >> 4) * VS + (tid & 15) * 16;
#pragma unroll
            for (int p_ = 0; p_ < NVC; ++p_) *(LAS u32x4*)(vw_ + 32 * p_ * VS) = vreg[p_];
        }
        __syncthreads();
        if (it + 1 < A.ntile) ATT_LOAD(it + 1);
        f32x16 st0, st1;
#pragma unroll
        for (int i = 0; i < 16; ++i) { st0[i] = 0.f; st1[i] = 0.f; }
        const LAS unsigned char* kb = lds + (64 * kp + r) * KS + 16 * h;
#pragma unroll
        for (int s = 0; s < NS; ++s) {
            const bf16x8 k0f = *(const LAS bf16x8*)(kb + 32 * s), k1f = *(const LAS bf16x8*)(kb + 32 * KS + 32 * s);
            st0 = __builtin_amdgcn_mfma_f32_32x32x16_bf16(k0f, qf[s], st0, 0, 0, 0);
            st1 = __builtin_amdgcn_mfma_f32_32x32x16_bf16(k1f, qf[s], st1, 0, 0, 0);
        }
        if (MODE == 1 && lat && it >= 2) {
            const int qpos = A.qpos0 + 32 * qg + r, kb0 = ATT_K0(it) - CTXL + 64 * kp + 4 * h;
#pragma unroll
            for (int i = 0; i < 16; ++i) { const int kpos = kb0 + (i & 3) + 8 * (i >> 2); const int d0 = qpos - kpos, d1 = d0 - 32;
                if (d0 > 128 || d0 < -128) st0[i] = -INFINITY;
                if (d1 > 128 || d1 < -128) st1[i] = -INFINITY; }
        }
        float mt = fmaxf(st0[0], st1[0]);
#pragma unroll
        for (int i = 1; i < 16; ++i) mt = fmaxf(mt, fmaxf(st0[i], st1[i]));
        mt = fmaxf(mt, __shfl_xor(mt, 32));
        const float mnew = fmaxf(m_run, mt);
        const float alpha = __builtin_amdgcn_exp2f(m_run - mnew);
        m_run = mnew;
        float ps = 0.f;
#pragma unroll
        for (int i = 0; i < 16; ++i) { st0[i] = __builtin_amdgcn_exp2f(st0[i] - mnew); st1[i] = __builtin_amdgcn_exp2f(st1[i] - mnew); ps += st0[i] + st1[i]; }
        l_run = l_run * alpha + ps;
#pragma unroll
        for (int d = 0; d < NDT; ++d)
#pragma unroll
            for (int i = 0; i < 16; ++i) acc[d][i] *= alpha;
        bf16x8 pf[2][2];
#pragma unroll
        for (int u = 0; u < 2; ++u) {
            u32x4 w0, w1;
            w0.x = pk2(st0[8 * u + 0], st0[8 * u + 1]); w0.y = pk2(st0[8 * u + 2], st0[8 * u + 3]); w0.z = pk2(st0[8 * u + 4], st0[8 * u + 5]); w0.w = pk2(st0[8 * u + 6], st0[8 * u + 7]);
            w1.x = pk2(st1[8 * u + 0], st1[8 * u + 1]); w1.y = pk2(st1[8 * u + 2], st1[8 * u + 3]); w1.z = pk2(st1[8 * u + 4], st1[8 * u + 5]); w1.w = pk2(st1[8 * u + 6], st1[8 * u + 7]);
            pf[0][u] = __builtin_bit_cast(bf16x8, w0); pf[1][u] = __builtin_bit_cast(bf16x8, w1);
        }
        const LAS unsigned char* vb = lds + VT_OFF + r * VS + (64 * kp + 4 * h) * 2;
#pragma unroll
        for (int kt = 0; kt < 2; ++kt)
#pragma unroll
            for (int u = 0; u < 2; ++u)
#pragma unroll
                for (int d = 0; d < NDT; ++d) {
                    const LAS unsigned char* p = vb + d * 32 * VS + (32 * kt + 16 * u) * 2;
                    const u32x2 lo = *(const LAS u32x2*)p, hi = *(const LAS u32x2*)(p + 16);
                    u32x4 w; w.x = lo.x; w.y = lo.y; w.z = hi.x; w.w = hi.y;
                    acc[d] = __builtin_amdgcn_mfma_f32_32x32x16_bf16(__builtin_bit_cast(bf16x8, w), pf[kt][u], acc[d], 0, 0, 0);
                }
    }
#undef ATT_LOAD
#undef ATT_K0
    l_run += __shfl_xor(l_run, 32);
    __syncthreads();
    LAS float* mb = (LAS float*)lds + (size_t)qg * (NDT * 16 + 2) * 64 + lane;
    if (kp == 1) {
        mb[0] = m_run; mb[64] = l_run;
#pragma unroll
        for (int d = 0; d < NDT; ++d)
#pragma unroll
            for (int i = 0; i < 16; ++i) mb[(2 + d * 16 + i) * 64] = acc[d][i];
    }
    __syncthreads();
    if (kp == 0) {
        const float m1 = mb[0], l1 = mb[64];
        const float M = fmaxf(m_run, m1), a0 = __builtin_amdgcn_exp2f(m_run - M), a1 = __builtin_amdgcn_exp2f(m1 - M);
        float L = l_run * a0 + l1 * a1;
        if (MODE == 1) L += __builtin_amdgcn_exp2f(A.sink_l2 - M);
        const float inv = 1.f / L;
        bf16* orow = A.O + (size_t)(32 * qg + r) * A.opitch + 4 * h;
#pragma unroll
        for (int d = 0; d < NDT; ++d)
#pragma unroll
            for (int i4 = 0; i4 < 4; ++i4) {
                float o[4];
#pragma unroll
                for (int j = 0; j < 4; ++j) o[j] = (acc[d][4 * i4 + j] * a0 + mb[(2 + d * 16 + 4 * i4 + j) * 64] * a1) * inv;
                u32x2 w; w.x = pk2(o[0], o[1]); w.y = pk2(o[2], o[3]);
                *(u32x2*)(orow + 32 * d + 8 * i4) = w;
            }
    }
    __syncthreads();
}

constexpr size_t WS_GU = WS_MG;
constexpr size_t WS_GDL = WS_MOD + 512 * 1024;
constexpr int CW_GLA = 8192;
__device__ __forceinline__ float logsigmoidf_(float x) { return fminf(x, 0.f) - __logf(1.f + __expf(-fabsf(x))); }
struct GlaArgs { const bf16* P; const bf16* VtC; bf16* Y; bf16* GU; float* GDL; unsigned* cnt; const float* wd; const float* bd; const float* gnw; int need_ctx; };
__device__ __forceinline__ void gla_rows(int c, int dir, int bl, int& row0, int& kap0) {
    if (c < 4) { const int ch = dir ? 3 - c : c; row0 = LAT_ROWS + bl * CTXL + 64 * ch; kap0 = 64 * ch; }
    else { const int ch = dir ? 35 - c : c - 4; row0 = bl * SEQ + 64 * ch; kap0 = CTXL + 64 * ch; }
}
constexpr int GL_RS = 144;
constexpr int GO_RQ = 0, GO_RK = 9216, GO_VT = 18432, GO_LR = 36864  , GO_WD = 40960  , GO_BD = 49152  , GO_GT = 49664, GO_DL = 51712, GO_QT = 51968, GO_KT = 61184,
              GO_KH = 70400, GO_AT = 79616, GO_ST = 88832, GO_RED = 107264  , GO_END = 108288;
__device__ __forceinline__ void gla_decay(LAS unsigned char* lds, int dsel, int dir, int wave, int d, float (&cum)[8], float& tot) {
    float la[8];
    {
        float wdv[16];
#pragma unroll
        for (int q = 0; q < 16; ++q) wdv[q] = ((const LAS float*)(lds + GO_WD + dsel * 4096))[q * 64 + d];
        const float bdv = ((const LAS float*)(lds + GO_BD + dsel * 256))[d];
#pragma unroll
        for (int i = 0; i < 8; ++i) { const LAS unsigned* lr = (const LAS unsigned*)(lds + GO_LR + dsel * 2048 + (8 * wave + i) * 32); float x = bdv;
#pragma unroll
            for (int q = 0; q < 8; ++q) { const unsigned w = lr[q]; x += bflo(w) * wdv[2 * q] + bfhi(w) * wdv[2 * q + 1]; }
            la[i] = logsigmoidf_(x) * (1.f / 16.f); }
    }
    float s = 0.f;
    if (dir == 0) {
#pragma unroll
        for (int i = 0; i < 8; ++i) { s += la[i]; cum[i] = s; } }
    else {
#pragma unroll
        for (int i = 7; i >= 0; --i) { s += la[i]; cum[i] = s; } }
    ((LAS float*)(lds + GO_GT))[wave * 64 + d] = s;
    __syncthreads();
    float pre = 0.f; tot = 0.f;
#pragma unroll
    for (int w8 = 0; w8 < 8; ++w8) { const float gt = ((const LAS float*)(lds + GO_GT))[w8 * 64 + d]; tot += gt; if (dir == 0 ? (w8 < wave) : (w8 > wave)) pre += gt; }
#pragma unroll
    for (int i = 0; i < 8; ++i) cum[i] += pre;
}
__device__ __forceinline__ void gla_signal(unsigned* word, unsigned v, int tid) {
    asm volatile("s_waitcnt vmcnt(0)" ::: "memory");
    __syncthreads();
    if (tid == 0) { __builtin_amdgcn_fence(__ATOMIC_RELEASE, "agent"); asm volatile("s_waitcnt vmcnt(0)" ::: "memory"); __hip_atomic_fetch_add(word, v, __ATOMIC_RELAXED, __HIP_MEMORY_SCOPE_AGENT); }
}
__device__ __forceinline__ void gla_wait(unsigned* w0, unsigned* w1, unsigned need, int tid) {
    if (tid == 0) {
        unsigned sp = 0;
        while (__hip_atomic_load(w0, __ATOMIC_RELAXED, __HIP_MEMORY_SCOPE_AGENT) < need || __hip_atomic_load(w1, __ATOMIC_RELAXED, __HIP_MEMORY_SCOPE_AGENT) < need) { __builtin_amdgcn_s_sleep(2); if (++sp > (1u << 22)) break; }
        __builtin_amdgcn_fence(__ATOMIC_ACQUIRE, "agent");
        asm volatile("s_waitcnt vmcnt(0)" ::: "memory");
    }
    __syncthreads();
}
__device__ __forceinline__ void gla_local(LAS unsigned char* lds, const GlaArgs& G, int chain, int c) {
    const int tid = tidx(), lane = tid & 63, wave = __builtin_amdgcn_readfirstlane(tid >> 6), r = lane & 31, hh = lane >> 5;
    const int dir = chain & 1, h = (chain >> 1) & 3, bl = chain >> 3;
    int row0, kap0; gla_rows(c, dir, bl, row0, kap0);
    const bf16* pr = G.P + (size_t)(row0 + (tid >> 3)) * PC + 8 * (tid & 7);
    const u32x4 rk = *(const u32x4*)(pr + PC_KC + 64 * h);
    const bf16* vp = G.VtC + ((size_t)(bl * 4 + h) * 128 + (tid >> 3)) * KEYS + kap0 + 8 * (tid & 7);
    const u32x4 rv0 = *(const u32x4*)vp, rv1 = *(const u32x4*)(vp + (size_t)64 * KEYS);
    u32x4 rl = {0u, 0u, 0u, 0u};
    if (tid < 128) rl = *(const u32x4*)(G.P + (size_t)(row0 + (tid >> 1)) * PC + PC_LRF + 16 * dir + 8 * (tid & 1));
    __syncthreads();
    for (int i = tid; i < 1024; i += 512) ((LAS float*)(lds + GO_WD))[i] = G.wd[(size_t)dir * 4096 + (size_t)(i >> 6) * 256 + 64 * h + (i & 63)];
    if (tid < 64) ((LAS float*)(lds + GO_BD))[tid] = G.bd[dir * 256 + 64 * h + tid];
    *(LAS u32x4*)(lds + GO_RK + (tid >> 3) * GL_RS + (tid & 7) * 16) = rk;
    *(LAS u32x4*)(lds + GO_VT + (tid >> 3) * GL_RS + (tid & 7) * 16) = rv0; *(LAS u32x4*)(lds + GO_VT + (64 + (tid >> 3)) * GL_RS + (tid & 7) * 16) = rv1;
    if (tid < 128) *(LAS u32x4*)(lds + GO_LR + (tid >> 1) * 32 + (tid & 1) * 16) = rl;
    __syncthreads();
    const int d = lane; float cum[8], tot;
    gla_decay(lds, 0, dir, wave, d, cum, tot);
    if (wave == 0) G.GDL[((size_t)chain * 36 + c) * 64 + d] = __expf(tot);
    {
        unsigned kh[4];
#pragma unroll
        for (int i = 0; i < 8; ++i) { const int s = 8 * wave + i; const float kv = bf2f(*(const LAS bf16*)(lds + GO_RK + s * GL_RS + 2 * d));
            const unsigned khv = f2bf(kv * __expf(tot - cum[i]));
            if (i & 1) kh[i >> 1] |= khv << 16; else kh[i >> 1] = khv; }
        u32x4 w; w.x = kh[0]; w.y = kh[1]; w.z = kh[2]; w.w = kh[3];
        *(LAS u32x4*)(lds + GO_KH + d * GL_RS + 16 * wave) = w;
    }
    __syncthreads();
    const int et = wave >> 1, dt = wave & 1;
    f32x16 u;
#pragma unroll
    for (int i = 0; i < 16; ++i) u[i] = 0.f;
#pragma unroll
    for (int kk = 0; kk < 4; ++kk) { const bf16x8 af = *(const LAS bf16x8*)(lds + GO_VT + (32 * et + r) * GL_RS + (16 * kk + 8 * hh) * 2), bfr = *(const LAS bf16x8*)(lds + GO_KH + (32 * dt + r) * GL_RS + (16 * kk + 8 * hh) * 2);
        u = __builtin_amdgcn_mfma_f32_32x32x16_bf16(af, bfr, u, 0, 0, 0); }
    bf16* up = G.GU + ((size_t)chain * 36 + c) * 8192 + 32 * dt + r;
#pragma unroll
    for (int i = 0; i < 16; ++i) { const int e = 32 * et + (i & 3) + 8 * (i >> 2) + 4 * hh; up[e * 64] = (bf16)f2bf(u[i]); }
}
__device__ __forceinline__ void gla_scan(const GlaArgs& G, int chain, int quarter) {
    const int tid = tidx();
    const int e = 32 * quarter + (tid >> 4), d0 = 4 * (tid & 15);
    bf16* up = G.GU + (size_t)chain * 36 * 8192 + e * 64 + d0; const float* dlp = G.GDL + (size_t)chain * 36 * 64 + d0;
    float S[4] = {0.f, 0.f, 0.f, 0.f};
#pragma unroll 1
    for (int c0 = 0; c0 < 36; c0 += 12) {
        u32x2 uu[12]; f32x4 dl[12];
#pragma unroll
        for (int j = 0; j < 12; ++j) { uu[j] = *(const u32x2*)(up + (size_t)(c0 + j) * 8192); dl[j] = *(const f32x4*)(dlp + (c0 + j) * 64); }
#pragma unroll
        for (int j = 0; j < 12; ++j) {
            S[0] = dl[j][0] * S[0] + bflo(uu[j].x); S[1] = dl[j][1] * S[1] + bfhi(uu[j].x); S[2] = dl[j][2] * S[2] + bflo(uu[j].y); S[3] = dl[j][3] * S[3] + bfhi(uu[j].y);
            const unsigned long long w = (unsigned long long)pk2(S[0], S[1]) | ((unsigned long long)pk2(S[2], S[3]) << 32);
            __hip_atomic_store((unsigned long long*)(up + (size_t)(c0 + j) * 8192), w, __ATOMIC_RELAXED, __HIP_MEMORY_SCOPE_AGENT); }
    }
    asm volatile("s_waitcnt vmcnt(0)" ::: "memory");
    __syncthreads();
    if (tid == 0) __hip_atomic_fetch_add(G.cnt + chain * 16, 100u, __ATOMIC_RELAXED, __HIP_MEMORY_SCOPE_AGENT);
}
__device__ __forceinline__ void gla_out(LAS unsigned char* lds, const GlaArgs& G, int bh, int j) {
    const int tid = tidx(), lane = tid & 63, wave = __builtin_amdgcn_readfirstlane(tid >> 6), r = lane & 31, hh = lane >> 5;
    const int h = bh & 3, bl = bh >> 2;
    const bool isctx = j >= 32; const int ch = isctx ? j - 32 : j;
    const int row0 = isctx ? LAT_ROWS + bl * CTXL + 64 * ch : bl * SEQ + 64 * ch, kap0 = isctx ? 64 * ch : CTXL + 64 * ch;
    const bf16* pr = G.P + (size_t)(row0 + (tid >> 3)) * PC + 8 * (tid & 7);
    const u32x4 rq = *(const u32x4*)(pr + PC_QC + 64 * h), rk = *(const u32x4*)(pr + PC_KC + 64 * h);
    const bf16* vp = G.VtC + ((size_t)(bl * 4 + h) * 128 + (tid >> 3)) * KEYS + kap0 + 8 * (tid & 7);
    const u32x4 rv0 = *(const u32x4*)vp, rv1 = *(const u32x4*)(vp + (size_t)64 * KEYS);
    u32x4 rl = {0u, 0u, 0u, 0u};
    if (tid < 256) rl = *(const u32x4*)(G.P + (size_t)(row0 + ((tid & 127) >> 1)) * PC + PC_LRF + 16 * (tid >> 7) + 8 * (tid & 1));
    __syncthreads();
    for (int i = tid; i < 2048; i += 512) { const int dsel = i >> 10, q = (i >> 6) & 15, dd = i & 63; ((LAS float*)(lds + GO_WD))[i] = G.wd[(size_t)dsel * 4096 + (size_t)q * 256 + 64 * h + dd]; }
    if (tid < 128) ((LAS float*)(lds + GO_BD))[tid] = G.bd[(tid >> 6) * 256 + 64 * h + (tid & 63)];
    *(LAS u32x4*)(lds + GO_RQ + (tid >> 3) * GL_RS + (tid & 7) * 16) = rq; *(LAS u32x4*)(lds + GO_RK + (tid >> 3) * GL_RS + (tid & 7) * 16) = rk;
    *(LAS u32x4*)(lds + GO_VT + (tid >> 3) * GL_RS + (tid & 7) * 16) = rv0; *(LAS u32x4*)(lds + GO_VT + (64 + (tid >> 3)) * GL_RS + (tid & 7) * 16) = rv1;
    if (tid < 256) *(LAS u32x4*)(lds + GO_LR + (tid >> 7) * 2048 + ((tid & 127) >> 1) * 32 + (tid & 1) * 16) = rl;
    const int chain0 = bh * 2;
    gla_wait(G.cnt + chain0 * 16, G.cnt + (chain0 + 1) * 16, 400u, tid);
    const int et = wave >> 1, tt = wave & 1, d = lane;
    f32x16 oc;
#pragma unroll
    for (int i = 0; i < 16; ++i) oc[i] = 0.f;
#pragma unroll 1
    for (int dir = 0; dir < 2; ++dir) {
        if (dir) __syncthreads();
        const int pos = dir == 0 ? (isctx ? ch : 4 + ch) : (isctx ? 3 - ch : 35 - ch);
        {
            u32x4 s0 = {0u, 0u, 0u, 0u}, s1 = {0u, 0u, 0u, 0u};
            if (pos > 0) { const bf16* sp = G.GU + ((size_t)(chain0 + dir) * 36 + pos - 1) * 8192 + (tid >> 3) * 64 + 8 * (tid & 7); s0 = *(const u32x4*)sp; s1 = *(const u32x4*)(sp + 64 * 64); }
            *(LAS u32x4*)(lds + GO_ST + (tid >> 3) * GL_RS + (tid & 7) * 16) = s0; *(LAS u32x4*)(lds + GO_ST + (64 + (tid >> 3)) * GL_RS + (tid & 7) * 16) = s1;
        }
        float cum[8], tot;
        gla_decay(lds, dir, dir, wave, d, cum, tot);
#pragma unroll
        for (int i = 0; i < 8; ++i) { const int s = 8 * wave + i;
            const float qv = bf2f(*(const LAS bf16*)(lds + GO_RQ + s * GL_RS + 2 * d)), kv = bf2f(*(const LAS bf16*)(lds + GO_RK + s * GL_RS + 2 * d));
            *(LAS bf16*)(lds + GO_QT + s * GL_RS + 2 * d) = (bf16)f2bf(qv * 0.125f * __expf(cum[i]));
            *(LAS bf16*)(lds + GO_KT + s * GL_RS + 2 * d) = (bf16)f2bf(kv * __expf(-cum[i])); }
        __syncthreads();
        if (wave < 4) {
            const int ss = wave & 1, t2 = wave >> 1;
            f32x16 sc;
#pragma unroll
            for (int i = 0; i < 16; ++i) sc[i] = 0.f;
#pragma unroll
            for (int kk = 0; kk < 4; ++kk) { const bf16x8 af = *(const LAS bf16x8*)(lds + GO_KT + (32 * ss + r) * GL_RS + (16 * kk + 8 * hh) * 2), bfr = *(const LAS bf16x8*)(lds + GO_QT + (32 * t2 + r) * GL_RS + (16 * kk + 8 * hh) * 2);
                sc = __builtin_amdgcn_mfma_f32_32x32x16_bf16(af, bfr, sc, 0, 0, 0); }
            const int t = 32 * t2 + r;
#pragma unroll
            for (int i4 = 0; i4 < 4; ++i4) { float v[4];
#pragma unroll
                for (int jj = 0; jj < 4; ++jj) { const int s = 32 * ss + 8 * i4 + 4 * hh + jj; const bool keep = dir == 0 ? (s <= t) : (s >= t); v[jj] = keep ? sc[4 * i4 + jj] : 0.f; }
                u32x2 w; w.x = pk2(v[0], v[1]); w.y = pk2(v[2], v[3]); *(LAS u32x2*)(lds + GO_AT + t * GL_RS + (32 * ss + 8 * i4 + 4 * hh) * 2) = w; }
        }
        __syncthreads();
#pragma unroll
        for (int kk = 0; kk < 4; ++kk) { const bf16x8 af = *(const LAS bf16x8*)(lds + GO_ST + (32 * et + r) * GL_RS + (16 * kk + 8 * hh) * 2), bfr = *(const LAS bf16x8*)(lds + GO_QT + (32 * tt + r) * GL_RS + (16 * kk + 8 * hh) * 2);
            oc = __builtin_amdgcn_mfma_f32_32x32x16_bf16(af, bfr, oc, 0, 0, 0); }
#pragma unroll
        for (int kk = 0; kk < 4; ++kk) { const bf16x8 af = *(const LAS bf16x8*)(lds + GO_VT + (32 * et + r) * GL_RS + (16 * kk + 8 * hh) * 2), bfr = *(const LAS bf16x8*)(lds + GO_AT + (32 * tt + r) * GL_RS + (16 * kk + 8 * hh) * 2);
            oc = __builtin_amdgcn_mfma_f32_32x32x16_bf16(af, bfr, oc, 0, 0, 0); }
    }
    float ss = 0.f;
#pragma unroll
    for (int i = 0; i < 16; ++i) ss += oc[i] * oc[i];
    ss += __shfl_xor(ss, 32);
    if (hh == 0) ((LAS float*)(lds + GO_RED))[et * 64 + 32 * tt + r] = ss;
    __syncthreads();
    const int t = 32 * tt + r;
    const float tot2 = ((const LAS float*)(lds + GO_RED))[t] + ((const LAS float*)(lds + GO_RED))[64 + t] + ((const LAS float*)(lds + GO_RED))[128 + t] + ((const LAS float*)(lds + GO_RED))[192 + t];
    const float rstd = rsqrtf(tot2 * (1.f / 128.f) + EPS);
    const int row = row0 + t;
    const bf16* rp = G.P + (size_t)row * PC + PC_RC + 128 * h + 32 * et + 4 * hh; bf16* yp = G.Y + (size_t)row * 2048 + 1024 + 128 * h + 32 * et + 4 * hh; const float* gw = G.gnw + 32 * et + 4 * hh;
#pragma unroll
    for (int i4 = 0; i4 < 4; ++i4) { const u32x2 rr = *(const u32x2*)(rp + 8 * i4); const f32x4 w = *(const f32x4*)(gw + 8 * i4);
        const float y0 = oc[4 * i4] * rstd * w[0] * siluf_(bflo(rr.x)), y1 = oc[4 * i4 + 1] * rstd * w[1] * siluf_(bfhi(rr.x)), y2 = oc[4 * i4 + 2] * rstd * w[2] * siluf_(bflo(rr.y)), y3 = oc[4 * i4 + 3] * rstd * w[3] * siluf_(bfhi(rr.y));
        u32x2 o; o.x = pk2(y0, y1); o.y = pk2(y2, y3); *(u32x2*)(yp + 8 * i4) = o; }
}

__device__ __forceinline__ GlaArgs make_gla(const Args& a, int l, int g) {
    unsigned char* ws = a.ws; GlaArgs G; G.P = (const bf16*)(ws + WS_P); G.VtC = (const bf16*)(ws + WS_VTC); G.Y = (bf16*)(ws + WS_Y); G.GU = (bf16*)(ws + WS_GU); G.GDL = (float*)(ws + WS_GDL);
    G.cnt = (unsigned*)(ws + WS_CTL) + CW_GLA + (l * 2 + g) * 32 * 16; G.wd = a.in[I_GWD] + (size_t)l * 2 * 16 * 256; G.bd = a.in[I_GBD] + (size_t)l * 2 * 256; G.gnw = a.in[I_GNW] + l * 128; G.need_ctx = (l == 0);
    return G;
}
__device__ __forceinline__ void attn_phase(const Args& a, int l, int g, LAS unsigned char* lds) {
    unsigned char* ws = a.ws;
    const bf16* P = (const bf16*)(ws + WS_P); const bf16* QA = (const bf16*)(ws + WS_QA); const bf16* KA = (const bf16*)(ws + WS_KA);
    bf16* Y = (bf16*)(ws + WS_Y);
    const int need_ctx = (l == 0);
    const int N_SCAN = 128, N_A = 256, N_D = 256, N_B = 512, N_AC = need_ctx ? 32 : 0, N_DC = N_AC, N_BC = need_ctx ? 64 : 0, N_OUT = (need_ctx ? 36 : 32) * 16;
    const int N_ATT = N_A + N_D + N_B + N_AC + N_DC + N_BC;
    const int total = N_SCAN + N_ATT + N_OUT;
    unsigned* ctr = (unsigned*)(ws + WS_CTL) + (l * 2 + g) * 64;
    volatile LAS int* slot = (volatile LAS int*)(lds + LDS_BYTES - 16);
    const GlaArgs G = make_gla(a, l, g);
    for (;;) {
        __syncthreads();
        if (threadIdx.x == 0) *slot = (int)__hip_atomic_fetch_add(ctr, 1u, __ATOMIC_RELAXED, __HIP_MEMORY_SCOPE_AGENT);
        __syncthreads();
        int idx = *slot;
        idx = __builtin_amdgcn_readfirstlane(idx);
        if (idx >= total) break;
        if (idx < N_SCAN) { gla_scan(G, idx >> 2, idx & 3); continue; }
        idx -= N_SCAN;
        if (idx >= N_ATT) { idx -= N_ATT; gla_out(lds, G, idx & 15, idx >> 4); continue; }
        AttnArgs A; A.sink_l2 = 0.f; A.qnw = nullptr; A.band_first = 0;
        if (idx < N_A || (idx >= N_A + N_D + N_B && idx < N_A + N_D + N_B + N_AC)) {
            int bl, h, row, ctxq;
            if (idx < N_A) { bl = idx >> 6; h = (idx >> 4) & 3; const int qb = idx & 15; row = bl * SEQ + 128 * qb; A.qpos0 = 128 * qb; A.ntile = 18; ctxq = 0; }
            else { const int j = idx - (N_A + N_D + N_B); bl = j >> 3; h = (j >> 1) & 3; const int qb = j & 1; row = LAT_ROWS + bl * CTXL + 128 * qb; A.qpos0 = -1; A.ntile = 2; ctxq = 1; }
            (void)ctxq;
            A.Q = QA + (size_t)row * 768 + 192 * h; A.qpitch = 768;
            A.Kc = KA + (size_t)(bl * 4 + h) * KEYS * 192; A.Kl = A.Kc + (size_t)CTXL * 192; A.kpitch = 192;
            A.Vt = (const bf16*)(ws + WS_VTA) + (size_t)(bl * 4 + h) * 128 * KEYS;
            A.O = Y + (size_t)row * 2048 + 128 * h; A.opitch = 2048;
            attn_unit<192, 128, 0>(lds, A); continue; }
        if ((idx >= N_A && idx < N_A + N_D) || (idx >= N_A + N_D + N_B + N_AC && idx < N_A + N_D + N_B + N_AC + N_DC)) {
            int bl, h, row;
            if (idx < N_A + N_D) { const int j = idx - N_A; bl = j >> 6; h = (j >> 4) & 3; const int qb = j & 15; row = bl * SEQ + 128 * qb; A.qpos0 = 128 * qb; A.ntile = 18; }
            else { const int j = idx - (N_A + N_D + N_B + N_AC); bl = j >> 3; h = (j >> 1) & 3; const int qb = j & 1; row = LAT_ROWS + bl * CTXL + 128 * qb; A.qpos0 = -1; A.ntile = 2; }
            const int kvh = h >> 1;
            A.Q = P + (size_t)row * PC + PC_QD + 128 * h; A.qpitch = PC;
            A.Kc = P + (size_t)(LAT_ROWS + bl * CTXL) * PC + PC_KD + 128 * kvh; A.Kl = P + (size_t)(bl * SEQ) * PC + PC_KD + 128 * kvh; A.kpitch = PC;
            A.Vt = (const bf16*)(ws + WS_VTD) + (size_t)(bl * 2 + kvh) * 128 * KEYS;
            A.O = Y + (size_t)row * 2048 + 1536 + 128 * h; A.opitch = 2048; A.qnw = a.in[I_QNW] + l * 128;
            attn_unit<128, 128, 2>(lds, A); continue; }
        {
            int bl, h, row;
            if (idx < N_A + N_D + N_B) { const int j = idx - (N_A + N_D); bl = j >> 7; h = (j >> 4) & 7; const int qb = j & 15; row = bl * SEQ + 128 * qb; A.qpos0 = 128 * qb;
                const int first = qb >= 1 ? qb - 1 : 0, last = qb + 1 < 16 ? qb + 1 : 15; A.band_first = first; A.ntile = 2 + (last - first + 1); }
            else { const int j = idx - (N_A + N_D + N_B + N_AC + N_DC); bl = j >> 4; h = (j >> 1) & 7; const int qb = j & 1; row = LAT_ROWS + bl * CTXL + 128 * qb; A.qpos0 = -1; A.ntile = 2; }
            const int kvh = h >> 2;
            A.Q = P + (size_t)row * PC + PC_QB + 64 * h; A.qpitch = PC;
            A.Kc = P + (size_t)(LAT_ROWS + bl * CTXL) * PC + PC_KB + 64 * kvh; A.Kl = P + (size_t)(bl * SEQ) * PC + PC_KB + 64 * kvh; A.kpitch = PC;
            A.Vt = (const bf16*)(ws + WS_VTB) + (size_t)(bl * 2 + kvh) * 64 * KEYS;
            A.O = Y + (size_t)row * 2048 + 512 + 64 * h; A.opitch = 2048; A.sink_l2 = a.in[I_SINK][l * 8 + h] * 1.4426950408889634f;
            attn_unit<64, 64, 1>(lds, A); }
    }
}


#define XB_TMO      128
#define XB_XCNT(j)  (256  + 64 * (j))
#define XB_XSUB(j)  (1280 + 64 * (j))
#define XB_XGEN(j)  (2304 + 64 * (j))
#define XB_TOP      3328
#define XB_TOPGEN   3392
#define XCD_BAR_WORDS 3456
#define XB_SPIN_CAP (1u << 22)
__device__ __forceinline__ unsigned xb_ld(unsigned* p)              { return __hip_atomic_load(p, __ATOMIC_RELAXED, __HIP_MEMORY_SCOPE_AGENT); }
__device__ __forceinline__ unsigned xb_add(unsigned* p, unsigned v) { return __hip_atomic_fetch_add(p, v, __ATOMIC_RELAXED, __HIP_MEMORY_SCOPE_AGENT); }
__device__ __forceinline__ unsigned xb_xcc_id() { return (unsigned)__builtin_amdgcn_s_getreg((3 << 11) | 20) & 0xFu; }
#define XB_SPIN(cond, bar) do { unsigned _sp = 0; while (cond) { __builtin_amdgcn_s_sleep(1); \
    if ((++_sp & 255u) == 0u) { if (xb_ld(&(bar)[XB_TMO])) break; if (_sp > XB_SPIN_CAP) { atomicAdd(&(bar)[XB_TMO], 1u); break; } } } } while (0)
struct XcdBarrier { unsigned* bar; unsigned x; volatile LAS unsigned* st; };
__device__ __forceinline__ XcdBarrier xcd_barrier_post(unsigned* bar, volatile LAS unsigned* st) {
    XcdBarrier b; b.bar = bar; b.x = xb_xcc_id(); b.st = st;
    if (threadIdx.x == 0) (void)xb_add(&bar[XB_XCNT(b.x)], 1u);
    return b;
}
__device__ __forceinline__ void xcd_barrier_complete(unsigned* bar, unsigned x, unsigned& nloc, unsigned& nx) {
    const unsigned G = gridDim.x * gridDim.y * gridDim.z;
    unsigned sum, cnt, mine, sp = 0u;
    for (;;) {
        sum = 0u; cnt = 0u; mine = 0u;
#pragma unroll
        for (unsigned j = 0; j < 16; ++j) { const unsigned c = xb_ld(&bar[XB_XCNT(j)]); sum += c; cnt += (c > 0u) ? 1u : 0u; mine = (j == x) ? c : mine; }
        if (sum == G) break;
        __builtin_amdgcn_s_sleep(1);
        if ((++sp & 255u) == 0u) { if (xb_ld(&bar[XB_TMO])) break; if (sp > XB_SPIN_CAP) { atomicAdd(&bar[XB_TMO], 1u); break; } }
    }
    nloc = mine > 0u ? mine : 1u; nx = cnt > 0u ? cnt : 1u;
}
__device__ __forceinline__ void xcd_barrier(const XcdBarrier& b) {
    asm volatile("s_waitcnt vmcnt(0)" ::: "memory");
    __syncthreads();
    if (threadIdx.x == 0) {
        unsigned* bar = b.bar;
        __builtin_amdgcn_s_waitcnt(0);
        unsigned nloc = b.st[0], nx = b.st[1];
        if (nloc == 0u) { xcd_barrier_complete(bar, b.x, nloc, nx); b.st[0] = nloc; b.st[1] = nx; }
        const unsigned old = xb_add(&bar[XB_XSUB(b.x)], 1u);
        const unsigned gen = old / nloc;
        if (old + 1u == (gen + 1u) * nloc) {
            __builtin_amdgcn_fence(__ATOMIC_RELEASE, "agent");
            asm volatile("s_waitcnt vmcnt(0)" ::: "memory");
            const unsigned og = xb_add(&bar[XB_TOP], 1u);
            const unsigned tg = og / nx;
            if (og + 1u == (tg + 1u) * nx) xb_add(&bar[XB_TOPGEN], 1u);
            else XB_SPIN(xb_ld(&bar[XB_TOPGEN]) == tg, bar);
            __builtin_amdgcn_fence(__ATOMIC_ACQUIRE, "agent");
            xb_add(&bar[XB_XGEN(b.x)], 1u);
            asm volatile("s_waitcnt vmcnt(0)" ::: "memory");
        } else {
            XB_SPIN(xb_ld(&bar[XB_XGEN(b.x)]) == gen, bar);
            __builtin_amdgcn_fence(__ATOMIC_ACQUIRE, "agent");
            asm volatile("s_waitcnt vmcnt(0)" ::: "memory");
        }
    }
    __syncthreads();
}
constexpr int CW_BAR = 4096;

#ifndef MK_CG_FIRST
#define MK_CG_FIRST 1
#endif
constexpr int N_PHASES = 46;
template <bool COOP>
__global__ void __launch_bounds__(512, 2) mk_fwd(Args args) {
    extern __shared__ __attribute__((aligned(16))) unsigned char lds_raw[];
    LAS unsigned char* lds = (LAS unsigned char*)lds_raw;
    unsigned char* ws = args.ws; unsigned char* wt = ws + WS_WT;
    const int G = gridDim.x, bx = blockIdx.x;
    volatile LAS unsigned* misc = (volatile LAS unsigned*)(lds + LDS_BYTES - 32);
    XcdBarrier bar; bar.bar = nullptr; bar.x = 0; bar.st = misc;
    if (COOP) { if (threadIdx.x < 2) misc[threadIdx.x] = 0u; __syncthreads(); bar = xcd_barrier_post((unsigned*)(ws + WS_CTL) + CW_BAR, misc); }
    for (int p = args.ph_lo; p < args.ph_hi; ++p) {
        if (COOP) { if (p == args.ph_lo + 1 && MK_CG_FIRST) cg::this_grid().sync(); else if (p > args.ph_lo) xcd_barrier(bar); }
        if (p == 0) { prep_weights(args, 0, lds); prep_mods(args, lds); continue; }
        if (p == N_PHASES - 1) { final_norm_rows(args); continue; }
        const int q = p - 1, lg = q / 11, k0 = q - lg * 11, k = k0 >= 5 ? k0 + 1 : k0, l = lg >> 1, g = lg & 1;
        const int nM = (l == 1) ? 32 : 36;
        pg8::StaticOrder S;
        switch (k) {
        case 0: if (l == 1 && g == 0) prep_weights(args, 1, lds); norm_mod_rows(args, l, g, MG_ROWS, 0); break;
        case 1: { pg8::Gemm gm{(const bf16*)(ws + WS_H), (const bf16*)(wt + WT_WIN), 1024, 1024, 1024, 0, 0}; S.init(36, 15, G, bx);
            EpiInProj E{(bf16*)(ws + WS_P), (bf16*)(ws + WS_VTB), (bf16*)(ws + WS_VTC), (bf16*)(ws + WS_VTD)}; pg8::gemm_phase(lds, gm, S, E); break; }
        case 2: { const GlaArgs GG = make_gla(args, l, g); for (int it = bx; it < 1152; it += G) gla_local(lds, GG, it & 31, it >> 5); post_rows(args, l); break; }
        case 3: { pg8::Gemm gm{(const bf16*)(ws + WS_CN), (const bf16*)(wt + WT_WMLA), 384, 384, 384, 0, 0}; S.init(36, 7, G, bx);
            EpiMla E{(bf16*)(ws + WS_QA), (bf16*)(ws + WS_KA), (bf16*)(ws + WS_VTA)}; pg8::gemm_phase(lds, gm, S, E); break; }
        case 4: attn_phase(args, l, g, lds); break;
        case 6: { pg8::Gemm gm{(const bf16*)(ws + WS_Y), (const bf16*)(wt + WT_WB), 2048, 512, 512, 4, 512}; S.init(nM, 16, G, bx);
            EpiStore<0> E{(bf16*)(ws + WS_Z), 4096}; pg8::gemm_phase(lds, gm, S, E); break; }
        case 7: { pg8::Gemm gm{(const bf16*)(ws + WS_H), (const bf16*)(wt + WT_WIN) + (size_t)PC * 1024, 1024, 1024, 1024, 0, 0}; S.init(nM, 16, G, bx);
            EpiMerge E{(const bf16*)(ws + WS_Z), (bf16*)(ws + WS_MG)}; pg8::gemm_phase(lds, gm, S, E); break; }
        case 8: { pg8::Gemm gm{(const bf16*)(ws + WS_MG), (const bf16*)(wt + WT_WO), 1024, 1024, 1024, 0, 0}; S.init(nM, 4, G, bx);
            EpiResid E{&args, l, g, 2, false}; pg8::gemm_phase(lds, gm, S, E); break; }
        case 9: norm_mod_rows(args, l, g, nM * 256, 1); break;
        case 10: { pg8::Gemm gm{(const bf16*)(ws + WS_H), (const bf16*)(wt + WT_W1), 1024, 1024, 1024, 0, 0}; S.init(nM, 16, G, bx);
            EpiStore<1> E{(bf16*)(ws + WS_Z), 4096}; pg8::gemm_phase(lds, gm, S, E); break; }
        default: { pg8::Gemm gm{(const bf16*)(ws + WS_Z), (const bf16*)(wt + WT_W2), 4096, 4096, 4096, 0, 0}; S.init(nM, 4, G, bx);
            EpiResid E{&args, l, g, 5, true}; pg8::gemm_phase(lds, gm, S, E); break; }
        }
    }
}

#ifndef MK_PER_PHASE
#define MK_PER_PHASE 0
#endif
extern "C" void kernel_launch(void* const* d_in, const int* in_sizes, int n_in, void* d_out, int out_size, void* d_ws, size_t ws_size, hipStream_t stream) {
    static int grid = 0;
    if (grid == 0) {
        if (n_in != 24 || out_size != NB * SEQ * DM || ws_size < WS_END) { fprintf(stderr, "kernel_launch: unexpected shapes (n_in %d out %d ws %zu)\n", n_in, out_size, ws_size); grid = -1; return; }
        int dev = 0, cus = 0, per_cu = 0;
        hipGetDevice(&dev); hipDeviceGetAttribute(&cus, hipDeviceAttributeMultiprocessorCount, dev);
        hipFuncSetAttribute((const void*)mk_fwd<true>, hipFuncAttributeMaxDynamicSharedMemorySize, LDS_BYTES);
        hipFuncSetAttribute((const void*)mk_fwd<false>, hipFuncAttributeMaxDynamicSharedMemorySize, LDS_BYTES);
        hipOccupancyMaxActiveBlocksPerMultiprocessor(&per_cu, (const void*)mk_fwd<true>, 512, LDS_BYTES);
        if (per_cu < 1) { fprintf(stderr, "kernel_launch: occupancy query says %d blocks per CU\n", per_cu); per_cu = 1; }
        (void)hipGetLastError();
        grid = cus;
    }
    if (grid < 0) return;
    hipMemsetAsync((char*)d_ws + WS_CTL, 0, 65536, stream);
    Args a{};
    for (int i = 0; i < 24; ++i) a.in[i] = (const float*)d_in[i];
    a.out = (float*)d_out; a.ws = (unsigned char*)d_ws;
#if MK_PER_PHASE
    for (int p = 0; p < N_PHASES; ++p) { a.ph_lo = p; a.ph_hi = p + 1; hipLaunchKernelGGL(mk_fwd<false>, dim3(grid), dim3(512), LDS_BYTES, stream, a); }
#else
    a.ph_lo = 0; a.ph_hi = N_PHASES;
    void* kargs[] = {&a};
    hipError_t e = hipLaunchCooperativeKernel((const void*)mk_fwd<true>, dim3(grid), dim3(512), kargs, LDS_BYTES, stream);
    if (e != hipSuccess) fprintf(stderr, "cooperative launch failed: %s (grid %d)\n", hipGetErrorString(e), grid);
#endif
}
```

```cpp
#include <hip/hip_runtime.h>
#include <hip/hip_cooperative_groups.h>
#include <cstdio>
#include <cstdint>
namespace cg = cooperative_groups;

#define LAS __attribute__((address_space(3)))
typedef unsigned short bf16;
typedef short bf16x8 __attribute__((ext_vector_type(8)));
typedef float f32x4 __attribute__((ext_vector_type(4)));
typedef float f32x16 __attribute__((ext_vector_type(16)));
typedef unsigned u32x4 __attribute__((ext_vector_type(4)));
typedef unsigned u32x2 __attribute__((ext_vector_type(2)));

constexpr int DM = 1024, NB = 8, SEQ = 2048, CTXL = 256, GB = 4, NGRP = 2;
constexpr int MG_ROWS = GB * (SEQ + CTXL);
constexpr int LAT_ROWS = GB * SEQ;
constexpr int KEYS = CTXL + SEQ;
constexpr int IN_COLS = 7904, PC = 3840;
constexpr int WIN_N = 7936;
constexpr float EPS = 1e-6f;
constexpr int PC_CQ = 0, PC_CKV = 256, PC_KR = 384, PC_QB = 448, PC_KB = 960, PC_VB = 1088, PC_QC = 1216, PC_KC = 1472, PC_VC = 1728, PC_RC = 2240,
              PC_LRF = 2752, PC_QD = 2784, PC_KD = 3296, PC_VD = 3552, PC_GATE = 3808;
constexpr size_t MiB = 1u << 20;
constexpr size_t WS_CTL = 0, CTL_BYTES = 1 * MiB;
constexpr size_t WS_MOD = 1 * MiB;
constexpr size_t WS_WT = 2 * MiB;
constexpr size_t WT_WIN = 0, WT_WMLA = WT_WIN + (size_t)WIN_N * 1024 * 2, WT_WB = WT_WMLA + (size_t)1792 * 384 * 2, WT_WO = WT_WB + (size_t)4096 * 512 * 2,
                 WT_W1 = WT_WO + (size_t)1024 * 1024 * 2, WT_W2 = WT_W1 + (size_t)4096 * 1024 * 2, WT_END = WT_W2 + (size_t)1024 * 4096 * 2;
static_assert(WT_END <= 40 * MiB, "weights");
constexpr size_t WS_XC1 = 42 * MiB;
constexpr size_t WS_H = 50 * MiB;
constexpr size_t WS_MG = 68 * MiB;
constexpr size_t WS_Y = 86 * MiB;
constexpr size_t WS_P = 122 * MiB;
constexpr size_t WS_CN = WS_P + (size_t)MG_ROWS * PC * 2;
constexpr size_t WS_QA = WS_CN + (size_t)MG_ROWS * 384 * 2;
constexpr size_t WS_KA = WS_QA + (size_t)MG_ROWS * 768 * 2;
constexpr size_t WS_VTA = WS_KA + (size_t)GB * 4 * KEYS * 192 * 2;
constexpr size_t WS_VTB = WS_VTA + (size_t)GB * 4 * 128 * KEYS * 2;
constexpr size_t WS_VTC = WS_VTB + (size_t)GB * 2 * 64 * KEYS * 2;
constexpr size_t WS_VTD = WS_VTC + (size_t)GB * 4 * 128 * KEYS * 2;
constexpr size_t WS_END = WS_VTD + (size_t)GB * 2 * 128 * KEYS * 2;
constexpr size_t WS_Z = WS_P;
static_assert(WS_Z + (size_t)MG_ROWS * 4096 * 2 <= WS_QA, "Z overlay must stay inside P|CN");
static_assert(WS_END <= 248 * MiB, "workspace");
constexpr size_t WS_H2 = 50 * MiB;
constexpr size_t WS_HID = 86 * MiB;
static_assert(WS_HID + (size_t)2 * MG_ROWS * 4096 * 2 <= 248 * MiB && WS_H2 + (size_t)2 * MG_ROWS * 1024 * 2 <= WS_HID, "merged MLP buffers");
constexpr int LDS_BYTES = 147456;

__device__ __forceinline__ unsigned f2bf(float f) { unsigned u = __builtin_bit_cast(unsigned, f); return (u + 0x7fffu + ((u >> 16) & 1u)) >> 16; }
typedef float f32x2_t __attribute__((ext_vector_type(2))); typedef __bf16 bf16x2_t __attribute__((ext_vector_type(2)));
__device__ __forceinline__ unsigned pk2(float lo, float hi) { f32x2_t v = {lo, hi}; bf16x2_t b = __builtin_convertvector(v, bf16x2_t); return __builtin_bit_cast(unsigned, b); }
__device__ __forceinline__ float bf2f(unsigned short b) { return __builtin_bit_cast(float, (unsigned)b << 16); }
__device__ __forceinline__ float bflo(unsigned w) { return __builtin_bit_cast(float, w << 16); }
__device__ __forceinline__ float bfhi(unsigned w) { return __builtin_bit_cast(float, w & 0xffff0000u); }
__device__ __forceinline__ float wave_sum(float v) {
#pragma unroll
    for (int o = 1; o < 64; o <<= 1) v += __shfl_xor(v, o);
    return v;
}
__device__ __forceinline__ int tidx() { int t = threadIdx.x; asm volatile("" : "+v"(t)); return t; }
__device__ __forceinline__ float sigmoidf_(float x) { return 1.f / (1.f + __expf(-x)); }
__device__ __forceinline__ float siluf_(float x) { return x / (1.f + __expf(-x)); }

namespace pg8 {
constexpr int BM = 256, BK = 64, HALF = 128, HTB = HALF * BK * 2, STAGE_BYTES = 8 * HTB, NXCD = 8, WGM = 8;
__host__ __device__ __forceinline__ int lds_byte(int r, int c) { const int st = (r >> 4) * 2 + (c >> 5), rr = r & 15, cc = c & 31, ob = rr * 64 + cc * 2; return st * 1024 + (ob ^ (((ob >> 9) & 1) << 5)); }
__host__ __device__ __forceinline__ void stage_rc(int b, int& R, int& C) { const int st = b / 1024, sb = b % 1024, swz = sb ^ (((sb >> 9) & 1) << 5); R = (st >> 1) * 16 + swz / 64; C = (st & 1) * 32 + (swz % 64) / 2; }
__host__ __device__ __forceinline__ int perm32(int rho) { const int n = rho >> 4, i = rho & 15; return 8 * (i >> 2) + 4 * n + (i & 3); }

struct Unit { int pm, pn; };
struct Gemm { const bf16* A; const bf16* Bt; int lda, ldb, K; int adiv, amul; };

struct StaticOrder {
    int nM, nN, nwg, G, c;
    __device__ void init(int nM_, int nN_, int G_, int c_) { nM = nM_; nN = nN_; nwg = nM * nN; G = G_; c = c_; }
    __device__ bool next(int i, Unit& u) const {
        const long L = (long)i * G + c; if (L >= nwg) return false;
        int wgid = (int)L; { const int q = nwg / NXCD, r = nwg % NXCD, xcd = wgid % NXCD, off = wgid / NXCD; wgid = (xcd < r ? xcd * (q + 1) : r * (q + 1) + (xcd - r) * q) + off; }
        const int nig = WGM * nN, gid = wgid / nig, fm = gid * WGM, gsz = (nM - fm) < WGM ? (nM - fm) : WGM;
        u.pm = fm + ((wgid % nig) % gsz); u.pn = (wgid % nig) / gsz; return true;
    }
};
template <class Epi>
__device__ __forceinline__ void gemm_phase(LAS unsigned char* lds, const Gemm g, const StaticOrder& S, const Epi& E) {
    const int tid = tidx(), wid = __builtin_amdgcn_readfirstlane(tid >> 6), lane = tid & 63, wr = wid >> 2, wc = wid & 3, fr = lane & 15, fq = lane >> 4;
    const int K = g.K, nt = K / BK;
    unsigned voffA[2], voffB[2];
#pragma unroll
    for (int i = 0; i < 2; ++i) { int R, C; stage_rc(tid * 16 + i * 8192, R, C); const int Rb = (R & ~31) + perm32(R & 31);
        voffA[i] = (unsigned)(R * g.lda + C) * 2u; voffB[i] = (unsigned)(Rb * g.ldb + C) * 2u; }
    const size_t kstep = (size_t)(BK * 2);
    const size_t hstepA = (size_t)HALF * g.lda * 2, hstepB = (size_t)HALF * g.ldb * 2;
    const size_t tstepA = 2 * hstepA, tstepB = 2 * hstepB;
    const unsigned ldsw = (unsigned)wid * 1024u;
    const int aoff = lds_byte(wr * 64 + fr, fq * 8), boff = lds_byte(wc * 32 + fr, fq * 8);
#define PG8_SA(b, h) (((b) * 2 + (h)) * HTB)
#define PG8_SB(b, h) ((4 + (b) * 2 + (h)) * HTB)
#define PG8_STAGE(bufoff, gbase, voff) do { _Pragma("unroll") for (int _i = 0; _i < 2; ++_i) \
        __builtin_amdgcn_global_load_lds((const unsigned*)((const char*)(gbase) + (voff)[_i]), (LAS unsigned*)(lds + (bufoff) + ldsw + _i * 8192), 16, 0, 0); } while (0)
#define PG8_LDA(dst, b, h) do { _Pragma("unroll") for (int m = 0; m < 4; ++m) _Pragma("unroll") for (int k = 0; k < 2; ++k) dst[m][k] = *(const LAS bf16x8*)(lds + PG8_SA(b, h) + aoff + m * 2048 + k * 1024); } while (0)
#define PG8_LDB(dst, b, h) do { _Pragma("unroll") for (int n = 0; n < 2; ++n) _Pragma("unroll") for (int k = 0; k < 2; ++k) dst[n][k] = *(const LAS bf16x8*)(lds + PG8_SB(b, h) + boff + n * 2048 + k * 1024); } while (0)
#define PG8_MMA(ai, bj, At, Bt) do { __builtin_amdgcn_s_setprio(1); _Pragma("unroll") for (int m = 0; m < 4; ++m) _Pragma("unroll") for (int n = 0; n < 2; ++n) _Pragma("unroll") for (int k = 0; k < 2; ++k) \
        acc[ai][bj][m][n] = __builtin_amdgcn_mfma_f32_16x16x32_bf16(Bt[n][k], At[m][k], acc[ai][bj][m][n], 0, 0, 0); __builtin_amdgcn_s_setprio(0); } while (0)
#define PG8_WAIT_V(n) asm volatile("s_waitcnt vmcnt(" #n ")" ::: "memory")
#define PG8_WAIT_L(n) asm volatile("s_waitcnt lgkmcnt(" #n ")" ::: "memory")
#define PG8_BAR __builtin_amdgcn_s_barrier()
#define PG8_SCHED __builtin_amdgcn_sched_barrier(0)
#define PG8_AOFF(u) ((size_t)(g.adiv ? ((u).pn / g.adiv) * g.amul * 2 : 0))
    Unit cur, nxt; int ui = 0;
    if (!S.next(0, cur)) return;
    f32x4 acc[2][2][4][2];
#pragma unroll
    for (int a = 0; a < 2; ++a)
#pragma unroll
        for (int b = 0; b < 2; ++b)
#pragma unroll
            for (int m = 0; m < 4; ++m)
#pragma unroll
                for (int n = 0; n < 2; ++n) acc[a][b][m][n] = (f32x4){0.f, 0.f, 0.f, 0.f};
    bf16x8 At[4][2], B0[2][2], B1[2][2];
    const char* cA = (const char*)g.A + (size_t)cur.pm * tstepA + PG8_AOFF(cur); const char* cB = (const char*)g.Bt + (size_t)cur.pn * tstepB;
    PG8_STAGE(PG8_SB(0, 0), cB, voffB); PG8_STAGE(PG8_SB(0, 1), cB + hstepB, voffB); PG8_STAGE(PG8_SA(0, 0), cA, voffA); PG8_STAGE(PG8_SA(0, 1), cA + hstepA, voffA);
    if (wr == 1) PG8_BAR;
    PG8_WAIT_V(2); PG8_BAR;
    PG8_STAGE(PG8_SB(1, 0), cB + kstep, voffB); PG8_STAGE(PG8_SA(1, 0), cA + kstep, voffA); PG8_STAGE(PG8_SB(1, 1), cB + hstepB + kstep, voffB);
    PG8_WAIT_V(6); PG8_BAR;
    for (;;) {
        const bool has_next = S.next(ui + 1, nxt);
        const char* nA = has_next ? (const char*)g.A + (size_t)nxt.pm * tstepA + PG8_AOFF(nxt) : cA; const char* nB = has_next ? (const char*)g.Bt + (size_t)nxt.pn * tstepB : cB;
#pragma unroll 1
        for (int t = 0; t < nt; t += 2) {
            const bool last = (t == nt - 2);
            const char* a1 = cA + (size_t)(t + 1) * kstep;
            const char* a2 = last ? nA : cA + (size_t)(t + 2) * kstep; const char* b2 = last ? nB : cB + (size_t)(t + 2) * kstep;
            const char* a3 = a2 + kstep; const char* b3 = b2 + kstep;
            PG8_LDB(B0, 0, 0); PG8_LDB(B1, 0, 1); PG8_SCHED; PG8_LDA(At, 0, 0); PG8_STAGE(PG8_SA(1, 1), a1 + hstepA, voffA);
            PG8_WAIT_V(8); PG8_WAIT_L(0); PG8_BAR; PG8_MMA(0, 0, At, B0); PG8_MMA(0, 1, At, B1); PG8_BAR; PG8_SCHED;
            PG8_LDA(At, 0, 1); PG8_STAGE(PG8_SB(0, 0), b2, voffB); PG8_STAGE(PG8_SB(0, 1), b2 + hstepB, voffB); PG8_STAGE(PG8_SA(0, 0), a2, voffA);
            PG8_WAIT_V(8); PG8_WAIT_L(0); PG8_BAR; PG8_MMA(1, 0, At, B0); PG8_MMA(1, 1, At, B1); PG8_BAR; PG8_SCHED;
            PG8_LDB(B0, 1, 0); PG8_LDB(B1, 1, 1); PG8_SCHED; PG8_LDA(At, 1, 0); PG8_STAGE(PG8_SA(0, 1), a2 + hstepA, voffA);
            PG8_WAIT_V(8); PG8_WAIT_L(0); PG8_BAR; PG8_MMA(0, 0, At, B0); PG8_MMA(0, 1, At, B1); PG8_BAR; PG8_SCHED;
            PG8_LDA(At, 1, 1); PG8_STAGE(PG8_SB(1, 0), b3, voffB); PG8_STAGE(PG8_SB(1, 1), b3 + hstepB, voffB); PG8_STAGE(PG8_SA(1, 0), a3, voffA);
            PG8_WAIT_V(8); PG8_WAIT_L(0); PG8_BAR; PG8_MMA(1, 0, At, B0); PG8_MMA(1, 1, At, B1); PG8_BAR; PG8_SCHED;
        }
        if (wr == 0) PG8_BAR;
        E(acc, cur, wr, wc, fr, fq);
        if (!has_next) break;
#pragma unroll
        for (int a = 0; a < 2; ++a)
#pragma unroll
            for (int b = 0; b < 2; ++b)
#pragma unroll
                for (int m = 0; m < 4; ++m)
#pragma unroll
                    for (int n = 0; n < 2; ++n) acc[a][b][m][n] = (f32x4){0.f, 0.f, 0.f, 0.f};
        cur = nxt; cA = nA; cB = nB; ++ui;
        if (wr == 1) PG8_BAR;
    }
    PG8_WAIT_V(0);
    PG8_BAR;
#undef PG8_SA
#undef PG8_SB
#undef PG8_STAGE
#undef PG8_LDA
#undef PG8_LDB
#undef PG8_MMA
#undef PG8_WAIT_V
#undef PG8_WAIT_L
#undef PG8_BAR
#undef PG8_SCHED
#undef PG8_AOFF
}
}

struct Args {
    const float* in[24];
    float* out; unsigned char* ws;
    int ph_lo, ph_hi;
};
enum { I_X = 0, I_C, I_CTX, I_CCTX, I_ADAW, I_ADAB, I_N1W, I_N2W, I_WIN, I_MQNW, I_MWUQ, I_MKVNW, I_MWUKV, I_SINK, I_GWD, I_GBD, I_GNW, I_QNW, I_KNW, I_WBR, I_WO, I_W1, I_W2, I_FNW };

struct Ctx {
    const Args* a; unsigned char* ws; int l, g;
};
__device__ __forceinline__ const float* xrow_src(const Args& a, int l, int g, int r) {
    if (r < LAT_ROWS) { const size_t gr = (size_t)(g * GB) * SEQ + r; return (l == 0 ? a.in[I_X] : a.out) + gr * DM; }
    const size_t cr = (size_t)(g * GB) * CTXL + (r - LAT_ROWS); return (l == 0 ? a.in[I_CTX] : (const float*)(a.ws + WS_XC1)) + cr * DM;
}
__device__ __forceinline__ float* xrow_dst(const Args& a, int g, int r) {
    if (r < LAT_ROWS) { const size_t gr = (size_t)(g * GB) * SEQ + r; return a.out + gr * DM; }
    const size_t cr = (size_t)(g * GB) * CTXL + (r - LAT_ROWS); return (float*)(a.ws + WS_XC1) + cr * DM;
}
__device__ __forceinline__ int row_bi(int g, int r) { return r < LAT_ROWS ? g * GB + (r >> 11) : 8; }
__device__ __forceinline__ void row_blk(int r, int& bl, int& kap) { if (r < LAT_ROWS) { bl = r >> 11; kap = CTXL + (r & 2047); } else { bl = (r - LAT_ROWS) >> 8; kap = (r - LAT_ROWS) & 255; } }

using pg8::Unit;
__device__ __forceinline__ u32x4 pack8(const f32x4 v0, const f32x4 v1) { u32x4 w; w.x = pk2(v0[0], v0[1]); w.y = pk2(v0[2], v0[3]); w.z = pk2(v1[0], v1[1]); w.w = pk2(v1[2], v1[3]); return w; }

template <int ACT> struct EpiStore {
    bf16* O; int ldc;
    __device__ __forceinline__ void operator()(const f32x4 (&acc)[2][2][4][2], const Unit& u, int wr, int wc, int fr, int fq) const {
        const int row0 = u.pm * 256 + wr * 64 + fr, col0 = u.pn * 256 + wc * 32 + 8 * fq;
#pragma unroll
        for (int ai = 0; ai < 2; ++ai)
#pragma unroll
            for (int m = 0; m < 4; ++m) { bf16* rowp = O + (size_t)(row0 + ai * 128 + m * 16) * ldc + col0;
#pragma unroll
                for (int bj = 0; bj < 2; ++bj) { f32x4 v0 = acc[ai][bj][m][0], v1 = acc[ai][bj][m][1];
                    if (ACT == 1) {
#pragma unroll
                        for (int j = 0; j < 4; ++j) { const float a = fmaxf(v0[j], 0.f), b = fmaxf(v1[j], 0.f); v0[j] = a * a; v1[j] = b * b; } }
                    *(u32x4*)(rowp + bj * 128) = pack8(v0, v1); } }
    }
};
__device__ __forceinline__ void store_vt(const f32x4 (&acc)[2][2][4][2], int bj, bf16* vt, int nheads, int dv, int colbase  , int pm, int wr, int fr, int fq) {
    int bl, kap0; row_blk(pm * 256, bl, kap0);
    const int c0 = colbase + 8 * fq, head = c0 / dv, e0 = c0 - head * dv;
    bf16* vp = vt + ((size_t)(bl * nheads + head) * dv + e0) * KEYS + kap0 + wr * 64 + fr;
#pragma unroll
    for (int ai = 0; ai < 2; ++ai)
#pragma unroll
        for (int m = 0; m < 4; ++m)
#pragma unroll
            for (int n = 0; n < 2; ++n)
#pragma unroll
                for (int j = 0; j < 4; ++j) vp[(size_t)(4 * n + j) * KEYS + ai * 128 + m * 16] = (bf16)f2bf(acc[ai][bj][m][n][j]);
}
struct EpiInProj {
    bf16* P; bf16 *vtb, *vtc, *vtd;
    __device__ __forceinline__ void operator()(const f32x4 (&acc)[2][2][4][2], const Unit& u, int wr, int wc, int fr, int fq) const {
        const int row0 = u.pm * 256 + wr * 64 + fr;
#pragma unroll
        for (int bj = 0; bj < 2; ++bj) {
            const int cg = u.pn * 256 + bj * 128 + wc * 32;
            if (cg >= PC_VB && cg < PC_QC) store_vt(acc, bj, vtb, 2, 64, cg - PC_VB, u.pm, wr, fr, fq);
            else if (cg >= PC_VC && cg < PC_RC) store_vt(acc, bj, vtc, 4, 128, cg - PC_VC, u.pm, wr, fr, fq);
            else if (cg >= PC_VD && cg < PC_GATE) store_vt(acc, bj, vtd, 2, 128, cg - PC_VD, u.pm, wr, fr, fq);
            else {
#pragma unroll
                for (int ai = 0; ai < 2; ++ai)
#pragma unroll
                    for (int m = 0; m < 4; ++m) *(u32x4*)(P + (size_t)(row0 + ai * 128 + m * 16) * PC + cg + 8 * fq) = pack8(acc[ai][bj][m][0], acc[ai][bj][m][1]);
            }
        }
    }
};
struct EpiMla {
    bf16 *QA, *KA, *vta;
    __device__ __forceinline__ void operator()(const f32x4 (&acc)[2][2][4][2], const Unit& u, int wr, int wc, int fr, int fq) const {
        const int row0 = u.pm * 256 + wr * 64 + fr;
        int bl, kap0; row_blk(u.pm * 256, bl, kap0);
#pragma unroll
        for (int bj = 0; bj < 2; ++bj) {
            const int cg = u.pn * 256 + bj * 128 + wc * 32;
            if (cg < 768) {
#pragma unroll
                for (int ai = 0; ai < 2; ++ai)
#pragma unroll
                    for (int m = 0; m < 4; ++m) *(u32x4*)(QA + (size_t)(row0 + ai * 128 + m * 16) * 768 + cg + 8 * fq) = pack8(acc[ai][bj][m][0], acc[ai][bj][m][1]);
            } else if (cg < 1280) {
                const int c = cg - 768 + 8 * fq, head = c >> 7, j0 = c & 127;
#pragma unroll
                for (int ai = 0; ai < 2; ++ai)
#pragma unroll
                    for (int m = 0; m < 4; ++m) { const int kap = kap0 + ai * 128 + wr * 64 + m * 16 + fr;
                        *(u32x4*)(KA + ((size_t)(bl * 4 + head) * KEYS + kap) * 192 + j0) = pack8(acc[ai][bj][m][0], acc[ai][bj][m][1]); }
            } else store_vt(acc, bj, vta, 4, 128, cg - 1280, u.pm, wr, fr, fq);
        }
    }
};
struct EpiMerge {
    const bf16* Z; bf16* MGo;
    __device__ __forceinline__ void operator()(const f32x4 (&acc)[2][2][4][2], const Unit& u, int wr, int wc, int fr, int fq) const {
        const int row0 = u.pm * 256 + wr * 64 + fr, d0 = u.pn * 64 + wc * 16 + fq * 4;
#pragma unroll
        for (int ai = 0; ai < 2; ++ai)
#pragma unroll
            for (int m = 0; m < 4; ++m) { const size_t row = (size_t)(row0 + ai * 128 + m * 16); float o[4] = {0.f, 0.f, 0.f, 0.f};
#pragma unroll
                for (int bj = 0; bj < 2; ++bj)
#pragma unroll
                    for (int n = 0; n < 2; ++n) { const int nb = 2 * bj + n; const u32x2 z = *(const u32x2*)(Z + row * 4096 + nb * 1024 + d0);
                        const f32x4 a = acc[ai][bj][m][n];
                        o[0] += sigmoidf_(a[0]) * bflo(z.x); o[1] += sigmoidf_(a[1]) * bfhi(z.x); o[2] += sigmoidf_(a[2]) * bflo(z.y); o[3] += sigmoidf_(a[3]) * bfhi(z.y); }
                u32x2 w; w.x = pk2(o[0], o[1]); w.y = pk2(o[2], o[3]); *(u32x2*)(MGo + row * 1024 + d0) = w; }
    }
};
struct EpiResid {
    const Args* a; int l, g, chunk; bool from_dst; int nMg;
    __device__ __forceinline__ void operator()(const f32x4 (&acc)[2][2][4][2], const Unit& u, int wr, int wc, int fr, int fq) const {
        const int g = nMg ? u.pm / nMg : this->g; const int rt = (nMg ? u.pm - g * nMg : u.pm) * 256; const int bi = row_bi(g, rt);
        const float* src = from_dst ? (const float*)xrow_dst(*a, g, rt) : xrow_src(*a, l, g, rt); float* dst = xrow_dst(*a, g, rt);
        const float* mod = (const float*)(a->ws + WS_MOD) + ((size_t)(l * 9 + bi) * 6 + chunk) * 1024;
        const int rl0 = wr * 64 + fr;
#pragma unroll
        for (int bj = 0; bj < 2; ++bj) { const int c0 = u.pn * 256 + bj * 128 + wc * 32 + 8 * fq;
            const f32x4 g0 = *(const f32x4*)(mod + c0), g1 = *(const f32x4*)(mod + c0 + 4);
#pragma unroll
            for (int ai = 0; ai < 2; ++ai)
#pragma unroll
                for (int m = 0; m < 4; ++m) { const size_t off = (size_t)(rl0 + ai * 128 + m * 16) * DM + c0;
                    const f32x4 x0 = *(const f32x4*)(src + off), x1 = *(const f32x4*)(src + off + 4);
                    *(f32x4*)(dst + off) = x0 + g0 * acc[ai][bj][m][0]; *(f32x4*)(dst + off + 4) = x1 + g1 * acc[ai][bj][m][1]; } }
    }
};

__device__ __forceinline__ float wfetch(const Args& a, int kind, int l, int n, int k) {
    switch (kind) {
    case 0: {
        int src;
        if (n < PC_GATE) src = n; else if (n < PC) return 0.f;
        else { const int t = n - PC, tg = t >> 8, c = t & 255; const int nb = 2 * (c >> 7) + ((c >> 2) & 1), dd = 16 * ((c >> 5) & 3) + 4 * ((c >> 3) & 3) + (c & 3); src = PC_GATE + nb * 1024 + 64 * tg + dd; }
        return a.in[I_WIN][((size_t)l * 1024 + k) * IN_COLS + src]; }
    case 1: {
        if (n < 768) return k < 256 ? a.in[I_MWUQ][((size_t)l * 256 + k) * 768 + n] : 0.f;
        if (k < 256) return 0.f;
        const int m = n - 768; const int src = m < 512 ? (m >> 7) * 256 + (m & 127) : ((m - 512) >> 7) * 256 + 128 + ((m - 512) & 127);
        return a.in[I_MWUKV][((size_t)l * 128 + (k - 256)) * 1024 + src]; }
    case 2: { const int nb = n >> 10, d = n & 1023; return a.in[I_WBR][(((size_t)l * 4 + nb) * 512 + k) * 1024 + d]; }
    case 3: return a.in[I_WO][((size_t)l * 1024 + k) * 1024 + n];
    case 4: return a.in[I_W1][((size_t)l * 1024 + k) * 4096 + n];
    default: return a.in[I_W2][((size_t)l * 4096 + k) * 1024 + n];
    }
}
__device__ __forceinline__ void transpose_item(const Args& a, int kind, int l, int K, bf16* WT, int item, int nblk, LAS float* scr, int lane) {
    const int kb = item / nblk, nb = item % nblk, k0 = 64 * kb, n0 = 32 * nb;
#pragma unroll 8
    for (int i = 0; i < 32; ++i) { const int kk = 2 * i + (lane >> 5); scr[kk * 33 + (lane & 31)] = wfetch(a, kind, l, n0 + (lane & 31), k0 + kk); }
    asm volatile("s_waitcnt lgkmcnt(0)" ::: "memory");
    const int c = lane & 7;
#pragma unroll
    for (int j = 0; j < 4; ++j) { const int n = (lane >> 3) + 8 * j; const LAS float* s = scr + (8 * c) * 33 + n;
        u32x4 o; o.x = pk2(s[0 * 33], s[1 * 33]); o.y = pk2(s[2 * 33], s[3 * 33]); o.z = pk2(s[4 * 33], s[5 * 33]); o.w = pk2(s[6 * 33], s[7 * 33]);
        *(u32x4*)(WT + (size_t)(n0 + n) * K + k0 + 8 * c) = o; }
    asm volatile("s_waitcnt lgkmcnt(0)" ::: "memory");
}
__device__ __forceinline__ void prep_weights(const Args& a, int l, LAS unsigned char* lds) {
    const int tid = tidx(), lane = tid & 63, wave = tid >> 6;
    LAS float* scr = (LAS float*)(lds + wave * 8704);
    unsigned char* wt = a.ws + WS_WT;
    constexpr int I0 = 16 * (WIN_N / 32), I1 = 6 * (1792 / 32), I2 = 8 * (4096 / 32), I3 = 16 * (1024 / 32), I4 = 16 * (4096 / 32), I5 = 64 * (1024 / 32);
    const int gw = blockIdx.x * 8 + wave, NGW = gridDim.x * 8;
    for (int it = gw; it < I0 + I1 + I2 + I3 + I4 + I5; it += NGW) {
        int r = it;
        if (r < I0) { transpose_item(a, 0, l, 1024, (bf16*)(wt + WT_WIN), r, WIN_N / 32, scr, lane); continue; } r -= I0;
        if (r < I1) { transpose_item(a, 1, l, 384, (bf16*)(wt + WT_WMLA), r, 1792 / 32, scr, lane); continue; } r -= I1;
        if (r < I2) { transpose_item(a, 2, l, 512, (bf16*)(wt + WT_WB), r, 4096 / 32, scr, lane); continue; } r -= I2;
        if (r < I3) { transpose_item(a, 3, l, 1024, (bf16*)(wt + WT_WO), r, 1024 / 32, scr, lane); continue; } r -= I3;
        if (r < I4) { transpose_item(a, 4, l, 1024, (bf16*)(wt + WT_W1), r, 4096 / 32, scr, lane); continue; } r -= I4;
        transpose_item(a, 5, l, 4096, (bf16*)(wt + WT_W2), r, 1024 / 32, scr, lane);
    }
}
__device__ __forceinline__ void prep_mods(const Args& a, LAS unsigned char* lds) {
    const int tid = tidx(), lane = tid & 63, wave = tid >> 6;
    LAS float* sc = (LAS float*)(lds + 73728);
    LAS float* red = (LAS float*)(lds + 73728 + 36864);
    for (int i = tid; i < 9 * 1024; i += 512) { const int bi = i >> 10, k = i & 1023; const float v = bi < 8 ? a.in[I_C][bi * 1024 + k] : a.in[I_CCTX][k]; sc[i] = siluf_(v); }
    __syncthreads();
    for (int item = blockIdx.x; item < 2 * 96; item += gridDim.x) {
        const int l = item / 96, n = (item % 96) * 64 + lane;
        float acc[9];
#pragma unroll
        for (int b = 0; b < 9; ++b) acc[b] = 0.f;
        const float* w = a.in[I_ADAW] + ((size_t)l * 1024 + wave * 128) * 6144 + n;
#pragma unroll 8
        for (int k = 0; k < 128; ++k) { const float wv = w[(size_t)k * 6144];
#pragma unroll
            for (int b = 0; b < 9; ++b) acc[b] += sc[b * 1024 + wave * 128 + k] * wv; }
#pragma unroll
        for (int b = 0; b < 9; ++b) red[(wave * 9 + b) * 64 + lane] = acc[b];
        __syncthreads();
        if (wave == 0) {
            const float bias = a.in[I_ADAB][l * 6144 + n];
#pragma unroll
            for (int b = 0; b < 9; ++b) { float s = bias;
#pragma unroll
                for (int w8 = 0; w8 < 8; ++w8) s += red[(w8 * 9 + b) * 64 + lane];
                ((float*)(a.ws + WS_MOD))[((size_t)l * 9 + b) * 6144 + n] = s; }
        }
        __syncthreads();
    }
}

__device__ __forceinline__ void norm_mod_rows(const Args& a, int l, int g0, int nrows, int which  ) {
    const int tid = tidx(), lane = tid & 63, gw = blockIdx.x * 8 + (tid >> 6), NGW = gridDim.x * 8;
    const float* nw = a.in[which ? I_N2W : I_N1W] + l * DM;
    bf16* H = (bf16*)(a.ws + (which ? WS_H2 : WS_H)); const int nMg = (l == 0) ? 36 : 32;
    for (int R = gw; R < nrows; R += NGW) {
        int g = g0, r = R; if (which) { const int T = R >> 8; g = T / nMg; r = (T - g * nMg) * 256 + (R & 255); }
        const float* xr = which ? (const float*)xrow_dst(a, g, r) : xrow_src(a, l, g, r);
        const float* mod = (const float*)(a.ws + WS_MOD) + ((size_t)(l * 9 + row_bi(g, r)) * 6 + (which ? 3 : 0)) * 1024;
        f32x4 v[4]; float s = 0.f;
#pragma unroll
        for (int j = 0; j < 4; ++j) { v[j] = *(const f32x4*)(xr + 4 * lane + 256 * j); s += (v[j][0] * v[j][0] + v[j][1] * v[j][1]) + (v[j][2] * v[j][2] + v[j][3] * v[j][3]); }
        const float rstd = rsqrtf(wave_sum(s) * (1.f / DM) + EPS);
#pragma unroll
        for (int j = 0; j < 4; ++j) { const int c = 4 * lane + 256 * j; const f32x4 w = *(const f32x4*)(nw + c), sh = *(const f32x4*)(mod + c), sc = *(const f32x4*)(mod + 1024 + c);
            f32x4 y;
#pragma unroll
            for (int e = 0; e < 4; ++e) y[e] = v[j][e] * rstd * w[e] * (1.f + sc[e]) + sh[e];
            u32x2 o; o.x = pk2(y[0], y[1]); o.y = pk2(y[2], y[3]); *(u32x2*)(H + (size_t)R * DM + c) = o; }
    }
}
__device__ __forceinline__ void final_norm_rows(const Args& a) {
    const int tid = tidx(), lane = tid & 63, gw = blockIdx.x * 8 + (tid >> 6), NGW = gridDim.x * 8;
    const float* nw = a.in[I_FNW];
    for (int r = gw; r < NB * SEQ; r += NGW) {
        float* xr = a.out + (size_t)r * DM;
        f32x4 v[4]; float s = 0.f;
#pragma unroll
        for (int j = 0; j < 4; ++j) { v[j] = *(const f32x4*)(xr + 4 * lane + 256 * j); s += (v[j][0] * v[j][0] + v[j][1] * v[j][1]) + (v[j][2] * v[j][2] + v[j][3] * v[j][3]); }
        const float rstd = rsqrtf(wave_sum(s) * (1.f / DM) + EPS);
#pragma unroll
        for (int j = 0; j < 4; ++j) { const int c = 4 * lane + 256 * j; const f32x4 w = *(const f32x4*)(nw + c); *(f32x4*)(xr + c) = v[j] * rstd * w; }
    }
}
__device__ __forceinline__ void rope_pair(float& x1, float& x2, int pos, int i, int quarter) {
    const float inv = exp2f(-(float)i * (13.287712379549449f / (float)quarter));
    const float ang = (float)pos * inv; const float s = __sinf(ang), c = __cosf(ang);
    const float a = x1 * c - x2 * s, b = x1 * s + x2 * c; x1 = a; x2 = b;
}
__device__ __forceinline__ void post_rows(const Args& a, int l) {
    const int tid = tidx(), lane = tid & 63, gw = blockIdx.x * 8 + (tid >> 6), NGW = gridDim.x * 8;
    bf16* P = (bf16*)(a.ws + WS_P); bf16* CN = (bf16*)(a.ws + WS_CN); bf16* KA = (bf16*)(a.ws + WS_KA);
    const float* qnw = a.in[I_MQNW] + l * 256; const float* kvnw = a.in[I_MKVNW] + l * 128; const float* knw = a.in[I_KNW] + l * 128;
    for (int r = gw; r < MG_ROWS; r += NGW) {
        bf16* pr = P + (size_t)r * PC;
        const bool lat = r < LAT_ROWS; const int t = r & 2047, rowp = t >> 6, colp = t & 63;
        int bl, kap; row_blk(r, bl, kap);
        {
            const u32x2 w = *(const u32x2*)(pr + PC_CQ + 4 * lane); float x[4] = {bflo(w.x), bfhi(w.x), bflo(w.y), bfhi(w.y)};
            const float rstd = rsqrtf(wave_sum(x[0] * x[0] + x[1] * x[1] + x[2] * x[2] + x[3] * x[3]) * (1.f / 256.f) + EPS);
            const f32x4 nw = *(const f32x4*)(qnw + 4 * lane);
            u32x2 o; o.x = pk2(x[0] * rstd * nw[0], x[1] * rstd * nw[1]); o.y = pk2(x[2] * rstd * nw[2], x[3] * rstd * nw[3]);
            *(u32x2*)(CN + (size_t)r * 384 + 4 * lane) = o; }
        {
            const unsigned w = *(const unsigned*)(pr + PC_CKV + 2 * lane); const float x0 = bflo(w), x1 = bfhi(w);
            const float rstd = rsqrtf(wave_sum(x0 * x0 + x1 * x1) * (1.f / 128.f) + EPS);
            *(unsigned*)(CN + (size_t)r * 384 + 256 + 2 * lane) = pk2(x0 * rstd * kvnw[2 * lane], x1 * rstd * kvnw[2 * lane + 1]); }
        if (lane < 32) {
            const int part = lane >> 4, i = lane & 15, d1 = 32 * part + i, d2 = d1 + 16;
            float x1 = bf2f(pr[PC_KR + d1]), x2 = bf2f(pr[PC_KR + d2]);
            if (lat) rope_pair(x1, x2, part ? colp : rowp, i, 16);
            const bf16 o1 = (bf16)f2bf(x1), o2 = (bf16)f2bf(x2);
#pragma unroll
            for (int h = 0; h < 4; ++h) { bf16* kd = KA + ((size_t)(bl * 4 + h) * KEYS + kap) * 192 + 128; kd[d1] = o1; kd[d2] = o2; }
        }
        if (lat) {
            const int hh = lane >> 5, part = (lane >> 4) & 1, i = lane & 15, d1 = 64 * hh + 32 * part + i, d2 = d1 + 16;
            float x1 = bf2f(pr[PC_KB + d1]), x2 = bf2f(pr[PC_KB + d2]);
            rope_pair(x1, x2, part ? colp : rowp, i, 16);
            pr[PC_KB + d1] = (bf16)f2bf(x1); pr[PC_KB + d2] = (bf16)f2bf(x2);
        }
        {
            const int hh = lane >> 5, i = lane & 31; bf16* kd = pr + PC_KD + 128 * hh;
            float x0 = bf2f(kd[i]), x1 = bf2f(kd[32 + i]), x2 = bf2f(kd[64 + i]), x3 = bf2f(kd[96 + i]);
            float ss = x0 * x0 + x1 * x1 + x2 * x2 + x3 * x3;
#pragma unroll
            for (int o = 1; o < 32; o <<= 1) ss += __shfl_xor(ss, o);
            const float rstd = rsqrtf(ss * (1.f / 128.f) + EPS);
            x0 *= rstd * knw[i]; x1 *= rstd * knw[32 + i]; x2 *= rstd * knw[64 + i]; x3 *= rstd * knw[96 + i];
            if (lat) { rope_pair(x0, x1, rowp, i, 32); rope_pair(x2, x3, colp, i, 32); }
            kd[i] = (bf16)f2bf(x0); kd[32 + i] = (bf16)f2bf(x1); kd[64 + i] = (bf16)f2bf(x2); kd[96 + i] = (bf16)f2bf(x3);
        }
    }
}
__device__ __forceinline__ void comb_rows(const Args& a, int l, int nrows) {
    const int tid = tidx(), lane = tid & 63, gw = blockIdx.x * 8 + (tid >> 6), NGW = gridDim.x * 8;
    const bf16* P = (const bf16*)(a.ws + WS_P); bf16* Y = (bf16*)(a.ws + WS_Y); const bf16* OB = (const bf16*)(a.ws + WS_MG);
    const float* gnw = a.in[I_GNW] + l * 128;
    for (int r = gw; r < nrows; r += NGW) {
#pragma unroll
        for (int h = 0; h < 4; ++h) {
            const int e = 2 * lane;
            const unsigned wf = *(const unsigned*)(Y + (size_t)r * 2048 + 1024 + 128 * h + e), wb = *(const unsigned*)(OB + (size_t)r * 512 + 128 * h + e), wr_ = *(const unsigned*)(P + (size_t)r * PC + PC_RC + 128 * h + e);
            const float o0 = bflo(wf) + bflo(wb), o1 = bfhi(wf) + bfhi(wb);
            const float rstd = rsqrtf(wave_sum(o0 * o0 + o1 * o1) * (1.f / 128.f) + EPS);
            *(unsigned*)(Y + (size_t)r * 2048 + 1024 + 128 * h + e) = pk2(o0 * rstd * gnw[e] * siluf_(bflo(wr_)), o1 * rstd * gnw[e + 1] * siluf_(bfhi(wr_)));
        }
    }
}

struct AttnArgs {
    const bf16* Q; int qpitch;
    const bf16* Kc; const bf16* Kl; int kpitch;
    const bf16* Vt;
    bf16* O; int opitch;
    int qpos0, ntile, band_first;
    float sink_l2; const float* qnw;
};
__device__ __forceinline__ float max3f(float a, float b, float c) { float r; asm("v_max3_f32 %0, %1, %2, %3" : "=v"(r) : "v"(a), "v"(b), "v"(c)); return r; }
template <int DK, int DV, int MODE>
__device__ __forceinline__ void attn_unit(LAS unsigned char* lds, const AttnArgs& A) {
    constexpr int KS = DK * 2 + 16, VS = 136, NS = DK / 16, NDT = DV / 32, KCH = DK / 8, NKC = KCH / 8, NVC = DV / 64;
    constexpr int V_OFF = 64 * KS, BUFSZ = V_OFF + DV * VS;
    static_assert(BUFSZ % 16 == 0 && 2 * BUFSZ <= LDS_BYTES - 64, "attention LDS");
    const int tid = tidx(), lane = tid & 63, wave = __builtin_amdgcn_readfirstlane(tid >> 6);
    const int r = lane & 31, h = lane >> 5;
    const bool lat = A.qpos0 >= 0;
    bf16x8 qf[NS];
    {
        float qv[NS][8];
        const bf16* qrow = A.Q + (size_t)(32 * wave + r) * A.qpitch + 8 * h;
#pragma unroll
        for (int s = 0; s < NS; ++s) { const u32x4 w = *(const u32x4*)(qrow + 16 * s);
            qv[s][0] = bflo(w.x); qv[s][1] = bfhi(w.x); qv[s][2] = bflo(w.y); qv[s][3] = bfhi(w.y); qv[s][4] = bflo(w.z); qv[s][5] = bfhi(w.z); qv[s][6] = bflo(w.w); qv[s][7] = bfhi(w.w); }
        if (MODE == 2) {
            float ss = 0.f;
#pragma unroll
            for (int s = 0; s < NS; ++s)
#pragma unroll
                for (int j = 0; j < 8; ++j) ss += qv[s][j] * qv[s][j];
            ss += __shfl_xor(ss, 32);
            const float rstd = rsqrtf(ss * (1.f / 128.f) + EPS);
#pragma unroll
            for (int s = 0; s < NS; ++s)
#pragma unroll
                for (int j = 0; j < 8; ++j) qv[s][j] *= rstd * A.qnw[16 * s + 8 * h + j];
        }
        if (lat) {
            const int pos = A.qpos0 + 32 * wave + r, rowp = pos >> 6, colp = pos & 63;
#pragma unroll
            for (int j = 0; j < 8; ++j) {
                if (MODE == 0) { rope_pair(qv[8][j], qv[9][j], rowp, 8 * h + j, 16); rope_pair(qv[10][j], qv[11][j], colp, 8 * h + j, 16); }
                if (MODE == 1) { rope_pair(qv[0][j], qv[1][j], rowp, 8 * h + j, 16); rope_pair(qv[2][j], qv[3][j], colp, 8 * h + j, 16); }
                if (MODE == 2) { rope_pair(qv[0][j], qv[2][j], rowp, 8 * h + j, 32); rope_pair(qv[1][j], qv[3][j], rowp, 16 + 8 * h + j, 32);
                                 rope_pair(qv[4][j], qv[6][j], colp, 8 * h + j, 32); rope_pair(qv[5][j], qv[7][j], colp, 16 + 8 * h + j, 32); }
            }
        }
        const float c = (MODE == 0 ? 0.07216878364870322f : MODE == 1 ? 0.125f : 0.08838834764831845f) * 1.4426950408889634f;
#pragma unroll
        for (int s = 0; s < NS; ++s) { u32x4 w; w.x = pk2(qv[s][0] * c, qv[s][1] * c); w.y = pk2(qv[s][2] * c, qv[s][3] * c); w.z = pk2(qv[s][4] * c, qv[s][5] * c); w.w = pk2(qv[s][6] * c, qv[s][7] * c);
            qf[s] = __builtin_bit_cast(bf16x8, w); }
    }
    float m_run = -INFINITY, l_run = 0.f;
    f32x16 acc[NDT];
#pragma unroll
    for (int d = 0; d < NDT; ++d)
#pragma unroll
        for (int i = 0; i < 16; ++i) acc[d][i] = 0.f;
    u32x4 kreg[NKC], vreg[NVC];
    const int qlo = A.qpos0 + 32 * wave;
#define ATT_K0(i) ((MODE == 1 && lat && (i) >= 4) ? CTXL + A.band_first + 64 * ((i) - 4) : 64 * (i))
#define ATT_LOAD(i) do { const int k0_ = ATT_K0(i); const bf16* kb_ = ((k0_ < CTXL) ? A.Kc + (size_t)k0_ * A.kpitch : A.Kl + (size_t)(k0_ - CTXL) * A.kpitch) + (size_t)(tid >> 3) * A.kpitch + 8 * (tid & 7); \
        _Pragma("unroll") for (int c_ = 0; c_ < NKC; ++c_) kreg[c_] = *(const u32x4*)(kb_ + 64 * c_); \
        const bf16* vb_ = A.Vt + (size_t)(tid >> 3) * KEYS + k0_ + 8 * (tid & 7); \
        _Pragma("unroll") for (int p_ = 0; p_ < NVC; ++p_) vreg[p_] = *(const u32x4*)(vb_ + (size_t)(64 * p_) * KEYS); } while (0)
#define ATT_WRITE(b) do { LAS unsigned char* kw_ = lds + (b) * BUFSZ + (tid >> 3) * KS + (tid & 7) * 16; \
        _Pragma("unroll") for (int c_ = 0; c_ < NKC; ++c_) *(LAS u32x4*)(kw_ + 128 * c_) = kreg[c_]; \
        LAS unsigned char* vw_ = lds + (b) * BUFSZ + V_OFF + (tid >> 3) * VS + (tid & 7) * 16; \
        _Pragma("unroll") for (int p_ = 0; p_ < NVC; ++p_) { u32x2 lo_, hi_; lo_.x = vreg[p_].x; lo_.y = vreg[p_].y; hi_.x = vreg[p_].z; hi_.y = vreg[p_].w; \
            *(LAS u32x2*)(vw_ + 64 * p_ * VS) = lo_; *(LAS u32x2*)(vw_ + 64 * p_ * VS + 8) = hi_; } } while (0)
    ATT_LOAD(0);
    __syncthreads();
    ATT_WRITE(0);
    __syncthreads();
#pragma unroll 1
    for (int it = 0; it < A.ntile; ++it) {
        const int buf = it & 1;
        const bool more = it + 1 < A.ntile;
        if (more) ATT_LOAD(it + 1);
        bool active = true;
        if (MODE == 1 && lat && it >= 4) { const int kb0 = A.band_first + 64 * (it - 4); active = !(kb0 > qlo + 31 + 128 || kb0 + 63 < qlo - 128); }
        if (active) {
            f32x16 st0, st1;
#pragma unroll
            for (int i = 0; i < 16; ++i) { st0[i] = 0.f; st1[i] = 0.f; }
            const LAS unsigned char* kb = lds + buf * BUFSZ + r * KS + 16 * h;
            {
                bf16x8 kfr[2][2];
                kfr[0][0] = *(const LAS bf16x8*)(kb); kfr[0][1] = *(const LAS bf16x8*)(kb + 32 * KS);
                kfr[1][0] = *(const LAS bf16x8*)(kb + 32); kfr[1][1] = *(const LAS bf16x8*)(kb + 32 * KS + 32);
#pragma unroll
                for (int s = 0; s < NS; ++s) {
                    st0 = __builtin_amdgcn_mfma_f32_32x32x16_bf16(kfr[s & 1][0], qf[s], st0, 0, 0, 0);
                    st1 = __builtin_amdgcn_mfma_f32_32x32x16_bf16(kfr[s & 1][1], qf[s], st1, 0, 0, 0);
                    if (s + 2 < NS) { kfr[s & 1][0] = *(const LAS bf16x8*)(kb + 32 * (s + 2)); kfr[s & 1][1] = *(const LAS bf16x8*)(kb + 32 * KS + 32 * (s + 2)); }
                }
            }
            if (MODE == 1 && lat && it >= 4) {
                const int qpos = qlo + r, kb0 = A.band_first + 64 * (it - 4) + 4 * h;
#pragma unroll
                for (int i = 0; i < 16; ++i) { const int kpos = kb0 + (i & 3) + 8 * (i >> 2); const int d0 = qpos - kpos, d1 = d0 - 32;
                    if (d0 > 128 || d0 < -128) st0[i] = -INFINITY;
                    if (d1 > 128 || d1 < -128) st1[i] = -INFINITY; }
            }
            float mt = max3f(st0[0], st1[0], st0[1]);
            mt = max3f(mt, st1[1], st0[2]);
#pragma unroll
            for (int i = 2; i < 15; ++i) mt = max3f(mt, st1[i], st0[i + 1]);
            mt = fmaxf(mt, st1[15]);
            mt = fmaxf(mt, __shfl_xor(mt, 32));
            const float mnew = fmaxf(m_run, mt);
            const float alpha = __builtin_amdgcn_exp2f(m_run - mnew);
            m_run = mnew;
            float ps = 0.f;
#pragma unroll
            for (int i = 0; i < 16; ++i) { st0[i] = __builtin_amdgcn_exp2f(st0[i] - mnew); st1[i] = __builtin_amdgcn_exp2f(st1[i] - mnew); ps += st0[i] + st1[i]; }
            l_run = l_run * alpha + ps;
#pragma unroll
            for (int d = 0; d < NDT; ++d)
#pragma unroll
                for (int i = 0; i < 16; ++i) acc[d][i] *= alpha;
            bf16x8 pf[2][2];
#pragma unroll
            for (int u = 0; u < 2; ++u) {
                u32x4 w0, w1;
                w0.x = pk2(st0[8 * u + 0], st0[8 * u + 1]); w0.y = pk2(st0[8 * u + 2], st0[8 * u + 3]); w0.z = pk2(st0[8 * u + 4], st0[8 * u + 5]); w0.w = pk2(st0[8 * u + 6], st0[8 * u + 7]);
                w1.x = pk2(st1[8 * u + 0], st1[8 * u + 1]); w1.y = pk2(st1[8 * u + 2], st1[8 * u + 3]); w1.z = pk2(st1[8 * u + 4], st1[8 * u + 5]); w1.w = pk2(st1[8 * u + 6], st1[8 * u + 7]);
                pf[0][u] = __builtin_bit_cast(bf16x8, w0); pf[1][u] = __builtin_bit_cast(bf16x8, w1);
            }
            const LAS unsigned char* vb = lds + buf * BUFSZ + V_OFF + r * VS + 8 * h;
            {
                constexpr int NM = 4 * NDT;
#define ATT_VLD(m) ({ const LAS unsigned char* p_ = vb + ((m) % NDT) * 32 * VS + (32 * ((m) / (2 * NDT)) + 16 * (((m) / NDT) & 1)) * 2; \
                const u32x2 lo_ = *(const LAS u32x2*)p_, hi_ = *(const LAS u32x2*)(p_ + 16); u32x4 w_; w_.x = lo_.x; w_.y = lo_.y; w_.z = hi_.x; w_.w = hi_.y; __builtin_bit_cast(bf16x8, w_); })
                bf16x8 vfr[2];
                vfr[0] = ATT_VLD(0); vfr[1] = ATT_VLD(1);
#pragma unroll
                for (int m = 0; m < NM; ++m) {
                    acc[m % NDT] = __builtin_amdgcn_mfma_f32_32x32x16_bf16(vfr[m & 1], pf[m / (2 * NDT)][(m / NDT) & 1], acc[m % NDT], 0, 0, 0);
                    if (m + 2 < NM) vfr[m & 1] = ATT_VLD(m + 2);
                }
#undef ATT_VLD
            }
        }
        if (more) ATT_WRITE(buf ^ 1);
        __syncthreads();
    }
#undef ATT_LOAD
#undef ATT_WRITE
#undef ATT_K0
    l_run += __shfl_xor(l_run, 32);
    if (MODE == 1) l_run += __builtin_amdgcn_exp2f(A.sink_l2 - m_run);
    const float inv = 1.f / l_run;
    bf16* orow = A.O + (size_t)(32 * wave + r) * A.opitch + 4 * h;
#pragma unroll
    for (int d = 0; d < NDT; ++d)
#pragma unroll
        for (int i4 = 0; i4 < 4; ++i4) {
            u32x2 w; w.x = pk2(acc[d][4 * i4] * inv, acc[d][4 * i4 + 1] * inv); w.y = pk2(acc[d][4 * i4 + 2] * inv, acc[d][4 * i4 + 3] * inv);
            *(u32x2*)(orow + 32 * d + 8 * i4) = w;
        }
}

constexpr size_t WS_GU = WS_MG;
constexpr size_t WS_GDL = WS_MOD + 512 * 1024;
constexpr int CW_GLA = 8192;
__device__ __forceinline__ float logsigmoidf_(float x) { return fminf(x, 0.f) - __logf(1.f + __expf(-fabsf(x))); }
struct GlaArgs { const bf16* P; const bf16* VtC; bf16* Y; bf16* GU; float* GDL; unsigned* cnt; const float* wd; const float* bd; const float* gnw; int need_ctx; };
__device__ __forceinline__ void gla_rows(int c, int dir, int bl, int& row0, int& kap0) {
    if (c < 4) { const int ch = dir ? 3 - c : c; row0 = LAT_ROWS + bl * CTXL + 64 * ch; kap0 = 64 * ch; }
    else { const int ch = dir ? 35 - c : c - 4; row0 = bl * SEQ + 64 * ch; kap0 = CTXL + 64 * ch; }
}
constexpr int GL_RS = 144;
constexpr int GO_RQ = 0, GO_RK = 9216, GO_VT = 18432, GO_LR = 36864  , GO_WD = 40960  , GO_BD = 49152  , GO_GT = 49664, GO_DL = 51712, GO_QT = 51968, GO_KT = 61184,
              GO_KH = 70400, GO_AT = 79616, GO_ST = 88832, GO_RED = 107264  , GO_END = 108288;
__device__ __forceinline__ void gla_decay(LAS unsigned char* lds, int dsel, int dir, int wave, int d, float (&cum)[8], float& tot) {
    float la[8];
    {
        float wdv[16];
#pragma unroll
        for (int q = 0; q < 16; ++q) wdv[q] = ((const LAS float*)(lds + GO_WD + dsel * 4096))[q * 64 + d];
        const float bdv = ((const LAS float*)(lds + GO_BD + dsel * 256))[d];
#pragma unroll
        for (int i = 0; i < 8; ++i) { const LAS unsigned* lr = (const LAS unsigned*)(lds + GO_LR + dsel * 2048 + (8 * wave + i) * 32); float x = bdv;
#pragma unroll
            for (int q = 0; q < 8; ++q) { const unsigned w = lr[q]; x += bflo(w) * wdv[2 * q] + bfhi(w) * wdv[2 * q + 1]; }
            la[i] = logsigmoidf_(x) * (1.f / 16.f); }
    }
    float s = 0.f;
    if (dir == 0) {
#pragma unroll
        for (int i = 0; i < 8; ++i) { s += la[i]; cum[i] = s; } }
    else {
#pragma unroll
        for (int i = 7; i >= 0; --i) { s += la[i]; cum[i] = s; } }
    ((LAS float*)(lds + GO_GT))[wave * 64 + d] = s;
    __syncthreads();
    float pre = 0.f; tot = 0.f;
#pragma unroll
    for (int w8 = 0; w8 < 8; ++w8) { const float gt = ((const LAS float*)(lds + GO_GT))[w8 * 64 + d]; tot += gt; if (dir == 0 ? (w8 < wave) : (w8 > wave)) pre += gt; }
#pragma unroll
    for (int i = 0; i < 8; ++i) cum[i] += pre;
}
__device__ __forceinline__ void gla_signal(unsigned* word, unsigned v, int tid) {
    asm volatile("s_waitcnt vmcnt(0)" ::: "memory");
    __syncthreads();
    if (tid == 0) { __builtin_amdgcn_fence(__ATOMIC_RELEASE, "agent"); asm volatile("s_waitcnt vmcnt(0)" ::: "memory"); __hip_atomic_fetch_add(word, v, __ATOMIC_RELAXED, __HIP_MEMORY_SCOPE_AGENT); }
}
__device__ __forceinline__ void gla_wait(unsigned* w0, unsigned* w1, unsigned need, int tid) {
    if (tid == 0) {
        unsigned sp = 0;
        while (__hip_atomic_load(w0, __ATOMIC_RELAXED, __HIP_MEMORY_SCOPE_AGENT) < need || __hip_atomic_load(w1, __ATOMIC_RELAXED, __HIP_MEMORY_SCOPE_AGENT) < need) { __builtin_amdgcn_s_sleep(2); if (++sp > (1u << 22)) break; }
        __builtin_amdgcn_fence(__ATOMIC_ACQUIRE, "agent");
        asm volatile("s_waitcnt vmcnt(0)" ::: "memory");
    }
    __syncthreads();
}
__device__ __forceinline__ void gla_local(LAS unsigned char* lds, const GlaArgs& G, int chain, int c) {
    const int tid = tidx(), lane = tid & 63, wave = __builtin_amdgcn_readfirstlane(tid >> 6), r = lane & 31, hh = lane >> 5;
    const int dir = chain & 1, h = (chain >> 1) & 3, bl = chain >> 3;
    int row0, kap0; gla_rows(c, dir, bl, row0, kap0);
    const bf16* pr = G.P + (size_t)(row0 + (tid >> 3)) * PC + 8 * (tid & 7);
    const u32x4 rk = *(const u32x4*)(pr + PC_KC + 64 * h);
    const bf16* vp = G.VtC + ((size_t)(bl * 4 + h) * 128 + (tid >> 3)) * KEYS + kap0 + 8 * (tid & 7);
    const u32x4 rv0 = *(const u32x4*)vp, rv1 = *(const u32x4*)(vp + (size_t)64 * KEYS);
    u32x4 rl = {0u, 0u, 0u, 0u};
    if (tid < 128) rl = *(const u32x4*)(G.P + (size_t)(row0 + (tid >> 1)) * PC + PC_LRF + 16 * dir + 8 * (tid & 1));
    __syncthreads();
    for (int i = tid; i < 1024; i += 512) ((LAS float*)(lds + GO_WD))[i] = G.wd[(size_t)dir * 4096 + (size_t)(i >> 6) * 256 + 64 * h + (i & 63)];
    if (tid < 64) ((LAS float*)(lds + GO_BD))[tid] = G.bd[dir * 256 + 64 * h + tid];
    *(LAS u32x4*)(lds + GO_RK + (tid >> 3) * GL_RS + (tid & 7) * 16) = rk;
    *(LAS u32x4*)(lds + GO_VT + (tid >> 3) * GL_RS + (tid & 7) * 16) = rv0; *(LAS u32x4*)(lds + GO_VT + (64 + (tid >> 3)) * GL_RS + (tid & 7) * 16) = rv1;
    if (tid < 128) *(LAS u32x4*)(lds + GO_LR + (tid >> 1) * 32 + (tid & 1) * 16) = rl;
    __syncthreads();
    const int d = lane; float cum[8], tot;
    gla_decay(lds, 0, dir, wave, d, cum, tot);
    if (wave == 0) G.GDL[((size_t)chain * 36 + c) * 64 + d] = __expf(tot);
    {
        unsigned kh[4];
#pragma unroll
        for (int i = 0; i < 8; ++i) { const int s = 8 * wave + i; const float kv = bf2f(*(const LAS bf16*)(lds + GO_RK + s * GL_RS + 2 * d));
            const unsigned khv = f2bf(kv * __expf(tot - cum[i]));
            if (i & 1) kh[i >> 1] |= khv << 16; else kh[i >> 1] = khv; }
        u32x4 w; w.x = kh[0]; w.y = kh[1]; w.z = kh[2]; w.w = kh[3];
        *(LAS u32x4*)(lds + GO_KH + d * GL_RS + 16 * wave) = w;
    }
    __syncthreads();
    const int et = wave >> 1, dt = wave & 1;
    f32x16 u;
#pragma unroll
    for (int i = 0; i < 16; ++i) u[i] = 0.f;
#pragma unroll
    for (int kk = 0; kk < 4; ++kk) { const bf16x8 af = *(const LAS bf16x8*)(lds + GO_VT + (32 * et + r) * GL_RS + (16 * kk + 8 * hh) * 2), bfr = *(const LAS bf16x8*)(lds + GO_KH + (32 * dt + r) * GL_RS + (16 * kk + 8 * hh) * 2);
        u = __builtin_amdgcn_mfma_f32_32x32x16_bf16(af, bfr, u, 0, 0, 0); }
    bf16* up = G.GU + ((size_t)chain * 36 + c) * 8192 + 32 * dt + r;
#pragma unroll
    for (int i = 0; i < 16; ++i) { const int e = 32 * et + (i & 3) + 8 * (i >> 2) + 4 * hh; up[e * 64] = (bf16)f2bf(u[i]); }
}
__device__ __forceinline__ void gla_scan(const GlaArgs& G, int chain, int quarter) {
    const int tid = tidx();
    const int e = 32 * quarter + (tid >> 4), d0 = 4 * (tid & 15);
    bf16* up = G.GU + (size_t)chain * 36 * 8192 + e * 64 + d0; const float* dlp = G.GDL + (size_t)chain * 36 * 64 + d0;
    float S[4] = {0.f, 0.f, 0.f, 0.f};
#pragma unroll 1
    for (int c0 = 0; c0 < 36; c0 += 12) {
        u32x2 uu[12]; f32x4 dl[12];
#pragma unroll
        for (int j = 0; j < 12; ++j) { uu[j] = *(const u32x2*)(up + (size_t)(c0 + j) * 8192); dl[j] = *(const f32x4*)(dlp + (c0 + j) * 64); }
#pragma unroll
        for (int j = 0; j < 12; ++j) {
            S[0] = dl[j][0] * S[0] + bflo(uu[j].x); S[1] = dl[j][1] * S[1] + bfhi(uu[j].x); S[2] = dl[j][2] * S[2] + bflo(uu[j].y); S[3] = dl[j][3] * S[3] + bfhi(uu[j].y);
            const unsigned long long w = (unsigned long long)pk2(S[0], S[1]) | ((unsigned long long)pk2(S[2], S[3]) << 32);
            __hip_atomic_store((unsigned long long*)(up + (size_t)(c0 + j) * 8192), w, __ATOMIC_RELAXED, __HIP_MEMORY_SCOPE_AGENT); }
    }
    asm volatile("s_waitcnt vmcnt(0)" ::: "memory");
    __syncthreads();
    if (tid == 0) __hip_atomic_fetch_add(G.cnt + chain * 16, 100u, __ATOMIC_RELAXED, __HIP_MEMORY_SCOPE_AGENT);
}
__device__ __forceinline__ void gla_out(LAS unsigned char* lds, const GlaArgs& G, int bh, int j) {
    const int tid = tidx(), lane = tid & 63, wave = __builtin_amdgcn_readfirstlane(tid >> 6), r = lane & 31, hh = lane >> 5;
    const int h = bh & 3, bl = bh >> 2;
    const bool isctx = j >= 32; const int ch = isctx ? j - 32 : j;
    const int row0 = isctx ? LAT_ROWS + bl * CTXL + 64 * ch : bl * SEQ + 64 * ch, kap0 = isctx ? 64 * ch : CTXL + 64 * ch;
    const bf16* pr = G.P + (size_t)(row0 + (tid >> 3)) * PC + 8 * (tid & 7);
    const u32x4 rq = *(const u32x4*)(pr + PC_QC + 64 * h), rk = *(const u32x4*)(pr + PC_KC + 64 * h);
    const bf16* vp = G.VtC + ((size_t)(bl * 4 + h) * 128 + (tid >> 3)) * KEYS + kap0 + 8 * (tid & 7);
    const u32x4 rv0 = *(const u32x4*)vp, rv1 = *(const u32x4*)(vp + (size_t)64 * KEYS);
    u32x4 rl = {0u, 0u, 0u, 0u};
    if (tid < 256) rl = *(const u32x4*)(G.P + (size_t)(row0 + ((tid & 127) >> 1)) * PC + PC_LRF + 16 * (tid >> 7) + 8 * (tid & 1));
    __syncthreads();
    for (int i = tid; i < 2048; i += 512) { const int dsel = i >> 10, q = (i >> 6) & 15, dd = i & 63; ((LAS float*)(lds + GO_WD))[i] = G.wd[(size_t)dsel * 4096 + (size_t)q * 256 + 64 * h + dd]; }
    if (tid < 128) ((LAS float*)(lds + GO_BD))[tid] = G.bd[(tid >> 6) * 256 + 64 * h + (tid & 63)];
    *(LAS u32x4*)(lds + GO_RQ + (tid >> 3) * GL_RS + (tid & 7) * 16) = rq; *(LAS u32x4*)(lds + GO_RK + (tid >> 3) * GL_RS + (tid & 7) * 16) = rk;
    *(LAS u32x4*)(lds + GO_VT + (tid >> 3) * GL_RS + (tid & 7) * 16) = rv0; *(LAS u32x4*)(lds + GO_VT + (64 + (tid >> 3)) * GL_RS + (tid & 7) * 16) = rv1;
    if (tid < 256) *(LAS u32x4*)(lds + GO_LR + (tid >> 7) * 2048 + ((tid & 127) >> 1) * 32 + (tid & 1) * 16) = rl;
    const int chain0 = bh * 2;
    gla_wait(G.cnt + chain0 * 16, G.cnt + (chain0 + 1) * 16, 400u, tid);
    const int et = wave >> 1, tt = wave & 1, d = lane;
    f32x16 oc;
#pragma unroll
    for (int i = 0; i < 16; ++i) oc[i] = 0.f;
#pragma unroll 1
    for (int dir = 0; dir < 2; ++dir) {
        if (dir) __syncthreads();
        const int pos = dir == 0 ? (isctx ? ch : 4 + ch) : (isctx ? 3 - ch : 35 - ch);
        {
            u32x4 s0 = {0u, 0u, 0u, 0u}, s1 = {0u, 0u, 0u, 0u};
            if (pos > 0) { const bf16* sp = G.GU + ((size_t)(chain0 + dir) * 36 + pos - 1) * 8192 + (tid >> 3) * 64 + 8 * (tid & 7); s0 = *(const u32x4*)sp; s1 = *(const u32x4*)(sp + 64 * 64); }
            *(LAS u32x4*)(lds + GO_ST + (tid >> 3) * GL_RS + (tid & 7) * 16) = s0; *(LAS u32x4*)(lds + GO_ST + (64 + (tid >> 3)) * GL_RS + (tid & 7) * 16) = s1;
        }
        float cum[8], tot;
        gla_decay(lds, dir, dir, wave, d, cum, tot);
#pragma unroll
        for (int i = 0; i < 8; ++i) { const int s = 8 * wave + i;
            const float qv = bf2f(*(const LAS bf16*)(lds + GO_RQ + s * GL_RS + 2 * d)), kv = bf2f(*(const LAS bf16*)(lds + GO_RK + s * GL_RS + 2 * d));
            *(LAS bf16*)(lds + GO_QT + s * GL_RS + 2 * d) = (bf16)f2bf(qv * 0.125f * __expf(cum[i]));
            *(LAS bf16*)(lds + GO_KT + s * GL_RS + 2 * d) = (bf16)f2bf(kv * __expf(-cum[i])); }
        __syncthreads();
        if (wave < 4) {
            const int ss = wave & 1, t2 = wave >> 1;
            f32x16 sc;
#pragma unroll
            for (int i = 0; i < 16; ++i) sc[i] = 0.f;
#pragma unroll
            for (int kk = 0; kk < 4; ++kk) { const bf16x8 af = *(const LAS bf16x8*)(lds + GO_KT + (32 * ss + r) * GL_RS + (16 * kk + 8 * hh) * 2), bfr = *(const LAS bf16x8*)(lds + GO_QT + (32 * t2 + r) * GL_RS + (16 * kk + 8 * hh) * 2);
                sc = __builtin_amdgcn_mfma_f32_32x32x16_bf16(af, bfr, sc, 0, 0, 0); }
            const int t = 32 * t2 + r;
#pragma unroll
            for (int i4 = 0; i4 < 4; ++i4) { float v[4];
#pragma unroll
                for (int jj = 0; jj < 4; ++jj) { const int s = 32 * ss + 8 * i4 + 4 * hh + jj; const bool keep = dir == 0 ? (s <= t) : (s >= t); v[jj] = keep ? sc[4 * i4 + jj] : 0.f; }
                u32x2 w; w.x = pk2(v[0], v[1]); w.y = pk2(v[2], v[3]); *(LAS u32x2*)(lds + GO_AT + t * GL_RS + (32 * ss + 8 * i4 + 4 * hh) * 2) = w; }
        }
        __syncthreads();
#pragma unroll
        for (int kk = 0; kk < 4; ++kk) { const bf16x8 af = *(const LAS bf16x8*)(lds + GO_ST + (32 * et + r) * GL_RS + (16 * kk + 8 * hh) * 2), bfr = *(const LAS bf16x8*)(lds + GO_QT + (32 * tt + r) * GL_RS + (16 * kk + 8 * hh) * 2);
            oc = __builtin_amdgcn_mfma_f32_32x32x16_bf16(af, bfr, oc, 0, 0, 0); }
#pragma unroll
        for (int kk = 0; kk < 4; ++kk) { const bf16x8 af = *(const LAS bf16x8*)(lds + GO_VT + (32 * et + r) * GL_RS + (16 * kk + 8 * hh) * 2), bfr = *(const LAS bf16x8*)(lds + GO_AT + (32 * tt + r) * GL_RS + (16 * kk + 8 * hh) * 2);
            oc = __builtin_amdgcn_mfma_f32_32x32x16_bf16(af, bfr, oc, 0, 0, 0); }
    }
    float ss = 0.f;
#pragma unroll
    for (int i = 0; i < 16; ++i) ss += oc[i] * oc[i];
    ss += __shfl_xor(ss, 32);
    if (hh == 0) ((LAS float*)(lds + GO_RED))[et * 64 + 32 * tt + r] = ss;
    __syncthreads();
    const int t = 32 * tt + r;
    const float tot2 = ((const LAS float*)(lds + GO_RED))[t] + ((const LAS float*)(lds + GO_RED))[64 + t] + ((const LAS float*)(lds + GO_RED))[128 + t] + ((const LAS float*)(lds + GO_RED))[192 + t];
    const float rstd = rsqrtf(tot2 * (1.f / 128.f) + EPS);
    const int row = row0 + t;
    const bf16* rp = G.P + (size_t)row * PC + PC_RC + 128 * h + 32 * et + 4 * hh; bf16* yp = G.Y + (size_t)row * 2048 + 1024 + 128 * h + 32 * et + 4 * hh; const float* gw = G.gnw + 32 * et + 4 * hh;
#pragma unroll
    for (int i4 = 0; i4 < 4; ++i4) { const u32x2 rr = *(const u32x2*)(rp + 8 * i4); const f32x4 w = *(const f32x4*)(gw + 8 * i4);
        const float y0 = oc[4 * i4] * rstd * w[0] * siluf_(bflo(rr.x)), y1 = oc[4 * i4 + 1] * rstd * w[1] * siluf_(bfhi(rr.x)), y2 = oc[4 * i4 + 2] * rstd * w[2] * siluf_(bflo(rr.y)), y3 = oc[4 * i4 + 3] * rstd * w[3] * siluf_(bfhi(rr.y));
        u32x2 o; o.x = pk2(y0, y1); o.y = pk2(y2, y3); *(u32x2*)(yp + 8 * i4) = o; }
}

__device__ __forceinline__ GlaArgs make_gla(const Args& a, int l, int g) {
    unsigned char* ws = a.ws; GlaArgs G; G.P = (const bf16*)(ws + WS_P); G.VtC = (const bf16*)(ws + WS_VTC); G.Y = (bf16*)(ws + WS_Y); G.GU = (bf16*)(ws + WS_GU); G.GDL = (float*)(ws + WS_GDL);
    G.cnt = (unsigned*)(ws + WS_CTL) + CW_GLA + (l * 2 + g) * 32 * 16; G.wd = a.in[I_GWD] + (size_t)l * 2 * 16 * 256; G.bd = a.in[I_GBD] + (size_t)l * 2 * 256; G.gnw = a.in[I_GNW] + l * 128; G.need_ctx = (l == 0);
    return G;
}
__device__ __forceinline__ void attn_phase(const Args& a, int l, int g, LAS unsigned char* lds) {
    unsigned char* ws = a.ws;
    const bf16* P = (const bf16*)(ws + WS_P); const bf16* QA = (const bf16*)(ws + WS_QA); const bf16* KA = (const bf16*)(ws + WS_KA);
    bf16* Y = (bf16*)(ws + WS_Y);
    const int need_ctx = (l == 0);
    const int N_SCAN = 128, N_A = 128, N_D = 128, N_B = 256, N_AC = need_ctx ? 16 : 0, N_DC = N_AC, N_BC = need_ctx ? 32 : 0, N_OUT = (need_ctx ? 36 : 32) * 16;
    const int N_ATT = N_A + N_D + N_B + N_AC + N_DC + N_BC;
    const int total = N_SCAN + N_ATT + N_OUT;
    unsigned* ctr = (unsigned*)(ws + WS_CTL) + (l * 2 + g) * 64;
    volatile LAS int* slot = (volatile LAS int*)(lds + LDS_BYTES - 16);
    const GlaArgs G = make_gla(a, l, g);
    for (;;) {
        __syncthreads();
        if (threadIdx.x == 0) *slot = (int)__hip_atomic_fetch_add(ctr, 1u, __ATOMIC_RELAXED, __HIP_MEMORY_SCOPE_AGENT);
        __syncthreads();
        int idx = *slot;
        idx = __builtin_amdgcn_readfirstlane(idx);
        if (idx >= total) break;
        if (idx < N_SCAN) { gla_scan(G, idx >> 2, idx & 3); continue; }
        idx -= N_SCAN;
        if (idx >= N_ATT) { idx -= N_ATT; gla_out(lds, G, idx & 15, idx >> 4); continue; }
        AttnArgs A; A.sink_l2 = 0.f; A.qnw = nullptr; A.band_first = 0;
        int kind, j, ctxq;
        if (idx < N_A) { kind = 0; j = idx; ctxq = 0; }
        else if (idx < N_A + N_D) { kind = 2; j = idx - N_A; ctxq = 0; }
        else if (idx < N_A + N_D + N_B) { kind = 1; j = idx - N_A - N_D; ctxq = 0; }
        else if (idx < N_A + N_D + N_B + N_AC) { kind = 0; j = idx - (N_A + N_D + N_B); ctxq = 1; }
        else if (idx < N_A + N_D + N_B + N_AC + N_DC) { kind = 2; j = idx - (N_A + N_D + N_B + N_AC); ctxq = 1; }
        else { kind = 1; j = idx - (N_A + N_D + N_B + N_AC + N_DC); ctxq = 1; }
        const int H = kind == 1 ? 8 : 4;
        int bl, h, row, qb = 0;
        if (!ctxq) { bl = j / (H * 8); h = (j >> 3) % H; qb = j & 7; row = bl * SEQ + 256 * qb; A.qpos0 = 256 * qb; A.ntile = 36; }
        else { bl = j / H; h = j % H; row = LAT_ROWS + bl * CTXL; A.qpos0 = -1; A.ntile = 4; }
        A.opitch = 2048;
        if (kind == 0) {
            A.Q = QA + (size_t)row * 768 + 192 * h; A.qpitch = 768;
            A.Kc = KA + (size_t)(bl * 4 + h) * KEYS * 192; A.Kl = A.Kc + (size_t)CTXL * 192; A.kpitch = 192;
            A.Vt = (const bf16*)(ws + WS_VTA) + (size_t)(bl * 4 + h) * 128 * KEYS;
            A.O = Y + (size_t)row * 2048 + 128 * h;
            attn_unit<192, 128, 0>(lds, A);
        } else if (kind == 2) {
            const int kvh = h >> 1;
            A.Q = P + (size_t)row * PC + PC_QD + 128 * h; A.qpitch = PC;
            A.Kc = P + (size_t)(LAT_ROWS + bl * CTXL) * PC + PC_KD + 128 * kvh; A.Kl = P + (size_t)(bl * SEQ) * PC + PC_KD + 128 * kvh; A.kpitch = PC;
            A.Vt = (const bf16*)(ws + WS_VTD) + (size_t)(bl * 2 + kvh) * 128 * KEYS;
            A.O = Y + (size_t)row * 2048 + 1536 + 128 * h; A.qnw = a.in[I_QNW] + l * 128;
            attn_unit<128, 128, 2>(lds, A);
        } else {
            const int kvh = h >> 2;
            if (!ctxq) { const int first = 256 * qb - 128 < 0 ? 0 : 256 * qb - 128, last = 256 * qb + 383 > SEQ - 1 ? SEQ - 1 : 256 * qb + 383; A.band_first = first; A.ntile = 4 + (last - first + 1) / 64; }
            A.Q = P + (size_t)row * PC + PC_QB + 64 * h; A.qpitch = PC;
            A.Kc = P + (size_t)(LAT_ROWS + bl * CTXL) * PC + PC_KB + 64 * kvh; A.Kl = P + (size_t)(bl * SEQ) * PC + PC_KB + 64 * kvh; A.kpitch = PC;
            A.Vt = (const bf16*)(ws + WS_VTB) + (size_t)(bl * 2 + kvh) * 64 * KEYS;
            A.O = Y + (size_t)row * 2048 + 512 + 64 * h; A.sink_l2 = a.in[I_SINK][l * 8 + h] * 1.4426950408889634f;
            attn_unit<64, 64, 1>(lds, A);
        }
    }
}

#define XB_TMO      128
#define XB_XCNT(j)  (256  + 64 * (j))
#define XB_XSUB(j)  (1280 + 64 * (j))
#define XB_XGEN(j)  (2304 + 64 * (j))
#define XB_TOP      3328
#define XB_TOPGEN   3392
#define XCD_BAR_WORDS 3456
#define XB_SPIN_CAP (1u << 22)
__device__ __forceinline__ unsigned xb_ld(unsigned* p)              { return __hip_atomic_load(p, __ATOMIC_RELAXED, __HIP_MEMORY_SCOPE_AGENT); }
__device__ __forceinline__ unsigned xb_add(unsigned* p, unsigned v) { return __hip_atomic_fetch_add(p, v, __ATOMIC_RELAXED, __HIP_MEMORY_SCOPE_AGENT); }
__device__ __forceinline__ unsigned xb_xcc_id() { return (unsigned)__builtin_amdgcn_s_getreg((3 << 11) | 20) & 0xFu; }
#define XB_SPIN(cond, bar) do { unsigned _sp = 0; while (cond) { __builtin_amdgcn_s_sleep(1); \
    if ((++_sp & 255u) == 0u) { if (xb_ld(&(bar)[XB_TMO])) break; if (_sp > XB_SPIN_CAP) { atomicAdd(&(bar)[XB_TMO], 1u); break; } } } } while (0)
struct XcdBarrier { unsigned* bar; unsigned x; volatile LAS unsigned* st; };
__device__ __forceinline__ XcdBarrier xcd_barrier_post(unsigned* bar, volatile LAS unsigned* st) {
    XcdBarrier b; b.bar = bar; b.x = xb_xcc_id(); b.st = st;
    if (threadIdx.x == 0) (void)xb_add(&bar[XB_XCNT(b.x)], 1u);
    return b;
}
__device__ __forceinline__ void xcd_barrier_complete(unsigned* bar, unsigned x, unsigned& nloc, unsigned& nx) {
    const unsigned G = gridDim.x * gridDim.y * gridDim.z;
    unsigned sum, cnt, mine, sp = 0u;
    for (;;) {
        sum = 0u; cnt = 0u; mine = 0u;
#pragma unroll
        for (unsigned j = 0; j < 16; ++j) { const unsigned c = xb_ld(&bar[XB_XCNT(j)]); sum += c; cnt += (c > 0u) ? 1u : 0u; mine = (j == x) ? c : mine; }
        if (sum == G) break;
        __builtin_amdgcn_s_sleep(1);
        if ((++sp & 255u) == 0u) { if (xb_ld(&bar[XB_TMO])) break; if (sp > XB_SPIN_CAP) { atomicAdd(&bar[XB_TMO], 1u); break; } }
    }
    nloc = mine > 0u ? mine : 1u; nx = cnt > 0u ? cnt : 1u;
}
__device__ __forceinline__ void xcd_barrier(const XcdBarrier& b) {
    asm volatile("s_waitcnt vmcnt(0)" ::: "memory");
    __syncthreads();
    if (threadIdx.x == 0) {
        unsigned* bar = b.bar;
        __builtin_amdgcn_s_waitcnt(0);
        unsigned nloc = b.st[0], nx = b.st[1];
        if (nloc == 0u) { xcd_barrier_complete(bar, b.x, nloc, nx); b.st[0] = nloc; b.st[1] = nx; }
        const unsigned old = xb_add(&bar[XB_XSUB(b.x)], 1u);
        const unsigned gen = old / nloc;
        if (old + 1u == (gen + 1u) * nloc) {
            __builtin_amdgcn_fence(__ATOMIC_RELEASE, "agent");
            asm volatile("s_waitcnt vmcnt(0)" ::: "memory");
            const unsigned og = xb_add(&bar[XB_TOP], 1u);
            const unsigned tg = og / nx;
            if (og + 1u == (tg + 1u) * nx) xb_add(&bar[XB_TOPGEN], 1u);
            else XB_SPIN(xb_ld(&bar[XB_TOPGEN]) == tg, bar);
            __builtin_amdgcn_fence(__ATOMIC_ACQUIRE, "agent");
            xb_add(&bar[XB_XGEN(b.x)], 1u);
            asm volatile("s_waitcnt vmcnt(0)" ::: "memory");
        } else {
            XB_SPIN(xb_ld(&bar[XB_XGEN(b.x)]) == gen, bar);
            __builtin_amdgcn_fence(__ATOMIC_ACQUIRE, "agent");
            asm volatile("s_waitcnt vmcnt(0)" ::: "memory");
        }
    }
    __syncthreads();
}
constexpr int CW_BAR = 4096;

#ifndef MK_CG_FIRST
#define MK_CG_FIRST 1
#endif
constexpr int N_PHASES = 40;
template <bool COOP>
__global__ void __launch_bounds__(512, 2) mk_fwd(Args args) {
    extern __shared__ __attribute__((aligned(16))) unsigned char lds_raw[];
    LAS unsigned char* lds = (LAS unsigned char*)lds_raw;
    unsigned char* ws = args.ws; unsigned char* wt = ws + WS_WT;
    const int G = gridDim.x, bx = blockIdx.x;
    volatile LAS unsigned* misc = (volatile LAS unsigned*)(lds + LDS_BYTES - 32);
    XcdBarrier bar; bar.bar = nullptr; bar.x = 0; bar.st = misc;
    if (COOP) { if (threadIdx.x < 2) misc[threadIdx.x] = 0u; __syncthreads(); bar = xcd_barrier_post((unsigned*)(ws + WS_CTL) + CW_BAR, misc); }
    for (int p = args.ph_lo; p < args.ph_hi; ++p) {
        if (COOP) { if (p == args.ph_lo + 1 && MK_CG_FIRST) cg::this_grid().sync(); else if (p > args.ph_lo) xcd_barrier(bar); }
        if (p == 0) { prep_weights(args, 0, lds); prep_mods(args, lds); continue; }
        if (p == N_PHASES - 1) { final_norm_rows(args); continue; }
        const int q = p - 1, l = q / 19, rr = q - l * 19, g = rr < 16 ? rr >> 3 : 0, k0 = rr < 16 ? (rr & 7) : rr - 8, k = k0 >= 5 ? k0 + 1 : k0;
        const int nM = (l == 1) ? 32 : 36;
        pg8::StaticOrder S;
        switch (k) {
        case 0: if (l == 1 && g == 0) prep_weights(args, 1, lds); norm_mod_rows(args, l, g, MG_ROWS, 0); break;
        case 1: { pg8::Gemm gm{(const bf16*)(ws + WS_H), (const bf16*)(wt + WT_WIN), 1024, 1024, 1024, 0, 0}; S.init(36, 15, G, bx);
            EpiInProj E{(bf16*)(ws + WS_P), (bf16*)(ws + WS_VTB), (bf16*)(ws + WS_VTC), (bf16*)(ws + WS_VTD)}; pg8::gemm_phase(lds, gm, S, E); break; }
        case 2: { const GlaArgs GG = make_gla(args, l, g); for (int it = bx; it < 1152; it += G) gla_local(lds, GG, it & 31, it >> 5); post_rows(args, l); break; }
        case 3: { pg8::Gemm gm{(const bf16*)(ws + WS_CN), (const bf16*)(wt + WT_WMLA), 384, 384, 384, 0, 0}; S.init(36, 7, G, bx);
            EpiMla E{(bf16*)(ws + WS_QA), (bf16*)(ws + WS_KA), (bf16*)(ws + WS_VTA)}; pg8::gemm_phase(lds, gm, S, E); break; }
        case 4: attn_phase(args, l, g, lds); break;
        case 6: { pg8::Gemm gm{(const bf16*)(ws + WS_Y), (const bf16*)(wt + WT_WB), 2048, 512, 512, 4, 512}; S.init(nM, 16, G, bx);
            EpiStore<0> E{(bf16*)(ws + WS_Z), 4096}; pg8::gemm_phase(lds, gm, S, E); break; }
        case 7: { pg8::Gemm gm{(const bf16*)(ws + WS_H), (const bf16*)(wt + WT_WIN) + (size_t)PC * 1024, 1024, 1024, 1024, 0, 0}; S.init(nM, 16, G, bx);
            EpiMerge E{(const bf16*)(ws + WS_Z), (bf16*)(ws + WS_MG)}; pg8::gemm_phase(lds, gm, S, E); break; }
        case 8: { pg8::Gemm gm{(const bf16*)(ws + WS_MG), (const bf16*)(wt + WT_WO), 1024, 1024, 1024, 0, 0}; S.init(nM, 4, G, bx);
            EpiResid E{&args, l, g, 2, false, 0}; pg8::gemm_phase(lds, gm, S, E); break; }
        case 9: norm_mod_rows(args, l, 0, 2 * nM * 256, 1); break;
        case 10: { pg8::Gemm gm{(const bf16*)(ws + WS_H2), (const bf16*)(wt + WT_W1), 1024, 1024, 1024, 0, 0}; S.init(2 * nM, 16, G, bx);
            EpiStore<1> E{(bf16*)(ws + WS_HID), 4096}; pg8::gemm_phase(lds, gm, S, E); break; }
        default: { pg8::Gemm gm{(const bf16*)(ws + WS_HID), (const bf16*)(wt + WT_W2), 4096, 4096, 4096, 0, 0}; S.init(2 * nM, 4, G, bx);
            EpiResid E{&args, l, 0, 5, true, nM}; pg8::gemm_phase(lds, gm, S, E); break; }
        }
    }
}

#ifndef MK_PER_PHASE
#define MK_PER_PHASE 0
#endif
extern "C" void kernel_launch(void* const* d_in, const int* in_sizes, int n_in, void* d_out, int out_size, void* d_ws, size_t ws_size, hipStream_t stream) {
    static int grid = 0;
    if (grid == 0) {
        if (n_in != 24 || out_size != NB * SEQ * DM || ws_size < WS_END) { fprintf(stderr, "kernel_launch: unexpected shapes (n_in %d out %d ws %zu)\n", n_in, out_size, ws_size); grid = -1; return; }
        int dev = 0, cus = 0, per_cu = 0;
        hipGetDevice(&dev); hipDeviceGetAttribute(&cus, hipDeviceAttributeMultiprocessorCount, dev);
        hipFuncSetAttribute((const void*)mk_fwd<true>, hipFuncAttributeMaxDynamicSharedMemorySize, LDS_BYTES);
        hipFuncSetAttribute((const void*)mk_fwd<false>, hipFuncAttributeMaxDynamicSharedMemorySize, LDS_BYTES);
        hipOccupancyMaxActiveBlocksPerMultiprocessor(&per_cu, (const void*)mk_fwd<true>, 512, LDS_BYTES);
        if (per_cu < 1) { fprintf(stderr, "kernel_launch: occupancy query says %d blocks per CU\n", per_cu); per_cu = 1; }
        (void)hipGetLastError();
        grid = cus;
    }
    if (grid < 0) return;
    hipMemsetAsync((char*)d_ws + WS_CTL, 0, 65536, stream);
    Args a{};
    for (int i = 0; i < 24; ++i) a.in[i] = (const float*)d_in[i];
    a.out = (float*)d_out; a.ws = (unsigned char*)d_ws;
#if MK_PER_PHASE
    for (int p = 0; p < N_PHASES; ++p) { a.ph_lo = p; a.ph_hi = p + 1; hipLaunchKernelGGL(mk_fwd<false>, dim3(grid), dim3(512), LDS_BYTES, stream, a); }
#else
    a.ph_lo = 0; a.ph_hi = N_PHASES;
    void* kargs[] = {&a};
    hipError_t e = hipLaunchCooperativeKernel((const void*)mk_fwd<true>, dim3(grid), dim3(512), kargs, LDS_BYTES, stream);
    if (e != hipSuccess) fprintf(stderr, "cooperative launch failed: %s (grid %d)\n", hipGetErrorString(e), grid);
#endif
}
```

```cpp
#include <hip/hip_runtime.h>
#include <hip/hip_cooperative_groups.h>
#include <cstdio>
#include <cstdint>
namespace cg = cooperative_groups;

#define LAS __attribute__((address_space(3)))
typedef unsigned short bf16;
typedef short bf16x8 __attribute__((ext_vector_type(8)));
typedef float f32x4 __attribute__((ext_vector_type(4)));
typedef float f32x16 __attribute__((ext_vector_type(16)));
typedef unsigned u32x4 __attribute__((ext_vector_type(4)));
typedef unsigned u32x2 __attribute__((ext_vector_type(2)));

constexpr int DM = 1024, NB = 8, SEQ = 2048, CTXL = 256, GB = 4, NGRP = 2;
constexpr int MG_ROWS = GB * (SEQ + CTXL);
constexpr int LAT_ROWS = GB * SEQ;
constexpr int KEYS = CTXL + SEQ;
constexpr int IN_COLS = 7904, PC = 3840;
constexpr int WIN_N = 7936;
constexpr float EPS = 1e-6f;
constexpr int PC_KR = 0, PC_KB = 64, PC_VB = 192, PC_KC = 320, PC_VC = 576, PC_LRF = 1088, PC_KD = 1120, PC_VD = 1376, PC_PAD = 1632, PC_CKV = 1664,
              PC_CQ = 1792, PC_QB = 2048, PC_QC = 2560, PC_RC = 2816, PC_QD = 3328;
constexpr int SRC_GATE = 3808;
__host__ __device__ __forceinline__ int pcol_src(int n) {
    if (n < PC_KB) return 384 + (n - PC_KR);
    if (n < PC_VB) return 960 + (n - PC_KB);
    if (n < PC_KC) return 1088 + (n - PC_VB);
    if (n < PC_VC) return 1472 + (n - PC_KC);
    if (n < PC_LRF) return 1728 + (n - PC_VC);
    if (n < PC_KD) return 2752 + (n - PC_LRF);
    if (n < PC_VD) return 3296 + (n - PC_KD);
    if (n < PC_PAD) return 3552 + (n - PC_VD);
    if (n < PC_CKV) return -1;
    if (n < PC_CQ) return 256 + (n - PC_CKV);
    if (n < PC_QB) return n - PC_CQ;
    if (n < PC_QC) return 448 + (n - PC_QB);
    if (n < PC_RC) return 1216 + (n - PC_QC);
    if (n < PC_QD) return 2240 + (n - PC_RC);
    return 2784 + (n - PC_QD);
}
__host__ __device__ __forceinline__ int gperm_in(int q) {
    if (q >= 56) return q;
    const int idx = (q >> 3) * 4 + (q & 3);
    if ((q & 4) == 0) return idx < 4 ? 6 + idx : idx < 20 ? 18 + (idx - 4) : 43 + (idx - 20);
    return idx < 6 ? idx : idx < 14 ? 10 + (idx - 6) : idx == 14 ? 34 : idx < 23 ? 35 + (idx - 15) : idx == 23 ? 51 : 52 + (idx - 24);
}
__host__ __device__ __forceinline__ int gperm_mla(int q) {
    const int t = q >> 3, wc = q & 3;
    if ((q & 4) == 0 && t < 4) return 40 + t * 4 + wc;
    return t < 4 ? t * 4 + wc : 16 + (t - 4) * 8 + (q & 7);
}
constexpr size_t MiB = 1u << 20;
constexpr size_t WS_CTL = 0, CTL_BYTES = 1 * MiB;
constexpr size_t WS_RS = 131072;
constexpr size_t WS_MOD = 1 * MiB;
constexpr size_t WS_WT = 2 * MiB;
constexpr size_t WT_WIN = 0, WT_WMLA = WT_WIN + (size_t)WIN_N * 1024 * 2, WT_WB = WT_WMLA + (size_t)1792 * 384 * 2, WT_WO = WT_WB + (size_t)4096 * 512 * 2,
                 WT_W1 = WT_WO + (size_t)1024 * 1024 * 2, WT_W2 = WT_W1 + (size_t)4096 * 1024 * 2, WT_END = WT_W2 + (size_t)1024 * 4096 * 2;
static_assert(WT_END <= 40 * MiB, "weights");
constexpr size_t WS_XC1 = 42 * MiB;
constexpr size_t WS_H = 50 * MiB;
constexpr size_t WS_MG = 68 * MiB;
constexpr size_t WS_Y = 86 * MiB;
constexpr size_t WS_P = 122 * MiB;
constexpr size_t WS_CN = WS_P + (size_t)MG_ROWS * PC * 2;
constexpr size_t WS_QA = WS_CN + (size_t)MG_ROWS * 384 * 2;
constexpr size_t WS_KA = WS_QA + (size_t)MG_ROWS * 768 * 2;
constexpr size_t WS_VTA = WS_KA + (size_t)GB * 4 * KEYS * 192 * 2;
constexpr size_t WS_VTB = WS_VTA + (size_t)GB * 4 * 128 * KEYS * 2;
constexpr size_t WS_VTC = WS_VTB + (size_t)GB * 2 * 64 * KEYS * 2;
constexpr size_t WS_VTD = WS_VTC + (size_t)GB * 4 * 128 * KEYS * 2;
constexpr size_t WS_END = WS_VTD + (size_t)GB * 2 * 128 * KEYS * 2;
constexpr size_t WS_Z = WS_P;
static_assert(WS_Z + (size_t)MG_ROWS * 4096 * 2 <= WS_QA, "Z overlay must stay inside P|CN");
static_assert(WS_END <= 248 * MiB, "workspace");
constexpr size_t WS_H2 = 50 * MiB;
constexpr size_t WS_HID = 86 * MiB;
static_assert(WS_HID + (size_t)2 * MG_ROWS * 4096 * 2 <= 248 * MiB && WS_H2 + (size_t)2 * MG_ROWS * 1024 * 2 <= WS_HID, "merged MLP buffers");
constexpr size_t WS_MG0 = 248 * MiB;
constexpr size_t WT_WG8 = WT_WIN + (size_t)PC * 1024 * 2;
constexpr size_t WT_WP8 = WT_WG8 + (size_t)4096 * 1024;
static_assert(WT_WP8 + (size_t)PC * 1024 <= WT_WMLA, "fp8 in-projection rows");
constexpr size_t WS_H8A = WS_Y + 20 * MiB, WS_H8B = WS_H8A + (size_t)16 * 256 * 1024; constexpr int H8_SPLIT = 16;
static_assert(WS_H8A + (size_t)MG_ROWS * 1024 <= WS_P && WS_Y + (size_t)MG_ROWS * 2048 <= WS_H8A, "H8 inside the Y buffer");
constexpr size_t WS_TOTAL = 266 * MiB;
constexpr int LDS_BYTES = 147456;

__device__ __forceinline__ unsigned f2bf(float f) { unsigned u = __builtin_bit_cast(unsigned, f); return (u + 0x7fffu + ((u >> 16) & 1u)) >> 16; }
typedef float f32x2_t __attribute__((ext_vector_type(2))); typedef __bf16 bf16x2_t __attribute__((ext_vector_type(2)));
__device__ __forceinline__ unsigned pk2(float lo, float hi) { f32x2_t v = {lo, hi}; bf16x2_t b = __builtin_convertvector(v, bf16x2_t); return __builtin_bit_cast(unsigned, b); }
__device__ __forceinline__ float bf2f(unsigned short b) { return __builtin_bit_cast(float, (unsigned)b << 16); }
__device__ __forceinline__ float bflo(unsigned w) { return __builtin_bit_cast(float, w << 16); }
__device__ __forceinline__ float bfhi(unsigned w) { return __builtin_bit_cast(float, w & 0xffff0000u); }
#define SHFLX(v, m) __builtin_bit_cast(float, __builtin_amdgcn_ds_bpermute(((lane) ^ (m)) << 2, __builtin_bit_cast(int, (float)(v))))
__device__ __forceinline__ float wave_sum_l(float v, int lane) {
#pragma unroll
    for (int o = 1; o < 64; o <<= 1) v += SHFLX(v, o);
    return v;
}
#define wave_sum(v) wave_sum_l((v), lane)
constexpr int LDS_WTAB = LDS_BYTES - 512;
__device__ __forceinline__ unsigned hw_wave_slot() { return (unsigned)__builtin_amdgcn_s_getreg(((6 - 1) << 11) | 4) & 63u; }
__device__ __forceinline__ int tidx() {
    int l; asm volatile("v_mbcnt_lo_u32_b32 %0, -1, 0\n\tv_mbcnt_hi_u32_b32 %0, -1, %0" : "=v"(l));
    const int w = __builtin_amdgcn_readfirstlane(*(volatile LAS int*)(size_t)(LDS_WTAB + 4 * hw_wave_slot()));
    return (w << 6) | l;
}
__device__ __forceinline__ float sigmoid64(float x64) { return __builtin_amdgcn_rcpf(1.f + __builtin_amdgcn_exp2f(x64 * (-1.4426950408889634f / 64.f))); }
__device__ __forceinline__ float sigmoidf_(float x) { return __builtin_amdgcn_rcpf(1.f + __expf(-x)); }
__device__ __forceinline__ float siluf_(float x) { return x * __builtin_amdgcn_rcpf(1.f + __expf(-x)); }

namespace pg8 {
constexpr int BM = 256, BK = 64, HALF = 128, HTB = HALF * BK * 2, STAGE_BYTES = 8 * HTB, NXCD = 8, WGM = 8;
__host__ __device__ __forceinline__ int lds_byte(int r, int c) { const int st = (r >> 4) * 2 + (c >> 5), rr = r & 15, cc = c & 31, ob = rr * 64 + cc * 2; return st * 1024 + (ob ^ (((ob >> 9) & 1) << 5)); }
__host__ __device__ __forceinline__ void stage_rc(int b, int& R, int& C) { const int st = b / 1024, sb = b % 1024, swz = sb ^ (((sb >> 9) & 1) << 5); R = (st >> 1) * 16 + swz / 64; C = (st & 1) * 32 + (swz % 64) / 2; }
__host__ __device__ __forceinline__ int perm32(int rho) { const int n = rho >> 4, i = rho & 15; return 8 * (i >> 2) + 4 * n + (i & 3); }

struct Unit { int pm, pn; };
struct Gemm { const bf16* A; const bf16* Bt; int lda, ldb, K; int adiv, amul; int ksplit; const bf16* A2; int a2_from; };

struct StaticOrder {
    int pnbase = 0, pnfrom = 1 << 30, pnadd = 0;
    int nM, nN, nwg, G, c, map;
    __device__ void init(int nM_, int nN_, int G_, int c_, int map_ = 0) { nM = nM_; nN = nN_; nwg = nM * nN; G = G_; c = c_; map = map_; }
    __device__ bool next(int i, Unit& u) const {
        const long L = (long)i * G + c; if (L >= nwg) return false;
        int wgid = (int)L; { const int q = nwg / NXCD, r = nwg % NXCD, xcd = wgid % NXCD, off = wgid / NXCD; wgid = (xcd < r ? xcd * (q + 1) : r * (q + 1) + (xcd - r) * q) + off; }
        const int nig = WGM * nN, gid = wgid / nig, fm = gid * WGM, gsz = (nM - fm) < WGM ? (nM - fm) : WGM;
        u.pm = fm + ((wgid % nig) % gsz); u.pn = (wgid % nig) / gsz;
        u.pn += pnbase; if (u.pn >= pnfrom) u.pn += pnadd;
        if (map == 1) u.pm += 4 * (u.pm >> 5); else if (map == 2) u.pm = 32 + 36 * (u.pm >> 2) + (u.pm & 3); else if (map == 3) u.pm += 32; else if (map == 4) u.pm += 36;
        return true;
    }
};
typedef int v8i_t __attribute__((ext_vector_type(8)));
__device__ __forceinline__ v8i_t cat8(const bf16x8 lo, const bf16x8 hi) { const u32x4 a = __builtin_bit_cast(u32x4, lo), b = __builtin_bit_cast(u32x4, hi); v8i_t r; r[0] = (int)a.x; r[1] = (int)a.y; r[2] = (int)a.z; r[3] = (int)a.w; r[4] = (int)b.x; r[5] = (int)b.y; r[6] = (int)b.z; r[7] = (int)b.w; return r; }
template <class Epi, bool F8 = false>
__device__ __forceinline__ void gemm_phase(LAS unsigned char* lds, const Gemm g, const StaticOrder& S, const Epi& E) {
    const int tid = tidx(), wid = __builtin_amdgcn_readfirstlane(tid >> 6), lane = tid & 63, wr = wid >> 2, wc = wid & 3, fr = lane & 15, fq = lane >> 4;
    const int K = g.K, nt = K / BK;
    unsigned voffA[2], voffB[2];
#pragma unroll
    for (int i = 0; i < 2; ++i) { int R, C; stage_rc(tid * 16 + i * 8192, R, C); const int Rb = (R & ~31) + perm32(R & 31);
        voffA[i] = (unsigned)(R * g.lda + C) * 2u; voffB[i] = (unsigned)(Rb * g.ldb + C) * 2u; }
    const size_t kstep = (size_t)(BK * 2);
    const size_t hstepA = (size_t)HALF * g.lda * 2, hstepB = (size_t)HALF * g.ldb * 2;
    const size_t tstepA = 2 * hstepA, tstepB = 2 * hstepB;
    const unsigned ldsw = (unsigned)wid * 1024u;
    const int aoff = lds_byte(wr * 64 + fr, fq * 8), boff = lds_byte(wc * 32 + fr, fq * 8);
#define PG8_SA(b, h) (((b) * 2 + (h)) * HTB)
#define PG8_SB(b, h) ((4 + (b) * 2 + (h)) * HTB)
#define PG8_STAGE(bufoff, gbase, voff) do { _Pragma("unroll") for (int _i = 0; _i < 2; ++_i) { \
        const unsigned la_ = (unsigned)(size_t)(lds + (bufoff) + _i * 8192) + ldsw; const char* gb_ = (const char*)(gbase); \
        asm volatile("s_nop 1\n\ts_mov_b32 m0, %2\n\ts_nop 1\n\tglobal_load_lds_dwordx4 %0, %1" :: "v"((voff)[_i]), "s"(gb_), "s"(la_) : "memory", "m0"); } } while (0)
#define PG8_LDA(dst, b, h) do { _Pragma("unroll") for (int m = 0; m < 4; ++m) _Pragma("unroll") for (int k = 0; k < 2; ++k) dst[m][k] = *(const LAS bf16x8*)(lds + PG8_SA(b, h) + aoff + m * 2048 + k * 1024); } while (0)
#define PG8_LDB(dst, b, h) do { _Pragma("unroll") for (int n = 0; n < 2; ++n) _Pragma("unroll") for (int k = 0; k < 2; ++k) dst[n][k] = *(const LAS bf16x8*)(lds + PG8_SB(b, h) + boff + n * 2048 + k * 1024); } while (0)
#define PG8_MMA(ai, bj, At, Bt) do { __builtin_amdgcn_s_setprio(1); \
        if (F8) { _Pragma("unroll") for (int m = 0; m < 4; ++m) _Pragma("unroll") for (int n = 0; n < 2; ++n) \
            acc[ai][bj][m][n] = __builtin_amdgcn_mfma_scale_f32_16x16x128_f8f6f4(cat8(Bt[n][0], Bt[n][1]), cat8(At[m][0], At[m][1]), acc[ai][bj][m][n], 0, 0, 0, 0, 0, 0); } \
        else { _Pragma("unroll") for (int m = 0; m < 4; ++m) _Pragma("unroll") for (int n = 0; n < 2; ++n) _Pragma("unroll") for (int k = 0; k < 2; ++k) \
            acc[ai][bj][m][n] = __builtin_amdgcn_mfma_f32_16x16x32_bf16(Bt[n][k], At[m][k], acc[ai][bj][m][n], 0, 0, 0); } \
        __builtin_amdgcn_s_setprio(0); } while (0)
#define PG8_WAIT_V(n) asm volatile("s_waitcnt vmcnt(" #n ")" ::: "memory")
#define PG8_WAIT_L(n) asm volatile("s_waitcnt lgkmcnt(" #n ")" ::: "memory")
#define PG8_BAR __builtin_amdgcn_s_barrier()
#define PG8_SCHED __builtin_amdgcn_sched_barrier(0)
#define PG8_ABASE(u) ((g.A2 && (u).pm >= g.a2_from) ? (const char*)g.A2 + (size_t)((u).pm - g.a2_from) * tstepA : (const char*)g.A + (size_t)(u).pm * tstepA)
#define PG8_AOFF(u) ((size_t)(g.adiv ? ((u).pn / g.adiv) * g.amul * 2 : 0) + (size_t)(g.ksplit ? ((u).pn % g.ksplit) * g.K * 2 : 0))
#define PG8_BTILE(u) (g.ksplit ? (u).pn / g.ksplit : (u).pn)
#define PG8_BOFF(u) ((size_t)(g.ksplit ? ((u).pn % g.ksplit) * g.K * 2 : 0))
    Unit cur, nxt; int ui = 0;
    if (!S.next(0, cur)) return;
    f32x4 acc[2][2][4][2];
#pragma unroll
    for (int a = 0; a < 2; ++a)
#pragma unroll
        for (int b = 0; b < 2; ++b)
#pragma unroll
            for (int m = 0; m < 4; ++m)
#pragma unroll
                for (int n = 0; n < 2; ++n) acc[a][b][m][n] = (f32x4){0.f, 0.f, 0.f, 0.f};
    bf16x8 At[4][2], B0[2][2], B1[2][2];
    const char* cA = PG8_ABASE(cur) + PG8_AOFF(cur); const char* cB = (const char*)g.Bt + (size_t)PG8_BTILE(cur) * tstepB + PG8_BOFF(cur);
    PG8_STAGE(PG8_SB(0, 0), cB, voffB); PG8_STAGE(PG8_SB(0, 1), cB + hstepB, voffB); PG8_STAGE(PG8_SA(0, 0), cA, voffA); PG8_STAGE(PG8_SA(0, 1), cA + hstepA, voffA);
    if (wr == 1) PG8_BAR;
    PG8_WAIT_V(2); PG8_BAR;
    PG8_STAGE(PG8_SB(1, 0), cB + kstep, voffB); PG8_STAGE(PG8_SA(1, 0), cA + kstep, voffA); PG8_STAGE(PG8_SB(1, 1), cB + hstepB + kstep, voffB);
    PG8_WAIT_V(6); PG8_BAR;
    for (;;) {
        const bool has_next = S.next(ui + 1, nxt);
        const char* nA = has_next ? PG8_ABASE(nxt) + PG8_AOFF(nxt) : cA; const char* nB = has_next ? (const char*)g.Bt + (size_t)PG8_BTILE(nxt) * tstepB + PG8_BOFF(nxt) : cB;
#pragma unroll 1
        for (int t = 0; t < nt; t += 2) {
            const bool last = (t == nt - 2);
            const char* a1 = cA + (size_t)(t + 1) * kstep;
            const char* a2 = last ? nA : cA + (size_t)(t + 2) * kstep; const char* b2 = last ? nB : cB + (size_t)(t + 2) * kstep;
            const char* a3 = a2 + kstep; const char* b3 = b2 + kstep;
            PG8_LDB(B0, 0, 0); PG8_LDB(B1, 0, 1); PG8_SCHED; PG8_LDA(At, 0, 0); PG8_STAGE(PG8_SA(1, 1), a1 + hstepA, voffA);
            PG8_WAIT_V(8); PG8_WAIT_L(0); PG8_BAR; PG8_MMA(0, 0, At, B0); PG8_MMA(0, 1, At, B1); PG8_BAR; PG8_SCHED;
            PG8_LDA(At, 0, 1); PG8_STAGE(PG8_SB(0, 0), b2, voffB); PG8_STAGE(PG8_SB(0, 1), b2 + hstepB, voffB); PG8_STAGE(PG8_SA(0, 0), a2, voffA);
            PG8_WAIT_V(8); PG8_WAIT_L(0); PG8_BAR; PG8_MMA(1, 0, At, B0); PG8_MMA(1, 1, At, B1); PG8_BAR; PG8_SCHED;
            PG8_LDB(B0, 1, 0); PG8_LDB(B1, 1, 1); PG8_SCHED; PG8_LDA(At, 1, 0); PG8_STAGE(PG8_SA(0, 1), a2 + hstepA, voffA);
            PG8_WAIT_V(8); PG8_WAIT_L(0); PG8_BAR; PG8_MMA(0, 0, At, B0); PG8_MMA(0, 1, At, B1); PG8_BAR; PG8_SCHED;
            PG8_LDA(At, 1, 1); PG8_STAGE(PG8_SB(1, 0), b3, voffB); PG8_STAGE(PG8_SB(1, 1), b3 + hstepB, voffB); PG8_STAGE(PG8_SA(1, 0), a3, voffA);
            PG8_WAIT_V(8); PG8_WAIT_L(0); PG8_BAR; PG8_MMA(1, 0, At, B0); PG8_MMA(1, 1, At, B1); PG8_BAR; PG8_SCHED;
        }
        if (wr == 0) PG8_BAR;
        { const int l2_ = tidx() & 63; E(acc, cur, wr, wc, l2_ & 15, l2_ >> 4); }
        if (!has_next) break;
#pragma unroll
        for (int a = 0; a < 2; ++a)
#pragma unroll
            for (int b = 0; b < 2; ++b)
#pragma unroll
                for (int m = 0; m < 4; ++m)
#pragma unroll
                    for (int n = 0; n < 2; ++n) acc[a][b][m][n] = (f32x4){0.f, 0.f, 0.f, 0.f};
        cur = nxt; cA = nA; cB = nB; ++ui;
        if (wr == 1) PG8_BAR;
    }
    PG8_WAIT_V(0);
    PG8_BAR;
#undef PG8_SA
#undef PG8_SB
#undef PG8_STAGE
#undef PG8_LDA
#undef PG8_LDB
#undef PG8_MMA
#undef PG8_WAIT_V
#undef PG8_WAIT_L
#undef PG8_BAR
#undef PG8_SCHED
#undef PG8_AOFF
#undef PG8_ABASE
#undef PG8_BTILE
#undef PG8_BOFF
}
}

struct Args {
    const float* in[24];
    float* out; unsigned char* ws;
    int ph_lo, ph_hi;
};
enum { I_X = 0, I_C, I_CTX, I_CCTX, I_ADAW, I_ADAB, I_N1W, I_N2W, I_WIN, I_MQNW, I_MWUQ, I_MKVNW, I_MWUKV, I_SINK, I_GWD, I_GBD, I_GNW, I_QNW, I_KNW, I_WBR, I_WO, I_W1, I_W2, I_FNW };

struct Ctx {
    const Args* a; unsigned char* ws; int l, g;
};
__device__ __forceinline__ const float* xrow_src(const Args& a, int l, int g, int r) {
    if (r < LAT_ROWS) { const size_t gr = (size_t)(g * GB) * SEQ + r; return (l == 0 ? a.in[I_X] : a.out) + gr * DM; }
    const size_t cr = (size_t)(g * GB) * CTXL + (r - LAT_ROWS); return (l == 0 ? a.in[I_CTX] : (const float*)(a.ws + WS_XC1)) + cr * DM;
}
__device__ __forceinline__ float* xrow_dst(const Args& a, int g, int r) {
    if (r < LAT_ROWS) { const size_t gr = (size_t)(g * GB) * SEQ + r; return a.out + gr * DM; }
    const size_t cr = (size_t)(g * GB) * CTXL + (r - LAT_ROWS); return (float*)(a.ws + WS_XC1) + cr * DM;
}
__device__ __forceinline__ int row_bi(int g, int r) { return r < LAT_ROWS ? g * GB + (r >> 11) : 8; }
__device__ __forceinline__ void row_blk(int r, int& bl, int& kap) { if (r < LAT_ROWS) { bl = r >> 11; kap = CTXL + (r & 2047); } else { bl = (r - LAT_ROWS) >> 8; kap = (r - LAT_ROWS) & 255; } }

using pg8::Unit;
__device__ __forceinline__ void st16_wt(void* p, const u32x4 v) { asm volatile("global_store_dwordx4 %0, %1, off sc1\n\ts_nop 2" :: "v"(p), "v"(v)); }
__device__ __forceinline__ void st16_wt(void* p, const f32x4 v) { asm volatile("global_store_dwordx4 %0, %1, off sc1\n\ts_nop 2" :: "v"(p), "v"(v)); }
__device__ __forceinline__ void st8_wt(void* p, const u32x2 v) { asm volatile("global_store_dwordx2 %0, %1, off sc1" :: "v"(p), "v"(v)); }
__device__ __forceinline__ unsigned pk4_fp8(float a, float b, float c, float d) { int w; asm("" : "=v"(w));   w = __builtin_amdgcn_cvt_pk_fp8_f32(a, b, w, false); w = __builtin_amdgcn_cvt_pk_fp8_f32(c, d, w, true); return (unsigned)w; }
__device__ __forceinline__ void st16_wt_s(const void* base  , unsigned off, const u32x4 v) { asm volatile("s_nop 4\n\tglobal_store_dwordx4 %0, %1, %2 sc1\n\ts_nop 2" :: "v"(off), "v"(v), "s"(base)); }
__device__ __forceinline__ u32x4 pack8(const f32x4 v0, const f32x4 v1) { u32x4 w; w.x = pk2(v0[0], v0[1]); w.y = pk2(v0[2], v0[3]); w.z = pk2(v1[0], v1[1]); w.w = pk2(v1[2], v1[3]); return w; }

template <int ACT> struct EpiStore {
    bf16* O; int ldc; float ascale = 1.f;
    __device__ __forceinline__ void operator()(const f32x4 (&acc)[2][2][4][2], const Unit& u, int wr, int wc, int fr, int fq) const {
        const unsigned ldb2 = (unsigned)ldc * 2u, off0 = (unsigned)(u.pm * 256 + wr * 64 + fr) * ldb2 + (unsigned)(u.pn * 256 + wc * 32 + 8 * fq) * 2u;
#pragma unroll
        for (int ai = 0; ai < 2; ++ai)
#pragma unroll
            for (int m = 0; m < 4; ++m) { const unsigned offr = off0 + (unsigned)(ai * 128 + m * 16) * ldb2;
#pragma unroll
                for (int bj = 0; bj < 2; ++bj) { f32x4 v0 = acc[ai][bj][m][0] * ascale, v1 = acc[ai][bj][m][1] * ascale;
                    if (ACT == 1) {
#pragma unroll
                        for (int j = 0; j < 4; ++j) { const float a = fmaxf(v0[j], 0.f), b = fmaxf(v1[j], 0.f); v0[j] = a * a; v1[j] = b * b; } }
                    st16_wt_s(O, offr + bj * 256, pack8(v0, v1)); } }
    }
};
__device__ __forceinline__ void store_vt(const f32x4 (&acc)[2][2][4][2], int bj, bf16* vt, int nheads, int dv, int colbase  , int pm, int wr, int fr, int fq) {
    int bl, kap0; row_blk(pm * 256, bl, kap0);
    const int c0 = colbase + 8 * fq, head = c0 / dv, e0 = c0 - head * dv;
    bf16* vp = vt + ((size_t)(bl * nheads + head) * dv + e0) * KEYS + kap0 + wr * 64 + fr;
#pragma unroll
    for (int ai = 0; ai < 2; ++ai)
#pragma unroll
        for (int m = 0; m < 4; ++m)
#pragma unroll
            for (int n = 0; n < 2; ++n)
#pragma unroll
                for (int j = 0; j < 4; ++j) vp[(size_t)(4 * n + j) * KEYS + ai * 128 + m * 16] = (bf16)f2bf(acc[ai][bj][m][n][j]);
}
__device__ __forceinline__ void store_vt8(const f32x4 (&acc)[2][2][4][2], int bj, unsigned char* vt, int nheads, int dv, int colbase, int pm, int wr, int fr, int fq) {
    int bl, kap0; row_blk(pm * 256, bl, kap0);
    const int c0 = colbase + 8 * fq, head = c0 / dv, e0 = c0 - head * dv;
    unsigned char* vp = vt + ((size_t)(bl * nheads + head) * dv + e0) * KEYS + kap0 + wr * 64 + fr;
#pragma unroll
    for (int ai = 0; ai < 2; ++ai)
#pragma unroll
        for (int m = 0; m < 4; ++m)
#pragma unroll
            for (int n = 0; n < 2; ++n)
#pragma unroll
                for (int j = 0; j < 4; j += 2) { const unsigned w = (unsigned)__builtin_amdgcn_cvt_pk_fp8_f32(acc[ai][bj][m][n][j], acc[ai][bj][m][n][j + 1], 0, false);
                    vp[(size_t)(4 * n + j) * KEYS + ai * 128 + m * 16] = (unsigned char)(w & 0xffu); vp[(size_t)(4 * n + j + 1) * KEYS + ai * 128 + m * 16] = (unsigned char)((w >> 8) & 0xffu); }
}
struct EpiInProj {
    bf16* P; bf16 *vtb, *vtc, *vtd; float* rs; float ascale = 1.f;
    __device__ __forceinline__ void operator()(const f32x4 (&acc)[2][2][4][2], const Unit& u, int wr, int wc, int fr, int fq) const {
        const int row0 = u.pm * 256 + wr * 64 + fr; const int lane = fr + 16 * fq;
#pragma unroll
        for (int bj = 0; bj < 2; ++bj) {
            const int cg = 32 * gperm_in(u.pn * 8 + bj * 4 + wc);
            if (cg >= PC_VB && cg < PC_VB + 128) store_vt(acc, bj, vtb, 2, 64, cg - PC_VB, u.pm, wr, fr, fq);
            else if (cg >= PC_VC && cg < PC_VC + 512) store_vt(acc, bj, vtc, 4, 128, cg - PC_VC, u.pm, wr, fr, fq);
            else if (cg >= PC_VD && cg < PC_VD + 256) store_vt8(acc, bj, (unsigned char*)vtd, 2, 128, cg - PC_VD, u.pm, wr, fr, fq);
            else {
                const bool lat = cg >= PC_CKV && cg < PC_QB; const int which = cg < PC_CQ ? 1 : 0;
#pragma unroll
                for (int ai = 0; ai < 2; ++ai)
#pragma unroll
                    for (int m = 0; m < 4; ++m) { const u32x4 w = pack8(acc[ai][bj][m][0] * ascale, acc[ai][bj][m][1] * ascale); *(u32x4*)(P + (size_t)(row0 + ai * 128 + m * 16) * PC + cg + 8 * fq) = w;
                        if (lat) { float ss = (bflo(w.x) * bflo(w.x) + bfhi(w.x) * bfhi(w.x)) + (bflo(w.y) * bflo(w.y) + bfhi(w.y) * bfhi(w.y)) + (bflo(w.z) * bflo(w.z) + bfhi(w.z) * bfhi(w.z)) + (bflo(w.w) * bflo(w.w) + bfhi(w.w) * bfhi(w.w));
                            ss += SHFLX(ss, 16); ss += SHFLX(ss, 32);
                            if (fq == 0) atomicAdd(rs + (size_t)(row0 + ai * 128 + m * 16) * 2 + which, ss); } }
            }
        }
    }
};
struct EpiMla {
    bf16 *QA, *KA, *vta; const float* rs;
    __device__ __forceinline__ void operator()(const f32x4 (&acc_)[2][2][4][2], const Unit& u, int wr, int wc, int fr, int fq) const {
        f32x4 acc[2][2][4][2];
        const int cg0 = 32 * gperm_mla(u.pn * 8 + wc), cg1 = 32 * gperm_mla(u.pn * 8 + 4 + wc);
#pragma unroll
        for (int ai = 0; ai < 2; ++ai)
#pragma unroll
            for (int m = 0; m < 4; ++m) { const f32x2_t r2 = *(const f32x2_t*)(rs + (size_t)(u.pm * 256 + wr * 64 + fr + ai * 128 + m * 16) * 2);
                const float scq = rsqrtf(r2[0] * (1.f / 256.f) + EPS), sckv = rsqrtf(r2[1] * (1.f / 128.f) + EPS), s0 = cg0 < 768 ? scq : sckv, s1 = cg1 < 768 ? scq : sckv;
#pragma unroll
                for (int n = 0; n < 2; ++n) { acc[ai][0][m][n] = acc_[ai][0][m][n] * s0; acc[ai][1][m][n] = acc_[ai][1][m][n] * s1; } }
        const int row0 = u.pm * 256 + wr * 64 + fr;
        int bl, kap0; row_blk(u.pm * 256, bl, kap0);
#pragma unroll
        for (int bj = 0; bj < 2; ++bj) {
            const int cg = bj ? cg1 : cg0;
            if (cg < 768) {
#pragma unroll
                for (int ai = 0; ai < 2; ++ai)
#pragma unroll
                    for (int m = 0; m < 4; ++m) *(u32x4*)(QA + (size_t)(row0 + ai * 128 + m * 16) * 768 + cg + 8 * fq) = pack8(acc[ai][bj][m][0], acc[ai][bj][m][1]);
            } else if (cg < 1280) {
                const int c = cg - 768 + 8 * fq, head = c >> 7, j0 = c & 127;
#pragma unroll
                for (int ai = 0; ai < 2; ++ai)
#pragma unroll
                    for (int m = 0; m < 4; ++m) { const int kap = kap0 + ai * 128 + wr * 64 + m * 16 + fr;
                        *(u32x4*)(KA + ((size_t)(bl * 4 + head) * KEYS + kap) * 192 + j0) = pack8(acc[ai][bj][m][0], acc[ai][bj][m][1]); }
            } else store_vt8(acc, bj, (unsigned char*)vta, 4, 128, cg - 1280, u.pm, wr, fr, fq);
        }
    }
};
struct EpiMerge {
    const bf16* Z; bf16* MGo;
    __device__ __forceinline__ void operator()(const f32x4 (&acc)[2][2][4][2], const Unit& u, int wr, int wc, int fr, int fq) const {
        const int row0 = u.pm * 256 + wr * 64 + fr, d0 = u.pn * 64 + wc * 16 + fq * 4;
#pragma unroll
        for (int ai = 0; ai < 2; ++ai)
#pragma unroll
            for (int m = 0; m < 4; ++m) { const size_t row = (size_t)(row0 + ai * 128 + m * 16); float o[4] = {0.f, 0.f, 0.f, 0.f};
#pragma unroll
                for (int bj = 0; bj < 2; ++bj)
#pragma unroll
                    for (int n = 0; n < 2; ++n) { const int nb = 2 * bj + n; const u32x2 z = *(const u32x2*)(Z + row * 4096 + nb * 1024 + d0);
                        const f32x4 a = acc[ai][bj][m][n];
                        o[0] += sigmoid64(a[0]) * bflo(z.x); o[1] += sigmoid64(a[1]) * bfhi(z.x); o[2] += sigmoid64(a[2]) * bflo(z.y); o[3] += sigmoid64(a[3]) * bfhi(z.y); }
                u32x2 w; w.x = pk2(o[0], o[1]); w.y = pk2(o[2], o[3]); *(u32x2*)(MGo + row * 1024 + d0) = w; }
    }
};
struct EpiPartial {
    float* part;
    __device__ __forceinline__ void operator()(const f32x4 (&acc)[2][2][4][2], const Unit& u, int wr, int wc, int fr, int fq) const {
        const int g = u.pm / 36, pml = u.pm - 36 * g, kp = u.pn & 3, pn = u.pn >> 2;
        float* base = part + ((size_t)kp * 2048 + (size_t)(g * 1024 + (pml - 32) * 256 + wr * 64 + fr)) * DM;
#pragma unroll
        for (int bj = 0; bj < 2; ++bj) { const int c0 = pn * 256 + bj * 128 + wc * 32 + 8 * fq;
#pragma unroll
            for (int ai = 0; ai < 2; ++ai)
#pragma unroll
                for (int m = 0; m < 4; ++m) { float* p = base + (size_t)(ai * 128 + m * 16) * DM + c0; *(f32x4*)p = acc[ai][bj][m][0]; *(f32x4*)(p + 4) = acc[ai][bj][m][1]; } }
    }
};
struct EpiResid {
    const Args* a; int l, g, chunk; bool from_dst; int nMg;
    __device__ __forceinline__ void operator()(const f32x4 (&acc)[2][2][4][2], const Unit& u, int wr, int wc, int fr, int fq) const {
        const int g = nMg ? u.pm / nMg : this->g; const int rt = (nMg ? u.pm - g * nMg : u.pm) * 256; const int bi = row_bi(g, rt);
        const float* src = from_dst ? (const float*)xrow_dst(*a, g, rt) : xrow_src(*a, l, g, rt); float* dst = xrow_dst(*a, g, rt);
        const float* mod = (const float*)(a->ws + WS_MOD) + ((size_t)(l * 9 + bi) * 6 + chunk) * 1024;
        const int rl0 = wr * 64 + fr;
#pragma unroll
        for (int bj = 0; bj < 2; ++bj) { const int c0 = u.pn * 256 + bj * 128 + wc * 32 + 8 * fq;
            const f32x4 g0 = *(const f32x4*)(mod + c0), g1 = *(const f32x4*)(mod + c0 + 4);
#pragma unroll
            for (int ai = 0; ai < 2; ++ai)
#pragma unroll
                for (int m = 0; m < 4; ++m) { const size_t off = (size_t)(rl0 + ai * 128 + m * 16) * DM + c0;
                    const f32x4 x0 = *(const f32x4*)(src + off), x1 = *(const f32x4*)(src + off + 4);
                    *(f32x4*)(dst + off) = x0 + g0 * acc[ai][bj][m][0]; *(f32x4*)(dst + off + 4) = x1 + g1 * acc[ai][bj][m][1]; } }
    }
};

__device__ __forceinline__ float wfetch(const Args& a, int kind, int l, int n, int k) {
    switch (kind) {
    case 0: {
        int src;
        if (n < PC) { src = pcol_src(32 * gperm_in(n >> 5) + (n & 31)); if (src < 0) return 0.f; }
        else { const int t = n - PC, tg = t >> 8, c = t & 255; const int nb = 2 * (c >> 7) + ((c >> 2) & 1), dd = 16 * ((c >> 5) & 3) + 4 * ((c >> 3) & 3) + (c & 3); src = SRC_GATE + nb * 1024 + 64 * tg + dd; }
        return a.in[I_WIN][((size_t)l * 1024 + k) * IN_COLS + src]; }
    case 1: {
        n = 32 * gperm_mla(n >> 5) + (n & 31);
        if (n < 768) return k >= 128 ? a.in[I_MWUQ][((size_t)l * 256 + (k - 128)) * 768 + n] * a.in[I_MQNW][l * 256 + (k - 128)] : 0.f;
        if (k >= 128) return 0.f;
        const int m = n - 768; const int src = m < 512 ? (m >> 7) * 256 + (m & 127) : ((m - 512) >> 7) * 256 + 128 + ((m - 512) & 127);
        return a.in[I_MWUKV][((size_t)l * 128 + k) * 1024 + src] * a.in[I_MKVNW][l * 128 + k]; }
    case 2: { const int nb = n >> 10, d = n & 1023; return a.in[I_WBR][(((size_t)l * 4 + nb) * 512 + k) * 1024 + d]; }
    case 3: return a.in[I_WO][((size_t)l * 1024 + k) * 1024 + n];
    case 4: return a.in[I_W1][((size_t)l * 1024 + k) * 4096 + n];
    default: return a.in[I_W2][((size_t)l * 4096 + k) * 1024 + n];
    }
}
__device__ __forceinline__ void transpose_item(const Args& a, int kind, int l, int K, bf16* WT, int item, int nblk, LAS float* scr, int lane) {
    const int kb = item / nblk, nb = item % nblk, k0 = 64 * kb, n0 = 32 * nb;
    float tv[32];
#pragma unroll
    for (int i = 0; i < 32; ++i) tv[i] = wfetch(a, kind, l, n0 + (lane & 31), k0 + 2 * i + (lane >> 5));
#pragma unroll
    for (int i = 0; i < 32; ++i) scr[(2 * i + (lane >> 5)) * 33 + (lane & 31)] = tv[i];
    asm volatile("s_waitcnt lgkmcnt(0)" ::: "memory");
    const int c = lane & 7;
    if (kind == 0 || kind == 2) {
        unsigned char* W8 = kind == 2 ? (unsigned char*)WT : (unsigned char*)WT + (n0 >= PC ? (size_t)PC * 1024 * 2 : (size_t)PC * 1024 * 2 + (size_t)4096 * 1024); const int nr = kind == 2 ? n0 : (n0 >= PC ? n0 - PC : n0); const float sc8 = kind == 2 ? 32.f : 64.f;
#pragma unroll
        for (int j = 0; j < 4; ++j) { const int n = (lane >> 3) + 8 * j; const LAS float* s = scr + (8 * c) * 33 + n;
            u32x2 o; o.x = pk4_fp8(sc8 * s[0 * 33], sc8 * s[1 * 33], sc8 * s[2 * 33], sc8 * s[3 * 33]); o.y = pk4_fp8(sc8 * s[4 * 33], sc8 * s[5 * 33], sc8 * s[6 * 33], sc8 * s[7 * 33]);
            st8_wt(W8 + (size_t)(nr + n) * K + k0 + 8 * c, o); }
    }
    if (!(kind == 2 || (kind == 0 && n0 >= PC)))
#pragma unroll
    for (int j = 0; j < 4; ++j) { const int n = (lane >> 3) + 8 * j; const LAS float* s = scr + (8 * c) * 33 + n;
        u32x4 o; o.x = pk2(s[0 * 33], s[1 * 33]); o.y = pk2(s[2 * 33], s[3 * 33]); o.z = pk2(s[4 * 33], s[5 * 33]); o.w = pk2(s[6 * 33], s[7 * 33]);
        st16_wt(WT + (size_t)(n0 + n) * K + k0 + 8 * c, o); }
    asm volatile("s_waitcnt lgkmcnt(0)" ::: "memory");
}
__device__ __forceinline__ void prep_weights(const Args& a, int l, LAS unsigned char* lds, int it_lo = 0, int it_hi = 1 << 30) {
    const int tid = tidx(), lane = tid & 63, wave = tid >> 6;
    LAS float* scr = (LAS float*)(lds + wave * 8704);
    unsigned char* wt = a.ws + WS_WT;
    constexpr int I0 = 16 * (WIN_N / 32), I1 = 6 * (1792 / 32), I2 = 8 * (4096 / 32), I3 = 16 * (1024 / 32), I4 = 16 * (4096 / 32), I5 = 64 * (1024 / 32);
    const int gw = blockIdx.x * 8 + wave, NGW = gridDim.x * 8;
    const int it_end = it_hi < I0 + I1 + I2 + I3 + I4 + I5 ? it_hi : I0 + I1 + I2 + I3 + I4 + I5;
    for (int it = it_lo + gw; it < it_end; it += NGW) {
        int r = it;
        if (r < I0) { transpose_item(a, 0, l, 1024, (bf16*)(wt + WT_WIN), r, WIN_N / 32, scr, lane); continue; } r -= I0;
        if (r < I1) { transpose_item(a, 1, l, 384, (bf16*)(wt + WT_WMLA), r, 1792 / 32, scr, lane); continue; } r -= I1;
        if (r < I2) { transpose_item(a, 2, l, 512, (bf16*)(wt + WT_WB), r, 4096 / 32, scr, lane); continue; } r -= I2;
        if (r < I3) { transpose_item(a, 3, l, 1024, (bf16*)(wt + WT_WO), r, 1024 / 32, scr, lane); continue; } r -= I3;
        if (r < I4) { transpose_item(a, 4, l, 1024, (bf16*)(wt + WT_W1), r, 4096 / 32, scr, lane); continue; } r -= I4;
        transpose_item(a, 5, l, 4096, (bf16*)(wt + WT_W2), r, 1024 / 32, scr, lane);
    }
}
__device__ __forceinline__ void prep_weights_dyn(const Args& a, int l, LAS unsigned char* lds, int it_lo, int it_hi, unsigned* ctr) {
    const int tid = tidx(), lane = tid & 63, wave = tid >> 6;
    LAS float* scr = (LAS float*)(lds + wave * 8704);
    volatile LAS int* slot = (volatile LAS int*)(lds + LDS_BYTES - 16);
    unsigned char* wt = a.ws + WS_WT;
    constexpr int I0 = 16 * (WIN_N / 32), I1 = 6 * (1792 / 32), I2 = 8 * (4096 / 32), I3 = 16 * (1024 / 32), I4 = 16 * (4096 / 32);
    for (;;) {
        __syncthreads();
        if (tid == 0) *slot = (int)__hip_atomic_fetch_add(ctr, 8u, __ATOMIC_RELAXED, __HIP_MEMORY_SCOPE_AGENT);
        __syncthreads();
        const int base = __builtin_amdgcn_readfirstlane(*slot) + it_lo;
        if (base >= it_hi) break;
        int r = base + wave;
        if (r >= it_hi) continue;
        if (r < I0) { transpose_item(a, 0, l, 1024, (bf16*)(wt + WT_WIN), r, WIN_N / 32, scr, lane); continue; } r -= I0;
        if (r < I1) { transpose_item(a, 1, l, 384, (bf16*)(wt + WT_WMLA), r, 1792 / 32, scr, lane); continue; } r -= I1;
        if (r < I2) { transpose_item(a, 2, l, 512, (bf16*)(wt + WT_WB), r, 4096 / 32, scr, lane); continue; } r -= I2;
        if (r < I3) { transpose_item(a, 3, l, 1024, (bf16*)(wt + WT_WO), r, 1024 / 32, scr, lane); continue; } r -= I3;
        if (r < I4) { transpose_item(a, 4, l, 1024, (bf16*)(wt + WT_W1), r, 4096 / 32, scr, lane); continue; } r -= I4;
        transpose_item(a, 5, l, 4096, (bf16*)(wt + WT_W2), r, 1024 / 32, scr, lane);
    }
}
constexpr int PREP_EARLY_ITEMS = 16 * (WIN_N / 32) + 6 * (1792 / 32) + 8 * (4096 / 32) + 16 * (1024 / 32) + 16 * (4096 / 32);
__device__ __forceinline__ void xc_reduce_rows(const Args& a) {
    const int tid = tidx(), lane = tid & 63, gw = blockIdx.x * 8 + (tid >> 6), NGW = gridDim.x * 8;
    float* xc = (float*)(a.ws + WS_XC1); const float* part = (const float*)(a.ws + WS_H2);
    const float* mod = (const float*)(a.ws + WS_MOD) + ((size_t)(0 * 9 + 8) * 6 + 5) * 1024;
    for (int r = gw; r < 2048; r += NGW) {
#pragma unroll
        for (int j = 0; j < 4; ++j) { const int c = 4 * lane + 256 * j; const size_t o = (size_t)r * DM + c;
            const f32x4 s = *(const f32x4*)(part + o) + *(const f32x4*)(part + (size_t)2048 * DM + o) + *(const f32x4*)(part + (size_t)2 * 2048 * DM + o) + *(const f32x4*)(part + (size_t)3 * 2048 * DM + o);
            st16_wt(xc + o, *(const f32x4*)(xc + o) + *(const f32x4*)(mod + c) * s); }
    }
}
__device__ __forceinline__ void prep_mods(const Args& a, LAS unsigned char* lds, int item) {
    const int tid = tidx(), lane = tid & 63, wave = tid >> 6;
    LAS float* sc = (LAS float*)lds;
    LAS float* red = (LAS float*)(lds + 36864);
    {
        float cv[18];
#pragma unroll
        for (int j = 0; j < 18; ++j) { const int i = tid + 512 * j, bi = i >> 10, k = i & 1023; cv[j] = bi < 8 ? a.in[I_C][bi * 1024 + k] : a.in[I_CCTX][k]; }
#pragma unroll
        for (int j = 0; j < 18; ++j) sc[tid + 512 * j] = siluf_(cv[j]);
    }
    __syncthreads();
    const int l = item / 24, n0 = (item % 24) * 256 + 4 * lane;
    f32x4 acc[9];
#pragma unroll
    for (int b = 0; b < 9; ++b) acc[b] = (f32x4){0.f, 0.f, 0.f, 0.f};
    const float* w = a.in[I_ADAW] + ((size_t)l * 1024 + wave * 128) * 6144 + n0;
#pragma unroll 1
    for (int k0 = 0; k0 < 128; k0 += 16) {
        f32x4 wv[16];
#pragma unroll
        for (int k = 0; k < 16; ++k) wv[k] = *(const f32x4*)(w + (size_t)(k0 + k) * 6144);
#pragma unroll
        for (int k4 = 0; k4 < 16; k4 += 4)
#pragma unroll
            for (int b = 0; b < 9; ++b) { const f32x4 s4 = *(const LAS f32x4*)(sc + b * 1024 + wave * 128 + k0 + k4);
                acc[b] += wv[k4] * s4[0] + wv[k4 + 1] * s4[1] + wv[k4 + 2] * s4[2] + wv[k4 + 3] * s4[3]; }
    }
#pragma unroll
    for (int b = 0; b < 9; ++b) *(LAS f32x4*)(red + (wave * 9 + b) * 256 + 4 * lane) = acc[b];
    __syncthreads();
    for (int o = tid; o < 9 * 64; o += 512) {
        const int b = o >> 6, q = o & 63, n = (item % 24) * 256 + 4 * q;
        f32x4 sum = *(const f32x4*)(a.in[I_ADAB] + l * 6144 + n);
#pragma unroll
        for (int w8 = 0; w8 < 8; ++w8) sum += *(const LAS f32x4*)(red + (w8 * 9 + b) * 256 + 4 * q);
        st16_wt((float*)(a.ws + WS_MOD) + ((size_t)l * 9 + b) * 6144 + n, sum);
    }
    __syncthreads();
}

__device__ __forceinline__ void norm_mod_rows(const Args& a, int l, int g0, int nrows, int which  ,
                                              int r_lo = 0, int wg_lo = 0, int wg_n = 0  , bf16* Hov = nullptr  ) {
    const int tid = tidx(), lane = tid & 63; const int nwg = wg_n ? wg_n : (int)gridDim.x, wgi = (int)blockIdx.x - wg_lo;
    if (wgi < 0 || wgi >= nwg) return;
    const int gw = wgi * 8 + (tid >> 6), NGW = nwg * 8;
    const float* nw = a.in[which ? I_N2W : I_N1W] + l * DM;
    bf16* H = Hov ? Hov : (bf16*)(a.ws + (which ? WS_H2 : WS_H)); const int nMg = (l == 0) ? 36 : 32;
    for (int R = r_lo + gw; R < nrows; R += NGW) {
        int g = g0, r = R; if (which) { const int T = R >> 8; g = T / nMg; r = (T - g * nMg) * 256 + (R & 255); }
        const float* xr = which ? (const float*)xrow_dst(a, g, r) : xrow_src(a, l, g, r);
        const float* mod = (const float*)(a.ws + WS_MOD) + ((size_t)(l * 9 + row_bi(g, r)) * 6 + (which ? 3 : 0)) * 1024;
        f32x4 v[4]; float s = 0.f;
#pragma unroll
        for (int j = 0; j < 4; ++j) { v[j] = *(const f32x4*)(xr + 8 * lane + 512 * (j >> 1) + 4 * (j & 1)); s += (v[j][0] * v[j][0] + v[j][1] * v[j][1]) + (v[j][2] * v[j][2] + v[j][3] * v[j][3]); }
        const float rstd = rsqrtf(wave_sum(s) * (1.f / DM) + EPS);
#pragma unroll
        for (int h = 0; h < 2; ++h) { const int c = 8 * lane + 512 * h; f32x4 y[2];
#pragma unroll
            for (int q = 0; q < 2; ++q) { const f32x4 w = *(const f32x4*)(nw + c + 4 * q), sh = *(const f32x4*)(mod + c + 4 * q), sc = *(const f32x4*)(mod + 1024 + c + 4 * q);
#pragma unroll
                for (int e = 0; e < 4; ++e) y[q][e] = v[2 * h + q][e] * rstd * w[e] * (1.f + sc[e]) + sh[e]; }
            st16_wt(H + (size_t)R * DM + c, pack8(y[0], y[1]));
            if (!which) { unsigned char* h8 = a.ws + ((R >> 8) < H8_SPLIT ? WS_H8A + (size_t)R * 1024 : WS_H8B + (size_t)(R - H8_SPLIT * 256) * 1024) + c;
                u32x2 o8; o8.x = pk4_fp8(y[0][0], y[0][1], y[0][2], y[0][3]); o8.y = pk4_fp8(y[1][0], y[1][1], y[1][2], y[1][3]); st8_wt(h8, o8); } }
    }
}
__device__ __forceinline__ void final_norm_rows(const Args& a) {
    const int tid = tidx(), lane = tid & 63, gw = blockIdx.x * 8 + (tid >> 6), NGW = gridDim.x * 8;
    const float* nw = a.in[I_FNW];
    for (int r = gw; r < NB * SEQ; r += NGW) {
        float* xr = a.out + (size_t)r * DM;
        f32x4 v[4]; float s = 0.f;
#pragma unroll
        for (int j = 0; j < 4; ++j) { v[j] = *(const f32x4*)(xr + 4 * lane + 256 * j); s += (v[j][0] * v[j][0] + v[j][1] * v[j][1]) + (v[j][2] * v[j][2] + v[j][3] * v[j][3]); }
        const float rstd = rsqrtf(wave_sum(s) * (1.f / DM) + EPS);
#pragma unroll
        for (int j = 0; j < 4; ++j) { const int c = 4 * lane + 256 * j; const f32x4 w = *(const f32x4*)(nw + c); *(f32x4*)(xr + c) = v[j] * rstd * w; }
    }
}
__device__ __forceinline__ void rope_pair(float& x1, float& x2, int pos, int i, int quarter) {
    const float inv = exp2f(-(float)i * (13.287712379549449f / (float)quarter));
    const float ang = (float)pos * inv; const float s = __sinf(ang), c = __cosf(ang);
    const float a = x1 * c - x2 * s, b = x1 * s + x2 * c; x1 = a; x2 = b;
}
struct PostRegs { bf16 kr1, kr2, kb1, kb2, kd0, kd1, kd2, kd3; };
__device__ __forceinline__ PostRegs post_load(const bf16* P, int r, int lane) {
    const bf16* pr = P + (size_t)r * PC; PostRegs R;
    { const int d1 = 32 * ((lane >> 4) & 1) + (lane & 15); R.kr1 = pr[PC_KR + d1]; R.kr2 = pr[PC_KR + d1 + 16]; }
    { const int d1 = 64 * (lane >> 5) + 32 * ((lane >> 4) & 1) + (lane & 15); R.kb1 = pr[PC_KB + d1]; R.kb2 = pr[PC_KB + d1 + 16]; }
    { const bf16* kd = pr + PC_KD + 128 * (lane >> 5) + (lane & 31); R.kd0 = kd[0]; R.kd1 = kd[32]; R.kd2 = kd[64]; R.kd3 = kd[96]; }
    return R;
}
__device__ __forceinline__ void post_rows(const Args& a, int l) {
    const int tid = tidx(), lane = tid & 63, gw = blockIdx.x * 8 + (tid >> 6), NGW = gridDim.x * 8;
    bf16* P = (bf16*)(a.ws + WS_P); bf16* KA = (bf16*)(a.ws + WS_KA);
    const float* knw = a.in[I_KNW] + l * 128;
    if (gw >= MG_ROWS) return;
    PostRegs R = post_load(P, gw, lane);
#pragma unroll 1
    for (int r = gw; r < MG_ROWS; r += NGW) {
        const PostRegs Rn = post_load(P, r + NGW < MG_ROWS ? r + NGW : r, lane);
        bf16* pr = P + (size_t)r * PC;
        const bool lat = r < LAT_ROWS; const int t = r & 2047, rowp = t >> 6, colp = t & 63;
        int bl, kap; row_blk(r, bl, kap);
        if (lane < 32) {
            const int part = lane >> 4, i = lane & 15, d1 = 32 * part + i, d2 = d1 + 16;
            float x1 = bf2f(R.kr1), x2 = bf2f(R.kr2);
            if (lat) rope_pair(x1, x2, part ? colp : rowp, i, 16);
            const bf16 o1 = (bf16)f2bf(x1), o2 = (bf16)f2bf(x2);
#pragma unroll
            for (int h = 0; h < 4; ++h) { bf16* kd = KA + ((size_t)(bl * 4 + h) * KEYS + kap) * 192 + 128; kd[d1] = o1; kd[d2] = o2; }
        }
        if (lat) {
            const int hh = lane >> 5, part = (lane >> 4) & 1, i = lane & 15, d1 = 64 * hh + 32 * part + i, d2 = d1 + 16;
            float x1 = bf2f(R.kb1), x2 = bf2f(R.kb2);
            rope_pair(x1, x2, part ? colp : rowp, i, 16);
            pr[PC_KB + d1] = (bf16)f2bf(x1); pr[PC_KB + d2] = (bf16)f2bf(x2);
        }
        {
            const int hh = lane >> 5, i = lane & 31; bf16* kd = pr + PC_KD + 128 * hh;
            float x0 = bf2f(R.kd0), x1 = bf2f(R.kd1), x2 = bf2f(R.kd2), x3 = bf2f(R.kd3);
            float ss = x0 * x0 + x1 * x1 + x2 * x2 + x3 * x3;
#pragma unroll
            for (int o = 1; o < 32; o <<= 1) ss += SHFLX(ss, o);
            const float rstd = rsqrtf(ss * (1.f / 128.f) + EPS);
            x0 *= rstd * knw[i]; x1 *= rstd * knw[32 + i]; x2 *= rstd * knw[64 + i]; x3 *= rstd * knw[96 + i];
            if (lat) { rope_pair(x0, x1, rowp, i, 32); rope_pair(x2, x3, colp, i, 32); }
            kd[i] = (bf16)f2bf(x0); kd[32 + i] = (bf16)f2bf(x1); kd[64 + i] = (bf16)f2bf(x2); kd[96 + i] = (bf16)f2bf(x3);
        }
        R = Rn;
    }
}
__device__ __forceinline__ void comb_rows(const Args& a, int l, int nrows) {
    const int tid = tidx(), lane = tid & 63, gw = blockIdx.x * 8 + (tid >> 6), NGW = gridDim.x * 8;
    const bf16* P = (const bf16*)(a.ws + WS_P); bf16* Y = (bf16*)(a.ws + WS_Y); const bf16* OB = (const bf16*)(a.ws + WS_MG);
    const float* gnw = a.in[I_GNW] + l * 128;
    for (int r = gw; r < nrows; r += NGW) {
#pragma unroll
        for (int h = 0; h < 4; ++h) {
            const int e = 2 * lane;
            const unsigned wf = *(const unsigned*)(Y + (size_t)r * 2048 + 1024 + 128 * h + e), wb = *(const unsigned*)(OB + (size_t)r * 512 + 128 * h + e), wr_ = *(const unsigned*)(P + (size_t)r * PC + PC_RC + 128 * h + e);
            const float o0 = bflo(wf) + bflo(wb), o1 = bfhi(wf) + bfhi(wb);
            const float rstd = rsqrtf(wave_sum(o0 * o0 + o1 * o1) * (1.f / 128.f) + EPS);
            *(unsigned*)(Y + (size_t)r * 2048 + 1024 + 128 * h + e) = pk2(o0 * rstd * gnw[e] * siluf_(bflo(wr_)), o1 * rstd * gnw[e + 1] * siluf_(bfhi(wr_)));
        }
    }
}

struct AttnArgs {
    const bf16* Q; int qpitch;
    const bf16* Kc; const bf16* Kl; int kpitch;
    const bf16* Vt;
    unsigned char* O; int opitch;
    int qpos0, ntile, band_first;
    float sink_l2; const float* qnw;
};
__device__ __forceinline__ float max3f(float a, float b, float c) { float r; asm("v_max3_f32 %0, %1, %2, %3" : "=v"(r) : "v"(a), "v"(b), "v"(c)); return r; }
template <int DK, int DV, int MODE>
__device__ __forceinline__ void attn_unit(LAS unsigned char* lds, const AttnArgs& A) {
    constexpr bool PV8 = (DV == 128);
    constexpr int KS = DK * 2 + 16, VS = PV8 ? 80 : 144, NS = DK / 16, NDT = DV / 32, KCH = DK / 8, NKC = KCH / 8, NVC = PV8 ? 1 : DV / 64;
    constexpr int V_OFF = 64 * KS, BUFSZ = V_OFF + DV * VS;
    static_assert(BUFSZ % 16 == 0 && 3 * BUFSZ <= LDS_BYTES - 64, "attention LDS");
    const int tid = tidx(), lane = tid & 63, wave = __builtin_amdgcn_readfirstlane(tid >> 6);
    const int r = lane & 31, h = lane >> 5;
    const bool lat = A.qpos0 >= 0;
    bf16x8 qf[NS];
    {
        float qv[NS][8];
        const bf16* qrow = A.Q + (size_t)(32 * wave + r) * A.qpitch + 8 * h;
#pragma unroll
        for (int s = 0; s < NS; ++s) { const u32x4 w = *(const u32x4*)(qrow + 16 * s);
            qv[s][0] = bflo(w.x); qv[s][1] = bfhi(w.x); qv[s][2] = bflo(w.y); qv[s][3] = bfhi(w.y); qv[s][4] = bflo(w.z); qv[s][5] = bfhi(w.z); qv[s][6] = bflo(w.w); qv[s][7] = bfhi(w.w); }
        if (MODE == 2) {
            float ss = 0.f;
#pragma unroll
            for (int s = 0; s < NS; ++s)
#pragma unroll
                for (int j = 0; j < 8; ++j) ss += qv[s][j] * qv[s][j];
            ss += SHFLX(ss, 32);
            const float rstd = rsqrtf(ss * (1.f / 128.f) + EPS);
#pragma unroll
            for (int s = 0; s < NS; ++s)
#pragma unroll
                for (int j = 0; j < 8; ++j) qv[s][j] *= rstd * A.qnw[16 * s + 8 * h + j];
        }
        if (lat) {
            const int pos = A.qpos0 + 32 * wave + r, rowp = pos >> 6, colp = pos & 63;
#pragma unroll
            for (int j = 0; j < 8; ++j) {
                if (MODE == 0) { rope_pair(qv[8][j], qv[9][j], rowp, 8 * h + j, 16); rope_pair(qv[10][j], qv[11][j], colp, 8 * h + j, 16); }
                if (MODE == 1) { rope_pair(qv[0][j], qv[1][j], rowp, 8 * h + j, 16); rope_pair(qv[2][j], qv[3][j], colp, 8 * h + j, 16); }
                if (MODE == 2) { rope_pair(qv[0][j], qv[2][j], rowp, 8 * h + j, 32); rope_pair(qv[1][j], qv[3][j], rowp, 16 + 8 * h + j, 32);
                                 rope_pair(qv[4][j], qv[6][j], colp, 8 * h + j, 32); rope_pair(qv[5][j], qv[7][j], colp, 16 + 8 * h + j, 32); }
            }
        }
        const float c = (MODE == 0 ? 0.07216878364870322f : MODE == 1 ? 0.125f : 0.08838834764831845f) * 1.4426950408889634f;
#pragma unroll
        for (int s = 0; s < NS; ++s) { u32x4 w; w.x = pk2(qv[s][0] * c, qv[s][1] * c); w.y = pk2(qv[s][2] * c, qv[s][3] * c); w.z = pk2(qv[s][4] * c, qv[s][5] * c); w.w = pk2(qv[s][6] * c, qv[s][7] * c);
            qf[s] = __builtin_bit_cast(bf16x8, w); }
    }
    float m_run = 0.f; f32x2_t l2 = {0.f, 0.f};
    f32x16 acc[NDT], negm;
#pragma unroll
    for (int d = 0; d < NDT; ++d)
#pragma unroll
        for (int i = 0; i < 16; ++i) acc[d][i] = 0.f;
#pragma unroll
    for (int i = 0; i < 16; ++i) negm[i] = 0.f;
    u32x4 kreg[NKC], vreg[NVC];
    const int qlo = A.qpos0 + 32 * wave;
#define ATT_K0(i) ((MODE == 1 && lat && (i) >= 4) ? CTXL + A.band_first + 64 * ((i) - 4) : 64 * (i))
#define ATT_LOAD(i) do { const int k0_ = ATT_K0(i); const bf16* kb_ = ((k0_ < CTXL) ? A.Kc + (size_t)k0_ * A.kpitch : A.Kl + (size_t)(k0_ - CTXL) * A.kpitch) + (size_t)(tid >> 3) * A.kpitch + 8 * (tid & 7); \
        _Pragma("unroll") for (int c_ = 0; c_ < NKC; ++c_) kreg[c_] = *(const u32x4*)(kb_ + 64 * c_); \
        if (PV8) { vreg[0] = *(const u32x4*)((const unsigned char*)A.Vt + (size_t)(tid >> 2) * KEYS + k0_ + 16 * (tid & 3)); } else { \
        const bf16* vb_ = A.Vt + (size_t)(tid >> 3) * KEYS + k0_ + 8 * (tid & 7); \
        _Pragma("unroll") for (int p_ = 0; p_ < NVC; ++p_) vreg[p_] = *(const u32x4*)(vb_ + (size_t)(64 * p_) * KEYS); } } while (0)
#define ATT_WRITE(boff) do { LAS unsigned char* kw_ = lds + (boff) + (tid >> 3) * KS + (tid & 7) * 16; \
        _Pragma("unroll") for (int c_ = 0; c_ < NKC; ++c_) *(LAS u32x4*)(kw_ + 128 * c_) = kreg[c_]; \
        if (PV8) { LAS unsigned char* vw8_ = lds + (boff) + V_OFF + (tid >> 2) * VS + 8 * (tid & 3); u32x2 lo_, hi_; lo_.x = vreg[0].x; lo_.y = vreg[0].z; hi_.x = vreg[0].y; hi_.y = vreg[0].w;     \
            *(LAS u32x2*)vw8_ = lo_; *(LAS u32x2*)(vw8_ + 32) = hi_; } else { \
        LAS unsigned char* vw_ = lds + (boff) + V_OFF + (tid >> 3) * VS + ((tid & 7) >> 1) * 32 + (tid & 1) * 8;     \
        _Pragma("unroll") for (int p_ = 0; p_ < NVC; ++p_) { u32x2 lo_, hi_; lo_.x = vreg[p_].x; lo_.y = vreg[p_].y; hi_.x = vreg[p_].z; hi_.y = vreg[p_].w; \
            *(LAS u32x2*)(vw_ + 64 * p_ * VS) = lo_; *(LAS u32x2*)(vw_ + 64 * p_ * VS + 16) = hi_; } } } while (0)
#define ATT_VLD(m) (*(const LAS bf16x8*)(vb + ((m) % NDT) * 32 * VS + (32 * ((m) / (2 * NDT)) + 16 * (((m) / NDT) & 1)) * 2))
    constexpr float THR = 8.f;
    constexpr int NM = 4 * NDT;
    constexpr int KD = (MODE == 0) ? 3 : 4, VD = 4;
    ATT_LOAD(0);
    __syncthreads();
    ATT_WRITE(0);
    __syncthreads();
    int b_cur = 0;
#pragma unroll 1
    for (int it = 0; it < A.ntile; ++it) {
        const bool more = it + 1 < A.ntile;
        if (more) ATT_LOAD(it + 1);
        f32x16 sc0, sc1;
        {
            const LAS unsigned char* kb = lds + b_cur + r * KS + 16 * h;
            bf16x8 kfr[KD][2];
#pragma unroll
            for (int d_ = 0; d_ < KD; ++d_) { kfr[d_][0] = *(const LAS bf16x8*)(kb + 32 * d_); kfr[d_][1] = *(const LAS bf16x8*)(kb + 32 * KS + 32 * d_); }
            __builtin_amdgcn_s_setprio(1);
#pragma unroll
            for (int s = 0; s < NS; ++s) {
                if (s == 0) { sc0 = __builtin_amdgcn_mfma_f32_32x32x16_bf16(kfr[0][0], qf[0], negm, 0, 0, 0); sc1 = __builtin_amdgcn_mfma_f32_32x32x16_bf16(kfr[0][1], qf[0], negm, 0, 0, 0); }
                else { sc0 = __builtin_amdgcn_mfma_f32_32x32x16_bf16(kfr[s % KD][0], qf[s], sc0, 0, 0, 0); sc1 = __builtin_amdgcn_mfma_f32_32x32x16_bf16(kfr[s % KD][1], qf[s], sc1, 0, 0, 0); }
                if (s + KD < NS) { kfr[s % KD][0] = *(const LAS bf16x8*)(kb + 32 * (s + KD)); kfr[s % KD][1] = *(const LAS bf16x8*)(kb + 32 * KS + 32 * (s + KD)); }
            }
            __builtin_amdgcn_s_setprio(0);
        }
        if (MODE == 1 && lat && it >= 4) { const int qpos = qlo + r, kb0 = A.band_first + 64 * (it - 4) + 4 * h;
#pragma unroll
            for (int i = 0; i < 16; ++i) { const int kpos = kb0 + (i & 3) + 8 * (i >> 2); const int d0 = qpos - kpos, d1 = d0 - 32;
                if (d0 > 128 || d0 < -128) sc0[i] = -INFINITY;
                if (d1 > 128 || d1 < -128) sc1[i] = -INFINITY; } }
        float mt = max3f(sc0[0], sc1[0], sc0[1]);
        mt = max3f(mt, sc1[1], sc0[2]);
#pragma unroll
        for (int i = 2; i < 15; ++i) mt = max3f(mt, sc1[i], sc0[i + 1]);
        mt = fmaxf(mt, sc1[15]);
        mt = fmaxf(mt, SHFLX(mt, 32));
        if (it == 0 || !__all(mt <= THR)) {
            const float dl = it == 0 ? mt : fmaxf(mt, 0.f);
            m_run += dl;
#pragma unroll
            for (int i = 0; i < 16; ++i) { sc0[i] -= dl; sc1[i] -= dl; negm[i] = -m_run; }
            if (it > 0) { const float alpha = __builtin_amdgcn_exp2f(-dl); l2 *= alpha;
#pragma unroll
                for (int d = 0; d < NDT; ++d)
#pragma unroll
                    for (int i = 0; i < 16; ++i) acc[d][i] *= alpha; }
        }
#pragma unroll
        for (int i = 0; i < 16; i += 2) {
            f32x2_t p0 = {__builtin_amdgcn_exp2f(sc0[i]), __builtin_amdgcn_exp2f(sc0[i + 1])}, p1 = {__builtin_amdgcn_exp2f(sc1[i]), __builtin_amdgcn_exp2f(sc1[i + 1])};
            l2 += p0; l2 += p1; sc0[i] = p0[0]; sc0[i + 1] = p0[1]; sc1[i] = p1[0]; sc1[i + 1] = p1[1]; }
        if (PV8) {
            typedef int av8i_t __attribute__((ext_vector_type(8)));
            av8i_t pf8;
#pragma unroll
            for (int j = 0; j < 4; ++j) { pf8[j] = (int)pk4_fp8(sc0[4 * j], sc0[4 * j + 1], sc0[4 * j + 2], sc0[4 * j + 3]); pf8[4 + j] = (int)pk4_fp8(sc1[4 * j], sc1[4 * j + 1], sc1[4 * j + 2], sc1[4 * j + 3]); }
            const LAS unsigned char* vb = lds + b_cur + V_OFF + r * VS + 32 * h;
#define ATT_VLD8(d) ({ const u32x4 lo_ = *(const LAS u32x4*)(vb + (d) * 32 * VS), hi_ = *(const LAS u32x4*)(vb + (d) * 32 * VS + 16); (av8i_t){(int)lo_.x, (int)lo_.y, (int)lo_.z, (int)lo_.w, (int)hi_.x, (int)hi_.y, (int)hi_.z, (int)hi_.w}; })
            av8i_t vf[NDT];
#pragma unroll
            for (int d = 0; d < NDT; ++d) vf[d] = ATT_VLD8(d);
            __builtin_amdgcn_s_setprio(1);
#pragma unroll
            for (int d = 0; d < NDT; ++d) acc[d] = __builtin_amdgcn_mfma_scale_f32_32x32x64_f8f6f4(vf[d], pf8, acc[d], 0, 0, 0, 0, 0, 0);
#undef ATT_VLD8
            __builtin_amdgcn_s_setprio(0);
        } else {
        bf16x8 pf[2][2];
#pragma unroll
        for (int u = 0; u < 2; ++u) {
            u32x4 w0, w1;
            w0.x = pk2(sc0[8 * u + 0], sc0[8 * u + 1]); w0.y = pk2(sc0[8 * u + 2], sc0[8 * u + 3]); w0.z = pk2(sc0[8 * u + 4], sc0[8 * u + 5]); w0.w = pk2(sc0[8 * u + 6], sc0[8 * u + 7]);
            w1.x = pk2(sc1[8 * u + 0], sc1[8 * u + 1]); w1.y = pk2(sc1[8 * u + 2], sc1[8 * u + 3]); w1.z = pk2(sc1[8 * u + 4], sc1[8 * u + 5]); w1.w = pk2(sc1[8 * u + 6], sc1[8 * u + 7]);
            pf[0][u] = __builtin_bit_cast(bf16x8, w0); pf[1][u] = __builtin_bit_cast(bf16x8, w1);
        }
        {
            const LAS unsigned char* vb = lds + b_cur + V_OFF + r * VS + 16 * h;
            bf16x8 vfr[VD];
#pragma unroll
            for (int d_ = 0; d_ < VD; ++d_) vfr[d_] = ATT_VLD(d_);
            __builtin_amdgcn_s_setprio(1);
#pragma unroll
            for (int m = 0; m < NM; ++m) {
                acc[m % NDT] = __builtin_amdgcn_mfma_f32_32x32x16_bf16(vfr[m % VD], pf[m / (2 * NDT)][(m / NDT) & 1], acc[m % NDT], 0, 0, 0);
                if (m + VD < NM) vfr[m % VD] = ATT_VLD(m + VD);
            }
            __builtin_amdgcn_s_setprio(0);
        }
        }
        if (more) ATT_WRITE(b_cur ^ BUFSZ);
        __syncthreads();
        b_cur ^= BUFSZ;
    }
#undef ATT_LOAD
#undef ATT_WRITE
#undef ATT_K0
#undef ATT_VLD
    float l_run = l2[0] + l2[1];
    l_run += SHFLX(l_run, 32);
    if (MODE == 1) l_run += __builtin_amdgcn_exp2f(A.sink_l2 - m_run);
    const float inv = 16.f / l_run;
    unsigned char* orow = A.O + (size_t)(32 * wave + r) * A.opitch + 8 * h;
#pragma unroll
    for (int d = 0; d < NDT; ++d)
#pragma unroll
        for (int kp = 0; kp < 2; ++kp) {
            const int i0 = 8 * kp, i1 = 8 * kp + 4;
            const unsigned ga = pk4_fp8(acc[d][i0] * inv, acc[d][i0 + 1] * inv, acc[d][i0 + 2] * inv, acc[d][i0 + 3] * inv), gb = pk4_fp8(acc[d][i1] * inv, acc[d][i1 + 1] * inv, acc[d][i1 + 2] * inv, acc[d][i1 + 3] * inv);
            const auto sw = __builtin_amdgcn_permlane32_swap(ga, gb, false, false);
            u32x2 o; o.x = sw[0]; o.y = sw[1];
            *(u32x2*)(orow + 32 * d + 16 * kp) = o;
        }
}

constexpr size_t WS_GU = WS_MG;
constexpr size_t WS_GDL = WS_MOD + 512 * 1024;
constexpr int CW_GLA = 8192;
__device__ __forceinline__ float logsigmoidf_(float x) { return fminf(x, 0.f) - __logf(1.f + __expf(-fabsf(x))); }
struct GlaArgs { const bf16* P; const bf16* VtC; bf16* Y; bf16* GU; float* GDL; unsigned* cnt; const float* wd; const float* bd; const float* gnw; int need_ctx; };
__device__ __forceinline__ void gla_rows(int c, int dir, int bl, int& row0, int& kap0) {
    if (c < 4) { const int ch = dir ? 3 - c : c; row0 = LAT_ROWS + bl * CTXL + 64 * ch; kap0 = 64 * ch; }
    else { const int ch = dir ? 35 - c : c - 4; row0 = bl * SEQ + 64 * ch; kap0 = CTXL + 64 * ch; }
}
constexpr int GL_RS = 144;
constexpr int GO_RQ = 0, GO_RK = 9216, GO_VT = 18432, GO_LR = 36864  , GO_WD = 40960  , GO_BD = 49152  , GO_GT = 49664, GO_DL = 51712, GO_QT = 51968, GO_KT = 61184,
              GO_KH = 70400, GO_AT = 79616, GO_ST = 88832, GO_RED = 107264  , GO_END = 108288;
__device__ __forceinline__ void gla_decay(LAS unsigned char* lds, int dsel, int dir, int wave, int d, float (&cum)[8], float& tot) {
    float la[8];
    {
        float wdv[16];
#pragma unroll
        for (int q = 0; q < 16; ++q) wdv[q] = ((const LAS float*)(lds + GO_WD + dsel * 4096))[q * 64 + d];
        const float bdv = ((const LAS float*)(lds + GO_BD + dsel * 256))[d];
#pragma unroll
        for (int i = 0; i < 8; ++i) { const LAS unsigned* lr = (const LAS unsigned*)(lds + GO_LR + dsel * 2048 + (8 * wave + i) * 32); float x = bdv;
#pragma unroll
            for (int q = 0; q < 8; ++q) { const unsigned w = lr[q]; x += bflo(w) * wdv[2 * q] + bfhi(w) * wdv[2 * q + 1]; }
            la[i] = logsigmoidf_(x) * (1.f / 16.f); }
    }
    float s = 0.f;
    if (dir == 0) {
#pragma unroll
        for (int i = 0; i < 8; ++i) { s += la[i]; cum[i] = s; } }
    else {
#pragma unroll
        for (int i = 7; i >= 0; --i) { s += la[i]; cum[i] = s; } }
    ((LAS float*)(lds + GO_GT))[wave * 64 + d] = s;
    __syncthreads();
    float pre = 0.f; tot = 0.f;
#pragma unroll
    for (int w8 = 0; w8 < 8; ++w8) { const float gt = ((const LAS float*)(lds + GO_GT))[w8 * 64 + d]; tot += gt; if (dir == 0 ? (w8 < wave) : (w8 > wave)) pre += gt; }
#pragma unroll
    for (int i = 0; i < 8; ++i) cum[i] += pre;
}
__device__ __forceinline__ void gla_signal(unsigned* word, unsigned v, int tid) {
    asm volatile("s_waitcnt vmcnt(0)" ::: "memory");
    __syncthreads();
    if (tid == 0) { __builtin_amdgcn_fence(__ATOMIC_RELEASE, "agent"); asm volatile("s_waitcnt vmcnt(0)" ::: "memory"); __hip_atomic_fetch_add(word, v, __ATOMIC_RELAXED, __HIP_MEMORY_SCOPE_AGENT); }
}
__device__ __forceinline__ void gla_wait(unsigned* w0, unsigned* w1, unsigned need, int tid) {
    if (tid == 0) {
        unsigned sp = 0;
        while (__hip_atomic_load(w0, __ATOMIC_RELAXED, __HIP_MEMORY_SCOPE_AGENT) < need || __hip_atomic_load(w1, __ATOMIC_RELAXED, __HIP_MEMORY_SCOPE_AGENT) < need) { __builtin_amdgcn_s_sleep(2); if (++sp > (1u << 22)) break; }
        __builtin_amdgcn_fence(__ATOMIC_ACQUIRE, "agent");
        asm volatile("s_waitcnt vmcnt(0)" ::: "memory");
    }
    __syncthreads();
}
__device__ __forceinline__ void gla_local(LAS unsigned char* lds, const GlaArgs& G, int chain, int c) {
    const int tid = tidx(), lane = tid & 63, wave = __builtin_amdgcn_readfirstlane(tid >> 6), r = lane & 31, hh = lane >> 5;
    const int dir = chain & 1, h = (chain >> 1) & 3, bl = chain >> 3;
    int row0, kap0; gla_rows(c, dir, bl, row0, kap0);
    const bf16* pr = G.P + (size_t)(row0 + (tid >> 3)) * PC + 8 * (tid & 7);
    const u32x4 rk = *(const u32x4*)(pr + PC_KC + 64 * h);
    const bf16* vp = G.VtC + ((size_t)(bl * 4 + h) * 128 + (tid >> 3)) * KEYS + kap0 + 8 * (tid & 7);
    const u32x4 rv0 = *(const u32x4*)vp, rv1 = *(const u32x4*)(vp + (size_t)64 * KEYS);
    u32x4 rl = {0u, 0u, 0u, 0u};
    if (tid < 128) rl = *(const u32x4*)(G.P + (size_t)(row0 + (tid >> 1)) * PC + PC_LRF + 16 * dir + 8 * (tid & 1));
    __syncthreads();
    for (int i = tid; i < 1024; i += 512) ((LAS float*)(lds + GO_WD))[i] = G.wd[(size_t)dir * 4096 + (size_t)(i >> 6) * 256 + 64 * h + (i & 63)];
    if (tid < 64) ((LAS float*)(lds + GO_BD))[tid] = G.bd[dir * 256 + 64 * h + tid];
    *(LAS u32x4*)(lds + GO_RK + (tid >> 3) * GL_RS + (tid & 7) * 16) = rk;
    *(LAS u32x4*)(lds + GO_VT + (tid >> 3) * GL_RS + (tid & 7) * 16) = rv0; *(LAS u32x4*)(lds + GO_VT + (64 + (tid >> 3)) * GL_RS + (tid & 7) * 16) = rv1;
    if (tid < 128) *(LAS u32x4*)(lds + GO_LR + (tid >> 1) * 32 + (tid & 1) * 16) = rl;
    __syncthreads();
    const int d = lane; float cum[8], tot;
    gla_decay(lds, 0, dir, wave, d, cum, tot);
    if (wave == 0) G.GDL[((size_t)chain * 36 + c) * 64 + d] = __expf(tot);
    {
        unsigned kh[4];
#pragma unroll
        for (int i = 0; i < 8; ++i) { const int s = 8 * wave + i; const float kv = bf2f(*(const LAS bf16*)(lds + GO_RK + s * GL_RS + 2 * d));
            const unsigned khv = f2bf(kv * __expf(tot - cum[i]));
            if (i & 1) kh[i >> 1] |= khv << 16; else kh[i >> 1] = khv; }
        u32x4 w; w.x = kh[0]; w.y = kh[1]; w.z = kh[2]; w.w = kh[3];
        *(LAS u32x4*)(lds + GO_KH + d * GL_RS + 16 * wave) = w;
    }
    __syncthreads();
    const int et = wave >> 1, dt = wave & 1;
    f32x16 u;
#pragma unroll
    for (int i = 0; i < 16; ++i) u[i] = 0.f;
#pragma unroll
    for (int kk = 0; kk < 4; ++kk) { const bf16x8 af = *(const LAS bf16x8*)(lds + GO_VT + (32 * et + r) * GL_RS + (16 * kk + 8 * hh) * 2), bfr = *(const LAS bf16x8*)(lds + GO_KH + (32 * dt + r) * GL_RS + (16 * kk + 8 * hh) * 2);
        u = __builtin_amdgcn_mfma_f32_32x32x16_bf16(af, bfr, u, 0, 0, 0); }
    bf16* up = G.GU + ((size_t)chain * 36 + c) * 8192 + 32 * dt + r;
#pragma unroll
    for (int i = 0; i < 16; ++i) { const int e = 32 * et + (i & 3) + 8 * (i >> 2) + 4 * hh; up[e * 64] = (bf16)f2bf(u[i]); }
}
__device__ __forceinline__ void gla_scan(const GlaArgs& G, int chain, int quarter) {
    const int tid = tidx();
    const int e = 32 * quarter + (tid >> 4), d0 = 4 * (tid & 15);
    bf16* up = G.GU + (size_t)chain * 36 * 8192 + e * 64 + d0; const float* dlp = G.GDL + (size_t)chain * 36 * 64 + d0;
    float S[4] = {0.f, 0.f, 0.f, 0.f};
#pragma unroll 1
    for (int c0 = 0; c0 < 36; c0 += 12) {
        u32x2 uu[12]; f32x4 dl[12];
#pragma unroll
        for (int j = 0; j < 12; ++j) { uu[j] = *(const u32x2*)(up + (size_t)(c0 + j) * 8192); dl[j] = *(const f32x4*)(dlp + (c0 + j) * 64); }
#pragma unroll
        for (int j = 0; j < 12; ++j) {
            S[0] = dl[j][0] * S[0] + bflo(uu[j].x); S[1] = dl[j][1] * S[1] + bfhi(uu[j].x); S[2] = dl[j][2] * S[2] + bflo(uu[j].y); S[3] = dl[j][3] * S[3] + bfhi(uu[j].y);
            const unsigned long long w = (unsigned long long)pk2(S[0], S[1]) | ((unsigned long long)pk2(S[2], S[3]) << 32);
            __hip_atomic_store((unsigned long long*)(up + (size_t)(c0 + j) * 8192), w, __ATOMIC_RELAXED, __HIP_MEMORY_SCOPE_AGENT); }
    }
    asm volatile("s_waitcnt vmcnt(0)" ::: "memory");
    __syncthreads();
    if (tid == 0) __hip_atomic_fetch_add(G.cnt + chain * 16, 100u, __ATOMIC_RELAXED, __HIP_MEMORY_SCOPE_AGENT);
}
__device__ __forceinline__ void gla_out(LAS unsigned char* lds, const GlaArgs& G, int bh, int j) {
    const int tid = tidx(), lane = tid & 63, wave = __builtin_amdgcn_readfirstlane(tid >> 6), r = lane & 31, hh = lane >> 5;
    const int h = bh & 3, bl = bh >> 2;
    const bool isctx = j >= 32; const int ch = isctx ? j - 32 : j;
    const int row0 = isctx ? LAT_ROWS + bl * CTXL + 64 * ch : bl * SEQ + 64 * ch, kap0 = isctx ? 64 * ch : CTXL + 64 * ch;
    const bf16* pr = G.P + (size_t)(row0 + (tid >> 3)) * PC + 8 * (tid & 7);
    const u32x4 rq = *(const u32x4*)(pr + PC_QC + 64 * h), rk = *(const u32x4*)(pr + PC_KC + 64 * h);
    const bf16* vp = G.VtC + ((size_t)(bl * 4 + h) * 128 + (tid >> 3)) * KEYS + kap0 + 8 * (tid & 7);
    const u32x4 rv0 = *(const u32x4*)vp, rv1 = *(const u32x4*)(vp + (size_t)64 * KEYS);
    u32x4 rl = {0u, 0u, 0u, 0u};
    if (tid < 256) rl = *(const u32x4*)(G.P + (size_t)(row0 + ((tid & 127) >> 1)) * PC + PC_LRF + 16 * (tid >> 7) + 8 * (tid & 1));
    __syncthreads();
    for (int i = tid; i < 2048; i += 512) { const int dsel = i >> 10, q = (i >> 6) & 15, dd = i & 63; ((LAS float*)(lds + GO_WD))[i] = G.wd[(size_t)dsel * 4096 + (size_t)q * 256 + 64 * h + dd]; }
    if (tid < 128) ((LAS float*)(lds + GO_BD))[tid] = G.bd[(tid >> 6) * 256 + 64 * h + (tid & 63)];
    *(LAS u32x4*)(lds + GO_RQ + (tid >> 3) * GL_RS + (tid & 7) * 16) = rq; *(LAS u32x4*)(lds + GO_RK + (tid >> 3) * GL_RS + (tid & 7) * 16) = rk;
    *(LAS u32x4*)(lds + GO_VT + (tid >> 3) * GL_RS + (tid & 7) * 16) = rv0; *(LAS u32x4*)(lds + GO_VT + (64 + (tid >> 3)) * GL_RS + (tid & 7) * 16) = rv1;
    if (tid < 256) *(LAS u32x4*)(lds + GO_LR + (tid >> 7) * 2048 + ((tid & 127) >> 1) * 32 + (tid & 1) * 16) = rl;
    const int chain0 = bh * 2;
    gla_wait(G.cnt + chain0 * 16, G.cnt + (chain0 + 1) * 16, 400u, tid);
    const int et = wave >> 1, tt = wave & 1, d = lane;
    f32x16 oc;
#pragma unroll
    for (int i = 0; i < 16; ++i) oc[i] = 0.f;
#pragma unroll 1
    for (int dir = 0; dir < 2; ++dir) {
        if (dir) __syncthreads();
        const int pos = dir == 0 ? (isctx ? ch : 4 + ch) : (isctx ? 3 - ch : 35 - ch);
        {
            u32x4 s0 = {0u, 0u, 0u, 0u}, s1 = {0u, 0u, 0u, 0u};
            if (pos > 0) { const bf16* sp = G.GU + ((size_t)(chain0 + dir) * 36 + pos - 1) * 8192 + (tid >> 3) * 64 + 8 * (tid & 7); s0 = *(const u32x4*)sp; s1 = *(const u32x4*)(sp + 64 * 64); }
            *(LAS u32x4*)(lds + GO_ST + (tid >> 3) * GL_RS + (tid & 7) * 16) = s0; *(LAS u32x4*)(lds + GO_ST + (64 + (tid >> 3)) * GL_RS + (tid & 7) * 16) = s1;
        }
        float cum[8], tot;
        gla_decay(lds, dir, dir, wave, d, cum, tot);
#pragma unroll
        for (int i = 0; i < 8; ++i) { const int s = 8 * wave + i;
            const float qv = bf2f(*(const LAS bf16*)(lds + GO_RQ + s * GL_RS + 2 * d)), kv = bf2f(*(const LAS bf16*)(lds + GO_RK + s * GL_RS + 2 * d));
            *(LAS bf16*)(lds + GO_QT + s * GL_RS + 2 * d) = (bf16)f2bf(qv * 0.125f * __expf(cum[i]));
            *(LAS bf16*)(lds + GO_KT + s * GL_RS + 2 * d) = (bf16)f2bf(kv * __expf(-cum[i])); }
        __syncthreads();
        if (wave < 4) {
            const int ss = wave & 1, t2 = wave >> 1;
            f32x16 sc;
#pragma unroll
            for (int i = 0; i < 16; ++i) sc[i] = 0.f;
#pragma unroll
            for (int kk = 0; kk < 4; ++kk) { const bf16x8 af = *(const LAS bf16x8*)(lds + GO_KT + (32 * ss + r) * GL_RS + (16 * kk + 8 * hh) * 2), bfr = *(const LAS bf16x8*)(lds + GO_QT + (32 * t2 + r) * GL_RS + (16 * kk + 8 * hh) * 2);
                sc = __builtin_amdgcn_mfma_f32_32x32x16_bf16(af, bfr, sc, 0, 0, 0); }
            const int t = 32 * t2 + r;
#pragma unroll
            for (int i4 = 0; i4 < 4; ++i4) { float v[4];
#pragma unroll
                for (int jj = 0; jj < 4; ++jj) { const int s = 32 * ss + 8 * i4 + 4 * hh + jj; const bool keep = dir == 0 ? (s <= t) : (s >= t); v[jj] = keep ? sc[4 * i4 + jj] : 0.f; }
                u32x2 w; w.x = pk2(v[0], v[1]); w.y = pk2(v[2], v[3]); *(LAS u32x2*)(lds + GO_AT + t * GL_RS + (32 * ss + 8 * i4 + 4 * hh) * 2) = w; }
        }
        __syncthreads();
#pragma unroll
        for (int kk = 0; kk < 4; ++kk) { const bf16x8 af = *(const LAS bf16x8*)(lds + GO_ST + (32 * et + r) * GL_RS + (16 * kk + 8 * hh) * 2), bfr = *(const LAS bf16x8*)(lds + GO_QT + (32 * tt + r) * GL_RS + (16 * kk + 8 * hh) * 2);
            oc = __builtin_amdgcn_mfma_f32_32x32x16_bf16(af, bfr, oc, 0, 0, 0); }
#pragma unroll
        for (int kk = 0; kk < 4; ++kk) { const bf16x8 af = *(const LAS bf16x8*)(lds + GO_VT + (32 * et + r) * GL_RS + (16 * kk + 8 * hh) * 2), bfr = *(const LAS bf16x8*)(lds + GO_AT + (32 * tt + r) * GL_RS + (16 * kk + 8 * hh) * 2);
            oc = __builtin_amdgcn_mfma_f32_32x32x16_bf16(af, bfr, oc, 0, 0, 0); }
    }
    float ss = 0.f;
#pragma unroll
    for (int i = 0; i < 16; ++i) ss += oc[i] * oc[i];
    ss += SHFLX(ss, 32);
    if (hh == 0) ((LAS float*)(lds + GO_RED))[et * 64 + 32 * tt + r] = ss;
    __syncthreads();
    const int t = 32 * tt + r;
    const float tot2 = ((const LAS float*)(lds + GO_RED))[t] + ((const LAS float*)(lds + GO_RED))[64 + t] + ((const LAS float*)(lds + GO_RED))[128 + t] + ((const LAS float*)(lds + GO_RED))[192 + t];
    const float rstd = rsqrtf(tot2 * (1.f / 128.f) + EPS);
    const int row = row0 + t;
    const bf16* rp = G.P + (size_t)row * PC + PC_RC + 128 * h + 32 * et + 4 * hh; unsigned char* yp = (unsigned char*)G.Y + (size_t)row * 2048 + 1024 + 128 * h + 32 * et + 4 * hh; const float* gw = G.gnw + 32 * et + 4 * hh;
#pragma unroll
    for (int i4 = 0; i4 < 4; ++i4) { const u32x2 rr = *(const u32x2*)(rp + 8 * i4); const f32x4 w = *(const f32x4*)(gw + 8 * i4);
        const float y0 = oc[4 * i4] * rstd * w[0] * siluf_(bflo(rr.x)), y1 = oc[4 * i4 + 1] * rstd * w[1] * siluf_(bfhi(rr.x)), y2 = oc[4 * i4 + 2] * rstd * w[2] * siluf_(bflo(rr.y)), y3 = oc[4 * i4 + 3] * rstd * w[3] * siluf_(bfhi(rr.y));
        *(unsigned*)(yp + 8 * i4) = pk4_fp8(16.f * y0, 16.f * y1, 16.f * y2, 16.f * y3); }
}

__device__ __forceinline__ GlaArgs make_gla(const Args& a, int l, int g) {
    unsigned char* ws = a.ws; GlaArgs G; G.P = (const bf16*)(ws + WS_P); G.VtC = (const bf16*)(ws + WS_VTC); G.Y = (bf16*)(ws + WS_Y); G.GU = (bf16*)(ws + WS_GU); G.GDL = (float*)(ws + WS_GDL);
    G.cnt = (unsigned*)(ws + WS_CTL) + CW_GLA + (l * 2 + g) * 32 * 16; G.wd = a.in[I_GWD] + (size_t)l * 2 * 16 * 256; G.bd = a.in[I_GBD] + (size_t)l * 2 * 256; G.gnw = a.in[I_GNW] + l * 128; G.need_ctx = (l == 0);
    return G;
}
__device__ __forceinline__ void attn_phase(const Args& a, int l, int g, LAS unsigned char* lds) {
    unsigned char* ws = a.ws;
    const bf16* P = (const bf16*)(ws + WS_P); const bf16* QA = (const bf16*)(ws + WS_QA); const bf16* KA = (const bf16*)(ws + WS_KA);
    unsigned char* Y = ws + WS_Y;
    const int need_ctx = (l == 0);
    const int NCH = need_ctx ? 36 : 32;
    const int C_SCAN = 16, C_A = 16, C_D = 16, C_B = 32, C_AC = need_ctx ? 2 : 0, C_DC = C_AC, C_BC = need_ctx ? 4 : 0, C_OUT = 2 * NCH;
    const int qtotal = C_SCAN + C_A + C_D + C_B + C_AC + C_DC + C_BC + C_OUT;
    unsigned* ctr0 = (unsigned*)(ws + WS_CTL) + (l * 2 + g) * 8 * 16;
    volatile LAS int* slot = (volatile LAS int*)(lds + LDS_BYTES - 16);
    const GlaArgs G = make_gla(a, l, g);
    const int x0 = (int)(__builtin_amdgcn_s_getreg((3 << 11) | 20) & 7);
    for (int qi = 0; qi < 8; ++qi) {
        const int x = (x0 + qi) & 7;
        for (;;) {
            __syncthreads();
            if (tidx() == 0) *slot = (int)__hip_atomic_fetch_add(ctr0 + x * 16, 1u, __ATOMIC_RELAXED, __HIP_MEMORY_SCOPE_AGENT);
            __syncthreads();
            int idx = *slot;
            idx = __builtin_amdgcn_readfirstlane(idx);
            if (idx >= qtotal) break;
            if (idx < C_SCAN) { const int bh = x + 8 * (idx >> 3); gla_scan(G, bh * 2 + ((idx >> 2) & 1), idx & 3); continue; }
            idx -= C_SCAN;
            if (idx >= qtotal - C_SCAN - C_OUT) { idx -= qtotal - C_SCAN - C_OUT; const int bh = x + 8 * (idx / NCH); gla_out(lds, G, bh, idx - (idx / NCH) * NCH); continue; }
            AttnArgs A; A.sink_l2 = 0.f; A.qnw = nullptr; A.band_first = 0;
            int kind, bl, h, qb = 0, ctxq = 0;
            if (idx < C_A) { kind = 0; const int bh = x + 8 * (idx >> 3); bl = bh >> 2; h = bh & 3; qb = idx & 7; }
            else if (idx < C_A + C_D) { const int i = idx - C_A; kind = 2; bl = x >> 1; h = 2 * (x & 1) + (i >> 3); qb = i & 7; }
            else if (idx < C_A + C_D + C_B) { const int i = idx - C_A - C_D; kind = 1; bl = x >> 1; h = 4 * (x & 1) + (i >> 3); qb = i & 7; }
            else if (idx < C_A + C_D + C_B + C_AC) { const int i = idx - (C_A + C_D + C_B); kind = 0; const int bh = x + 8 * i; bl = bh >> 2; h = bh & 3; ctxq = 1; }
            else if (idx < C_A + C_D + C_B + C_AC + C_DC) { const int i = idx - (C_A + C_D + C_B + C_AC); kind = 2; bl = x >> 1; h = 2 * (x & 1) + i; ctxq = 1; }
            else { const int i = idx - (C_A + C_D + C_B + C_AC + C_DC); kind = 1; bl = x >> 1; h = 4 * (x & 1) + i; ctxq = 1; }
            int row;
            if (!ctxq) { row = bl * SEQ + 256 * qb; A.qpos0 = 256 * qb; A.ntile = 36; }
            else { row = LAT_ROWS + bl * CTXL; A.qpos0 = -1; A.ntile = 4; }
            A.opitch = 2048;
            if (kind == 0) {
                A.Q = QA + (size_t)row * 768 + 192 * h; A.qpitch = 768;
                A.Kc = KA + (size_t)(bl * 4 + h) * KEYS * 192; A.Kl = A.Kc + (size_t)CTXL * 192; A.kpitch = 192;
                A.Vt = (const bf16*)(ws + WS_VTA + (size_t)(bl * 4 + h) * 128 * KEYS);
                A.O = Y + (size_t)row * 2048 + 128 * h;
                attn_unit<192, 128, 0>(lds, A);
            } else if (kind == 2) {
                const int kvh = h >> 1;
                A.Q = P + (size_t)row * PC + PC_QD + 128 * h; A.qpitch = PC;
                A.Kc = P + (size_t)(LAT_ROWS + bl * CTXL) * PC + PC_KD + 128 * kvh; A.Kl = P + (size_t)(bl * SEQ) * PC + PC_KD + 128 * kvh; A.kpitch = PC;
                A.Vt = (const bf16*)(ws + WS_VTD + (size_t)(bl * 2 + kvh) * 128 * KEYS);
                A.O = Y + (size_t)row * 2048 + 1536 + 128 * h; A.qnw = a.in[I_QNW] + l * 128;
                attn_unit<128, 128, 2>(lds, A);
            } else {
                const int kvh = h >> 2;
                if (!ctxq) { const int first = 256 * qb - 128 < 0 ? 0 : 256 * qb - 128, last = 256 * qb + 383 > SEQ - 1 ? SEQ - 1 : 256 * qb + 383; A.band_first = first; A.ntile = 4 + (last - first + 1) / 64; }
                A.Q = P + (size_t)row * PC + PC_QB + 64 * h; A.qpitch = PC;
                A.Kc = P + (size_t)(LAT_ROWS + bl * CTXL) * PC + PC_KB + 64 * kvh; A.Kl = P + (size_t)(bl * SEQ) * PC + PC_KB + 64 * kvh; A.kpitch = PC;
                A.Vt = (const bf16*)(ws + WS_VTB) + (size_t)(bl * 2 + kvh) * 64 * KEYS;
                A.O = Y + (size_t)row * 2048 + 512 + 64 * h; A.sink_l2 = a.in[I_SINK][l * 8 + h] * 1.4426950408889634f;
                attn_unit<64, 64, 1>(lds, A);
            }
        }
    }
}

#define XB_TMO      128
#define XB_XCNT(j)  (256  + 64 * (j))
#define XB_XSUB(j)  (1280 + 64 * (j))
#define XB_XGEN(j)  (2304 + 64 * (j))
#define XB_TOP      3328
#define XB_TOPGEN   3392
#define XCD_BAR_WORDS 3456
#define XB_SPIN_CAP (1u << 22)
__device__ __forceinline__ unsigned xb_ld(unsigned* p)              { return __hip_atomic_load(p, __ATOMIC_RELAXED, __HIP_MEMORY_SCOPE_AGENT); }
__device__ __forceinline__ unsigned xb_add(unsigned* p, unsigned v) { return __hip_atomic_fetch_add(p, v, __ATOMIC_RELAXED, __HIP_MEMORY_SCOPE_AGENT); }
__device__ __forceinline__ unsigned xb_xcc_id() { return (unsigned)__builtin_amdgcn_s_getreg((3 << 11) | 20) & 0xFu; }
#define XB_SPIN(cond, bar) do { unsigned _sp = 0; while (cond) { __builtin_amdgcn_s_sleep(1); \
    if ((++_sp & 255u) == 0u) { if (xb_ld(&(bar)[XB_TMO])) break; if (_sp > XB_SPIN_CAP) { atomicAdd(&(bar)[XB_TMO], 1u); break; } } } } while (0)
struct XcdBarrier { unsigned* bar; unsigned x; volatile LAS unsigned* st; };
__device__ __forceinline__ XcdBarrier xcd_barrier_post(unsigned* bar, volatile LAS unsigned* st) {
    XcdBarrier b; b.bar = bar; b.x = xb_xcc_id(); b.st = st;
    if (tidx() == 0) (void)xb_add(&bar[XB_XCNT(b.x)], 1u);
    return b;
}
__device__ __forceinline__ void xcd_barrier_complete(unsigned* bar, unsigned x, unsigned& nloc, unsigned& nx) {
    const unsigned G = gridDim.x * gridDim.y * gridDim.z;
    unsigned sum, cnt, mine, sp = 0u;
    for (;;) {
        sum = 0u; cnt = 0u; mine = 0u;
#pragma unroll
        for (unsigned j = 0; j < 16; ++j) { const unsigned c = xb_ld(&bar[XB_XCNT(j)]); sum += c; cnt += (c > 0u) ? 1u : 0u; mine = (j == x) ? c : mine; }
        if (sum == G) break;
        __builtin_amdgcn_s_sleep(1);
        if ((++sp & 255u) == 0u) { if (xb_ld(&bar[XB_TMO])) break; if (sp > XB_SPIN_CAP) { atomicAdd(&bar[XB_TMO], 1u); break; } }
    }
    nloc = mine > 0u ? mine : 1u; nx = cnt > 0u ? cnt : 1u;
}
__device__ __forceinline__ void xcd_barrier(const XcdBarrier& b, const bool rel = true) {
    asm volatile("s_waitcnt vmcnt(0)" ::: "memory");
    __syncthreads();
    if (tidx() == 0) {
        unsigned* bar = b.bar;
        __builtin_amdgcn_s_waitcnt(0);
        unsigned nloc = b.st[0], nx = b.st[1];
        if (nloc == 0u) { xcd_barrier_complete(bar, b.x, nloc, nx); b.st[0] = nloc; b.st[1] = nx; }
        const unsigned gen = b.st[2]; b.st[2] = gen + 1u;
        const unsigned old = xb_add(&bar[XB_XSUB(b.x)], 1u);
        if (old + 1u == (gen + 1u) * nloc) {
            if (rel) __builtin_amdgcn_fence(__ATOMIC_RELEASE, "agent");
            asm volatile("s_waitcnt vmcnt(0)" ::: "memory");
            (void)xb_add(&bar[XB_TOP], 1u);
        }
        const unsigned tgt = (gen + 1u) * nx;
        asm volatile("buffer_inv sc1" ::: "memory");
        XB_SPIN(xb_ld(&bar[XB_TOP]) < tgt, bar);
        asm volatile("s_waitcnt vmcnt(0)" ::: "memory");
    }
    __syncthreads();
}
__device__ __forceinline__ bool phase_plain_stores(int q) {
    if (q == 0 || q == 17) return false;
    const int l = q > 17, rr = l ? q - 18 : q - 1;
    if (rr >= 12) return rr - 12 == 0 || rr - 12 == 3;
    const int k0 = rr % 6; return !(k0 == 4 || k0 == 0);
}
constexpr int CW_BAR = 4096;

#ifndef MK_CG_FIRST
#define MK_CG_FIRST 0
#endif
constexpr int N_PHASES = 35;
template <bool COOP>
__global__ void __launch_bounds__(512, 2) mk_fwd(Args args) {
    extern __shared__ __attribute__((aligned(16))) unsigned char lds_raw[];
    LAS unsigned char* lds = (LAS unsigned char*)lds_raw;
    unsigned char* ws = args.ws; unsigned char* wt = ws + WS_WT;
    const int G = gridDim.x, bx = blockIdx.x;
    volatile LAS unsigned* misc = (volatile LAS unsigned*)(lds + LDS_BYTES - 32);
    XcdBarrier bar; bar.bar = nullptr; bar.x = 0; bar.st = misc;
    if ((threadIdx.x & 63u) == 0u) *(volatile LAS int*)(size_t)(LDS_WTAB + 4 * hw_wave_slot()) = (int)(threadIdx.x >> 6);
    if (COOP) { if (threadIdx.x < 4) misc[threadIdx.x] = 0u; __syncthreads(); bar = xcd_barrier_post((unsigned*)(ws + WS_CTL) + CW_BAR, misc); }
#ifdef PROBE_PHASE
    volatile LAS unsigned long long* tp = (volatile LAS unsigned long long*)(lds + LDS_BYTES - 64);
    if (threadIdx.x == 0) { tp[0] = 0; tp[1] = __builtin_amdgcn_s_memrealtime(); }
    int prev_kind = 100;
#endif
    for (int p = args.ph_lo; p < args.ph_hi; ++p) {
        if (COOP) { if (p == args.ph_lo + 1 && MK_CG_FIRST) cg::this_grid().sync(); else if (p > args.ph_lo) xcd_barrier(bar, phase_plain_stores(p - 1)); }
#ifdef PROBE_PHASE
        { if (bx == 0 && threadIdx.x == 0) { const unsigned long long t = __builtin_amdgcn_s_memrealtime(); if (prev_kind == PROBE_PHASE) tp[0] += t - tp[1]; tp[1] = t; }
          int kind_; if (p == 0) kind_ = 12; else if (p == 19) kind_ = 13; else if (p == N_PHASES - 1) kind_ = 14; else { const int l_ = p > 19, rr_ = l_ ? p - 20 : p - 1, g_ = rr_ < 14 ? rr_ / 7 : 0, k0_ = rr_ < 14 ? rr_ - 7 * g_ : rr_ - 14; kind_ = rr_ < 14 ? (k0_ >= 5 ? k0_ + 1 : k0_) : 8 + k0_; }
          prev_kind = kind_; }
#endif
        if (p == 0) { if (bx < 48) prep_mods(args, lds, bx); prep_weights_dyn(args, 0, lds, 0, PREP_EARLY_ITEMS + 64 * (1024 / 32), (unsigned*)(ws + WS_CTL) + 2176); continue; }
        if (p == N_PHASES - 1) { final_norm_rows(args); continue; }
        if (p == 17) { xc_reduce_rows(args); continue; }
        const int l = p > 17, rr = l ? p - 18 : p - 1, g = rr < 12 ? rr / 6 : 0, k0 = rr < 12 ? rr - 6 * g : rr - 12, k = rr < 12 ? (k0 >= 3 ? k0 + 1 : k0) + (k0 >= 4 ? 1 : 0) : 8 + k0;
        const int nM = (l == 1) ? 32 : 36;
        pg8::StaticOrder S;
        switch (k) {
        case 0: if (l == 1 && g == 0) prep_weights(args, 1, lds, PREP_EARLY_ITEMS); norm_mod_rows(args, l, g, MG_ROWS, 0); break;
        case 1: {
            pg8::Gemm gm{(const bf16*)(ws + WS_H), (const bf16*)(wt + WT_WIN), 1024, 1024, 1024, 0, 0, 0, nullptr, 0};
            pg8::Gemm g8{(const bf16*)(ws + WS_H8A), (const bf16*)(wt + WT_WP8), 512, 512, 512, 0, 0, 0, (const bf16*)(ws + WS_H8B), H8_SPLIT};
            EpiInProj E{(bf16*)(ws + WS_P), (bf16*)(ws + WS_VTB), (bf16*)(ws + WS_VTC), (bf16*)(ws + WS_VTD), (float*)(ws + WS_RS) + (size_t)(l * 2 + g) * MG_ROWS * 2};
            EpiInProj E8 = E; E8.ascale = 1.f / 64.f;
            if (l == 0) {
                S.init(36, 10, G, bx); S.pnfrom = 7; S.pnadd = 3; pg8::gemm_phase(lds, gm, S, E);
                S.init(36, 5, G, (bx + G - 104) % G); S.pnbase = 7; S.pnfrom = 10; S.pnadd = 3; pg8::gemm_phase<EpiInProj, true>(lds, g8, S, E8);
                if (g == 1) {
                    pg8::Gemm go{(const bf16*)(ws + WS_MG0), (const bf16*)(wt + WT_WO), 1024, 1024, 1024, 0, 0, 0, nullptr, 0}; S.init(36, 4, G, (bx + G - 104) % G); S.pnbase = 0; S.pnfrom = 1 << 30; S.pnadd = 0;
                    EpiResid Eo{&args, l, 0, 2, false, 36}; pg8::gemm_phase(lds, go, S, Eo); } }
            else {
                S.init(32, 10, G, bx); S.pnfrom = 7; S.pnadd = 3; pg8::gemm_phase(lds, gm, S, E);
                S.init(4, 7, G, (bx + G - 64) % G, 3); S.pnbase = 0; S.pnfrom = 1 << 30; S.pnadd = 0; pg8::gemm_phase(lds, gm, S, E);
                S.init(32, 5, G, (bx + G - 92) % G); S.pnbase = 7; S.pnfrom = 10; S.pnadd = 3; pg8::gemm_phase<EpiInProj, true>(lds, g8, S, E8); }
            break; }
        case 2: {
            { pg8::Gemm gm{(const bf16*)(ws + WS_P) + PC_CKV, (const bf16*)(wt + WT_WMLA), PC, 384, 384, 0, 0, 0, nullptr, 0}; S.init(36, 7, G, bx);
              EpiMla E{(bf16*)(ws + WS_QA), (bf16*)(ws + WS_KA), (bf16*)(ws + WS_VTA), (const float*)(ws + WS_RS) + (size_t)(l * 2 + g) * MG_ROWS * 2}; pg8::gemm_phase(lds, gm, S, E); }
            const GlaArgs GG = make_gla(args, l, g); for (int it = bx; it < 1152; it += G) gla_local(lds, GG, it & 31, it >> 5); post_rows(args, l); break; }
        case 4: attn_phase(args, l, g, lds); break;
        case 6: { pg8::Gemm gm{(const bf16*)(ws + WS_Y), (const bf16*)(wt + WT_WB), 1024, 256, 256, 4, 256, 0, nullptr, 0}; S.init(nM, 16, G, bx);
            EpiStore<0> E{(bf16*)(ws + WS_Z), 4096, 1.f / 512.f}; pg8::gemm_phase<EpiStore<0>, true>(lds, gm, S, E); break; }
        case 7: { pg8::Gemm gm{(const bf16*)(ws + WS_H8A), (const bf16*)(wt + WT_WG8), 512, 512, 512, 0, 0, 0, (const bf16*)(ws + WS_H8B), H8_SPLIT}; S.init(nM, 16, G, bx);
            EpiMerge E{(const bf16*)(ws + WS_Z), (bf16*)(ws + (g == 0 ? WS_MG0 : WS_MG))}; pg8::gemm_phase<EpiMerge, true>(lds, gm, S, E);
            if (l == 0 && g == 1) norm_mod_rows(args, l, 0, 36 * 256, 1, 0, 64, G - 64, (bf16*)(ws + WS_MG0));
            break; }
        case 8: { pg8::Gemm gm{(const bf16*)(ws + WS_MG0), (const bf16*)(wt + WT_WO), 1024, 1024, 1024, 0, 0, 0, (const bf16*)(ws + WS_MG), nM};
            if (l == 0) S.init(36, 4, G, bx, 4); else S.init(2 * nM, 4, G, bx);
            EpiResid E{&args, l, 0, 2, false, nM}; pg8::gemm_phase(lds, gm, S, E); break; }
        case 9: norm_mod_rows(args, l, 0, 2 * nM * 256, 1, l == 0 ? 36 * 256 : 0); break;
        case 10: { pg8::Gemm gm{(const bf16*)(ws + (l == 0 ? WS_MG0 : WS_H2)), (const bf16*)(wt + WT_W1), 1024, 1024, 1024, 0, 0, 0, l == 0 ? (const bf16*)(ws + WS_H2) + (size_t)36 * 256 * 1024 : nullptr, l == 0 ? 36 : 0}; S.init(2 * nM, 16, G, bx);
            EpiStore<1> E{(bf16*)(ws + WS_HID), 4096}; pg8::gemm_phase(lds, gm, S, E); break; }
        default:
            if (l == 1) { pg8::Gemm gm{(const bf16*)(ws + WS_HID), (const bf16*)(wt + WT_W2), 4096, 4096, 4096, 0, 0, 0, nullptr, 0}; S.init(2 * nM, 4, G, bx);
                EpiResid E{&args, l, 0, 5, true, nM}; pg8::gemm_phase(lds, gm, S, E); }
            else {
                { pg8::Gemm gm{(const bf16*)(ws + WS_HID), (const bf16*)(wt + WT_W2), 4096, 4096, 4096, 0, 0, 0, nullptr, 0}; S.init(64, 4, G, bx, 1);
                  EpiResid E{&args, l, 0, 5, true, nM}; pg8::gemm_phase(lds, gm, S, E); }
                { pg8::Gemm gm{(const bf16*)(ws + WS_HID), (const bf16*)(wt + WT_W2), 4096, 4096, 1024, 0, 0, 4, nullptr, 0}; S.init(8, 16, G, (bx + 128) % G, 2);
                  EpiPartial E{(float*)(ws + WS_H2)}; pg8::gemm_phase(lds, gm, S, E); }
                prep_weights_dyn(args, 1, lds, 0, PREP_EARLY_ITEMS, (unsigned*)(ws + WS_CTL) + 2048);
            }
            break;
        }
    }
#ifdef PROBE_PHASE
    xcd_barrier(bar);
    if (bx == 0) { const unsigned long long t = __builtin_amdgcn_s_memrealtime(); if (threadIdx.x == 0 && prev_kind == PROBE_PHASE) tp[0] += t - tp[1]; __syncthreads();
        const float v = (float)tp[0] * PROBE_SCALE; for (int i = tidx(); i < 128; i += 512) args.out[i] = v; }
#endif
}

#ifndef MK_PER_PHASE
#define MK_PER_PHASE 0
#endif
extern "C" void kernel_launch(void* const* d_in, const int* in_sizes, int n_in, void* d_out, int out_size, void* d_ws, size_t ws_size, hipStream_t stream) {
    static int grid = 0;
    if (grid == 0) {
        if (n_in != 24 || out_size != NB * SEQ * DM || ws_size < WS_TOTAL) { fprintf(stderr, "kernel_launch: unexpected shapes (n_in %d out %d ws %zu)\n", n_in, out_size, ws_size); grid = -1; return; }
        int dev = 0, cus = 0, per_cu = 0;
        hipGetDevice(&dev); hipDeviceGetAttribute(&cus, hipDeviceAttributeMultiprocessorCount, dev);
        hipFuncSetAttribute((const void*)mk_fwd<!MK_PER_PHASE>, hipFuncAttributeMaxDynamicSharedMemorySize, LDS_BYTES);
        hipOccupancyMaxActiveBlocksPerMultiprocessor(&per_cu, (const void*)mk_fwd<!MK_PER_PHASE>, 512, LDS_BYTES);
        if (per_cu < 1) { fprintf(stderr, "kernel_launch: occupancy query says %d blocks per CU\n", per_cu); per_cu = 1; }
        (void)hipGetLastError();
        grid = cus;
    }
    if (grid < 0) return;
    hipMemsetAsync((char*)d_ws + WS_CTL, 0, 524288, stream);
    Args a{};
    for (int i = 0; i < 24; ++i) a.in[i] = (const float*)d_in[i];
    a.out = (float*)d_out; a.ws = (unsigned char*)d_ws;
#if MK_PER_PHASE
    for (int p = 0; p < N_PHASES; ++p) { a.ph_lo = p; a.ph_hi = p + 1; hipLaunchKernelGGL(mk_fwd<false>, dim3(grid), dim3(512), LDS_BYTES, stream, a); }
#else
    a.ph_lo = 0; a.ph_hi = N_PHASES;
    void* kargs[] = {&a};
    hipError_t e = hipLaunchCooperativeKernel((const void*)mk_fwd<true>, dim3(grid), dim3(512), kargs, LDS_BYTES, stream);
    if (e != hipSuccess) fprintf(stderr, "cooperative launch failed: %s (grid %d)\n", hipGetErrorString(e), grid);
#endif
}
```

```cpp
#include <hip/hip_runtime.h>
#include <hip/hip_cooperative_groups.h>
#include <cstdio>
#include <cstdint>
namespace cg = cooperative_groups;

#define LAS __attribute__((address_space(3)))
typedef unsigned short bf16;
typedef short bf16x8 __attribute__((ext_vector_type(8)));
typedef float f32x4 __attribute__((ext_vector_type(4)));
typedef float f32x16 __attribute__((ext_vector_type(16)));
typedef unsigned u32x4 __attribute__((ext_vector_type(4)));
typedef unsigned u32x2 __attribute__((ext_vector_type(2)));

constexpr int DM = 1024, NB = 8, SEQ = 2048, CTXL = 256, GB = 4, NGRP = 2;
constexpr int MG_ROWS = GB * (SEQ + CTXL);
constexpr int LAT_ROWS = GB * SEQ;
constexpr int KEYS = CTXL + SEQ;
constexpr int IN_COLS = 7904, PC = 3840;
constexpr int WIN_N = 7936;
constexpr float EPS = 1e-6f;
constexpr int PC_KR = 0, PC_KB = 64, PC_VB = 192, PC_KC = 320, PC_VC = 576, PC_LRF = 1088, PC_KD = 1120, PC_VD = 1376, PC_PAD = 1632, PC_CKV = 1664,
              PC_CQ = 1792, PC_QB = 2048, PC_QC = 2560, PC_RC = 2816, PC_QD = 3328;
constexpr int SRC_GATE = 3808;
__host__ __device__ __forceinline__ int pcol_src(int n) {
    if (n < PC_KB) return 384 + (n - PC_KR);
    if (n < PC_VB) return 960 + (n - PC_KB);
    if (n < PC_KC) return 1088 + (n - PC_VB);
    if (n < PC_VC) return 1472 + (n - PC_KC);
    if (n < PC_LRF) return 1728 + (n - PC_VC);
    if (n < PC_KD) return 2752 + (n - PC_LRF);
    if (n < PC_VD) return 3296 + (n - PC_KD);
    if (n < PC_PAD) return 3552 + (n - PC_VD);
    if (n < PC_CKV) return -1;
    if (n < PC_CQ) return 256 + (n - PC_CKV);
    if (n < PC_QB) return n - PC_CQ;
    if (n < PC_QC) return 448 + (n - PC_QB);
    if (n < PC_RC) return 1216 + (n - PC_QC);
    if (n < PC_QD) return 2240 + (n - PC_RC);
    return 2784 + (n - PC_QD);
}
__host__ __device__ __forceinline__ int gperm_in(int q) {
    if (q >= 56) return q;
    const int idx = (q >> 3) * 4 + (q & 3);
    if ((q & 4) == 0) return idx < 4 ? 6 + idx : idx < 20 ? 18 + (idx - 4) : 43 + (idx - 20);
    return idx < 6 ? idx : idx < 14 ? 10 + (idx - 6) : idx == 14 ? 34 : idx < 23 ? 35 + (idx - 15) : idx == 23 ? 51 : 52 + (idx - 24);
}
__host__ __device__ __forceinline__ int gperm_mla(int q) {
    const int t = q >> 3, wc = q & 3;
    if ((q & 4) == 0 && t < 4) return 40 + t * 4 + wc;
    return t < 4 ? t * 4 + wc : 16 + (t - 4) * 8 + (q & 7);
}
constexpr size_t MiB = 1u << 20;
constexpr size_t WS_CTL = 0, CTL_BYTES = 1 * MiB;
constexpr size_t WS_RS = 131072;
constexpr size_t WS_MOD = 1 * MiB;
constexpr size_t WS_WT = 2 * MiB;
constexpr size_t WT_WIN = 0, WT_WMLA = WT_WIN + (size_t)WIN_N * 1024 * 2, WT_WB = WT_WMLA + (size_t)1792 * 384 * 2, WT_WO = WT_WB + (size_t)4096 * 512 * 2,
                 WT_W1 = WT_WO + (size_t)1024 * 1024 * 2, WT_W2 = WT_W1 + (size_t)4096 * 1024 * 2, WT_END = WT_W2 + (size_t)1024 * 4096 * 2;
static_assert(WT_END <= 40 * MiB, "weights");
constexpr size_t WS_XC1 = 42 * MiB;
constexpr size_t WS_H = 50 * MiB;
constexpr size_t WS_MG = 68 * MiB;
constexpr size_t WS_Y = 86 * MiB;
constexpr size_t WS_P = 122 * MiB;
constexpr size_t WS_CN = WS_P + (size_t)MG_ROWS * PC * 2;
constexpr size_t WS_QA = WS_CN + (size_t)MG_ROWS * 384 * 2;
constexpr size_t WS_KA = WS_QA + (size_t)MG_ROWS * 768 * 2;
constexpr size_t WS_VTA = WS_KA + (size_t)GB * 4 * KEYS * 192 * 2;
constexpr size_t WS_VTB = WS_VTA + (size_t)GB * 4 * 128 * KEYS * 2;
constexpr size_t WS_VTC = WS_VTB + (size_t)GB * 2 * 64 * KEYS * 2;
constexpr size_t WS_VTD = WS_VTC + (size_t)GB * 4 * 128 * KEYS * 2;
constexpr size_t WS_END = WS_VTD + (size_t)GB * 2 * 128 * KEYS * 2;
constexpr size_t WS_Z = WS_P;
static_assert(WS_Z + (size_t)MG_ROWS * 4096 * 2 <= WS_QA, "Z overlay must stay inside P|CN");
static_assert(WS_END <= 248 * MiB, "workspace");
constexpr size_t WS_H2 = 50 * MiB;
constexpr size_t WS_HID = 86 * MiB;
static_assert(WS_HID + (size_t)2 * MG_ROWS * 4096 * 2 <= 248 * MiB && WS_H2 + (size_t)2 * MG_ROWS * 1024 * 2 <= WS_HID, "merged MLP buffers");
constexpr size_t WS_MG0 = 248 * MiB;
constexpr size_t WT_WG8 = WT_WIN + (size_t)PC * 1024 * 2;
constexpr size_t WS_H8A = WS_WT + WT_WG8 + (size_t)4096 * 1024, WS_H8B = 266 * MiB; constexpr int H8_SPLIT = 16;
static_assert(WS_H8A + (size_t)H8_SPLIT * 256 * 1024 <= WS_WT + WT_WMLA, "H8 piece A");
constexpr size_t WS_TOTAL = 271 * MiB;
constexpr int LDS_BYTES = 147456;

__device__ __forceinline__ unsigned f2bf(float f) { unsigned u = __builtin_bit_cast(unsigned, f); return (u + 0x7fffu + ((u >> 16) & 1u)) >> 16; }
typedef float f32x2_t __attribute__((ext_vector_type(2))); typedef __bf16 bf16x2_t __attribute__((ext_vector_type(2)));
__device__ __forceinline__ unsigned pk2(float lo, float hi) { f32x2_t v = {lo, hi}; bf16x2_t b = __builtin_convertvector(v, bf16x2_t); return __builtin_bit_cast(unsigned, b); }
__device__ __forceinline__ float bf2f(unsigned short b) { return __builtin_bit_cast(float, (unsigned)b << 16); }
__device__ __forceinline__ float bflo(unsigned w) { return __builtin_bit_cast(float, w << 16); }
__device__ __forceinline__ float bfhi(unsigned w) { return __builtin_bit_cast(float, w & 0xffff0000u); }
#define SHFLX(v, m) __builtin_bit_cast(float, __builtin_amdgcn_ds_bpermute(((lane) ^ (m)) << 2, __builtin_bit_cast(int, (float)(v))))
__device__ __forceinline__ float wave_sum_l(float v, int lane) {
#pragma unroll
    for (int o = 1; o < 64; o <<= 1) v += SHFLX(v, o);
    return v;
}
#define wave_sum(v) wave_sum_l((v), lane)
constexpr int LDS_WTAB = LDS_BYTES - 512;
__device__ __forceinline__ unsigned hw_wave_slot() { return (unsigned)__builtin_amdgcn_s_getreg(((6 - 1) << 11) | 4) & 63u; }
__device__ __forceinline__ int tidx() {
    int l; asm volatile("v_mbcnt_lo_u32_b32 %0, -1, 0\n\tv_mbcnt_hi_u32_b32 %0, -1, %0" : "=v"(l));
    const int w = __builtin_amdgcn_readfirstlane(*(volatile LAS int*)(size_t)(LDS_WTAB + 4 * hw_wave_slot()));
    return (w << 6) | l;
}
__device__ __forceinline__ float sigmoid64(float x64) { return __builtin_amdgcn_rcpf(1.f + __builtin_amdgcn_exp2f(x64 * (-1.4426950408889634f / 64.f))); }
__device__ __forceinline__ float sigmoidf_(float x) { return __builtin_amdgcn_rcpf(1.f + __expf(-x)); }
__device__ __forceinline__ float siluf_(float x) { return x * __builtin_amdgcn_rcpf(1.f + __expf(-x)); }

namespace pg8 {
constexpr int BM = 256, BK = 64, HALF = 128, HTB = HALF * BK * 2, STAGE_BYTES = 8 * HTB, NXCD = 8, WGM = 8;
__host__ __device__ __forceinline__ int lds_byte(int r, int c) { const int st = (r >> 4) * 2 + (c >> 5), rr = r & 15, cc = c & 31, ob = rr * 64 + cc * 2; return st * 1024 + (ob ^ (((ob >> 9) & 1) << 5)); }
__host__ __device__ __forceinline__ void stage_rc(int b, int& R, int& C) { const int st = b / 1024, sb = b % 1024, swz = sb ^ (((sb >> 9) & 1) << 5); R = (st >> 1) * 16 + swz / 64; C = (st & 1) * 32 + (swz % 64) / 2; }
__host__ __device__ __forceinline__ int perm32(int rho) { const int n = rho >> 4, i = rho & 15; return 8 * (i >> 2) + 4 * n + (i & 3); }

struct Unit { int pm, pn; };
struct Gemm { const bf16* A; const bf16* Bt; int lda, ldb, K; int adiv, amul; int ksplit; const bf16* A2; int a2_from; };

struct StaticOrder {
    int nM, nN, nwg, G, c, map;
    __device__ void init(int nM_, int nN_, int G_, int c_, int map_ = 0) { nM = nM_; nN = nN_; nwg = nM * nN; G = G_; c = c_; map = map_; }
    __device__ bool next(int i, Unit& u) const {
        const long L = (long)i * G + c; if (L >= nwg) return false;
        int wgid = (int)L; { const int q = nwg / NXCD, r = nwg % NXCD, xcd = wgid % NXCD, off = wgid / NXCD; wgid = (xcd < r ? xcd * (q + 1) : r * (q + 1) + (xcd - r) * q) + off; }
        const int nig = WGM * nN, gid = wgid / nig, fm = gid * WGM, gsz = (nM - fm) < WGM ? (nM - fm) : WGM;
        u.pm = fm + ((wgid % nig) % gsz); u.pn = (wgid % nig) / gsz;
        if (map == 1) u.pm += 4 * (u.pm >> 5); else if (map == 2) u.pm = 32 + 36 * (u.pm >> 2) + (u.pm & 3); else if (map == 3) u.pm += 32; else if (map == 4) u.pm += 36;
        return true;
    }
};
typedef int v8i_t __attribute__((ext_vector_type(8)));
__device__ __forceinline__ v8i_t cat8(const bf16x8 lo, const bf16x8 hi) { const u32x4 a = __builtin_bit_cast(u32x4, lo), b = __builtin_bit_cast(u32x4, hi); v8i_t r; r[0] = (int)a.x; r[1] = (int)a.y; r[2] = (int)a.z; r[3] = (int)a.w; r[4] = (int)b.x; r[5] = (int)b.y; r[6] = (int)b.z; r[7] = (int)b.w; return r; }
template <class Epi, bool F8 = false>
__device__ __forceinline__ void gemm_phase(LAS unsigned char* lds, const Gemm g, const StaticOrder& S, const Epi& E) {
    const int tid = tidx(), wid = __builtin_amdgcn_readfirstlane(tid >> 6), lane = tid & 63, wr = wid >> 2, wc = wid & 3, fr = lane & 15, fq = lane >> 4;
    const int K = g.K, nt = K / BK;
    unsigned voffA[2], voffB[2];
#pragma unroll
    for (int i = 0; i < 2; ++i) { int R, C; stage_rc(tid * 16 + i * 8192, R, C); const int Rb = (R & ~31) + perm32(R & 31);
        voffA[i] = (unsigned)(R * g.lda + C) * 2u; voffB[i] = (unsigned)(Rb * g.ldb + C) * 2u; }
    const size_t kstep = (size_t)(BK * 2);
    const size_t hstepA = (size_t)HALF * g.lda * 2, hstepB = (size_t)HALF * g.ldb * 2;
    const size_t tstepA = 2 * hstepA, tstepB = 2 * hstepB;
    const unsigned ldsw = (unsigned)wid * 1024u;
    const int aoff = lds_byte(wr * 64 + fr, fq * 8), boff = lds_byte(wc * 32 + fr, fq * 8);
#define PG8_SA(b, h) (((b) * 2 + (h)) * HTB)
#define PG8_SB(b, h) ((4 + (b) * 2 + (h)) * HTB)
#define PG8_STAGE(bufoff, gbase, voff) do { _Pragma("unroll") for (int _i = 0; _i < 2; ++_i) { \
        const unsigned la_ = (unsigned)(size_t)(lds + (bufoff) + _i * 8192) + ldsw; const char* gb_ = (const char*)(gbase); \
        asm volatile("s_nop 1\n\ts_mov_b32 m0, %2\n\ts_nop 1\n\tglobal_load_lds_dwordx4 %0, %1" :: "v"((voff)[_i]), "s"(gb_), "s"(la_) : "memory", "m0"); } } while (0)
#define PG8_LDA(dst, b, h) do { _Pragma("unroll") for (int m = 0; m < 4; ++m) _Pragma("unroll") for (int k = 0; k < 2; ++k) dst[m][k] = *(const LAS bf16x8*)(lds + PG8_SA(b, h) + aoff + m * 2048 + k * 1024); } while (0)
#define PG8_LDB(dst, b, h) do { _Pragma("unroll") for (int n = 0; n < 2; ++n) _Pragma("unroll") for (int k = 0; k < 2; ++k) dst[n][k] = *(const LAS bf16x8*)(lds + PG8_SB(b, h) + boff + n * 2048 + k * 1024); } while (0)
#define PG8_MMA(ai, bj, At, Bt) do { __builtin_amdgcn_s_setprio(1); \
        if (F8) { _Pragma("unroll") for (int m = 0; m < 4; ++m) _Pragma("unroll") for (int n = 0; n < 2; ++n) \
            acc[ai][bj][m][n] = __builtin_amdgcn_mfma_scale_f32_16x16x128_f8f6f4(cat8(Bt[n][0], Bt[n][1]), cat8(At[m][0], At[m][1]), acc[ai][bj][m][n], 0, 0, 0, 0, 0, 0); } \
        else { _Pragma("unroll") for (int m = 0; m < 4; ++m) _Pragma("unroll") for (int n = 0; n < 2; ++n) _Pragma("unroll") for (int k = 0; k < 2; ++k) \
            acc[ai][bj][m][n] = __builtin_amdgcn_mfma_f32_16x16x32_bf16(Bt[n][k], At[m][k], acc[ai][bj][m][n], 0, 0, 0); } \
        __builtin_amdgcn_s_setprio(0); } while (0)
#define PG8_WAIT_V(n) asm volatile("s_waitcnt vmcnt(" #n ")" ::: "memory")
#define PG8_WAIT_L(n) asm volatile("s_waitcnt lgkmcnt(" #n ")" ::: "memory")
#define PG8_BAR __builtin_amdgcn_s_barrier()
#define PG8_SCHED __builtin_amdgcn_sched_barrier(0)
#define PG8_ABASE(u) ((g.A2 && (u).pm >= g.a2_from) ? (const char*)g.A2 + (size_t)((u).pm - g.a2_from) * tstepA : (const char*)g.A + (size_t)(u).pm * tstepA)
#define PG8_AOFF(u) ((size_t)(g.adiv ? ((u).pn / g.adiv) * g.amul * 2 : 0) + (size_t)(g.ksplit ? ((u).pn % g.ksplit) * g.K * 2 : 0))
#define PG8_BTILE(u) (g.ksplit ? (u).pn / g.ksplit : (u).pn)
#define PG8_BOFF(u) ((size_t)(g.ksplit ? ((u).pn % g.ksplit) * g.K * 2 : 0))
    Unit cur, nxt; int ui = 0;
    if (!S.next(0, cur)) return;
    f32x4 acc[2][2][4][2];
#pragma unroll
    for (int a = 0; a < 2; ++a)
#pragma unroll
        for (int b = 0; b < 2; ++b)
#pragma unroll
            for (int m = 0; m < 4; ++m)
#pragma unroll
                for (int n = 0; n < 2; ++n) acc[a][b][m][n] = (f32x4){0.f, 0.f, 0.f, 0.f};
    bf16x8 At[4][2], B0[2][2], B1[2][2];
    const char* cA = PG8_ABASE(cur) + PG8_AOFF(cur); const char* cB = (const char*)g.Bt + (size_t)PG8_BTILE(cur) * tstepB + PG8_BOFF(cur);
    PG8_STAGE(PG8_SB(0, 0), cB, voffB); PG8_STAGE(PG8_SB(0, 1), cB + hstepB, voffB); PG8_STAGE(PG8_SA(0, 0), cA, voffA); PG8_STAGE(PG8_SA(0, 1), cA + hstepA, voffA);
    if (wr == 1) PG8_BAR;
    PG8_WAIT_V(2); PG8_BAR;
    PG8_STAGE(PG8_SB(1, 0), cB + kstep, voffB); PG8_STAGE(PG8_SA(1, 0), cA + kstep, voffA); PG8_STAGE(PG8_SB(1, 1), cB + hstepB + kstep, voffB);
    PG8_WAIT_V(6); PG8_BAR;
    for (;;) {
        const bool has_next = S.next(ui + 1, nxt);
        const char* nA = has_next ? PG8_ABASE(nxt) + PG8_AOFF(nxt) : cA; const char* nB = has_next ? (const char*)g.Bt + (size_t)PG8_BTILE(nxt) * tstepB + PG8_BOFF(nxt) : cB;
#pragma unroll 1
        for (int t = 0; t < nt; t += 2) {
            const bool last = (t == nt - 2);
            const char* a1 = cA + (size_t)(t + 1) * kstep;
            const char* a2 = last ? nA : cA + (size_t)(t + 2) * kstep; const char* b2 = last ? nB : cB + (size_t)(t + 2) * kstep;
            const char* a3 = a2 + kstep; const char* b3 = b2 + kstep;
            PG8_LDB(B0, 0, 0); PG8_LDB(B1, 0, 1); PG8_SCHED; PG8_LDA(At, 0, 0); PG8_STAGE(PG8_SA(1, 1), a1 + hstepA, voffA);
            PG8_WAIT_V(8); PG8_WAIT_L(0); PG8_BAR; PG8_MMA(0, 0, At, B0); PG8_MMA(0, 1, At, B1); PG8_BAR; PG8_SCHED;
            PG8_LDA(At, 0, 1); PG8_STAGE(PG8_SB(0, 0), b2, voffB); PG8_STAGE(PG8_SB(0, 1), b2 + hstepB, voffB); PG8_STAGE(PG8_SA(0, 0), a2, voffA);
            PG8_WAIT_V(8); PG8_WAIT_L(0); PG8_BAR; PG8_MMA(1, 0, At, B0); PG8_MMA(1, 1, At, B1); PG8_BAR; PG8_SCHED;
            PG8_LDB(B0, 1, 0); PG8_LDB(B1, 1, 1); PG8_SCHED; PG8_LDA(At, 1, 0); PG8_STAGE(PG8_SA(0, 1), a2 + hstepA, voffA);
            PG8_WAIT_V(8); PG8_WAIT_L(0); PG8_BAR; PG8_MMA(0, 0, At, B0); PG8_MMA(0, 1, At, B1); PG8_BAR; PG8_SCHED;
            PG8_LDA(At, 1, 1); PG8_STAGE(PG8_SB(1, 0), b3, voffB); PG8_STAGE(PG8_SB(1, 1), b3 + hstepB, voffB); PG8_STAGE(PG8_SA(1, 0), a3, voffA);
            PG8_WAIT_V(8); PG8_WAIT_L(0); PG8_BAR; PG8_MMA(1, 0, At, B0); PG8_MMA(1, 1, At, B1); PG8_BAR; PG8_SCHED;
        }
        if (wr == 0) PG8_BAR;
        { const int l2_ = tidx() & 63; E(acc, cur, wr, wc, l2_ & 15, l2_ >> 4); }
        if (!has_next) break;
#pragma unroll
        for (int a = 0; a < 2; ++a)
#pragma unroll
            for (int b = 0; b < 2; ++b)
#pragma unroll
                for (int m = 0; m < 4; ++m)
#pragma unroll
                    for (int n = 0; n < 2; ++n) acc[a][b][m][n] = (f32x4){0.f, 0.f, 0.f, 0.f};
        cur = nxt; cA = nA; cB = nB; ++ui;
        if (wr == 1) PG8_BAR;
    }
    PG8_WAIT_V(0);
    PG8_BAR;
#undef PG8_SA
#undef PG8_SB
#undef PG8_STAGE
#undef PG8_LDA
#undef PG8_LDB
#undef PG8_MMA
#undef PG8_WAIT_V
#undef PG8_WAIT_L
#undef PG8_BAR
#undef PG8_SCHED
#undef PG8_AOFF
#undef PG8_ABASE
#undef PG8_BTILE
#undef PG8_BOFF
}
}

struct Args {
    const float* in[24];
    float* out; unsigned char* ws;
    int ph_lo, ph_hi;
};
enum { I_X = 0, I_C, I_CTX, I_CCTX, I_ADAW, I_ADAB, I_N1W, I_N2W, I_WIN, I_MQNW, I_MWUQ, I_MKVNW, I_MWUKV, I_SINK, I_GWD, I_GBD, I_GNW, I_QNW, I_KNW, I_WBR, I_WO, I_W1, I_W2, I_FNW };

struct Ctx {
    const Args* a; unsigned char* ws; int l, g;
};
__device__ __forceinline__ const float* xrow_src(const Args& a, int l, int g, int r) {
    if (r < LAT_ROWS) { const size_t gr = (size_t)(g * GB) * SEQ + r; return (l == 0 ? a.in[I_X] : a.out) + gr * DM; }
    const size_t cr = (size_t)(g * GB) * CTXL + (r - LAT_ROWS); return (l == 0 ? a.in[I_CTX] : (const float*)(a.ws + WS_XC1)) + cr * DM;
}
__device__ __forceinline__ float* xrow_dst(const Args& a, int g, int r) {
    if (r < LAT_ROWS) { const size_t gr = (size_t)(g * GB) * SEQ + r; return a.out + gr * DM; }
    const size_t cr = (size_t)(g * GB) * CTXL + (r - LAT_ROWS); return (float*)(a.ws + WS_XC1) + cr * DM;
}
__device__ __forceinline__ int row_bi(int g, int r) { return r < LAT_ROWS ? g * GB + (r >> 11) : 8; }
__device__ __forceinline__ void row_blk(int r, int& bl, int& kap) { if (r < LAT_ROWS) { bl = r >> 11; kap = CTXL + (r & 2047); } else { bl = (r - LAT_ROWS) >> 8; kap = (r - LAT_ROWS) & 255; } }

using pg8::Unit;
__device__ __forceinline__ void st16_wt(void* p, const u32x4 v) { asm volatile("global_store_dwordx4 %0, %1, off sc1\n\ts_nop 2" :: "v"(p), "v"(v)); }
__device__ __forceinline__ void st16_wt(void* p, const f32x4 v) { asm volatile("global_store_dwordx4 %0, %1, off sc1\n\ts_nop 2" :: "v"(p), "v"(v)); }
__device__ __forceinline__ void st8_wt(void* p, const u32x2 v) { asm volatile("global_store_dwordx2 %0, %1, off sc1" :: "v"(p), "v"(v)); }
__device__ __forceinline__ unsigned pk4_fp8(float a, float b, float c, float d) { int w; asm("" : "=v"(w));   w = __builtin_amdgcn_cvt_pk_fp8_f32(a, b, w, false); w = __builtin_amdgcn_cvt_pk_fp8_f32(c, d, w, true); return (unsigned)w; }
__device__ __forceinline__ void st16_wt_s(const void* base  , unsigned off, const u32x4 v) { asm volatile("s_nop 4\n\tglobal_store_dwordx4 %0, %1, %2 sc1\n\ts_nop 2" :: "v"(off), "v"(v), "s"(base)); }
__device__ __forceinline__ u32x4 pack8(const f32x4 v0, const f32x4 v1) { u32x4 w; w.x = pk2(v0[0], v0[1]); w.y = pk2(v0[2], v0[3]); w.z = pk2(v1[0], v1[1]); w.w = pk2(v1[2], v1[3]); return w; }

template <int ACT> struct EpiStore {
    bf16* O; int ldc; float ascale = 1.f;
    __device__ __forceinline__ void operator()(const f32x4 (&acc)[2][2][4][2], const Unit& u, int wr, int wc, int fr, int fq) const {
        const unsigned ldb2 = (unsigned)ldc * 2u, off0 = (unsigned)(u.pm * 256 + wr * 64 + fr) * ldb2 + (unsigned)(u.pn * 256 + wc * 32 + 8 * fq) * 2u;
#pragma unroll
        for (int ai = 0; ai < 2; ++ai)
#pragma unroll
            for (int m = 0; m < 4; ++m) { const unsigned offr = off0 + (unsigned)(ai * 128 + m * 16) * ldb2;
#pragma unroll
                for (int bj = 0; bj < 2; ++bj) { f32x4 v0 = acc[ai][bj][m][0] * ascale, v1 = acc[ai][bj][m][1] * ascale;
                    if (ACT == 1) {
#pragma unroll
                        for (int j = 0; j < 4; ++j) { const float a = fmaxf(v0[j], 0.f), b = fmaxf(v1[j], 0.f); v0[j] = a * a; v1[j] = b * b; } }
                    st16_wt_s(O, offr + bj * 256, pack8(v0, v1)); } }
    }
};
__device__ __forceinline__ void store_vt(const f32x4 (&acc)[2][2][4][2], int bj, bf16* vt, int nheads, int dv, int colbase  , int pm, int wr, int fr, int fq) {
    int bl, kap0; row_blk(pm * 256, bl, kap0);
    const int c0 = colbase + 8 * fq, head = c0 / dv, e0 = c0 - head * dv;
    bf16* vp = vt + ((size_t)(bl * nheads + head) * dv + e0) * KEYS + kap0 + wr * 64 + fr;
#pragma unroll
    for (int ai = 0; ai < 2; ++ai)
#pragma unroll
        for (int m = 0; m < 4; ++m)
#pragma unroll
            for (int n = 0; n < 2; ++n)
#pragma unroll
                for (int j = 0; j < 4; ++j) vp[(size_t)(4 * n + j) * KEYS + ai * 128 + m * 16] = (bf16)f2bf(acc[ai][bj][m][n][j]);
}
__device__ __forceinline__ void store_vt8(const f32x4 (&acc)[2][2][4][2], int bj, unsigned char* vt, int nheads, int dv, int colbase, int pm, int wr, int fr, int fq) {
    int bl, kap0; row_blk(pm * 256, bl, kap0);
    const int c0 = colbase + 8 * fq, head = c0 / dv, e0 = c0 - head * dv;
    unsigned char* vp = vt + ((size_t)(bl * nheads + head) * dv + e0) * KEYS + kap0 + wr * 64 + fr;
#pragma unroll
    for (int ai = 0; ai < 2; ++ai)
#pragma unroll
        for (int m = 0; m < 4; ++m)
#pragma unroll
            for (int n = 0; n < 2; ++n)
#pragma unroll
                for (int j = 0; j < 4; j += 2) { const unsigned w = (unsigned)__builtin_amdgcn_cvt_pk_fp8_f32(acc[ai][bj][m][n][j], acc[ai][bj][m][n][j + 1], 0, false);
                    vp[(size_t)(4 * n + j) * KEYS + ai * 128 + m * 16] = (unsigned char)(w & 0xffu); vp[(size_t)(4 * n + j + 1) * KEYS + ai * 128 + m * 16] = (unsigned char)((w >> 8) & 0xffu); }
}
struct EpiInProj {
    bf16* P; bf16 *vtb, *vtc, *vtd; float* rs;
    __device__ __forceinline__ void operator()(const f32x4 (&acc)[2][2][4][2], const Unit& u, int wr, int wc, int fr, int fq) const {
        const int row0 = u.pm * 256 + wr * 64 + fr; const int lane = fr + 16 * fq;
#pragma unroll
        for (int bj = 0; bj < 2; ++bj) {
            const int cg = 32 * gperm_in(u.pn * 8 + bj * 4 + wc);
            if (cg >= PC_VB && cg < PC_VB + 128) store_vt8(acc, bj, (unsigned char*)vtb, 2, 64, cg - PC_VB, u.pm, wr, fr, fq);
            else if (cg >= PC_VC && cg < PC_VC + 512) store_vt(acc, bj, vtc, 4, 128, cg - PC_VC, u.pm, wr, fr, fq);
            else if (cg >= PC_VD && cg < PC_VD + 256) store_vt8(acc, bj, (unsigned char*)vtd, 2, 128, cg - PC_VD, u.pm, wr, fr, fq);
            else {
                const bool lat = cg >= PC_CKV && cg < PC_QB; const int which = cg < PC_CQ ? 1 : 0;
#pragma unroll
                for (int ai = 0; ai < 2; ++ai)
#pragma unroll
                    for (int m = 0; m < 4; ++m) { const u32x4 w = pack8(acc[ai][bj][m][0], acc[ai][bj][m][1]); *(u32x4*)(P + (size_t)(row0 + ai * 128 + m * 16) * PC + cg + 8 * fq) = w;
                        if (lat) { float ss = (bflo(w.x) * bflo(w.x) + bfhi(w.x) * bfhi(w.x)) + (bflo(w.y) * bflo(w.y) + bfhi(w.y) * bfhi(w.y)) + (bflo(w.z) * bflo(w.z) + bfhi(w.z) * bfhi(w.z)) + (bflo(w.w) * bflo(w.w) + bfhi(w.w) * bfhi(w.w));
                            ss += SHFLX(ss, 16); ss += SHFLX(ss, 32);
                            if (fq == 0) atomicAdd(rs + (size_t)(row0 + ai * 128 + m * 16) * 2 + which, ss); } }
            }
        }
    }
};
struct EpiMla {
    bf16 *QA, *KA, *vta; const float* rs;
    __device__ __forceinline__ void operator()(const f32x4 (&acc_)[2][2][4][2], const Unit& u, int wr, int wc, int fr, int fq) const {
        f32x4 acc[2][2][4][2];
        const int cg0 = 32 * gperm_mla(u.pn * 8 + wc), cg1 = 32 * gperm_mla(u.pn * 8 + 4 + wc);
#pragma unroll
        for (int ai = 0; ai < 2; ++ai)
#pragma unroll
            for (int m = 0; m < 4; ++m) { const f32x2_t r2 = *(const f32x2_t*)(rs + (size_t)(u.pm * 256 + wr * 64 + fr + ai * 128 + m * 16) * 2);
                const float scq = rsqrtf(r2[0] * (1.f / 256.f) + EPS), sckv = rsqrtf(r2[1] * (1.f / 128.f) + EPS), s0 = cg0 < 768 ? scq : sckv, s1 = cg1 < 768 ? scq : sckv;
#pragma unroll
                for (int n = 0; n < 2; ++n) { acc[ai][0][m][n] = acc_[ai][0][m][n] * s0; acc[ai][1][m][n] = acc_[ai][1][m][n] * s1; } }
        const int row0 = u.pm * 256 + wr * 64 + fr;
        int bl, kap0; row_blk(u.pm * 256, bl, kap0);
#pragma unroll
        for (int bj = 0; bj < 2; ++bj) {
            const int cg = bj ? cg1 : cg0;
            if (cg < 768) {
#pragma unroll
                for (int ai = 0; ai < 2; ++ai)
#pragma unroll
                    for (int m = 0; m < 4; ++m) *(u32x4*)(QA + (size_t)(row0 + ai * 128 + m * 16) * 768 + cg + 8 * fq) = pack8(acc[ai][bj][m][0], acc[ai][bj][m][1]);
            } else if (cg < 1280) {
                const int c = cg - 768 + 8 * fq, head = c >> 7, j0 = c & 127;
#pragma unroll
                for (int ai = 0; ai < 2; ++ai)
#pragma unroll
                    for (int m = 0; m < 4; ++m) { const int kap = kap0 + ai * 128 + wr * 64 + m * 16 + fr;
                        *(u32x4*)(KA + ((size_t)(bl * 4 + head) * KEYS + kap) * 192 + j0) = pack8(acc[ai][bj][m][0], acc[ai][bj][m][1]); }
            } else store_vt8(acc, bj, (unsigned char*)vta, 4, 128, cg - 1280, u.pm, wr, fr, fq);
        }
    }
};
struct EpiMerge {
    const bf16* Z; bf16* MGo;
    __device__ __forceinline__ void operator()(const f32x4 (&acc)[2][2][4][2], const Unit& u, int wr, int wc, int fr, int fq) const {
        const int row0 = u.pm * 256 + wr * 64 + fr, d0 = u.pn * 64 + wc * 16 + fq * 4;
#pragma unroll
        for (int ai = 0; ai < 2; ++ai)
#pragma unroll
            for (int m = 0; m < 4; ++m) { const size_t row = (size_t)(row0 + ai * 128 + m * 16); float o[4] = {0.f, 0.f, 0.f, 0.f};
#pragma unroll
                for (int bj = 0; bj < 2; ++bj)
#pragma unroll
                    for (int n = 0; n < 2; ++n) { const int nb = 2 * bj + n; const u32x2 z = *(const u32x2*)(Z + row * 4096 + nb * 1024 + d0);
                        const f32x4 a = acc[ai][bj][m][n];
                        o[0] += sigmoid64(a[0]) * bflo(z.x); o[1] += sigmoid64(a[1]) * bfhi(z.x); o[2] += sigmoid64(a[2]) * bflo(z.y); o[3] += sigmoid64(a[3]) * bfhi(z.y); }
                u32x2 w; w.x = pk2(o[0], o[1]); w.y = pk2(o[2], o[3]); *(u32x2*)(MGo + row * 1024 + d0) = w; }
    }
};
struct EpiPartial {
    float* part;
    __device__ __forceinline__ void operator()(const f32x4 (&acc)[2][2][4][2], const Unit& u, int wr, int wc, int fr, int fq) const {
        const int g = u.pm / 36, pml = u.pm - 36 * g, kp = u.pn & 3, pn = u.pn >> 2;
        float* base = part + ((size_t)kp * 2048 + (size_t)(g * 1024 + (pml - 32) * 256 + wr * 64 + fr)) * DM;
#pragma unroll
        for (int bj = 0; bj < 2; ++bj) { const int c0 = pn * 256 + bj * 128 + wc * 32 + 8 * fq;
#pragma unroll
            for (int ai = 0; ai < 2; ++ai)
#pragma unroll
                for (int m = 0; m < 4; ++m) { float* p = base + (size_t)(ai * 128 + m * 16) * DM + c0; *(f32x4*)p = acc[ai][bj][m][0]; *(f32x4*)(p + 4) = acc[ai][bj][m][1]; } }
    }
};
struct EpiResid {
    const Args* a; int l, g, chunk; bool from_dst; int nMg;
    __device__ __forceinline__ void operator()(const f32x4 (&acc)[2][2][4][2], const Unit& u, int wr, int wc, int fr, int fq) const {
        const int g = nMg ? u.pm / nMg : this->g; const int rt = (nMg ? u.pm - g * nMg : u.pm) * 256; const int bi = row_bi(g, rt);
        const float* src = from_dst ? (const float*)xrow_dst(*a, g, rt) : xrow_src(*a, l, g, rt); float* dst = xrow_dst(*a, g, rt);
        const float* mod = (const float*)(a->ws + WS_MOD) + ((size_t)(l * 9 + bi) * 6 + chunk) * 1024;
        const int rl0 = wr * 64 + fr;
#pragma unroll
        for (int bj = 0; bj < 2; ++bj) { const int c0 = u.pn * 256 + bj * 128 + wc * 32 + 8 * fq;
            const f32x4 g0 = *(const f32x4*)(mod + c0), g1 = *(const f32x4*)(mod + c0 + 4);
#pragma unroll
            for (int ai = 0; ai < 2; ++ai)
#pragma unroll
                for (int m = 0; m < 4; ++m) { const size_t off = (size_t)(rl0 + ai * 128 + m * 16) * DM + c0;
                    const f32x4 x0 = *(const f32x4*)(src + off), x1 = *(const f32x4*)(src + off + 4);
                    *(f32x4*)(dst + off) = x0 + g0 * acc[ai][bj][m][0]; *(f32x4*)(dst + off + 4) = x1 + g1 * acc[ai][bj][m][1]; } }
    }
};

__device__ __forceinline__ float wfetch(const Args& a, int kind, int l, int n, int k) {
    switch (kind) {
    case 0: {
        int src;
        if (n < PC) { src = pcol_src(32 * gperm_in(n >> 5) + (n & 31)); if (src < 0) return 0.f; }
        else { const int t = n - PC, tg = t >> 8, c = t & 255; const int nb = 2 * (c >> 7) + ((c >> 2) & 1), dd = 16 * ((c >> 5) & 3) + 4 * ((c >> 3) & 3) + (c & 3); src = SRC_GATE + nb * 1024 + 64 * tg + dd; }
        return a.in[I_WIN][((size_t)l * 1024 + k) * IN_COLS + src]; }
    case 1: {
        n = 32 * gperm_mla(n >> 5) + (n & 31);
        if (n < 768) return k >= 128 ? a.in[I_MWUQ][((size_t)l * 256 + (k - 128)) * 768 + n] * a.in[I_MQNW][l * 256 + (k - 128)] : 0.f;
        if (k >= 128) return 0.f;
        const int m = n - 768; const int src = m < 512 ? (m >> 7) * 256 + (m & 127) : ((m - 512) >> 7) * 256 + 128 + ((m - 512) & 127);
        return a.in[I_MWUKV][((size_t)l * 128 + k) * 1024 + src] * a.in[I_MKVNW][l * 128 + k]; }
    case 2: { const int nb = n >> 10, d = n & 1023; return a.in[I_WBR][(((size_t)l * 4 + nb) * 512 + k) * 1024 + d]; }
    case 3: return a.in[I_WO][((size_t)l * 1024 + k) * 1024 + n];
    case 4: return a.in[I_W1][((size_t)l * 1024 + k) * 4096 + n];
    default: return a.in[I_W2][((size_t)l * 4096 + k) * 1024 + n];
    }
}
__device__ __forceinline__ void transpose_item(const Args& a, int kind, int l, int K, bf16* WT, int item, int nblk, LAS float* scr, int lane) {
    const int kb = item / nblk, nb = item % nblk, k0 = 64 * kb, n0 = 32 * nb;
    float tv[32];
#pragma unroll
    for (int i = 0; i < 32; ++i) tv[i] = wfetch(a, kind, l, n0 + (lane & 31), k0 + 2 * i + (lane >> 5));
#pragma unroll
    for (int i = 0; i < 32; ++i) scr[(2 * i + (lane >> 5)) * 33 + (lane & 31)] = tv[i];
    asm volatile("s_waitcnt lgkmcnt(0)" ::: "memory");
    const int c = lane & 7;
    if ((kind == 0 && n0 >= PC) || kind == 2) {
        unsigned char* W8 = kind == 2 ? (unsigned char*)WT : (unsigned char*)WT + (size_t)PC * 1024 * 2; const int nr = kind == 2 ? n0 : n0 - PC; const float sc8 = kind == 2 ? 32.f : 64.f;
#pragma unroll
        for (int j = 0; j < 4; ++j) { const int n = (lane >> 3) + 8 * j; const LAS float* s = scr + (8 * c) * 33 + n;
            u32x2 o; o.x = pk4_fp8(sc8 * s[0 * 33], sc8 * s[1 * 33], sc8 * s[2 * 33], sc8 * s[3 * 33]); o.y = pk4_fp8(sc8 * s[4 * 33], sc8 * s[5 * 33], sc8 * s[6 * 33], sc8 * s[7 * 33]);
            st8_wt(W8 + (size_t)(nr + n) * K + k0 + 8 * c, o); }
    } else
#pragma unroll
    for (int j = 0; j < 4; ++j) { const int n = (lane >> 3) + 8 * j; const LAS float* s = scr + (8 * c) * 33 + n;
        u32x4 o; o.x = pk2(s[0 * 33], s[1 * 33]); o.y = pk2(s[2 * 33], s[3 * 33]); o.z = pk2(s[4 * 33], s[5 * 33]); o.w = pk2(s[6 * 33], s[7 * 33]);
        st16_wt(WT + (size_t)(n0 + n) * K + k0 + 8 * c, o); }
    asm volatile("s_waitcnt lgkmcnt(0)" ::: "memory");
}
__device__ __forceinline__ void prep_weights(const Args& a, int l, LAS unsigned char* lds, int it_lo = 0, int it_hi = 1 << 30) {
    const int tid = tidx(), lane = tid & 63, wave = tid >> 6;
    LAS float* scr = (LAS float*)(lds + wave * 8704);
    unsigned char* wt = a.ws + WS_WT;
    constexpr int I0 = 16 * (WIN_N / 32), I1 = 6 * (1792 / 32), I2 = 8 * (4096 / 32), I3 = 16 * (1024 / 32), I4 = 16 * (4096 / 32), I5 = 64 * (1024 / 32);
    const int gw = blockIdx.x * 8 + wave, NGW = gridDim.x * 8;
    const int it_end = it_hi < I0 + I1 + I2 + I3 + I4 + I5 ? it_hi : I0 + I1 + I2 + I3 + I4 + I5;
    for (int it = it_lo + gw; it < it_end; it += NGW) {
        int r = it;
        if (r < I0) { transpose_item(a, 0, l, 1024, (bf16*)(wt + WT_WIN), r, WIN_N / 32, scr, lane); continue; } r -= I0;
        if (r < I1) { transpose_item(a, 1, l, 384, (bf16*)(wt + WT_WMLA), r, 1792 / 32, scr, lane); continue; } r -= I1;
        if (r < I2) { transpose_item(a, 2, l, 512, (bf16*)(wt + WT_WB), r, 4096 / 32, scr, lane); continue; } r -= I2;
        if (r < I3) { transpose_item(a, 3, l, 1024, (bf16*)(wt + WT_WO), r, 1024 / 32, scr, lane); continue; } r -= I3;
        if (r < I4) { transpose_item(a, 4, l, 1024, (bf16*)(wt + WT_W1), r, 4096 / 32, scr, lane); continue; } r -= I4;
        transpose_item(a, 5, l, 4096, (bf16*)(wt + WT_W2), r, 1024 / 32, scr, lane);
    }
}
__device__ __forceinline__ void prep_weights_dyn(const Args& a, int l, LAS unsigned char* lds, int it_lo, int it_hi, unsigned* ctr) {
    const int tid = tidx(), lane = tid & 63, wave = tid >> 6;
    LAS float* scr = (LAS float*)(lds + wave * 8704);
    volatile LAS int* slot = (volatile LAS int*)(lds + LDS_BYTES - 16);
    unsigned char* wt = a.ws + WS_WT;
    constexpr int I0 = 16 * (WIN_N / 32), I1 = 6 * (1792 / 32), I2 = 8 * (4096 / 32), I3 = 16 * (1024 / 32), I4 = 16 * (4096 / 32);
    for (;;) {
        __syncthreads();
        if (tid == 0) *slot = (int)__hip_atomic_fetch_add(ctr, 8u, __ATOMIC_RELAXED, __HIP_MEMORY_SCOPE_AGENT);
        __syncthreads();
        const int base = __builtin_amdgcn_readfirstlane(*slot) + it_lo;
        if (base >= it_hi) break;
        int r = base + wave;
        if (r >= it_hi) continue;
        if (r < I0) { transpose_item(a, 0, l, 1024, (bf16*)(wt + WT_WIN), r, WIN_N / 32, scr, lane); continue; } r -= I0;
        if (r < I1) { transpose_item(a, 1, l, 384, (bf16*)(wt + WT_WMLA), r, 1792 / 32, scr, lane); continue; } r -= I1;
        if (r < I2) { transpose_item(a, 2, l, 512, (bf16*)(wt + WT_WB), r, 4096 / 32, scr, lane); continue; } r -= I2;
        if (r < I3) { transpose_item(a, 3, l, 1024, (bf16*)(wt + WT_WO), r, 1024 / 32, scr, lane); continue; } r -= I3;
        if (r < I4) { transpose_item(a, 4, l, 1024, (bf16*)(wt + WT_W1), r, 4096 / 32, scr, lane); continue; } r -= I4;
        transpose_item(a, 5, l, 4096, (bf16*)(wt + WT_W2), r, 1024 / 32, scr, lane);
    }
}
constexpr int PREP_EARLY_ITEMS = 16 * (WIN_N / 32) + 6 * (1792 / 32) + 8 * (4096 / 32) + 16 * (1024 / 32) + 16 * (4096 / 32);
__device__ __forceinline__ void xc_reduce_rows(const Args& a) {
    const int tid = tidx(), lane = tid & 63, gw = blockIdx.x * 8 + (tid >> 6), NGW = gridDim.x * 8;
    float* xc = (float*)(a.ws + WS_XC1); const float* part = (const float*)(a.ws + WS_H2);
    const float* mod = (const float*)(a.ws + WS_MOD) + ((size_t)(0 * 9 + 8) * 6 + 5) * 1024;
    for (int r = gw; r < 2048; r += NGW) {
#pragma unroll
        for (int j = 0; j < 4; ++j) { const int c = 4 * lane + 256 * j; const size_t o = (size_t)r * DM + c;
            const f32x4 s = *(const f32x4*)(part + o) + *(const f32x4*)(part + (size_t)2048 * DM + o) + *(const f32x4*)(part + (size_t)2 * 2048 * DM + o) + *(const f32x4*)(part + (size_t)3 * 2048 * DM + o);
            st16_wt(xc + o, *(const f32x4*)(xc + o) + *(const f32x4*)(mod + c) * s); }
    }
}
__device__ __forceinline__ void prep_mods(const Args& a, LAS unsigned char* lds, int item) {
    const int tid = tidx(), lane = tid & 63, wave = tid >> 6;
    LAS float* sc = (LAS float*)lds;
    LAS float* red = (LAS float*)(lds + 36864);
    {
        float cv[18];
#pragma unroll
        for (int j = 0; j < 18; ++j) { const int i = tid + 512 * j, bi = i >> 10, k = i & 1023; cv[j] = bi < 8 ? a.in[I_C][bi * 1024 + k] : a.in[I_CCTX][k]; }
#pragma unroll
        for (int j = 0; j < 18; ++j) sc[tid + 512 * j] = siluf_(cv[j]);
    }
    __syncthreads();
    const int l = item / 24, n0 = (item % 24) * 256 + 4 * lane;
    f32x4 acc[9];
#pragma unroll
    for (int b = 0; b < 9; ++b) acc[b] = (f32x4){0.f, 0.f, 0.f, 0.f};
    const float* w = a.in[I_ADAW] + ((size_t)l * 1024 + wave * 128) * 6144 + n0;
#pragma unroll 1
    for (int k0 = 0; k0 < 128; k0 += 16) {
        f32x4 wv[16];
#pragma unroll
        for (int k = 0; k < 16; ++k) wv[k] = *(const f32x4*)(w + (size_t)(k0 + k) * 6144);
#pragma unroll
        for (int k4 = 0; k4 < 16; k4 += 4)
#pragma unroll
            for (int b = 0; b < 9; ++b) { const f32x4 s4 = *(const LAS f32x4*)(sc + b * 1024 + wave * 128 + k0 + k4);
                acc[b] += wv[k4] * s4[0] + wv[k4 + 1] * s4[1] + wv[k4 + 2] * s4[2] + wv[k4 + 3] * s4[3]; }
    }
#pragma unroll
    for (int b = 0; b < 9; ++b) *(LAS f32x4*)(red + (wave * 9 + b) * 256 + 4 * lane) = acc[b];
    __syncthreads();
    for (int o = tid; o < 9 * 64; o += 512) {
        const int b = o >> 6, q = o & 63, n = (item % 24) * 256 + 4 * q;
        f32x4 sum = *(const f32x4*)(a.in[I_ADAB] + l * 6144 + n);
#pragma unroll
        for (int w8 = 0; w8 < 8; ++w8) sum += *(const LAS f32x4*)(red + (w8 * 9 + b) * 256 + 4 * q);
        st16_wt((float*)(a.ws + WS_MOD) + ((size_t)l * 9 + b) * 6144 + n, sum);
    }
    __syncthreads();
}

__device__ __forceinline__ void norm_mod_rows(const Args& a, int l, int g0, int nrows, int which  ,
                                              int r_lo = 0, int wg_lo = 0, int wg_n = 0  , bf16* Hov = nullptr  ) {
    const int tid = tidx(), lane = tid & 63; const int nwg = wg_n ? wg_n : (int)gridDim.x, wgi = (int)blockIdx.x - wg_lo;
    if (wgi < 0 || wgi >= nwg) return;
    const int gw = wgi * 8 + (tid >> 6), NGW = nwg * 8;
    const float* nw = a.in[which ? I_N2W : I_N1W] + l * DM;
    bf16* H = Hov ? Hov : (bf16*)(a.ws + (which ? WS_H2 : WS_H)); const int nMg = (l == 0) ? 36 : 32;
    for (int R = r_lo + gw; R < nrows; R += NGW) {
        int g = g0, r = R; if (which) { const int T = R >> 8; g = T / nMg; r = (T - g * nMg) * 256 + (R & 255); }
        const float* xr = which ? (const float*)xrow_dst(a, g, r) : xrow_src(a, l, g, r);
        const float* mod = (const float*)(a.ws + WS_MOD) + ((size_t)(l * 9 + row_bi(g, r)) * 6 + (which ? 3 : 0)) * 1024;
        f32x4 v[4]; float s = 0.f;
#pragma unroll
        for (int j = 0; j < 4; ++j) { v[j] = *(const f32x4*)(xr + 8 * lane + 512 * (j >> 1) + 4 * (j & 1)); s += (v[j][0] * v[j][0] + v[j][1] * v[j][1]) + (v[j][2] * v[j][2] + v[j][3] * v[j][3]); }
        const float rstd = rsqrtf(wave_sum(s) * (1.f / DM) + EPS);
#pragma unroll
        for (int h = 0; h < 2; ++h) { const int c = 8 * lane + 512 * h; f32x4 y[2];
#pragma unroll
            for (int q = 0; q < 2; ++q) { const f32x4 w = *(const f32x4*)(nw + c + 4 * q), sh = *(const f32x4*)(mod + c + 4 * q), sc = *(const f32x4*)(mod + 1024 + c + 4 * q);
#pragma unroll
                for (int e = 0; e < 4; ++e) y[q][e] = v[2 * h + q][e] * rstd * w[e] * (1.f + sc[e]) + sh[e]; }
            st16_wt(H + (size_t)R * DM + c, pack8(y[0], y[1]));
            if (!which) { unsigned char* h8 = a.ws + ((R >> 8) < H8_SPLIT ? WS_H8A + (size_t)R * 1024 : WS_H8B + (size_t)(R - H8_SPLIT * 256) * 1024) + c;
                u32x2 o8; o8.x = pk4_fp8(y[0][0], y[0][1], y[0][2], y[0][3]); o8.y = pk4_fp8(y[1][0], y[1][1], y[1][2], y[1][3]); st8_wt(h8, o8); } }
    }
}
__device__ __forceinline__ void final_norm_rows(const Args& a) {
    const int tid = tidx(), lane = tid & 63, gw = blockIdx.x * 8 + (tid >> 6), NGW = gridDim.x * 8;
    const float* nw = a.in[I_FNW];
    for (int r = gw; r < NB * SEQ; r += NGW) {
        float* xr = a.out + (size_t)r * DM;
        f32x4 v[4]; float s = 0.f;
#pragma unroll
        for (int j = 0; j < 4; ++j) { v[j] = *(const f32x4*)(xr + 4 * lane + 256 * j); s += (v[j][0] * v[j][0] + v[j][1] * v[j][1]) + (v[j][2] * v[j][2] + v[j][3] * v[j][3]); }
        const float rstd = rsqrtf(wave_sum(s) * (1.f / DM) + EPS);
#pragma unroll
        for (int j = 0; j < 4; ++j) { const int c = 4 * lane + 256 * j; const f32x4 w = *(const f32x4*)(nw + c); *(f32x4*)(xr + c) = v[j] * rstd * w; }
    }
}
__device__ __forceinline__ void rope_pair(float& x1, float& x2, int pos, int i, int quarter) {
    const float inv = exp2f(-(float)i * (13.287712379549449f / (float)quarter));
    const float ang = (float)pos * inv; const float s = __sinf(ang), c = __cosf(ang);
    const float a = x1 * c - x2 * s, b = x1 * s + x2 * c; x1 = a; x2 = b;
}
struct PostRegs { bf16 kr1, kr2, kb1, kb2, kd0, kd1, kd2, kd3; };
__device__ __forceinline__ PostRegs post_load(const bf16* P, int r, int lane) {
    const bf16* pr = P + (size_t)r * PC; PostRegs R;
    { const int d1 = 32 * ((lane >> 4) & 1) + (lane & 15); R.kr1 = pr[PC_KR + d1]; R.kr2 = pr[PC_KR + d1 + 16]; }
    { const int d1 = 64 * (lane >> 5) + 32 * ((lane >> 4) & 1) + (lane & 15); R.kb1 = pr[PC_KB + d1]; R.kb2 = pr[PC_KB + d1 + 16]; }
    { const bf16* kd = pr + PC_KD + 128 * (lane >> 5) + (lane & 31); R.kd0 = kd[0]; R.kd1 = kd[32]; R.kd2 = kd[64]; R.kd3 = kd[96]; }
    return R;
}
__device__ __forceinline__ void post_rows(const Args& a, int l) {
    const int tid = tidx(), lane = tid & 63, gw = blockIdx.x * 8 + (tid >> 6), NGW = gridDim.x * 8;
    bf16* P = (bf16*)(a.ws + WS_P); bf16* KA = (bf16*)(a.ws + WS_KA);
    const float* knw = a.in[I_KNW] + l * 128;
    if (gw >= MG_ROWS) return;
    PostRegs R = post_load(P, gw, lane);
#pragma unroll 1
    for (int r = gw; r < MG_ROWS; r += NGW) {
        const PostRegs Rn = post_load(P, r + NGW < MG_ROWS ? r + NGW : r, lane);
        bf16* pr = P + (size_t)r * PC;
        const bool lat = r < LAT_ROWS; const int t = r & 2047, rowp = t >> 6, colp = t & 63;
        int bl, kap; row_blk(r, bl, kap);
        if (lane < 32) {
            const int part = lane >> 4, i = lane & 15, d1 = 32 * part + i, d2 = d1 + 16;
            float x1 = bf2f(R.kr1), x2 = bf2f(R.kr2);
            if (lat) rope_pair(x1, x2, part ? colp : rowp, i, 16);
            const bf16 o1 = (bf16)f2bf(x1), o2 = (bf16)f2bf(x2);
#pragma unroll
            for (int h = 0; h < 4; ++h) { bf16* kd = KA + ((size_t)(bl * 4 + h) * KEYS + kap) * 192 + 128; kd[d1] = o1; kd[d2] = o2; }
        }
        if (lat) {
            const int hh = lane >> 5, part = (lane >> 4) & 1, i = lane & 15, d1 = 64 * hh + 32 * part + i, d2 = d1 + 16;
            float x1 = bf2f(R.kb1), x2 = bf2f(R.kb2);
            rope_pair(x1, x2, part ? colp : rowp, i, 16);
            pr[PC_KB + d1] = (bf16)f2bf(x1); pr[PC_KB + d2] = (bf16)f2bf(x2);
        }
        {
            const int hh = lane >> 5, i = lane & 31; bf16* kd = pr + PC_KD + 128 * hh;
            float x0 = bf2f(R.kd0), x1 = bf2f(R.kd1), x2 = bf2f(R.kd2), x3 = bf2f(R.kd3);
            float ss = x0 * x0 + x1 * x1 + x2 * x2 + x3 * x3;
#pragma unroll
            for (int o = 1; o < 32; o <<= 1) ss += SHFLX(ss, o);
            const float rstd = rsqrtf(ss * (1.f / 128.f) + EPS);
            x0 *= rstd * knw[i]; x1 *= rstd * knw[32 + i]; x2 *= rstd * knw[64 + i]; x3 *= rstd * knw[96 + i];
            if (lat) { rope_pair(x0, x1, rowp, i, 32); rope_pair(x2, x3, colp, i, 32); }
            kd[i] = (bf16)f2bf(x0); kd[32 + i] = (bf16)f2bf(x1); kd[64 + i] = (bf16)f2bf(x2); kd[96 + i] = (bf16)f2bf(x3);
        }
        R = Rn;
    }
}
__device__ __forceinline__ void comb_rows(const Args& a, int l, int nrows) {
    const int tid = tidx(), lane = tid & 63, gw = blockIdx.x * 8 + (tid >> 6), NGW = gridDim.x * 8;
    const bf16* P = (const bf16*)(a.ws + WS_P); bf16* Y = (bf16*)(a.ws + WS_Y); const bf16* OB = (const bf16*)(a.ws + WS_MG);
    const float* gnw = a.in[I_GNW] + l * 128;
    for (int r = gw; r < nrows; r += NGW) {
#pragma unroll
        for (int h = 0; h < 4; ++h) {
            const int e = 2 * lane;
            const unsigned wf = *(const unsigned*)(Y + (size_t)r * 2048 + 1024 + 128 * h + e), wb = *(const unsigned*)(OB + (size_t)r * 512 + 128 * h + e), wr_ = *(const unsigned*)(P + (size_t)r * PC + PC_RC + 128 * h + e);
            const float o0 = bflo(wf) + bflo(wb), o1 = bfhi(wf) + bfhi(wb);
            const float rstd = rsqrtf(wave_sum(o0 * o0 + o1 * o1) * (1.f / 128.f) + EPS);
            *(unsigned*)(Y + (size_t)r * 2048 + 1024 + 128 * h + e) = pk2(o0 * rstd * gnw[e] * siluf_(bflo(wr_)), o1 * rstd * gnw[e + 1] * siluf_(bfhi(wr_)));
        }
    }
}

struct AttnArgs {
    const bf16* Q; int qpitch;
    const bf16* Kc; const bf16* Kl; int kpitch;
    const bf16* Vt;
    unsigned char* O; int opitch;
    int qpos0, ntile, band_first;
    float sink_l2; const float* qnw;
};
__device__ __forceinline__ float max3f(float a, float b, float c) { float r; asm("v_max3_f32 %0, %1, %2, %3" : "=v"(r) : "v"(a), "v"(b), "v"(c)); return r; }
template <int DK, int DV, int MODE>
__device__ __forceinline__ void attn_unit(LAS unsigned char* lds, const AttnArgs& A) {
    constexpr bool PV8 = true;
    constexpr int KS = DK * 2 + 16, VS = PV8 ? 80 : 144, NS = DK / 16, NDT = DV / 32, KCH = DK / 8, NKC = KCH / 8, NVC = PV8 ? 1 : DV / 64;
    constexpr int V_OFF = 64 * KS, BUFSZ = V_OFF + DV * VS;
    static_assert(BUFSZ % 16 == 0 && 3 * BUFSZ <= LDS_BYTES - 64, "attention LDS");
    const int tid = tidx(), lane = tid & 63, wave = __builtin_amdgcn_readfirstlane(tid >> 6);
    const int r = lane & 31, h = lane >> 5;
    const bool lat = A.qpos0 >= 0;
    bf16x8 qf[NS];
    {
        float qv[NS][8];
        const bf16* qrow = A.Q + (size_t)(32 * wave + r) * A.qpitch + 8 * h;
#pragma unroll
        for (int s = 0; s < NS; ++s) { const u32x4 w = *(const u32x4*)(qrow + 16 * s);
            qv[s][0] = bflo(w.x); qv[s][1] = bfhi(w.x); qv[s][2] = bflo(w.y); qv[s][3] = bfhi(w.y); qv[s][4] = bflo(w.z); qv[s][5] = bfhi(w.z); qv[s][6] = bflo(w.w); qv[s][7] = bfhi(w.w); }
        if (MODE == 2) {
            float ss = 0.f;
#pragma unroll
            for (int s = 0; s < NS; ++s)
#pragma unroll
                for (int j = 0; j < 8; ++j) ss += qv[s][j] * qv[s][j];
            ss += SHFLX(ss, 32);
            const float rstd = rsqrtf(ss * (1.f / 128.f) + EPS);
#pragma unroll
            for (int s = 0; s < NS; ++s)
#pragma unroll
                for (int j = 0; j < 8; ++j) qv[s][j] *= rstd * A.qnw[16 * s + 8 * h + j];
        }
        if (lat) {
            const int pos = A.qpos0 + 32 * wave + r, rowp = pos >> 6, colp = pos & 63;
#pragma unroll
            for (int j = 0; j < 8; ++j) {
                if (MODE == 0) { rope_pair(qv[8][j], qv[9][j], rowp, 8 * h + j, 16); rope_pair(qv[10][j], qv[11][j], colp, 8 * h + j, 16); }
                if (MODE == 1) { rope_pair(qv[0][j], qv[1][j], rowp, 8 * h + j, 16); rope_pair(qv[2][j], qv[3][j], colp, 8 * h + j, 16); }
                if (MODE == 2) { rope_pair(qv[0][j], qv[2][j], rowp, 8 * h + j, 32); rope_pair(qv[1][j], qv[3][j], rowp, 16 + 8 * h + j, 32);
                                 rope_pair(qv[4][j], qv[6][j], colp, 8 * h + j, 32); rope_pair(qv[5][j], qv[7][j], colp, 16 + 8 * h + j, 32); }
            }
        }
        const float c = (MODE == 0 ? 0.07216878364870322f : MODE == 1 ? 0.125f : 0.08838834764831845f) * 1.4426950408889634f;
#pragma unroll
        for (int s = 0; s < NS; ++s) { u32x4 w; w.x = pk2(qv[s][0] * c, qv[s][1] * c); w.y = pk2(qv[s][2] * c, qv[s][3] * c); w.z = pk2(qv[s][4] * c, qv[s][5] * c); w.w = pk2(qv[s][6] * c, qv[s][7] * c);
            qf[s] = __builtin_bit_cast(bf16x8, w); }
    }
    float m_run = 0.f; f32x2_t l2 = {0.f, 0.f};
    f32x16 acc[NDT], negm;
#pragma unroll
    for (int d = 0; d < NDT; ++d)
#pragma unroll
        for (int i = 0; i < 16; ++i) acc[d][i] = 0.f;
#pragma unroll
    for (int i = 0; i < 16; ++i) negm[i] = 0.f;
    u32x4 kreg[NKC], vreg[NVC];
    const int qlo = A.qpos0 + 32 * wave;
#define ATT_K0(i) ((MODE == 1 && lat && (i) >= 4) ? CTXL + A.band_first + 64 * ((i) - 4) : 64 * (i))
#define ATT_LOAD(i) do { const int k0_ = ATT_K0(i); const bf16* kb_ = ((k0_ < CTXL) ? A.Kc + (size_t)k0_ * A.kpitch : A.Kl + (size_t)(k0_ - CTXL) * A.kpitch) + (size_t)(tid >> 3) * A.kpitch + 8 * (tid & 7); \
        _Pragma("unroll") for (int c_ = 0; c_ < NKC; ++c_) kreg[c_] = *(const u32x4*)(kb_ + 64 * c_); \
        if (PV8) { if (DV == 128 || tid < 4 * DV) vreg[0] = *(const u32x4*)((const unsigned char*)A.Vt + (size_t)(tid >> 2) * KEYS + k0_ + 16 * (tid & 3)); } else { \
        const bf16* vb_ = A.Vt + (size_t)(tid >> 3) * KEYS + k0_ + 8 * (tid & 7); \
        _Pragma("unroll") for (int p_ = 0; p_ < NVC; ++p_) vreg[p_] = *(const u32x4*)(vb_ + (size_t)(64 * p_) * KEYS); } } while (0)
#define ATT_WRITE(boff) do { LAS unsigned char* kw_ = lds + (boff) + (tid >> 3) * KS + (tid & 7) * 16; \
        _Pragma("unroll") for (int c_ = 0; c_ < NKC; ++c_) *(LAS u32x4*)(kw_ + 128 * c_) = kreg[c_]; \
        if (PV8) { if (DV == 128 || tid < 4 * DV) { LAS unsigned char* vw8_ = lds + (boff) + V_OFF + (tid >> 2) * VS + 8 * (tid & 3); u32x2 lo_, hi_; lo_.x = vreg[0].x; lo_.y = vreg[0].z; hi_.x = vreg[0].y; hi_.y = vreg[0].w;     \
            *(LAS u32x2*)vw8_ = lo_; *(LAS u32x2*)(vw8_ + 32) = hi_; } } else { \
        LAS unsigned char* vw_ = lds + (boff) + V_OFF + (tid >> 3) * VS + ((tid & 7) >> 1) * 32 + (tid & 1) * 8;     \
        _Pragma("unroll") for (int p_ = 0; p_ < NVC; ++p_) { u32x2 lo_, hi_; lo_.x = vreg[p_].x; lo_.y = vreg[p_].y; hi_.x = vreg[p_].z; hi_.y = vreg[p_].w; \
            *(LAS u32x2*)(vw_ + 64 * p_ * VS) = lo_; *(LAS u32x2*)(vw_ + 64 * p_ * VS + 16) = hi_; } } } while (0)
#define ATT_VLD(m) (*(const LAS bf16x8*)(vb + ((m) % NDT) * 32 * VS + (32 * ((m) / (2 * NDT)) + 16 * (((m) / NDT) & 1)) * 2))
    constexpr float THR = 8.f;
    constexpr int NM = 4 * NDT;
    constexpr int KD = (MODE == 0) ? 3 : 4, VD = 4;
    ATT_LOAD(0);
    __syncthreads();
    ATT_WRITE(0);
    __syncthreads();
    int b_cur = 0;
#pragma unroll 1
    for (int it = 0; it < A.ntile; ++it) {
        const bool more = it + 1 < A.ntile;
        if (more) ATT_LOAD(it + 1);
        f32x16 sc0, sc1;
        {
            const LAS unsigned char* kb = lds + b_cur + r * KS + 16 * h;
            bf16x8 kfr[KD][2];
#pragma unroll
            for (int d_ = 0; d_ < KD; ++d_) { kfr[d_][0] = *(const LAS bf16x8*)(kb + 32 * d_); kfr[d_][1] = *(const LAS bf16x8*)(kb + 32 * KS + 32 * d_); }
            __builtin_amdgcn_s_setprio(1);
#pragma unroll
            for (int s = 0; s < NS; ++s) {
                if (s == 0) { sc0 = __builtin_amdgcn_mfma_f32_32x32x16_bf16(kfr[0][0], qf[0], negm, 0, 0, 0); sc1 = __builtin_amdgcn_mfma_f32_32x32x16_bf16(kfr[0][1], qf[0], negm, 0, 0, 0); }
                else { sc0 = __builtin_amdgcn_mfma_f32_32x32x16_bf16(kfr[s % KD][0], qf[s], sc0, 0, 0, 0); sc1 = __builtin_amdgcn_mfma_f32_32x32x16_bf16(kfr[s % KD][1], qf[s], sc1, 0, 0, 0); }
                if (s + KD < NS) { kfr[s % KD][0] = *(const LAS bf16x8*)(kb + 32 * (s + KD)); kfr[s % KD][1] = *(const LAS bf16x8*)(kb + 32 * KS + 32 * (s + KD)); }
            }
            __builtin_amdgcn_s_setprio(0);
        }
        if (MODE == 1 && lat && it >= 4) { const int qpos = qlo + r, kb0 = A.band_first + 64 * (it - 4) + 4 * h;
#pragma unroll
            for (int i = 0; i < 16; ++i) { const int kpos = kb0 + (i & 3) + 8 * (i >> 2); const int d0 = qpos - kpos, d1 = d0 - 32;
                if (d0 > 128 || d0 < -128) sc0[i] = -INFINITY;
                if (d1 > 128 || d1 < -128) sc1[i] = -INFINITY; } }
        float mt = max3f(sc0[0], sc1[0], sc0[1]);
        mt = max3f(mt, sc1[1], sc0[2]);
#pragma unroll
        for (int i = 2; i < 15; ++i) mt = max3f(mt, sc1[i], sc0[i + 1]);
        mt = fmaxf(mt, sc1[15]);
        mt = fmaxf(mt, SHFLX(mt, 32));
        if (it == 0 || !__all(mt <= THR)) {
            const float dl = it == 0 ? mt : fmaxf(mt, 0.f);
            m_run += dl;
#pragma unroll
            for (int i = 0; i < 16; ++i) { sc0[i] -= dl; sc1[i] -= dl; negm[i] = -m_run; }
            if (it > 0) { const float alpha = __builtin_amdgcn_exp2f(-dl); l2 *= alpha;
#pragma unroll
                for (int d = 0; d < NDT; ++d)
#pragma unroll
                    for (int i = 0; i < 16; ++i) acc[d][i] *= alpha; }
        }
#pragma unroll
        for (int i = 0; i < 16; i += 2) {
            f32x2_t p0 = {__builtin_amdgcn_exp2f(sc0[i]), __builtin_amdgcn_exp2f(sc0[i + 1])}, p1 = {__builtin_amdgcn_exp2f(sc1[i]), __builtin_amdgcn_exp2f(sc1[i + 1])};
            l2 += p0; l2 += p1; sc0[i] = p0[0]; sc0[i + 1] = p0[1]; sc1[i] = p1[0]; sc1[i + 1] = p1[1]; }
        if (PV8) {
            typedef int av8i_t __attribute__((ext_vector_type(8)));
            av8i_t pf8;
#pragma unroll
            for (int j = 0; j < 4; ++j) { pf8[j] = (int)pk4_fp8(sc0[4 * j], sc0[4 * j + 1], sc0[4 * j + 2], sc0[4 * j + 3]); pf8[4 + j] = (int)pk4_fp8(sc1[4 * j], sc1[4 * j + 1], sc1[4 * j + 2], sc1[4 * j + 3]); }
            const LAS unsigned char* vb = lds + b_cur + V_OFF + r * VS + 32 * h;
#define ATT_VLD8(d) ({ const u32x4 lo_ = *(const LAS u32x4*)(vb + (d) * 32 * VS), hi_ = *(const LAS u32x4*)(vb + (d) * 32 * VS + 16); (av8i_t){(int)lo_.x, (int)lo_.y, (int)lo_.z, (int)lo_.w, (int)hi_.x, (int)hi_.y, (int)hi_.z, (int)hi_.w}; })
            av8i_t vf[NDT];
#pragma unroll
            for (int d = 0; d < NDT; ++d) vf[d] = ATT_VLD8(d);
            __builtin_amdgcn_s_setprio(1);
#pragma unroll
            for (int d = 0; d < NDT; ++d) acc[d] = __builtin_amdgcn_mfma_scale_f32_32x32x64_f8f6f4(vf[d], pf8, acc[d], 0, 0, 0, 0, 0, 0);
#undef ATT_VLD8
            __builtin_amdgcn_s_setprio(0);
        } else {
        bf16x8 pf[2][2];
#pragma unroll
        for (int u = 0; u < 2; ++u) {
            u32x4 w0, w1;
            w0.x = pk2(sc0[8 * u + 0], sc0[8 * u + 1]); w0.y = pk2(sc0[8 * u + 2], sc0[8 * u + 3]); w0.z = pk2(sc0[8 * u + 4], sc0[8 * u + 5]); w0.w = pk2(sc0[8 * u + 6], sc0[8 * u + 7]);
            w1.x = pk2(sc1[8 * u + 0], sc1[8 * u + 1]); w1.y = pk2(sc1[8 * u + 2], sc1[8 * u + 3]); w1.z = pk2(sc1[8 * u + 4], sc1[8 * u + 5]); w1.w = pk2(sc1[8 * u + 6], sc1[8 * u + 7]);
            pf[0][u] = __builtin_bit_cast(bf16x8, w0); pf[1][u] = __builtin_bit_cast(bf16x8, w1);
        }
        {
            const LAS unsigned char* vb = lds + b_cur + V_OFF + r * VS + 16 * h;
            bf16x8 vfr[VD];
#pragma unroll
            for (int d_ = 0; d_ < VD; ++d_) vfr[d_] = ATT_VLD(d_);
            __builtin_amdgcn_s_setprio(1);
#pragma unroll
            for (int m = 0; m < NM; ++m) {
                acc[m % NDT] = __builtin_amdgcn_mfma_f32_32x32x16_bf16(vfr[m % VD], pf[m / (2 * NDT)][(m / NDT) & 1], acc[m % NDT], 0, 0, 0);
                if (m + VD < NM) vfr[m % VD] = ATT_VLD(m + VD);
            }
            __builtin_amdgcn_s_setprio(0);
        }
        }
        if (more) ATT_WRITE(b_cur ^ BUFSZ);
        __syncthreads();
        b_cur ^= BUFSZ;
    }
#undef ATT_LOAD
#undef ATT_WRITE
#undef ATT_K0
#undef ATT_VLD
    float l_run = l2[0] + l2[1];
    l_run += SHFLX(l_run, 32);
    if (MODE == 1) l_run += __builtin_amdgcn_exp2f(A.sink_l2 - m_run);
    const float inv = 16.f / l_run;
    unsigned char* orow = A.O + (size_t)(32 * wave + r) * A.opitch + 8 * h;
#pragma unroll
    for (int d = 0; d < NDT; ++d)
#pragma unroll
        for (int kp = 0; kp < 2; ++kp) {
            const int i0 = 8 * kp, i1 = 8 * kp + 4;
            const unsigned ga = pk4_fp8(acc[d][i0] * inv, acc[d][i0 + 1] * inv, acc[d][i0 + 2] * inv, acc[d][i0 + 3] * inv), gb = pk4_fp8(acc[d][i1] * inv, acc[d][i1 + 1] * inv, acc[d][i1 + 2] * inv, acc[d][i1 + 3] * inv);
            const auto sw = __builtin_amdgcn_permlane32_swap(ga, gb, false, false);
            u32x2 o; o.x = sw[0]; o.y = sw[1];
            *(u32x2*)(orow + 32 * d + 16 * kp) = o;
        }
}

constexpr size_t WS_GU = WS_MG;
constexpr size_t WS_GDL = WS_MOD + 512 * 1024;
constexpr int CW_GLA = 8192;
__device__ __forceinline__ float logsigmoidf_(float x) { return fminf(x, 0.f) - __logf(1.f + __expf(-fabsf(x))); }
struct GlaArgs { const bf16* P; const bf16* VtC; bf16* Y; bf16* GU; float* GDL; unsigned* cnt; const float* wd; const float* bd; const float* gnw; int need_ctx; };
__device__ __forceinline__ void gla_rows(int c, int dir, int bl, int& row0, int& kap0) {
    if (c < 4) { const int ch = dir ? 3 - c : c; row0 = LAT_ROWS + bl * CTXL + 64 * ch; kap0 = 64 * ch; }
    else { const int ch = dir ? 35 - c : c - 4; row0 = bl * SEQ + 64 * ch; kap0 = CTXL + 64 * ch; }
}
constexpr int GL_RS = 144;
constexpr int GO_RQ = 0, GO_RK = 9216, GO_VT = 18432, GO_LR = 36864  , GO_WD = 40960  , GO_BD = 49152  , GO_GT = 49664, GO_DL = 51712, GO_QT = 51968, GO_KT = 61184,
              GO_KH = 70400, GO_AT = 79616, GO_ST = 88832, GO_RED = 107264  , GO_END = 108288;
__device__ __forceinline__ void gla_decay(LAS unsigned char* lds, int dsel, int dir, int wave, int d, float (&cum)[8], float& tot) {
    float la[8];
    {
        float wdv[16];
#pragma unroll
        for (int q = 0; q < 16; ++q) wdv[q] = ((const LAS float*)(lds + GO_WD + dsel * 4096))[q * 64 + d];
        const float bdv = ((const LAS float*)(lds + GO_BD + dsel * 256))[d];
#pragma unroll
        for (int i = 0; i < 8; ++i) { const LAS unsigned* lr = (const LAS unsigned*)(lds + GO_LR + dsel * 2048 + (8 * wave + i) * 32); float x = bdv;
#pragma unroll
            for (int q = 0; q < 8; ++q) { const unsigned w = lr[q]; x += bflo(w) * wdv[2 * q] + bfhi(w) * wdv[2 * q + 1]; }
            la[i] = logsigmoidf_(x) * (1.f / 16.f); }
    }
    float s = 0.f;
    if (dir == 0) {
#pragma unroll
        for (int i = 0; i < 8; ++i) { s += la[i]; cum[i] = s; } }
    else {
#pragma unroll
        for (int i = 7; i >= 0; --i) { s += la[i]; cum[i] = s; } }
    ((LAS float*)(lds + GO_GT))[wave * 64 + d] = s;
    __syncthreads();
    float pre = 0.f; tot = 0.f;
#pragma unroll
    for (int w8 = 0; w8 < 8; ++w8) { const float gt = ((const LAS float*)(lds + GO_GT))[w8 * 64 + d]; tot += gt; if (dir == 0 ? (w8 < wave) : (w8 > wave)) pre += gt; }
#pragma unroll
    for (int i = 0; i < 8; ++i) cum[i] += pre;
}
__device__ __forceinline__ void gla_signal(unsigned* word, unsigned v, int tid) {
    asm volatile("s_waitcnt vmcnt(0)" ::: "memory");
    __syncthreads();
    if (tid == 0) { __builtin_amdgcn_fence(__ATOMIC_RELEASE, "agent"); asm volatile("s_waitcnt vmcnt(0)" ::: "memory"); __hip_atomic_fetch_add(word, v, __ATOMIC_RELAXED, __HIP_MEMORY_SCOPE_AGENT); }
}
__device__ __forceinline__ void gla_wait(unsigned* w0, unsigned* w1, unsigned need, int tid) {
    if (tid == 0) {
        unsigned sp = 0;
        while (__hip_atomic_load(w0, __ATOMIC_RELAXED, __HIP_MEMORY_SCOPE_AGENT) < need || __hip_atomic_load(w1, __ATOMIC_RELAXED, __HIP_MEMORY_SCOPE_AGENT) < need) { __builtin_amdgcn_s_sleep(2); if (++sp > (1u << 22)) break; }
        __builtin_amdgcn_fence(__ATOMIC_ACQUIRE, "agent");
        asm volatile("s_waitcnt vmcnt(0)" ::: "memory");
    }
    __syncthreads();
}
__device__ __forceinline__ void gla_local(LAS unsigned char* lds, const GlaArgs& G, int chain, int c) {
    const int tid = tidx(), lane = tid & 63, wave = __builtin_amdgcn_readfirstlane(tid >> 6), r = lane & 31, hh = lane >> 5;
    const int dir = chain & 1, h = (chain >> 1) & 3, bl = chain >> 3;
    int row0, kap0; gla_rows(c, dir, bl, row0, kap0);
    const bf16* pr = G.P + (size_t)(row0 + (tid >> 3)) * PC + 8 * (tid & 7);
    const u32x4 rk = *(const u32x4*)(pr + PC_KC + 64 * h);
    const bf16* vp = G.VtC + ((size_t)(bl * 4 + h) * 128 + (tid >> 3)) * KEYS + kap0 + 8 * (tid & 7);
    const u32x4 rv0 = *(const u32x4*)vp, rv1 = *(const u32x4*)(vp + (size_t)64 * KEYS);
    u32x4 rl = {0u, 0u, 0u, 0u};
    if (tid < 128) rl = *(const u32x4*)(G.P + (size_t)(row0 + (tid >> 1)) * PC + PC_LRF + 16 * dir + 8 * (tid & 1));
    __syncthreads();
    for (int i = tid; i < 1024; i += 512) ((LAS float*)(lds + GO_WD))[i] = G.wd[(size_t)dir * 4096 + (size_t)(i >> 6) * 256 + 64 * h + (i & 63)];
    if (tid < 64) ((LAS float*)(lds + GO_BD))[tid] = G.bd[dir * 256 + 64 * h + tid];
    *(LAS u32x4*)(lds + GO_RK + (tid >> 3) * GL_RS + (tid & 7) * 16) = rk;
    *(LAS u32x4*)(lds + GO_VT + (tid >> 3) * GL_RS + (tid & 7) * 16) = rv0; *(LAS u32x4*)(lds + GO_VT + (64 + (tid >> 3)) * GL_RS + (tid & 7) * 16) = rv1;
    if (tid < 128) *(LAS u32x4*)(lds + GO_LR + (tid >> 1) * 32 + (tid & 1) * 16) = rl;
    __syncthreads();
    const int d = lane; float cum[8], tot;
    gla_decay(lds, 0, dir, wave, d, cum, tot);
    if (wave == 0) G.GDL[((size_t)chain * 36 + c) * 64 + d] = __expf(tot);
    {
        unsigned kh[4];
#pragma unroll
        for (int i = 0; i < 8; ++i) { const int s = 8 * wave + i; const float kv = bf2f(*(const LAS bf16*)(lds + GO_RK + s * GL_RS + 2 * d));
            const unsigned khv = f2bf(kv * __expf(tot - cum[i]));
            if (i & 1) kh[i >> 1] |= khv << 16; else kh[i >> 1] = khv; }
        u32x4 w; w.x = kh[0]; w.y = kh[1]; w.z = kh[2]; w.w = kh[3];
        *(LAS u32x4*)(lds + GO_KH + d * GL_RS + 16 * wave) = w;
    }
    __syncthreads();
    const int et = wave >> 1, dt = wave & 1;
    f32x16 u;
#pragma unroll
    for (int i = 0; i < 16; ++i) u[i] = 0.f;
#pragma unroll
    for (int kk = 0; kk < 4; ++kk) { const bf16x8 af = *(const LAS bf16x8*)(lds + GO_VT + (32 * et + r) * GL_RS + (16 * kk + 8 * hh) * 2), bfr = *(const LAS bf16x8*)(lds + GO_KH + (32 * dt + r) * GL_RS + (16 * kk + 8 * hh) * 2);
        u = __builtin_amdgcn_mfma_f32_32x32x16_bf16(af, bfr, u, 0, 0, 0); }
    bf16* up = G.GU + ((size_t)chain * 36 + c) * 8192 + 32 * dt + r;
#pragma unroll
    for (int i = 0; i < 16; ++i) { const int e = 32 * et + (i & 3) + 8 * (i >> 2) + 4 * hh; up[e * 64] = (bf16)f2bf(u[i]); }
}
__device__ __forceinline__ void gla_scan(const GlaArgs& G, int chain, int quarter) {
    const int tid = tidx();
    const int e = 32 * quarter + (tid >> 4), d0 = 4 * (tid & 15);
    bf16* up = G.GU + (size_t)chain * 36 * 8192 + e * 64 + d0; const float* dlp = G.GDL + (size_t)chain * 36 * 64 + d0;
    float S[4] = {0.f, 0.f, 0.f, 0.f};
#pragma unroll 1
    for (int c0 = 0; c0 < 36; c0 += 12) {
        u32x2 uu[12]; f32x4 dl[12];
#pragma unroll
        for (int j = 0; j < 12; ++j) { uu[j] = *(const u32x2*)(up + (size_t)(c0 + j) * 8192); dl[j] = *(const f32x4*)(dlp + (c0 + j) * 64); }
#pragma unroll
        for (int j = 0; j < 12; ++j) {
            S[0] = dl[j][0] * S[0] + bflo(uu[j].x); S[1] = dl[j][1] * S[1] + bfhi(uu[j].x); S[2] = dl[j][2] * S[2] + bflo(uu[j].y); S[3] = dl[j][3] * S[3] + bfhi(uu[j].y);
            const unsigned long long w = (unsigned long long)pk2(S[0], S[1]) | ((unsigned long long)pk2(S[2], S[3]) << 32);
            __hip_atomic_store((unsigned long long*)(up + (size_t)(c0 + j) * 8192), w, __ATOMIC_RELAXED, __HIP_MEMORY_SCOPE_AGENT); }
    }
    asm volatile("s_waitcnt vmcnt(0)" ::: "memory");
    __syncthreads();
    if (tid == 0) __hip_atomic_fetch_add(G.cnt + chain * 16, 100u, __ATOMIC_RELAXED, __HIP_MEMORY_SCOPE_AGENT);
}
__device__ __forceinline__ void gla_out(LAS unsigned char* lds, const GlaArgs& G, int bh, int j) {
    const int tid = tidx(), lane = tid & 63, wave = __builtin_amdgcn_readfirstlane(tid >> 6), r = lane & 31, hh = lane >> 5;
    const int h = bh & 3, bl = bh >> 2;
    const bool isctx = j >= 32; const int ch = isctx ? j - 32 : j;
    const int row0 = isctx ? LAT_ROWS + bl * CTXL + 64 * ch : bl * SEQ + 64 * ch, kap0 = isctx ? 64 * ch : CTXL + 64 * ch;
    const bf16* pr = G.P + (size_t)(row0 + (tid >> 3)) * PC + 8 * (tid & 7);
    const u32x4 rq = *(const u32x4*)(pr + PC_QC + 64 * h), rk = *(const u32x4*)(pr + PC_KC + 64 * h);
    const bf16* vp = G.VtC + ((size_t)(bl * 4 + h) * 128 + (tid >> 3)) * KEYS + kap0 + 8 * (tid & 7);
    const u32x4 rv0 = *(const u32x4*)vp, rv1 = *(const u32x4*)(vp + (size_t)64 * KEYS);
    u32x4 rl = {0u, 0u, 0u, 0u};
    if (tid < 256) rl = *(const u32x4*)(G.P + (size_t)(row0 + ((tid & 127) >> 1)) * PC + PC_LRF + 16 * (tid >> 7) + 8 * (tid & 1));
    __syncthreads();
    for (int i = tid; i < 2048; i += 512) { const int dsel = i >> 10, q = (i >> 6) & 15, dd = i & 63; ((LAS float*)(lds + GO_WD))[i] = G.wd[(size_t)dsel * 4096 + (size_t)q * 256 + 64 * h + dd]; }
    if (tid < 128) ((LAS float*)(lds + GO_BD))[tid] = G.bd[(tid >> 6) * 256 + 64 * h + (tid & 63)];
    *(LAS u32x4*)(lds + GO_RQ + (tid >> 3) * GL_RS + (tid & 7) * 16) = rq; *(LAS u32x4*)(lds + GO_RK + (tid >> 3) * GL_RS + (tid & 7) * 16) = rk;
    *(LAS u32x4*)(lds + GO_VT + (tid >> 3) * GL_RS + (tid & 7) * 16) = rv0; *(LAS u32x4*)(lds + GO_VT + (64 + (tid >> 3)) * GL_RS + (tid & 7) * 16) = rv1;
    if (tid < 256) *(LAS u32x4*)(lds + GO_LR + (tid >> 7) * 2048 + ((tid & 127) >> 1) * 32 + (tid & 1) * 16) = rl;
    const int chain0 = bh * 2;
    gla_wait(G.cnt + chain0 * 16, G.cnt + (chain0 + 1) * 16, 400u, tid);
    const int et = wave >> 1, tt = wave & 1, d = lane;
    f32x16 oc;
#pragma unroll
    for (int i = 0; i < 16; ++i) oc[i] = 0.f;
#pragma unroll 1
    for (int dir = 0; dir < 2; ++dir) {
        if (dir) __syncthreads();
        const int pos = dir == 0 ? (isctx ? ch : 4 + ch) : (isctx ? 3 - ch : 35 - ch);
        {
            u32x4 s0 = {0u, 0u, 0u, 0u}, s1 = {0u, 0u, 0u, 0u};
            if (pos > 0) { const bf16* sp = G.GU + ((size_t)(chain0 + dir) * 36 + pos - 1) * 8192 + (tid >> 3) * 64 + 8 * (tid & 7); s0 = *(const u32x4*)sp; s1 = *(const u32x4*)(sp + 64 * 64); }
            *(LAS u32x4*)(lds + GO_ST + (tid >> 3) * GL_RS + (tid & 7) * 16) = s0; *(LAS u32x4*)(lds + GO_ST + (64 + (tid >> 3)) * GL_RS + (tid & 7) * 16) = s1;
        }
        float cum[8], tot;
        gla_decay(lds, dir, dir, wave, d, cum, tot);
#pragma unroll
        for (int i = 0; i < 8; ++i) { const int s = 8 * wave + i;
            const float qv = bf2f(*(const LAS bf16*)(lds + GO_RQ + s * GL_RS + 2 * d)), kv = bf2f(*(const LAS bf16*)(lds + GO_RK + s * GL_RS + 2 * d));
            *(LAS bf16*)(lds + GO_QT + s * GL_RS + 2 * d) = (bf16)f2bf(qv * 0.125f * __expf(cum[i]));
            *(LAS bf16*)(lds + GO_KT + s * GL_RS + 2 * d) = (bf16)f2bf(kv * __expf(-cum[i])); }
        __syncthreads();
        if (wave < 4) {
            const int ss = wave & 1, t2 = wave >> 1;
            f32x16 sc;
#pragma unroll
            for (int i = 0; i < 16; ++i) sc[i] = 0.f;
#pragma unroll
            for (int kk = 0; kk < 4; ++kk) { const bf16x8 af = *(const LAS bf16x8*)(lds + GO_KT + (32 * ss + r) * GL_RS + (16 * kk + 8 * hh) * 2), bfr = *(const LAS bf16x8*)(lds + GO_QT + (32 * t2 + r) * GL_RS + (16 * kk + 8 * hh) * 2);
                sc = __builtin_amdgcn_mfma_f32_32x32x16_bf16(af, bfr, sc, 0, 0, 0); }
            const int t = 32 * t2 + r;
#pragma unroll
            for (int i4 = 0; i4 < 4; ++i4) { float v[4];
#pragma unroll
                for (int jj = 0; jj < 4; ++jj) { const int s = 32 * ss + 8 * i4 + 4 * hh + jj; const bool keep = dir == 0 ? (s <= t) : (s >= t); v[jj] = keep ? sc[4 * i4 + jj] : 0.f; }
                u32x2 w; w.x = pk2(v[0], v[1]); w.y = pk2(v[2], v[3]); *(LAS u32x2*)(lds + GO_AT + t * GL_RS + (32 * ss + 8 * i4 + 4 * hh) * 2) = w; }
        }
        __syncthreads();
#pragma unroll
        for (int kk = 0; kk < 4; ++kk) { const bf16x8 af = *(const LAS bf16x8*)(lds + GO_ST + (32 * et + r) * GL_RS + (16 * kk + 8 * hh) * 2), bfr = *(const LAS bf16x8*)(lds + GO_QT + (32 * tt + r) * GL_RS + (16 * kk + 8 * hh) * 2);
            oc = __builtin_amdgcn_mfma_f32_32x32x16_bf16(af, bfr, oc, 0, 0, 0); }
#pragma unroll
        for (int kk = 0; kk < 4; ++kk) { const bf16x8 af = *(const LAS bf16x8*)(lds + GO_VT + (32 * et + r) * GL_RS + (16 * kk + 8 * hh) * 2), bfr = *(const LAS bf16x8*)(lds + GO_AT + (32 * tt + r) * GL_RS + (16 * kk + 8 * hh) * 2);
            oc = __builtin_amdgcn_mfma_f32_32x32x16_bf16(af, bfr, oc, 0, 0, 0); }
    }
    float ss = 0.f;
#pragma unroll
    for (int i = 0; i < 16; ++i) ss += oc[i] * oc[i];
    ss += SHFLX(ss, 32);
    if (hh == 0) ((LAS float*)(lds + GO_RED))[et * 64 + 32 * tt + r] = ss;
    __syncthreads();
    const int t = 32 * tt + r;
    const float tot2 = ((const LAS float*)(lds + GO_RED))[t] + ((const LAS float*)(lds + GO_RED))[64 + t] + ((const LAS float*)(lds + GO_RED))[128 + t] + ((const LAS float*)(lds + GO_RED))[192 + t];
    const float rstd = rsqrtf(tot2 * (1.f / 128.f) + EPS);
    const int row = row0 + t;
    const bf16* rp = G.P + (size_t)row * PC + PC_RC + 128 * h + 32 * et + 4 * hh; unsigned char* yp = (unsigned char*)G.Y + (size_t)row * 2048 + 1024 + 128 * h + 32 * et + 4 * hh; const float* gw = G.gnw + 32 * et + 4 * hh;
#pragma unroll
    for (int i4 = 0; i4 < 4; ++i4) { const u32x2 rr = *(const u32x2*)(rp + 8 * i4); const f32x4 w = *(const f32x4*)(gw + 8 * i4);
        const float y0 = oc[4 * i4] * rstd * w[0] * siluf_(bflo(rr.x)), y1 = oc[4 * i4 + 1] * rstd * w[1] * siluf_(bfhi(rr.x)), y2 = oc[4 * i4 + 2] * rstd * w[2] * siluf_(bflo(rr.y)), y3 = oc[4 * i4 + 3] * rstd * w[3] * siluf_(bfhi(rr.y));
        *(unsigned*)(yp + 8 * i4) = pk4_fp8(16.f * y0, 16.f * y1, 16.f * y2, 16.f * y3); }
}

__device__ __forceinline__ GlaArgs make_gla(const Args& a, int l, int g) {
    unsigned char* ws = a.ws; GlaArgs G; G.P = (const bf16*)(ws + WS_P); G.VtC = (const bf16*)(ws + WS_VTC); G.Y = (bf16*)(ws + WS_Y); G.GU = (bf16*)(ws + WS_GU); G.GDL = (float*)(ws + WS_GDL);
    G.cnt = (unsigned*)(ws + WS_CTL) + CW_GLA + (l * 2 + g) * 32 * 16; G.wd = a.in[I_GWD] + (size_t)l * 2 * 16 * 256; G.bd = a.in[I_GBD] + (size_t)l * 2 * 256; G.gnw = a.in[I_GNW] + l * 128; G.need_ctx = (l == 0);
    return G;
}
__device__ __forceinline__ void attn_phase(const Args& a, int l, int g, LAS unsigned char* lds) {
    unsigned char* ws = a.ws;
    const bf16* P = (const bf16*)(ws + WS_P); const bf16* QA = (const bf16*)(ws + WS_QA); const bf16* KA = (const bf16*)(ws + WS_KA);
    unsigned char* Y = ws + WS_Y;
    const int need_ctx = (l == 0);
    const int NCH = need_ctx ? 36 : 32;
    const int C_SCAN = 16, C_A = 16, C_D = 16, C_B = 32, C_AC = need_ctx ? 2 : 0, C_DC = C_AC, C_BC = need_ctx ? 4 : 0, C_OUT = 2 * NCH;
    const int qtotal = C_SCAN + C_A + C_D + C_B + C_AC + C_DC + C_BC + C_OUT;
    unsigned* ctr0 = (unsigned*)(ws + WS_CTL) + (l * 2 + g) * 8 * 16;
    volatile LAS int* slot = (volatile LAS int*)(lds + LDS_BYTES - 16);
    const GlaArgs G = make_gla(a, l, g);
    const int x0 = (int)(__builtin_amdgcn_s_getreg((3 << 11) | 20) & 7);
    for (int qi = 0; qi < 8; ++qi) {
        const int x = (x0 + qi) & 7;
        for (;;) {
            __syncthreads();
            if (tidx() == 0) *slot = (int)__hip_atomic_fetch_add(ctr0 + x * 16, 1u, __ATOMIC_RELAXED, __HIP_MEMORY_SCOPE_AGENT);
            __syncthreads();
            int idx = *slot;
            idx = __builtin_amdgcn_readfirstlane(idx);
            if (idx >= qtotal) break;
            if (idx < C_SCAN) { const int bh = x + 8 * (idx >> 3); gla_scan(G, bh * 2 + ((idx >> 2) & 1), idx & 3); continue; }
            idx -= C_SCAN;
            if (idx >= qtotal - C_SCAN - C_OUT) { idx -= qtotal - C_SCAN - C_OUT; const int bh = x + 8 * (idx / NCH); gla_out(lds, G, bh, idx - (idx / NCH) * NCH); continue; }
            AttnArgs A; A.sink_l2 = 0.f; A.qnw = nullptr; A.band_first = 0;
            int kind, bl, h, qb = 0, ctxq = 0;
            if (idx < C_A) { kind = 0; const int bh = x + 8 * (idx >> 3); bl = bh >> 2; h = bh & 3; qb = idx & 7; }
            else if (idx < C_A + C_D) { const int i = idx - C_A; kind = 2; bl = x >> 1; h = 2 * (x & 1) + (i >> 3); qb = i & 7; }
            else if (idx < C_A + C_D + C_B) { const int i = idx - C_A - C_D; kind = 1; bl = x >> 1; h = 4 * (x & 1) + (i >> 3); qb = i & 7; }
            else if (idx < C_A + C_D + C_B + C_AC) { const int i = idx - (C_A + C_D + C_B); kind = 0; const int bh = x + 8 * i; bl = bh >> 2; h = bh & 3; ctxq = 1; }
            else if (idx < C_A + C_D + C_B + C_AC + C_DC) { const int i = idx - (C_A + C_D + C_B + C_AC); kind = 2; bl = x >> 1; h = 2 * (x & 1) + i; ctxq = 1; }
            else { const int i = idx - (C_A + C_D + C_B + C_AC + C_DC); kind = 1; bl = x >> 1; h = 4 * (x & 1) + i; ctxq = 1; }
            int row;
            if (!ctxq) { row = bl * SEQ + 256 * qb; A.qpos0 = 256 * qb; A.ntile = 36; }
            else { row = LAT_ROWS + bl * CTXL; A.qpos0 = -1; A.ntile = 4; }
            A.opitch = 2048;
            if (kind == 0) {
                A.Q = QA + (size_t)row * 768 + 192 * h; A.qpitch = 768;
                A.Kc = KA + (size_t)(bl * 4 + h) * KEYS * 192; A.Kl = A.Kc + (size_t)CTXL * 192; A.kpitch = 192;
                A.Vt = (const bf16*)(ws + WS_VTA + (size_t)(bl * 4 + h) * 128 * KEYS);
                A.O = Y + (size_t)row * 2048 + 128 * h;
                attn_unit<192, 128, 0>(lds, A);
            } else if (kind == 2) {
                const int kvh = h >> 1;
                A.Q = P + (size_t)row * PC + PC_QD + 128 * h; A.qpitch = PC;
                A.Kc = P + (size_t)(LAT_ROWS + bl * CTXL) * PC + PC_KD + 128 * kvh; A.Kl = P + (size_t)(bl * SEQ) * PC + PC_KD + 128 * kvh; A.kpitch = PC;
                A.Vt = (const bf16*)(ws + WS_VTD + (size_t)(bl * 2 + kvh) * 128 * KEYS);
                A.O = Y + (size_t)row * 2048 + 1536 + 128 * h; A.qnw = a.in[I_QNW] + l * 128;
                attn_unit<128, 128, 2>(lds, A);
            } else {
                const int kvh = h >> 2;
                if (!ctxq) { const int first = 256 * qb - 128 < 0 ? 0 : 256 * qb - 128, last = 256 * qb + 383 > SEQ - 1 ? SEQ - 1 : 256 * qb + 383; A.band_first = first; A.ntile = 4 + (last - first + 1) / 64; }
                A.Q = P + (size_t)row * PC + PC_QB + 64 * h; A.qpitch = PC;
                A.Kc = P + (size_t)(LAT_ROWS + bl * CTXL) * PC + PC_KB + 64 * kvh; A.Kl = P + (size_t)(bl * SEQ) * PC + PC_KB + 64 * kvh; A.kpitch = PC;
                A.Vt = (const bf16*)(ws + WS_VTB + (size_t)(bl * 2 + kvh) * 64 * KEYS);
                A.O = Y + (size_t)row * 2048 + 512 + 64 * h; A.sink_l2 = a.in[I_SINK][l * 8 + h] * 1.4426950408889634f;
                attn_unit<64, 64, 1>(lds, A);
            }
        }
    }
}

#define XB_TMO      128
#define XB_XCNT(j)  (256  + 64 * (j))
#define XB_XSUB(j)  (1280 + 64 * (j))
#define XB_XGEN(j)  (2304 + 64 * (j))
#define XB_TOP      3328
#define XB_TOPGEN   3392
#define XCD_BAR_WORDS 3456
#define XB_SPIN_CAP (1u << 22)
__device__ __forceinline__ unsigned xb_ld(unsigned* p)              { return __hip_atomic_load(p, __ATOMIC_RELAXED, __HIP_MEMORY_SCOPE_AGENT); }
__device__ __forceinline__ unsigned xb_add(unsigned* p, unsigned v) { return __hip_atomic_fetch_add(p, v, __ATOMIC_RELAXED, __HIP_MEMORY_SCOPE_AGENT); }
__device__ __forceinline__ unsigned xb_xcc_id() { return (unsigned)__builtin_amdgcn_s_getreg((3 << 11) | 20) & 0xFu; }
#define XB_SPIN(cond, bar) do { unsigned _sp = 0; while (cond) { __builtin_amdgcn_s_sleep(1); \
    if ((++_sp & 255u) == 0u) { if (xb_ld(&(bar)[XB_TMO])) break; if (_sp > XB_SPIN_CAP) { atomicAdd(&(bar)[XB_TMO], 1u); break; } } } } while (0)
struct XcdBarrier { unsigned* bar; unsigned x; volatile LAS unsigned* st; };
__device__ __forceinline__ XcdBarrier xcd_barrier_post(unsigned* bar, volatile LAS unsigned* st) {
    XcdBarrier b; b.bar = bar; b.x = xb_xcc_id(); b.st = st;
    if (tidx() == 0) (void)xb_add(&bar[XB_XCNT(b.x)], 1u);
    return b;
}
__device__ __forceinline__ void xcd_barrier_complete(unsigned* bar, unsigned x, unsigned& nloc, unsigned& nx) {
    const unsigned G = gridDim.x * gridDim.y * gridDim.z;
    unsigned sum, cnt, mine, sp = 0u;
    for (;;) {
        sum = 0u; cnt = 0u; mine = 0u;
#pragma unroll
        for (unsigned j = 0; j < 16; ++j) { const unsigned c = xb_ld(&bar[XB_XCNT(j)]); sum += c; cnt += (c > 0u) ? 1u : 0u; mine = (j == x) ? c : mine; }
        if (sum == G) break;
        __builtin_amdgcn_s_sleep(1);
        if ((++sp & 255u) == 0u) { if (xb_ld(&bar[XB_TMO])) break; if (sp > XB_SPIN_CAP) { atomicAdd(&bar[XB_TMO], 1u); break; } }
    }
    nloc = mine > 0u ? mine : 1u; nx = cnt > 0u ? cnt : 1u;
}
__device__ __forceinline__ void xcd_barrier(const XcdBarrier& b, const bool rel = true) {
    asm volatile("s_waitcnt vmcnt(0)" ::: "memory");
    __syncthreads();
    if (tidx() == 0) {
        unsigned* bar = b.bar;
        __builtin_amdgcn_s_waitcnt(0);
        unsigned nloc = b.st[0], nx = b.st[1];
        if (nloc == 0u) { xcd_barrier_complete(bar, b.x, nloc, nx); b.st[0] = nloc; b.st[1] = nx; }
        const unsigned gen = b.st[2]; b.st[2] = gen + 1u;
        const unsigned old = xb_add(&bar[XB_XSUB(b.x)], 1u);
        if (old + 1u == (gen + 1u) * nloc) {
            if (rel) __builtin_amdgcn_fence(__ATOMIC_RELEASE, "agent");
            asm volatile("s_waitcnt vmcnt(0)" ::: "memory");
            (void)xb_add(&bar[XB_TOP], 1u);
        }
        const unsigned tgt = (gen + 1u) * nx;
        asm volatile("buffer_inv sc1" ::: "memory");
        XB_SPIN(xb_ld(&bar[XB_TOP]) < tgt, bar);
        asm volatile("s_waitcnt vmcnt(0)" ::: "memory");
    }
    __syncthreads();
}
__device__ __forceinline__ bool phase_plain_stores(int q) {
    if (q == 0 || q == 17) return false;
    const int l = q > 17, rr = l ? q - 18 : q - 1;
    if (rr >= 12) return rr - 12 == 0 || rr - 12 == 3;
    const int k0 = rr % 6; return !(k0 == 4 || k0 == 0);
}
constexpr int CW_BAR = 4096;

#ifndef MK_CG_FIRST
#define MK_CG_FIRST 0
#endif
constexpr int N_PHASES = 35;
template <bool COOP>
__global__ void __launch_bounds__(512, 2) mk_fwd(Args args) {
    extern __shared__ __attribute__((aligned(16))) unsigned char lds_raw[];
    LAS unsigned char* lds = (LAS unsigned char*)lds_raw;
    unsigned char* ws = args.ws; unsigned char* wt = ws + WS_WT;
    const int G = gridDim.x, bx = blockIdx.x;
    volatile LAS unsigned* misc = (volatile LAS unsigned*)(lds + LDS_BYTES - 32);
    XcdBarrier bar; bar.bar = nullptr; bar.x = 0; bar.st = misc;
    if ((threadIdx.x & 63u) == 0u) *(volatile LAS int*)(size_t)(LDS_WTAB + 4 * hw_wave_slot()) = (int)(threadIdx.x >> 6);
    if (COOP) { if (threadIdx.x < 4) misc[threadIdx.x] = 0u; __syncthreads(); bar = xcd_barrier_post((unsigned*)(ws + WS_CTL) + CW_BAR, misc); }
#ifdef PROBE_PHASE
    volatile LAS unsigned long long* tp = (volatile LAS unsigned long long*)(lds + LDS_BYTES - 64);
    if (threadIdx.x == 0) { tp[0] = 0; tp[1] = __builtin_amdgcn_s_memrealtime(); }
    int prev_kind = 100;
#endif
    for (int p = args.ph_lo; p < args.ph_hi; ++p) {
        if (COOP) { if (p == args.ph_lo + 1 && MK_CG_FIRST) cg::this_grid().sync(); else if (p > args.ph_lo) xcd_barrier(bar, phase_plain_stores(p - 1)); }
#ifdef PROBE_PHASE
        { if (bx == 0 && threadIdx.x == 0) { const unsigned long long t = __builtin_amdgcn_s_memrealtime(); if (prev_kind == PROBE_PHASE) tp[0] += t - tp[1]; tp[1] = t; }
          int kind_; if (p == 0) kind_ = 12; else if (p == 19) kind_ = 13; else if (p == N_PHASES - 1) kind_ = 14; else { const int l_ = p > 19, rr_ = l_ ? p - 20 : p - 1, g_ = rr_ < 14 ? rr_ / 7 : 0, k0_ = rr_ < 14 ? rr_ - 7 * g_ : rr_ - 14; kind_ = rr_ < 14 ? (k0_ >= 5 ? k0_ + 1 : k0_) : 8 + k0_; }
          prev_kind = kind_; }
#endif
        if (p == 0) { if (bx < 48) prep_mods(args, lds, bx); prep_weights_dyn(args, 0, lds, 0, PREP_EARLY_ITEMS + 64 * (1024 / 32), (unsigned*)(ws + WS_CTL) + 2176); continue; }
        if (p == N_PHASES - 1) { final_norm_rows(args); continue; }
        if (p == 17) { xc_reduce_rows(args); continue; }
        const int l = p > 17, rr = l ? p - 18 : p - 1, g = rr < 12 ? rr / 6 : 0, k0 = rr < 12 ? rr - 6 * g : rr - 12, k = rr < 12 ? (k0 >= 3 ? k0 + 1 : k0) + (k0 >= 4 ? 1 : 0) : 8 + k0;
        const int nM = (l == 1) ? 32 : 36;
        pg8::StaticOrder S;
        switch (k) {
        case 0: if (l == 1 && g == 0) prep_weights(args, 1, lds, PREP_EARLY_ITEMS); norm_mod_rows(args, l, g, MG_ROWS, 0); break;
        case 1: { pg8::Gemm gm{(const bf16*)(ws + WS_H), (const bf16*)(wt + WT_WIN), 1024, 1024, 1024, 0, 0, 0, nullptr, 0};
            EpiInProj E{(bf16*)(ws + WS_P), (bf16*)(ws + WS_VTB), (bf16*)(ws + WS_VTC), (bf16*)(ws + WS_VTD), (float*)(ws + WS_RS) + (size_t)(l * 2 + g) * MG_ROWS * 2};
            if (l == 0) { S.init(36, 15, G, bx); pg8::gemm_phase(lds, gm, S, E);
                if (g == 1) {
                    pg8::Gemm go{(const bf16*)(ws + WS_MG0), (const bf16*)(wt + WT_WO), 1024, 1024, 1024, 0, 0, 0, nullptr, 0}; S.init(36, 4, G, (bx + G - 28) % G);
                    EpiResid Eo{&args, l, 0, 2, false, 36}; pg8::gemm_phase(lds, go, S, Eo); } }
            else {
                S.init(32, 15, G, bx); pg8::gemm_phase(lds, gm, S, E);
                S.init(4, 7, G, (bx + 32) % G, 3); pg8::gemm_phase(lds, gm, S, E); }
            break; }
        case 2: {
            { pg8::Gemm gm{(const bf16*)(ws + WS_P) + PC_CKV, (const bf16*)(wt + WT_WMLA), PC, 384, 384, 0, 0, 0, nullptr, 0}; S.init(36, 7, G, bx);
              EpiMla E{(bf16*)(ws + WS_QA), (bf16*)(ws + WS_KA), (bf16*)(ws + WS_VTA), (const float*)(ws + WS_RS) + (size_t)(l * 2 + g) * MG_ROWS * 2}; pg8::gemm_phase(lds, gm, S, E); }
            const GlaArgs GG = make_gla(args, l, g); for (int it = bx; it < 1152; it += G) gla_local(lds, GG, it & 31, it >> 5); post_rows(args, l); break; }
        case 4: attn_phase(args, l, g, lds); break;
        case 6: { pg8::Gemm gm{(const bf16*)(ws + WS_Y), (const bf16*)(wt + WT_WB), 1024, 256, 256, 4, 256, 0, nullptr, 0}; S.init(nM, 16, G, bx);
            EpiStore<0> E{(bf16*)(ws + WS_Z), 4096, 1.f / 512.f}; pg8::gemm_phase<EpiStore<0>, true>(lds, gm, S, E); break; }
        case 7: { pg8::Gemm gm{(const bf16*)(ws + WS_H8A), (const bf16*)(wt + WT_WG8), 512, 512, 512, 0, 0, 0, (const bf16*)(ws + WS_H8B), H8_SPLIT}; S.init(nM, 16, G, bx);
            EpiMerge E{(const bf16*)(ws + WS_Z), (bf16*)(ws + (g == 0 ? WS_MG0 : WS_MG))}; pg8::gemm_phase<EpiMerge, true>(lds, gm, S, E);
            if (l == 0 && g == 1) norm_mod_rows(args, l, 0, 36 * 256, 1, 0, 64, G - 64, (bf16*)(ws + WS_MG0));
            break; }
        case 8: { pg8::Gemm gm{(const bf16*)(ws + WS_MG0), (const bf16*)(wt + WT_WO), 1024, 1024, 1024, 0, 0, 0, (const bf16*)(ws + WS_MG), nM};
            if (l == 0) S.init(36, 4, G, bx, 4); else S.init(2 * nM, 4, G, bx);
            EpiResid E{&args, l, 0, 2, false, nM}; pg8::gemm_phase(lds, gm, S, E); break; }
        case 9: norm_mod_rows(args, l, 0, 2 * nM * 256, 1, l == 0 ? 36 * 256 : 0); break;
        case 10: { pg8::Gemm gm{(const bf16*)(ws + (l == 0 ? WS_MG0 : WS_H2)), (const bf16*)(wt + WT_W1), 1024, 1024, 1024, 0, 0, 0, l == 0 ? (const bf16*)(ws + WS_H2) + (size_t)36 * 256 * 1024 : nullptr, l == 0 ? 36 : 0}; S.init(2 * nM, 16, G, bx);
            EpiStore<1> E{(bf16*)(ws + WS_HID), 4096}; pg8::gemm_phase(lds, gm, S, E); break; }
        default:
            if (l == 1) { pg8::Gemm gm{(const bf16*)(ws + WS_HID), (const bf16*)(wt + WT_W2), 4096, 4096, 4096, 0, 0, 0, nullptr, 0}; S.init(2 * nM, 4, G, bx);
                EpiResid E{&args, l, 0, 5, true, nM}; pg8::gemm_phase(lds, gm, S, E); }
            else {
                { pg8::Gemm gm{(const bf16*)(ws + WS_HID), (const bf16*)(wt + WT_W2), 4096, 4096, 4096, 0, 0, 0, nullptr, 0}; S.init(64, 4, G, bx, 1);
                  EpiResid E{&args, l, 0, 5, true, nM}; pg8::gemm_phase(lds, gm, S, E); }
                { pg8::Gemm gm{(const bf16*)(ws + WS_HID), (const bf16*)(wt + WT_W2), 4096, 4096, 1024, 0, 0, 4, nullptr, 0}; S.init(8, 16, G, (bx + 128) % G, 2);
                  EpiPartial E{(float*)(ws + WS_H2)}; pg8::gemm_phase(lds, gm, S, E); }
                prep_weights_dyn(args, 1, lds, 0, PREP_EARLY_ITEMS, (unsigned*)(ws + WS_CTL) + 2048);
            }
            break;
        }
    }
#ifdef PROBE_PHASE
    xcd_barrier(bar);
    if (bx == 0) { const unsigned long long t = __builtin_amdgcn_s_memrealtime(); if (threadIdx.x == 0 && prev_kind == PROBE_PHASE) tp[0] += t - tp[1]; __syncthreads();
        const float v = (float)tp[0] * PROBE_SCALE; for (int i = tidx(); i < 128; i += 512) args.out[i] = v; }
#endif
}

#ifndef MK_PER_PHASE
#define MK_PER_PHASE 0
#endif
extern "C" void kernel_launch(void* const* d_in, const int* in_sizes, int n_in, void* d_out, int out_size, void* d_ws, size_t ws_size, hipStream_t stream) {
    static int grid = 0;
    if (grid == 0) {
        if (n_in != 24 || out_size != NB * SEQ * DM || ws_size < WS_TOTAL) { fprintf(stderr, "kernel_launch: unexpected shapes (n_in %d out %d ws %zu)\n", n_in, out_size, ws_size); grid = -1; return; }
        int dev = 0, cus = 0, per_cu = 0;
        hipGetDevice(&dev); hipDeviceGetAttribute(&cus, hipDeviceAttributeMultiprocessorCount, dev);
        hipFuncSetAttribute((const void*)mk_fwd<!MK_PER_PHASE>, hipFuncAttributeMaxDynamicSharedMemorySize, LDS_BYTES);
        hipOccupancyMaxActiveBlocksPerMultiprocessor(&per_cu, (const void*)mk_fwd<!MK_PER_PHASE>, 512, LDS_BYTES);
        if (per_cu < 1) { fprintf(stderr, "kernel_launch: occupancy query says %d blocks per CU\n", per_cu); per_cu = 1; }
        (void)hipGetLastError();
        grid = cus;
    }
    if (grid < 0) return;
    hipMemsetAsync((char*)d_ws + WS_CTL, 0, 524288, stream);
    Args a{};
    for (int i = 0; i < 24; ++i) a.in[i] = (const float*)d_in[i];
    a.out = (float*)d_out; a.ws = (unsigned char*)d_ws;
#if MK_PER_PHASE
    for (int p = 0; p < N_PHASES; ++p) { a.ph_lo = p; a.ph_hi = p + 1; hipLaunchKernelGGL(mk_fwd<false>, dim3(grid), dim3(512), LDS_BYTES, stream, a); }
#else
    a.ph_lo = 0; a.ph_hi = N_PHASES;
    void* kargs[] = {&a};
    hipError_t e = hipLaunchCooperativeKernel((const void*)mk_fwd<true>, dim3(grid), dim3(512), kargs, LDS_BYTES, stream);
    if (e != hipSuccess) fprintf(stderr, "cooperative launch failed: %s (grid %d)\n", hipGetErrorString(e), grid);
#endif
}
```

```cpp
#include <hip/hip_runtime.h>
#include <hip/hip_cooperative_groups.h>
#include <cstdio>
#include <cstdint>
namespace cg = cooperative_groups;

#define LAS __attribute__((address_space(3)))
typedef unsigned short bf16;
typedef short bf16x8 __attribute__((ext_vector_type(8)));
typedef float f32x4 __attribute__((ext_vector_type(4)));
typedef float f32x16 __attribute__((ext_vector_type(16)));
typedef unsigned u32x4 __attribute__((ext_vector_type(4)));
typedef unsigned u32x2 __attribute__((ext_vector_type(2)));

constexpr int DM = 1024, NB = 8, SEQ = 2048, CTXL = 256, GB = 4, NGRP = 2;
constexpr int MG_ROWS = GB * (SEQ + CTXL);
constexpr int LAT_ROWS = GB * SEQ;
constexpr int KEYS = CTXL + SEQ;
constexpr int IN_COLS = 7904, PC = 3840;
constexpr int WIN_N = 7936;
constexpr float EPS = 1e-6f;
constexpr int PC_KR = 0, PC_KB = 64, PC_VB = 192, PC_KC = 320, PC_VC = 576, PC_LRF = 1088, PC_KD = 1120, PC_VD = 1376, PC_PAD = 1632, PC_CKV = 1664,
              PC_CQ = 1792, PC_QB = 2048, PC_QC = 2560, PC_RC = 2816, PC_QD = 3328;
constexpr int SRC_GATE = 3808;
__host__ __device__ __forceinline__ int pcol_src(int n) {
    if (n < PC_KB) return 384 + (n - PC_KR);
    if (n < PC_VB) return 960 + (n - PC_KB);
    if (n < PC_KC) return 1088 + (n - PC_VB);
    if (n < PC_VC) return 1472 + (n - PC_KC);
    if (n < PC_LRF) return 1728 + (n - PC_VC);
    if (n < PC_KD) return 2752 + (n - PC_LRF);
    if (n < PC_VD) return 3296 + (n - PC_KD);
    if (n < PC_PAD) return 3552 + (n - PC_VD);
    if (n < PC_CKV) return -1;
    if (n < PC_CQ) return 256 + (n - PC_CKV);
    if (n < PC_QB) return n - PC_CQ;
    if (n < PC_QC) return 448 + (n - PC_QB);
    if (n < PC_RC) return 1216 + (n - PC_QC);
    if (n < PC_QD) return 2240 + (n - PC_RC);
    return 2784 + (n - PC_QD);
}
__host__ __device__ __forceinline__ int gperm_in(int q) {
    if (q >= 56) return q;
    const int idx = (q >> 3) * 4 + (q & 3);
    if ((q & 4) == 0) return idx < 4 ? 6 + idx : idx < 20 ? 18 + (idx - 4) : 43 + (idx - 20);
    return idx < 6 ? idx : idx < 14 ? 10 + (idx - 6) : idx == 14 ? 34 : idx < 23 ? 35 + (idx - 15) : idx == 23 ? 51 : 52 + (idx - 24);
}
__host__ __device__ __forceinline__ int gperm_mla(int q) {
    const int t = q >> 3, wc = q & 3;
    if ((q & 4) == 0 && t < 4) return 40 + t * 4 + wc;
    return t < 4 ? t * 4 + wc : 16 + (t - 4) * 8 + (q & 7);
}
constexpr size_t MiB = 1u << 20;
constexpr size_t WS_CTL = 0, CTL_BYTES = 1 * MiB;
constexpr size_t WS_RS = 131072;
constexpr size_t WS_MOD = 1 * MiB;
constexpr size_t WS_WT = 2 * MiB;
constexpr size_t WT_WIN = 0, WT_WMLA = WT_WIN + (size_t)WIN_N * 1024 * 2, WT_WB = WT_WMLA + (size_t)1792 * 384 * 2, WT_WO = WT_WB + (size_t)4096 * 512 * 2,
                 WT_W1 = WT_WO + (size_t)1024 * 1024 * 2, WT_W2 = WT_W1 + (size_t)4096 * 1024 * 2, WT_END = WT_W2 + (size_t)1024 * 4096 * 2;
static_assert(WT_END <= 40 * MiB, "weights");
constexpr size_t WS_XC1 = 42 * MiB;
constexpr size_t WS_H = 50 * MiB;
constexpr size_t WS_MG = 68 * MiB;
constexpr size_t WS_Y = 86 * MiB;
constexpr size_t WS_P = 122 * MiB;
constexpr size_t WS_CN = WS_P + (size_t)MG_ROWS * PC * 2;
constexpr size_t WS_QA = WS_CN + (size_t)MG_ROWS * 384 * 2;
constexpr size_t WS_KA = WS_QA + (size_t)MG_ROWS * 768 * 2;
constexpr size_t WS_VTA = WS_KA + (size_t)GB * 4 * KEYS * 192 * 2;
constexpr size_t WS_VTB = WS_VTA + (size_t)GB * 4 * 128 * KEYS * 2;
constexpr size_t WS_VTC = WS_VTB + (size_t)GB * 2 * 64 * KEYS * 2;
constexpr size_t WS_VTD = WS_VTC + (size_t)GB * 4 * 128 * KEYS * 2;
constexpr size_t WS_END = WS_VTD + (size_t)GB * 2 * 128 * KEYS * 2;
constexpr size_t WS_Z = WS_P;
static_assert(WS_Z + (size_t)MG_ROWS * 4096 * 2 <= WS_QA, "Z overlay must stay inside P|CN");
static_assert(WS_END <= 248 * MiB, "workspace");
constexpr size_t WS_H2 = 50 * MiB;
constexpr size_t WS_HID = 86 * MiB;
static_assert(WS_HID + (size_t)2 * MG_ROWS * 4096 * 2 <= 248 * MiB && WS_H2 + (size_t)2 * MG_ROWS * 1024 * 2 <= WS_HID, "merged MLP buffers");
constexpr size_t WS_MG0 = 248 * MiB;
constexpr size_t WT_WG8 = WT_WIN + (size_t)PC * 1024 * 2;
constexpr size_t WS_H8A = WS_WT + WT_WG8 + (size_t)4096 * 1024, WS_H8B = 266 * MiB; constexpr int H8_SPLIT = 16;
static_assert(WS_H8A + (size_t)H8_SPLIT * 256 * 1024 <= WS_WT + WT_WMLA, "H8 piece A");
constexpr size_t WS_TOTAL = 271 * MiB;
constexpr int LDS_BYTES = 147456;

__device__ __forceinline__ unsigned f2bf(float f) { unsigned u = __builtin_bit_cast(unsigned, f); return (u + 0x7fffu + ((u >> 16) & 1u)) >> 16; }
typedef float f32x2_t __attribute__((ext_vector_type(2))); typedef __bf16 bf16x2_t __attribute__((ext_vector_type(2)));
__device__ __forceinline__ unsigned pk2(float lo, float hi) { f32x2_t v = {lo, hi}; bf16x2_t b = __builtin_convertvector(v, bf16x2_t); return __builtin_bit_cast(unsigned, b); }
__device__ __forceinline__ float bf2f(unsigned short b) { return __builtin_bit_cast(float, (unsigned)b << 16); }
__device__ __forceinline__ float bflo(unsigned w) { return __builtin_bit_cast(float, w << 16); }
__device__ __forceinline__ float bfhi(unsigned w) { return __builtin_bit_cast(float, w & 0xffff0000u); }
#define SHFLX(v, m) __builtin_bit_cast(float, __builtin_amdgcn_ds_bpermute(((lane) ^ (m)) << 2, __builtin_bit_cast(int, (float)(v))))
__device__ __forceinline__ float wave_sum_l(float v, int lane) {
#pragma unroll
    for (int o = 1; o < 64; o <<= 1) v += SHFLX(v, o);
    return v;
}
#define wave_sum(v) wave_sum_l((v), lane)
constexpr int LDS_WTAB = LDS_BYTES - 512;
__device__ __forceinline__ unsigned hw_wave_slot() { return (unsigned)__builtin_amdgcn_s_getreg(((6 - 1) << 11) | 4) & 63u; }
__device__ __forceinline__ int tidx() {
    int l; asm volatile("v_mbcnt_lo_u32_b32 %0, -1, 0\n\tv_mbcnt_hi_u32_b32 %0, -1, %0" : "=v"(l));
    const int w = __builtin_amdgcn_readfirstlane(*(volatile LAS int*)(size_t)(LDS_WTAB + 4 * hw_wave_slot()));
    return (w << 6) | l;
}
__device__ __forceinline__ float sigmoid64(float x64) { return __builtin_amdgcn_rcpf(1.f + __builtin_amdgcn_exp2f(x64 * (-1.4426950408889634f / 64.f))); }
__device__ __forceinline__ float sigmoidf_(float x) { return __builtin_amdgcn_rcpf(1.f + __expf(-x)); }
__device__ __forceinline__ float siluf_(float x) { return x * __builtin_amdgcn_rcpf(1.f + __expf(-x)); }

namespace pg8 {
constexpr int BM = 256, BK = 64, HALF = 128, HTB = HALF * BK * 2, STAGE_BYTES = 8 * HTB, NXCD = 8, WGM = 8;
__host__ __device__ __forceinline__ int lds_byte(int r, int c) { const int st = (r >> 4) * 2 + (c >> 5), rr = r & 15, cc = c & 31, ob = rr * 64 + cc * 2; return st * 1024 + (ob ^ (((ob >> 9) & 1) << 5)); }
__host__ __device__ __forceinline__ void stage_rc(int b, int& R, int& C) { const int st = b / 1024, sb = b % 1024, swz = sb ^ (((sb >> 9) & 1) << 5); R = (st >> 1) * 16 + swz / 64; C = (st & 1) * 32 + (swz % 64) / 2; }
__host__ __device__ __forceinline__ int perm32(int rho) { const int n = rho >> 4, i = rho & 15; return 8 * (i >> 2) + 4 * n + (i & 3); }

struct Unit { int pm, pn; };
struct Gemm { const bf16* A; const bf16* Bt; int lda, ldb, K; int adiv, amul; int ksplit; const bf16* A2; int a2_from; };

struct StaticOrder {
    int nM, nN, nwg, G, c, map;
    __device__ void init(int nM_, int nN_, int G_, int c_, int map_ = 0) { nM = nM_; nN = nN_; nwg = nM * nN; G = G_; c = c_; map = map_; }
    __device__ bool next(int i, Unit& u) const {
        const long L = (long)i * G + c; if (L >= nwg) return false;
        int wgid = (int)L; { const int q = nwg / NXCD, r = nwg % NXCD, xcd = wgid % NXCD, off = wgid / NXCD; wgid = (xcd < r ? xcd * (q + 1) : r * (q + 1) + (xcd - r) * q) + off; }
        const int nig = WGM * nN, gid = wgid / nig, fm = gid * WGM, gsz = (nM - fm) < WGM ? (nM - fm) : WGM;
        u.pm = fm + ((wgid % nig) % gsz); u.pn = (wgid % nig) / gsz;
        if (map == 1) u.pm += 4 * (u.pm >> 5); else if (map == 2) u.pm = 32 + 36 * (u.pm >> 2) + (u.pm & 3); else if (map == 3) u.pm += 32; else if (map == 4) u.pm += 36;
        return true;
    }
};
typedef int v8i_t __attribute__((ext_vector_type(8)));
__device__ __forceinline__ v8i_t cat8(const bf16x8 lo, const bf16x8 hi) { const u32x4 a = __builtin_bit_cast(u32x4, lo), b = __builtin_bit_cast(u32x4, hi); v8i_t r; r[0] = (int)a.x; r[1] = (int)a.y; r[2] = (int)a.z; r[3] = (int)a.w; r[4] = (int)b.x; r[5] = (int)b.y; r[6] = (int)b.z; r[7] = (int)b.w; return r; }
template <class Epi, bool F8 = false>
__device__ __forceinline__ void gemm_phase(LAS unsigned char* lds, const Gemm g, const StaticOrder& S, const Epi& E) {
    const int tid = tidx(), wid = __builtin_amdgcn_readfirstlane(tid >> 6), lane = tid & 63, wr = wid >> 2, wc = wid & 3, fr = lane & 15, fq = lane >> 4;
    const int K = g.K, nt = K / BK;
    unsigned voffA[2], voffB[2];
#pragma unroll
    for (int i = 0; i < 2; ++i) { int R, C; stage_rc(tid * 16 + i * 8192, R, C); const int Rb = (R & ~31) + perm32(R & 31);
        voffA[i] = (unsigned)(R * g.lda + C) * 2u; voffB[i] = (unsigned)(Rb * g.ldb + C) * 2u; }
    const size_t kstep = (size_t)(BK * 2);
    const size_t hstepA = (size_t)HALF * g.lda * 2, hstepB = (size_t)HALF * g.ldb * 2;
    const size_t tstepA = 2 * hstepA, tstepB = 2 * hstepB;
    const unsigned ldsw = (unsigned)wid * 1024u;
    const int aoff = lds_byte(wr * 64 + fr, fq * 8), boff = lds_byte(wc * 32 + fr, fq * 8);
#define PG8_SA(b, h) (((b) * 2 + (h)) * HTB)
#define PG8_SB(b, h) ((4 + (b) * 2 + (h)) * HTB)
#define PG8_STAGE(bufoff, gbase, voff) do { _Pragma("unroll") for (int _i = 0; _i < 2; ++_i) { \
        const unsigned la_ = (unsigned)(size_t)(lds + (bufoff) + _i * 8192) + ldsw; const char* gb_ = (const char*)(gbase); \
        asm volatile("s_nop 1\n\ts_mov_b32 m0, %2\n\ts_nop 1\n\tglobal_load_lds_dwordx4 %0, %1" :: "v"((voff)[_i]), "s"(gb_), "s"(la_) : "memory", "m0"); } } while (0)
#define PG8_LDA(dst, b, h) do { _Pragma("unroll") for (int m = 0; m < 4; ++m) _Pragma("unroll") for (int k = 0; k < 2; ++k) dst[m][k] = *(const LAS bf16x8*)(lds + PG8_SA(b, h) + aoff + m * 2048 + k * 1024); } while (0)
#define PG8_LDB(dst, b, h) do { _Pragma("unroll") for (int n = 0; n < 2; ++n) _Pragma("unroll") for (int k = 0; k < 2; ++k) dst[n][k] = *(const LAS bf16x8*)(lds + PG8_SB(b, h) + boff + n * 2048 + k * 1024); } while (0)
#define PG8_MMA(ai, bj, At, Bt) do { __builtin_amdgcn_s_setprio(1); \
        if (F8) { _Pragma("unroll") for (int m = 0; m < 4; ++m) _Pragma("unroll") for (int n = 0; n < 2; ++n) \
            acc[ai][bj][m][n] = __builtin_amdgcn_mfma_scale_f32_16x16x128_f8f6f4(cat8(Bt[n][0], Bt[n][1]), cat8(At[m][0], At[m][1]), acc[ai][bj][m][n], 0, 0, 0, 0, 0, 0); } \
        else { _Pragma("unroll") for (int m = 0; m < 4; ++m) _Pragma("unroll") for (int n = 0; n < 2; ++n) _Pragma("unroll") for (int k = 0; k < 2; ++k) \
            acc[ai][bj][m][n] = __builtin_amdgcn_mfma_f32_16x16x32_bf16(Bt[n][k], At[m][k], acc[ai][bj][m][n], 0, 0, 0); } \
        __builtin_amdgcn_s_setprio(0); } while (0)
#define PG8_WAIT_V(n) asm volatile("s_waitcnt vmcnt(" #n ")" ::: "memory")
#define PG8_WAIT_L(n) asm volatile("s_waitcnt lgkmcnt(" #n ")" ::: "memory")
#define PG8_BAR __builtin_amdgcn_s_barrier()
#define PG8_SCHED __builtin_amdgcn_sched_barrier(0)
#define PG8_ABASE(u) ((g.A2 && (u).pm >= g.a2_from) ? (const char*)g.A2 + (size_t)((u).pm - g.a2_from) * tstepA : (const char*)g.A + (size_t)(u).pm * tstepA)
#define PG8_AOFF(u) ((size_t)(g.adiv ? ((u).pn / g.adiv) * g.amul * 2 : 0) + (size_t)(g.ksplit ? ((u).pn % g.ksplit) * g.K * 2 : 0))
#define PG8_BTILE(u) (g.ksplit ? (u).pn / g.ksplit : (u).pn)
#define PG8_BOFF(u) ((size_t)(g.ksplit ? ((u).pn % g.ksplit) * g.K * 2 : 0))
    Unit cur, nxt; int ui = 0;
    if (!S.next(0, cur)) return;
    f32x4 acc[2][2][4][2];
#pragma unroll
    for (int a = 0; a < 2; ++a)
#pragma unroll
        for (int b = 0; b < 2; ++b)
#pragma unroll
            for (int m = 0; m < 4; ++m)
#pragma unroll
                for (int n = 0; n < 2; ++n) acc[a][b][m][n] = (f32x4){0.f, 0.f, 0.f, 0.f};
    bf16x8 At[4][2], B0[2][2], B1[2][2];
    const char* cA = PG8_ABASE(cur) + PG8_AOFF(cur); const char* cB = (const char*)g.Bt + (size_t)PG8_BTILE(cur) * tstepB + PG8_BOFF(cur);
    PG8_STAGE(PG8_SB(0, 0), cB, voffB); PG8_STAGE(PG8_SB(0, 1), cB + hstepB, voffB); PG8_STAGE(PG8_SA(0, 0), cA, voffA); PG8_STAGE(PG8_SA(0, 1), cA + hstepA, voffA);
    if (wr == 1) PG8_BAR;
    PG8_WAIT_V(2); PG8_BAR;
    PG8_STAGE(PG8_SB(1, 0), cB + kstep, voffB); PG8_STAGE(PG8_SA(1, 0), cA + kstep, voffA); PG8_STAGE(PG8_SB(1, 1), cB + hstepB + kstep, voffB);
    PG8_WAIT_V(6); PG8_BAR;
    for (;;) {
        const bool has_next = S.next(ui + 1, nxt);
        const char* nA = has_next ? PG8_ABASE(nxt) + PG8_AOFF(nxt) : cA; const char* nB = has_next ? (const char*)g.Bt + (size_t)PG8_BTILE(nxt) * tstepB + PG8_BOFF(nxt) : cB;
#pragma unroll 1
        for (int t = 0; t < nt; t += 2) {
            const bool last = (t == nt - 2);
            const char* a1 = cA + (size_t)(t + 1) * kstep;
            const char* a2 = last ? nA : cA + (size_t)(t + 2) * kstep; const char* b2 = last ? nB : cB + (size_t)(t + 2) * kstep;
            const char* a3 = a2 + kstep; const char* b3 = b2 + kstep;
            PG8_LDB(B0, 0, 0); PG8_LDB(B1, 0, 1); PG8_SCHED; PG8_LDA(At, 0, 0); PG8_STAGE(PG8_SA(1, 1), a1 + hstepA, voffA);
            PG8_WAIT_V(8); PG8_WAIT_L(0); PG8_BAR; PG8_MMA(0, 0, At, B0); PG8_MMA(0, 1, At, B1); PG8_BAR; PG8_SCHED;
            PG8_LDA(At, 0, 1); PG8_STAGE(PG8_SB(0, 0), b2, voffB); PG8_STAGE(PG8_SB(0, 1), b2 + hstepB, voffB); PG8_STAGE(PG8_SA(0, 0), a2, voffA);
            PG8_WAIT_V(8); PG8_WAIT_L(0); PG8_BAR; PG8_MMA(1, 0, At, B0); PG8_MMA(1, 1, At, B1); PG8_BAR; PG8_SCHED;
            PG8_LDB(B0, 1, 0); PG8_LDB(B1, 1, 1); PG8_SCHED; PG8_LDA(At, 1, 0); PG8_STAGE(PG8_SA(0, 1), a2 + hstepA, voffA);
            PG8_WAIT_V(8); PG8_WAIT_L(0); PG8_BAR; PG8_MMA(0, 0, At, B0); PG8_MMA(0, 1, At, B1); PG8_BAR; PG8_SCHED;
            PG8_LDA(At, 1, 1); PG8_STAGE(PG8_SB(1, 0), b3, voffB); PG8_STAGE(PG8_SB(1, 1), b3 + hstepB, voffB); PG8_STAGE(PG8_SA(1, 0), a3, voffA);
            PG8_WAIT_V(8); PG8_WAIT_L(0); PG8_BAR; PG8_MMA(1, 0, At, B0); PG8_MMA(1, 1, At, B1); PG8_BAR; PG8_SCHED;
        }
        if (wr == 0) PG8_BAR;
        { const int l2_ = tidx() & 63; E(acc, cur, wr, wc, l2_ & 15, l2_ >> 4); }
        if (!has_next) break;
#pragma unroll
        for (int a = 0; a < 2; ++a)
#pragma unroll
            for (int b = 0; b < 2; ++b)
#pragma unroll
                for (int m = 0; m < 4; ++m)
#pragma unroll
                    for (int n = 0; n < 2; ++n) acc[a][b][m][n] = (f32x4){0.f, 0.f, 0.f, 0.f};
        cur = nxt; cA = nA; cB = nB; ++ui;
        if (wr == 1) PG8_BAR;
    }
    PG8_WAIT_V(0);
    PG8_BAR;
#undef PG8_SA
#undef PG8_SB
#undef PG8_STAGE
#undef PG8_LDA
#undef PG8_LDB
#undef PG8_MMA
#undef PG8_WAIT_V
#undef PG8_WAIT_L
#undef PG8_BAR
#undef PG8_SCHED
#undef PG8_AOFF
#undef PG8_ABASE
#undef PG8_BTILE
#undef PG8_BOFF
}
}

struct Args {
    const float* in[24];
    float* out; unsigned char* ws;
    int ph_lo, ph_hi;
};
enum { I_X = 0, I_C, I_CTX, I_CCTX, I_ADAW, I_ADAB, I_N1W, I_N2W, I_WIN, I_MQNW, I_MWUQ, I_MKVNW, I_MWUKV, I_SINK, I_GWD, I_GBD, I_GNW, I_QNW, I_KNW, I_WBR, I_WO, I_W1, I_W2, I_FNW };

struct Ctx {
    const Args* a; unsigned char* ws; int l, g;
};
__device__ __forceinline__ const float* xrow_src(const Args& a, int l, int g, int r) {
    if (r < LAT_ROWS) { const size_t gr = (size_t)(g * GB) * SEQ + r; return (l == 0 ? a.in[I_X] : a.out) + gr * DM; }
    const size_t cr = (size_t)(g * GB) * CTXL + (r - LAT_ROWS); return (l == 0 ? a.in[I_CTX] : (const float*)(a.ws + WS_XC1)) + cr * DM;
}
__device__ __forceinline__ float* xrow_dst(const Args& a, int g, int r) {
    if (r < LAT_ROWS) { const size_t gr = (size_t)(g * GB) * SEQ + r; return a.out + gr * DM; }
    const size_t cr = (size_t)(g * GB) * CTXL + (r - LAT_ROWS); return (float*)(a.ws + WS_XC1) + cr * DM;
}
__device__ __forceinline__ int row_bi(int g, int r) { return r < LAT_ROWS ? g * GB + (r >> 11) : 8; }
__device__ __forceinline__ void row_blk(int r, int& bl, int& kap) { if (r < LAT_ROWS) { bl = r >> 11; kap = CTXL + (r & 2047); } else { bl = (r - LAT_ROWS) >> 8; kap = (r - LAT_ROWS) & 255; } }

using pg8::Unit;
__device__ __forceinline__ void st16_wt(void* p, const u32x4 v) { asm volatile("global_store_dwordx4 %0, %1, off sc1\n\ts_nop 2" :: "v"(p), "v"(v)); }
__device__ __forceinline__ void st16_wt(void* p, const f32x4 v) { asm volatile("global_store_dwordx4 %0, %1, off sc1\n\ts_nop 2" :: "v"(p), "v"(v)); }
__device__ __forceinline__ void st8_wt(void* p, const u32x2 v) { asm volatile("global_store_dwordx2 %0, %1, off sc1" :: "v"(p), "v"(v)); }
__device__ __forceinline__ unsigned pk4_fp8(float a, float b, float c, float d) { int w; asm("" : "=v"(w));   w = __builtin_amdgcn_cvt_pk_fp8_f32(a, b, w, false); w = __builtin_amdgcn_cvt_pk_fp8_f32(c, d, w, true); return (unsigned)w; }
__device__ __forceinline__ void st16_wt_s(const void* base  , unsigned off, const u32x4 v) { asm volatile("s_nop 4\n\tglobal_store_dwordx4 %0, %1, %2 sc1\n\ts_nop 2" :: "v"(off), "v"(v), "s"(base)); }
__device__ __forceinline__ u32x4 pack8(const f32x4 v0, const f32x4 v1) { u32x4 w; w.x = pk2(v0[0], v0[1]); w.y = pk2(v0[2], v0[3]); w.z = pk2(v1[0], v1[1]); w.w = pk2(v1[2], v1[3]); return w; }

template <int ACT> struct EpiStore {
    bf16* O; int ldc; float ascale = 1.f;
    __device__ __forceinline__ void operator()(const f32x4 (&acc)[2][2][4][2], const Unit& u, int wr, int wc, int fr, int fq) const {
        const unsigned ldb2 = (unsigned)ldc * 2u, off0 = (unsigned)(u.pm * 256 + wr * 64 + fr) * ldb2 + (unsigned)(u.pn * 256 + wc * 32 + 8 * fq) * 2u;
#pragma unroll
        for (int ai = 0; ai < 2; ++ai)
#pragma unroll
            for (int m = 0; m < 4; ++m) { const unsigned offr = off0 + (unsigned)(ai * 128 + m * 16) * ldb2;
#pragma unroll
                for (int bj = 0; bj < 2; ++bj) { f32x4 v0 = acc[ai][bj][m][0] * ascale, v1 = acc[ai][bj][m][1] * ascale;
                    if (ACT == 1) {
#pragma unroll
                        for (int j = 0; j < 4; ++j) { const float a = fmaxf(v0[j], 0.f), b = fmaxf(v1[j], 0.f); v0[j] = a * a; v1[j] = b * b; } }
                    st16_wt_s(O, offr + bj * 256, pack8(v0, v1)); } }
    }
};
__device__ __forceinline__ void store_vt(const f32x4 (&acc)[2][2][4][2], int bj, bf16* vt, int nheads, int dv, int colbase  , int pm, int wr, int fr, int fq) {
    int bl, kap0; row_blk(pm * 256, bl, kap0);
    const int c0 = colbase + 8 * fq, head = c0 / dv, e0 = c0 - head * dv;
    bf16* vp = vt + ((size_t)(bl * nheads + head) * dv + e0) * KEYS + kap0 + wr * 64 + fr;
#pragma unroll
    for (int ai = 0; ai < 2; ++ai)
#pragma unroll
        for (int m = 0; m < 4; ++m)
#pragma unroll
            for (int n = 0; n < 2; ++n)
#pragma unroll
                for (int j = 0; j < 4; ++j) vp[(size_t)(4 * n + j) * KEYS + ai * 128 + m * 16] = (bf16)f2bf(acc[ai][bj][m][n][j]);
}
__device__ __forceinline__ void store_vt8(const f32x4 (&acc)[2][2][4][2], int bj, unsigned char* vt, int nheads, int dv, int colbase, int pm, int wr, int fr, int fq) {
    int bl, kap0; row_blk(pm * 256, bl, kap0);
    const int c0 = colbase + 8 * fq, head = c0 / dv, e0 = c0 - head * dv;
    unsigned char* vp = vt + ((size_t)(bl * nheads + head) * dv + e0) * KEYS + kap0 + wr * 64 + fr;
#pragma unroll
    for (int ai = 0; ai < 2; ++ai)
#pragma unroll
        for (int m = 0; m < 4; ++m)
#pragma unroll
            for (int n = 0; n < 2; ++n)
#pragma unroll
                for (int j = 0; j < 4; j += 2) { const unsigned w = (unsigned)__builtin_amdgcn_cvt_pk_fp8_f32(acc[ai][bj][m][n][j], acc[ai][bj][m][n][j + 1], 0, false);
                    vp[(size_t)(4 * n + j) * KEYS + ai * 128 + m * 16] = (unsigned char)(w & 0xffu); vp[(size_t)(4 * n + j + 1) * KEYS + ai * 128 + m * 16] = (unsigned char)((w >> 8) & 0xffu); }
}
struct EpiInProj {
    bf16* P; bf16 *vtb, *vtc, *vtd; float* rs;
    __device__ __forceinline__ void operator()(const f32x4 (&acc)[2][2][4][2], const Unit& u, int wr, int wc, int fr, int fq) const {
        const int row0 = u.pm * 256 + wr * 64 + fr; const int lane = fr + 16 * fq;
#pragma unroll
        for (int bj = 0; bj < 2; ++bj) {
            const int cg = 32 * gperm_in(u.pn * 8 + bj * 4 + wc);
            if (cg >= PC_VB && cg < PC_VB + 128) store_vt8(acc, bj, (unsigned char*)vtb, 2, 64, cg - PC_VB, u.pm, wr, fr, fq);
            else if (cg >= PC_VC && cg < PC_VC + 512) store_vt(acc, bj, vtc, 4, 128, cg - PC_VC, u.pm, wr, fr, fq);
            else if (cg >= PC_VD && cg < PC_VD + 256) store_vt8(acc, bj, (unsigned char*)vtd, 2, 128, cg - PC_VD, u.pm, wr, fr, fq);
            else {
                const bool lat = cg >= PC_CKV && cg < PC_QB; const int which = cg < PC_CQ ? 1 : 0;
#pragma unroll
                for (int ai = 0; ai < 2; ++ai)
#pragma unroll
                    for (int m = 0; m < 4; ++m) { const u32x4 w = pack8(acc[ai][bj][m][0], acc[ai][bj][m][1]); *(u32x4*)(P + (size_t)(row0 + ai * 128 + m * 16) * PC + cg + 8 * fq) = w;
                        if (lat) { float ss = (bflo(w.x) * bflo(w.x) + bfhi(w.x) * bfhi(w.x)) + (bflo(w.y) * bflo(w.y) + bfhi(w.y) * bfhi(w.y)) + (bflo(w.z) * bflo(w.z) + bfhi(w.z) * bfhi(w.z)) + (bflo(w.w) * bflo(w.w) + bfhi(w.w) * bfhi(w.w));
                            ss += SHFLX(ss, 16); ss += SHFLX(ss, 32);
                            if (fq == 0) atomicAdd(rs + (size_t)(row0 + ai * 128 + m * 16) * 2 + which, ss); } }
            }
        }
    }
};
struct EpiMla {
    bf16 *QA, *KA, *vta; const float* rs;
    __device__ __forceinline__ void operator()(const f32x4 (&acc_)[2][2][4][2], const Unit& u, int wr, int wc, int fr, int fq) const {
        f32x4 acc[2][2][4][2];
        const int cg0 = 32 * gperm_mla(u.pn * 8 + wc), cg1 = 32 * gperm_mla(u.pn * 8 + 4 + wc);
#pragma unroll
        for (int ai = 0; ai < 2; ++ai)
#pragma unroll
            for (int m = 0; m < 4; ++m) { const f32x2_t r2 = *(const f32x2_t*)(rs + (size_t)(u.pm * 256 + wr * 64 + fr + ai * 128 + m * 16) * 2);
                const float scq = rsqrtf(r2[0] * (1.f / 256.f) + EPS), sckv = rsqrtf(r2[1] * (1.f / 128.f) + EPS), s0 = cg0 < 768 ? scq : sckv, s1 = cg1 < 768 ? scq : sckv;
#pragma unroll
                for (int n = 0; n < 2; ++n) { acc[ai][0][m][n] = acc_[ai][0][m][n] * s0; acc[ai][1][m][n] = acc_[ai][1][m][n] * s1; } }
        const int row0 = u.pm * 256 + wr * 64 + fr;
        int bl, kap0; row_blk(u.pm * 256, bl, kap0);
#pragma unroll
        for (int bj = 0; bj < 2; ++bj) {
            const int cg = bj ? cg1 : cg0;
            if (cg < 768) {
#pragma unroll
                for (int ai = 0; ai < 2; ++ai)
#pragma unroll
                    for (int m = 0; m < 4; ++m) *(u32x4*)(QA + (size_t)(row0 + ai * 128 + m * 16) * 768 + cg + 8 * fq) = pack8(acc[ai][bj][m][0], acc[ai][bj][m][1]);
            } else if (cg < 1280) {
                const int c = cg - 768 + 8 * fq, head = c >> 7, j0 = c & 127;
#pragma unroll
                for (int ai = 0; ai < 2; ++ai)
#pragma unroll
                    for (int m = 0; m < 4; ++m) { const int kap = kap0 + ai * 128 + wr * 64 + m * 16 + fr;
                        *(u32x4*)(KA + ((size_t)(bl * 4 + head) * KEYS + kap) * 192 + j0) = pack8(acc[ai][bj][m][0], acc[ai][bj][m][1]); }
            } else store_vt8(acc, bj, (unsigned char*)vta, 4, 128, cg - 1280, u.pm, wr, fr, fq);
        }
    }
};
struct EpiMerge {
    const bf16* Z; bf16* MGo;
    __device__ __forceinline__ void operator()(const f32x4 (&acc)[2][2][4][2], const Unit& u, int wr, int wc, int fr, int fq) const {
        const int row0 = u.pm * 256 + wr * 64 + fr, d0 = u.pn * 64 + wc * 16 + fq * 4;
#pragma unroll
        for (int ai = 0; ai < 2; ++ai)
#pragma unroll
            for (int m = 0; m < 4; ++m) { const unsigned row = (unsigned)(row0 + ai * 128 + m * 16); float o[4] = {0.f, 0.f, 0.f, 0.f};
                const unsigned zb = (row * 4096u + (unsigned)d0) * 2u;
#pragma unroll
                for (int bj = 0; bj < 2; ++bj)
#pragma unroll
                    for (int n = 0; n < 2; ++n) { const int nb = 2 * bj + n; const u32x2 z = *(const u32x2*)((const char*)Z + (zb + (unsigned)nb * 2048u));
                        const f32x4 a = acc[ai][bj][m][n];
                        o[0] += sigmoid64(a[0]) * bflo(z.x); o[1] += sigmoid64(a[1]) * bfhi(z.x); o[2] += sigmoid64(a[2]) * bflo(z.y); o[3] += sigmoid64(a[3]) * bfhi(z.y); }
                u32x2 w; w.x = pk2(o[0], o[1]); w.y = pk2(o[2], o[3]); *(u32x2*)((char*)MGo + (row * 1024u + (unsigned)d0) * 2u) = w; }
    }
};
struct EpiPartial {
    float* part;
    __device__ __forceinline__ void operator()(const f32x4 (&acc)[2][2][4][2], const Unit& u, int wr, int wc, int fr, int fq) const {
        const int g = u.pm / 36, pml = u.pm - 36 * g, kp = u.pn & 3, pn = u.pn >> 2;
        float* base = part + ((size_t)kp * 2048 + (size_t)(g * 1024 + (pml - 32) * 256 + wr * 64 + fr)) * DM;
#pragma unroll
        for (int bj = 0; bj < 2; ++bj) { const int c0 = pn * 256 + bj * 128 + wc * 32 + 8 * fq;
#pragma unroll
            for (int ai = 0; ai < 2; ++ai)
#pragma unroll
                for (int m = 0; m < 4; ++m) { float* p = base + (size_t)(ai * 128 + m * 16) * DM + c0; *(f32x4*)p = acc[ai][bj][m][0]; *(f32x4*)(p + 4) = acc[ai][bj][m][1]; } }
    }
};
struct EpiResid {
    const Args* a; int l, g, chunk; bool from_dst; int nMg;
    __device__ __forceinline__ void operator()(const f32x4 (&acc)[2][2][4][2], const Unit& u, int wr, int wc, int fr, int fq) const {
        const int g = nMg ? u.pm / nMg : this->g; const int rt = (nMg ? u.pm - g * nMg : u.pm) * 256; const int bi = row_bi(g, rt);
        const float* src = from_dst ? (const float*)xrow_dst(*a, g, rt) : xrow_src(*a, l, g, rt); float* dst = xrow_dst(*a, g, rt);
        const float* mod = (const float*)(a->ws + WS_MOD) + ((size_t)(l * 9 + bi) * 6 + chunk) * 1024;
        const int rl0 = wr * 64 + fr;
#pragma unroll
        for (int bj = 0; bj < 2; ++bj) { const int c0 = u.pn * 256 + bj * 128 + wc * 32 + 8 * fq;
            const f32x4 g0 = *(const f32x4*)(mod + c0), g1 = *(const f32x4*)(mod + c0 + 4);
#pragma unroll
            for (int ai = 0; ai < 2; ++ai)
#pragma unroll
                for (int m = 0; m < 4; ++m) { const size_t off = (size_t)(rl0 + ai * 128 + m * 16) * DM + c0;
                    const f32x4 x0 = *(const f32x4*)(src + off), x1 = *(const f32x4*)(src + off + 4);
                    *(f32x4*)(dst + off) = x0 + g0 * acc[ai][bj][m][0]; *(f32x4*)(dst + off + 4) = x1 + g1 * acc[ai][bj][m][1]; } }
    }
};

__device__ __forceinline__ float wfetch(const Args& a, int kind, int l, int n, int k) {
    switch (kind) {
    case 0: {
        int src;
        if (n < PC) { src = pcol_src(32 * gperm_in(n >> 5) + (n & 31)); if (src < 0) return 0.f; }
        else { const int t = n - PC, tg = t >> 8, c = t & 255; const int nb = 2 * (c >> 7) + ((c >> 2) & 1), dd = 16 * ((c >> 5) & 3) + 4 * ((c >> 3) & 3) + (c & 3); src = SRC_GATE + nb * 1024 + 64 * tg + dd; }
        return a.in[I_WIN][((size_t)l * 1024 + k) * IN_COLS + src]; }
    case 1: {
        n = 32 * gperm_mla(n >> 5) + (n & 31);
        if (n < 768) return k >= 128 ? a.in[I_MWUQ][((size_t)l * 256 + (k - 128)) * 768 + n] * a.in[I_MQNW][l * 256 + (k - 128)] : 0.f;
        if (k >= 128) return 0.f;
        const int m = n - 768; const int src = m < 512 ? (m >> 7) * 256 + (m & 127) : ((m - 512) >> 7) * 256 + 128 + ((m - 512) & 127);
        return a.in[I_MWUKV][((size_t)l * 128 + k) * 1024 + src] * a.in[I_MKVNW][l * 128 + k]; }
    case 2: { const int nb = n >> 10, d = n & 1023; return a.in[I_WBR][(((size_t)l * 4 + nb) * 512 + k) * 1024 + d]; }
    case 3: return a.in[I_WO][((size_t)l * 1024 + k) * 1024 + n];
    case 4: return a.in[I_W1][((size_t)l * 1024 + k) * 4096 + n];
    default: return a.in[I_W2][((size_t)l * 4096 + k) * 1024 + n];
    }
}
__device__ __forceinline__ void transpose_item(const Args& a, int kind, int l, int K, bf16* WT, int item, int nblk, LAS float* scr, int lane) {
    const int kb = item / nblk, nb = item % nblk, k0 = 64 * kb, n0 = 32 * nb;
    float tv[32];
#pragma unroll
    for (int i = 0; i < 32; ++i) tv[i] = wfetch(a, kind, l, n0 + (lane & 31), k0 + 2 * i + (lane >> 5));
#pragma unroll
    for (int i = 0; i < 32; ++i) scr[(2 * i + (lane >> 5)) * 33 + (lane & 31)] = tv[i];
    asm volatile("s_waitcnt lgkmcnt(0)" ::: "memory");
    const int c = lane & 7;
    if ((kind == 0 && n0 >= PC) || kind == 2) {
        unsigned char* W8 = kind == 2 ? (unsigned char*)WT : (unsigned char*)WT + (size_t)PC * 1024 * 2; const int nr = kind == 2 ? n0 : n0 - PC; const float sc8 = kind == 2 ? 32.f : 64.f;
#pragma unroll
        for (int j = 0; j < 4; ++j) { const int n = (lane >> 3) + 8 * j; const LAS float* s = scr + (8 * c) * 33 + n;
            u32x2 o; o.x = pk4_fp8(sc8 * s[0 * 33], sc8 * s[1 * 33], sc8 * s[2 * 33], sc8 * s[3 * 33]); o.y = pk4_fp8(sc8 * s[4 * 33], sc8 * s[5 * 33], sc8 * s[6 * 33], sc8 * s[7 * 33]);
            st8_wt(W8 + (size_t)(nr + n) * K + k0 + 8 * c, o); }
    } else
#pragma unroll
    for (int j = 0; j < 4; ++j) { const int n = (lane >> 3) + 8 * j; const LAS float* s = scr + (8 * c) * 33 + n;
        u32x4 o; o.x = pk2(s[0 * 33], s[1 * 33]); o.y = pk2(s[2 * 33], s[3 * 33]); o.z = pk2(s[4 * 33], s[5 * 33]); o.w = pk2(s[6 * 33], s[7 * 33]);
        st16_wt(WT + (size_t)(n0 + n) * K + k0 + 8 * c, o); }
    asm volatile("s_waitcnt lgkmcnt(0)" ::: "memory");
}
__device__ __forceinline__ void prep_weights(const Args& a, int l, LAS unsigned char* lds, int it_lo = 0, int it_hi = 1 << 30) {
    const int tid = tidx(), lane = tid & 63, wave = tid >> 6;
    LAS float* scr = (LAS float*)(lds + wave * 8704);
    unsigned char* wt = a.ws + WS_WT;
    constexpr int I0 = 16 * (WIN_N / 32), I1 = 6 * (1792 / 32), I2 = 8 * (4096 / 32), I3 = 16 * (1024 / 32), I4 = 16 * (4096 / 32), I5 = 64 * (1024 / 32);
    const int gw = blockIdx.x * 8 + wave, NGW = gridDim.x * 8;
    const int it_end = it_hi < I0 + I1 + I2 + I3 + I4 + I5 ? it_hi : I0 + I1 + I2 + I3 + I4 + I5;
    for (int it = it_lo + gw; it < it_end; it += NGW) {
        int r = it;
        if (r < I0) { transpose_item(a, 0, l, 1024, (bf16*)(wt + WT_WIN), r, WIN_N / 32, scr, lane); continue; } r -= I0;
        if (r < I1) { transpose_item(a, 1, l, 384, (bf16*)(wt + WT_WMLA), r, 1792 / 32, scr, lane); continue; } r -= I1;
        if (r < I2) { transpose_item(a, 2, l, 512, (bf16*)(wt + WT_WB), r, 4096 / 32, scr, lane); continue; } r -= I2;
        if (r < I3) { transpose_item(a, 3, l, 1024, (bf16*)(wt + WT_WO), r, 1024 / 32, scr, lane); continue; } r -= I3;
        if (r < I4) { transpose_item(a, 4, l, 1024, (bf16*)(wt + WT_W1), r, 4096 / 32, scr, lane); continue; } r -= I4;
        transpose_item(a, 5, l, 4096, (bf16*)(wt + WT_W2), r, 1024 / 32, scr, lane);
    }
}
__device__ __forceinline__ void prep_weights_dyn(const Args& a, int l, LAS unsigned char* lds, int it_lo, int it_hi, unsigned* ctr) {
    const int tid = tidx(), lane = tid & 63, wave = tid >> 6;
    LAS float* scr = (LAS float*)(lds + wave * 8704);
    volatile LAS int* slot = (volatile LAS int*)(lds + LDS_BYTES - 16);
    unsigned char* wt = a.ws + WS_WT;
    constexpr int I0 = 16 * (WIN_N / 32), I1 = 6 * (1792 / 32), I2 = 8 * (4096 / 32), I3 = 16 * (1024 / 32), I4 = 16 * (4096 / 32);
    for (;;) {
        __syncthreads();
        if (tid == 0) *slot = (int)__hip_atomic_fetch_add(ctr, 8u, __ATOMIC_RELAXED, __HIP_MEMORY_SCOPE_AGENT);
        __syncthreads();
        const int base = __builtin_amdgcn_readfirstlane(*slot) + it_lo;
        if (base >= it_hi) break;
        int r = base + wave;
        if (r >= it_hi) continue;
        if (r < I0) { transpose_item(a, 0, l, 1024, (bf16*)(wt + WT_WIN), r, WIN_N / 32, scr, lane); continue; } r -= I0;
        if (r < I1) { transpose_item(a, 1, l, 384, (bf16*)(wt + WT_WMLA), r, 1792 / 32, scr, lane); continue; } r -= I1;
        if (r < I2) { transpose_item(a, 2, l, 512, (bf16*)(wt + WT_WB), r, 4096 / 32, scr, lane); continue; } r -= I2;
        if (r < I3) { transpose_item(a, 3, l, 1024, (bf16*)(wt + WT_WO), r, 1024 / 32, scr, lane); continue; } r -= I3;
        if (r < I4) { transpose_item(a, 4, l, 1024, (bf16*)(wt + WT_W1), r, 4096 / 32, scr, lane); continue; } r -= I4;
        transpose_item(a, 5, l, 4096, (bf16*)(wt + WT_W2), r, 1024 / 32, scr, lane);
    }
}
constexpr int PREP_EARLY_ITEMS = 16 * (WIN_N / 32) + 6 * (1792 / 32) + 8 * (4096 / 32) + 16 * (1024 / 32) + 16 * (4096 / 32);
__device__ __forceinline__ void xc_reduce_rows(const Args& a) {
    const int tid = tidx(), lane = tid & 63, gw = blockIdx.x * 8 + (tid >> 6), NGW = gridDim.x * 8;
    float* xc = (float*)(a.ws + WS_XC1); const float* part = (const float*)(a.ws + WS_H2);
    const float* mod = (const float*)(a.ws + WS_MOD) + ((size_t)(0 * 9 + 8) * 6 + 5) * 1024;
    for (int r = gw; r < 2048; r += NGW) {
#pragma unroll
        for (int j = 0; j < 4; ++j) { const int c = 4 * lane + 256 * j; const size_t o = (size_t)r * DM + c;
            const f32x4 s = *(const f32x4*)(part + o) + *(const f32x4*)(part + (size_t)2048 * DM + o) + *(const f32x4*)(part + (size_t)2 * 2048 * DM + o) + *(const f32x4*)(part + (size_t)3 * 2048 * DM + o);
            st16_wt(xc + o, *(const f32x4*)(xc + o) + *(const f32x4*)(mod + c) * s); }
    }
}
__device__ __forceinline__ void prep_mods(const Args& a, LAS unsigned char* lds, int item) {
    const int tid = tidx(), lane = tid & 63, wave = tid >> 6;
    LAS float* sc = (LAS float*)lds;
    LAS float* red = (LAS float*)(lds + 36864);
    {
        float cv[18];
#pragma unroll
        for (int j = 0; j < 18; ++j) { const int i = tid + 512 * j, bi = i >> 10, k = i & 1023; cv[j] = bi < 8 ? a.in[I_C][bi * 1024 + k] : a.in[I_CCTX][k]; }
#pragma unroll
        for (int j = 0; j < 18; ++j) sc[tid + 512 * j] = siluf_(cv[j]);
    }
    __syncthreads();
    const int l = item / 24, n0 = (item % 24) * 256 + 4 * lane;
    f32x4 acc[9];
#pragma unroll
    for (int b = 0; b < 9; ++b) acc[b] = (f32x4){0.f, 0.f, 0.f, 0.f};
    const float* w = a.in[I_ADAW] + ((size_t)l * 1024 + wave * 128) * 6144 + n0;
#pragma unroll 1
    for (int k0 = 0; k0 < 128; k0 += 16) {
        f32x4 wv[16];
#pragma unroll
        for (int k = 0; k < 16; ++k) wv[k] = *(const f32x4*)(w + (size_t)(k0 + k) * 6144);
#pragma unroll
        for (int k4 = 0; k4 < 16; k4 += 4)
#pragma unroll
            for (int b = 0; b < 9; ++b) { const f32x4 s4 = *(const LAS f32x4*)(sc + b * 1024 + wave * 128 + k0 + k4);
                acc[b] += wv[k4] * s4[0] + wv[k4 + 1] * s4[1] + wv[k4 + 2] * s4[2] + wv[k4 + 3] * s4[3]; }
    }
#pragma unroll
    for (int b = 0; b < 9; ++b) *(LAS f32x4*)(red + (wave * 9 + b) * 256 + 4 * lane) = acc[b];
    __syncthreads();
    for (int o = tid; o < 9 * 64; o += 512) {
        const int b = o >> 6, q = o & 63, n = (item % 24) * 256 + 4 * q;
        f32x4 sum = *(const f32x4*)(a.in[I_ADAB] + l * 6144 + n);
#pragma unroll
        for (int w8 = 0; w8 < 8; ++w8) sum += *(const LAS f32x4*)(red + (w8 * 9 + b) * 256 + 4 * q);
        st16_wt((float*)(a.ws + WS_MOD) + ((size_t)l * 9 + b) * 6144 + n, sum);
    }
    __syncthreads();
}

__device__ __forceinline__ void norm_mod_rows(const Args& a, int l, int g0, int nrows, int which  ,
                                              int r_lo = 0, int wg_lo = 0, int wg_n = 0  , bf16* Hov = nullptr  ) {
    const int tid = tidx(), lane = tid & 63; const int nwg = wg_n ? wg_n : (int)gridDim.x, wgi = (int)blockIdx.x - wg_lo;
    if (wgi < 0 || wgi >= nwg) return;
    const int gw = wgi * 8 + (tid >> 6), NGW = nwg * 8;
    const float* nw = a.in[which ? I_N2W : I_N1W] + l * DM;
    bf16* H = Hov ? Hov : (bf16*)(a.ws + (which ? WS_H2 : WS_H)); const int nMg = (l == 0) ? 36 : 32;
    for (int R = r_lo + gw; R < nrows; R += NGW) {
        int g = g0, r = R; if (which) { const int T = R >> 8; g = T / nMg; r = (T - g * nMg) * 256 + (R & 255); }
        const float* xr = which ? (const float*)xrow_dst(a, g, r) : xrow_src(a, l, g, r);
        const float* mod = (const float*)(a.ws + WS_MOD) + ((size_t)(l * 9 + row_bi(g, r)) * 6 + (which ? 3 : 0)) * 1024;
        f32x4 v[4]; float s = 0.f;
#pragma unroll
        for (int j = 0; j < 4; ++j) { v[j] = *(const f32x4*)(xr + 8 * lane + 512 * (j >> 1) + 4 * (j & 1)); s += (v[j][0] * v[j][0] + v[j][1] * v[j][1]) + (v[j][2] * v[j][2] + v[j][3] * v[j][3]); }
        const float rstd = rsqrtf(wave_sum(s) * (1.f / DM) + EPS);
#pragma unroll
        for (int h = 0; h < 2; ++h) { const int c = 8 * lane + 512 * h; f32x4 y[2];
#pragma unroll
            for (int q = 0; q < 2; ++q) { const f32x4 w = *(const f32x4*)(nw + c + 4 * q), sh = *(const f32x4*)(mod + c + 4 * q), sc = *(const f32x4*)(mod + 1024 + c + 4 * q);
#pragma unroll
                for (int e = 0; e < 4; ++e) y[q][e] = v[2 * h + q][e] * rstd * w[e] * (1.f + sc[e]) + sh[e]; }
            st16_wt(H + (size_t)R * DM + c, pack8(y[0], y[1]));
            if (!which) { unsigned char* h8 = a.ws + ((R >> 8) < H8_SPLIT ? WS_H8A + (size_t)R * 1024 : WS_H8B + (size_t)(R - H8_SPLIT * 256) * 1024) + c;
                u32x2 o8; o8.x = pk4_fp8(y[0][0], y[0][1], y[0][2], y[0][3]); o8.y = pk4_fp8(y[1][0], y[1][1], y[1][2], y[1][3]); st8_wt(h8, o8); } }
    }
}
__device__ __forceinline__ void final_norm_rows(const Args& a) {
    const int tid = tidx(), lane = tid & 63, gw = blockIdx.x * 8 + (tid >> 6), NGW = gridDim.x * 8;
    const float* nw = a.in[I_FNW];
    for (int r = gw; r < NB * SEQ; r += NGW) {
        float* xr = a.out + (size_t)r * DM;
        f32x4 v[4]; float s = 0.f;
#pragma unroll
        for (int j = 0; j < 4; ++j) { v[j] = *(const f32x4*)(xr + 4 * lane + 256 * j); s += (v[j][0] * v[j][0] + v[j][1] * v[j][1]) + (v[j][2] * v[j][2] + v[j][3] * v[j][3]); }
        const float rstd = rsqrtf(wave_sum(s) * (1.f / DM) + EPS);
#pragma unroll
        for (int j = 0; j < 4; ++j) { const int c = 4 * lane + 256 * j; const f32x4 w = *(const f32x4*)(nw + c); *(f32x4*)(xr + c) = v[j] * rstd * w; }
    }
}
__device__ __forceinline__ void rope_pair(float& x1, float& x2, int pos, int i, int quarter) {
    const float inv = exp2f(-(float)i * (13.287712379549449f / (float)quarter));
    const float ang = (float)pos * inv; const float s = __sinf(ang), c = __cosf(ang);
    const float a = x1 * c - x2 * s, b = x1 * s + x2 * c; x1 = a; x2 = b;
}
struct PostRegs { bf16 kr1, kr2, kb1, kb2, kd0, kd1, kd2, kd3; };
__device__ __forceinline__ PostRegs post_load(const bf16* P, int r, int lane) {
    const bf16* pr = P + (size_t)r * PC; PostRegs R;
    { const int d1 = 32 * ((lane >> 4) & 1) + (lane & 15); R.kr1 = pr[PC_KR + d1]; R.kr2 = pr[PC_KR + d1 + 16]; }
    { const int d1 = 64 * (lane >> 5) + 32 * ((lane >> 4) & 1) + (lane & 15); R.kb1 = pr[PC_KB + d1]; R.kb2 = pr[PC_KB + d1 + 16]; }
    { const bf16* kd = pr + PC_KD + 128 * (lane >> 5) + (lane & 31); R.kd0 = kd[0]; R.kd1 = kd[32]; R.kd2 = kd[64]; R.kd3 = kd[96]; }
    return R;
}
__device__ __forceinline__ void post_rows(const Args& a, int l) {
    const int tid = tidx(), lane = tid & 63, gw = blockIdx.x * 8 + (tid >> 6), NGW = gridDim.x * 8;
    bf16* P = (bf16*)(a.ws + WS_P); bf16* KA = (bf16*)(a.ws + WS_KA);
    const float* knw = a.in[I_KNW] + l * 128;
    if (gw >= MG_ROWS) return;
    PostRegs R = post_load(P, gw, lane);
#pragma unroll 1
    for (int r = gw; r < MG_ROWS; r += NGW) {
        const PostRegs Rn = post_load(P, r + NGW < MG_ROWS ? r + NGW : r, lane);
        bf16* pr = P + (size_t)r * PC;
        const bool lat = r < LAT_ROWS; const int t = r & 2047, rowp = t >> 6, colp = t & 63;
        int bl, kap; row_blk(r, bl, kap);
        if (lane < 32) {
            const int part = lane >> 4, i = lane & 15, d1 = 32 * part + i, d2 = d1 + 16;
            float x1 = bf2f(R.kr1), x2 = bf2f(R.kr2);
            if (lat) rope_pair(x1, x2, part ? colp : rowp, i, 16);
            const bf16 o1 = (bf16)f2bf(x1), o2 = (bf16)f2bf(x2);
#pragma unroll
            for (int h = 0; h < 4; ++h) { bf16* kd = KA + ((size_t)(bl * 4 + h) * KEYS + kap) * 192 + 128; kd[d1] = o1; kd[d2] = o2; }
        }
        if (lat) {
            const int hh = lane >> 5, part = (lane >> 4) & 1, i = lane & 15, d1 = 64 * hh + 32 * part + i, d2 = d1 + 16;
            float x1 = bf2f(R.kb1), x2 = bf2f(R.kb2);
            rope_pair(x1, x2, part ? colp : rowp, i, 16);
            pr[PC_KB + d1] = (bf16)f2bf(x1); pr[PC_KB + d2] = (bf16)f2bf(x2);
        }
        {
            const int hh = lane >> 5, i = lane & 31; bf16* kd = pr + PC_KD + 128 * hh;
            float x0 = bf2f(R.kd0), x1 = bf2f(R.kd1), x2 = bf2f(R.kd2), x3 = bf2f(R.kd3);
            float ss = x0 * x0 + x1 * x1 + x2 * x2 + x3 * x3;
#pragma unroll
            for (int o = 1; o < 32; o <<= 1) ss += SHFLX(ss, o);
            const float rstd = rsqrtf(ss * (1.f / 128.f) + EPS);
            x0 *= rstd * knw[i]; x1 *= rstd * knw[32 + i]; x2 *= rstd * knw[64 + i]; x3 *= rstd * knw[96 + i];
            if (lat) { rope_pair(x0, x1, rowp, i, 32); rope_pair(x2, x3, colp, i, 32); }
            kd[i] = (bf16)f2bf(x0); kd[32 + i] = (bf16)f2bf(x1); kd[64 + i] = (bf16)f2bf(x2); kd[96 + i] = (bf16)f2bf(x3);
        }
        R = Rn;
    }
}
__device__ __forceinline__ void comb_rows(const Args& a, int l, int nrows) {
    const int tid = tidx(), lane = tid & 63, gw = blockIdx.x * 8 + (tid >> 6), NGW = gridDim.x * 8;
    const bf16* P = (const bf16*)(a.ws + WS_P); bf16* Y = (bf16*)(a.ws + WS_Y); const bf16* OB = (const bf16*)(a.ws + WS_MG);
    const float* gnw = a.in[I_GNW] + l * 128;
    for (int r = gw; r < nrows; r += NGW) {
#pragma unroll
        for (int h = 0; h < 4; ++h) {
            const int e = 2 * lane;
            const unsigned wf = *(const unsigned*)(Y + (size_t)r * 2048 + 1024 + 128 * h + e), wb = *(const unsigned*)(OB + (size_t)r * 512 + 128 * h + e), wr_ = *(const unsigned*)(P + (size_t)r * PC + PC_RC + 128 * h + e);
            const float o0 = bflo(wf) + bflo(wb), o1 = bfhi(wf) + bfhi(wb);
            const float rstd = rsqrtf(wave_sum(o0 * o0 + o1 * o1) * (1.f / 128.f) + EPS);
            *(unsigned*)(Y + (size_t)r * 2048 + 1024 + 128 * h + e) = pk2(o0 * rstd * gnw[e] * siluf_(bflo(wr_)), o1 * rstd * gnw[e + 1] * siluf_(bfhi(wr_)));
        }
    }
}

struct AttnArgs {
    const bf16* Q; int qpitch;
    const bf16* Kc; const bf16* Kl; int kpitch;
    const bf16* Vt;
    unsigned char* O; int opitch;
    int qpos0, ntile, band_first;
    float sink_l2; const float* qnw;
};
__device__ __forceinline__ float max3f(float a, float b, float c) { float r; asm("v_max3_f32 %0, %1, %2, %3" : "=v"(r) : "v"(a), "v"(b), "v"(c)); return r; }
template <int DK, int DV, int MODE>
__device__ __forceinline__ void attn_unit(LAS unsigned char* lds, const AttnArgs& A) {
    constexpr bool PV8 = true;
    constexpr int KS = DK * 2 + 16, VS = PV8 ? 80 : 144, NS = DK / 16, NDT = DV / 32, KCH = DK / 8, NKC = KCH / 8, NVC = PV8 ? 1 : DV / 64;
    constexpr int V_OFF = 64 * KS, BUFSZ = V_OFF + DV * VS;
    static_assert(BUFSZ % 16 == 0 && 3 * BUFSZ <= LDS_BYTES - 64, "attention LDS");
    const int tid = tidx(), lane = tid & 63, wave = __builtin_amdgcn_readfirstlane(tid >> 6);
    const int r = lane & 31, h = lane >> 5;
    const bool lat = A.qpos0 >= 0;
    bf16x8 qf[NS];
    {
        float qv[NS][8];
        const bf16* qrow = A.Q + (size_t)(32 * wave + r) * A.qpitch + 8 * h;
#pragma unroll
        for (int s = 0; s < NS; ++s) { const u32x4 w = *(const u32x4*)(qrow + 16 * s);
            qv[s][0] = bflo(w.x); qv[s][1] = bfhi(w.x); qv[s][2] = bflo(w.y); qv[s][3] = bfhi(w.y); qv[s][4] = bflo(w.z); qv[s][5] = bfhi(w.z); qv[s][6] = bflo(w.w); qv[s][7] = bfhi(w.w); }
        if (MODE == 2) {
            float ss = 0.f;
#pragma unroll
            for (int s = 0; s < NS; ++s)
#pragma unroll
                for (int j = 0; j < 8; ++j) ss += qv[s][j] * qv[s][j];
            ss += SHFLX(ss, 32);
            const float rstd = rsqrtf(ss * (1.f / 128.f) + EPS);
#pragma unroll
            for (int s = 0; s < NS; ++s)
#pragma unroll
                for (int j = 0; j < 8; ++j) qv[s][j] *= rstd * A.qnw[16 * s + 8 * h + j];
        }
        if (lat) {
            const int pos = A.qpos0 + 32 * wave + r, rowp = pos >> 6, colp = pos & 63;
#pragma unroll
            for (int j = 0; j < 8; ++j) {
                if (MODE == 0) { rope_pair(qv[8][j], qv[9][j], rowp, 8 * h + j, 16); rope_pair(qv[10][j], qv[11][j], colp, 8 * h + j, 16); }
                if (MODE == 1) { rope_pair(qv[0][j], qv[1][j], rowp, 8 * h + j, 16); rope_pair(qv[2][j], qv[3][j], colp, 8 * h + j, 16); }
                if (MODE == 2) { rope_pair(qv[0][j], qv[2][j], rowp, 8 * h + j, 32); rope_pair(qv[1][j], qv[3][j], rowp, 16 + 8 * h + j, 32);
                                 rope_pair(qv[4][j], qv[6][j], colp, 8 * h + j, 32); rope_pair(qv[5][j], qv[7][j], colp, 16 + 8 * h + j, 32); }
            }
        }
        const float c = (MODE == 0 ? 0.07216878364870322f : MODE == 1 ? 0.125f : 0.08838834764831845f) * 1.4426950408889634f;
#pragma unroll
        for (int s = 0; s < NS; ++s) { u32x4 w; w.x = pk2(qv[s][0] * c, qv[s][1] * c); w.y = pk2(qv[s][2] * c, qv[s][3] * c); w.z = pk2(qv[s][4] * c, qv[s][5] * c); w.w = pk2(qv[s][6] * c, qv[s][7] * c);
            qf[s] = __builtin_bit_cast(bf16x8, w); }
    }
    float m_run = 0.f; f32x2_t l2 = {0.f, 0.f};
    f32x16 acc[NDT], negm;
#pragma unroll
    for (int d = 0; d < NDT; ++d)
#pragma unroll
        for (int i = 0; i < 16; ++i) acc[d][i] = 0.f;
#pragma unroll
    for (int i = 0; i < 16; ++i) negm[i] = 0.f;
    u32x4 kreg[NKC], vreg[NVC];
    const int qlo = A.qpos0 + 32 * wave;
#define ATT_K0(i) ((MODE == 1 && lat && (i) >= 4) ? CTXL + A.band_first + 64 * ((i) - 4) : 64 * (i))
#define ATT_LOAD(i) do { const int k0_ = ATT_K0(i); const bf16* kb_ = ((k0_ < CTXL) ? A.Kc + (size_t)k0_ * A.kpitch : A.Kl + (size_t)(k0_ - CTXL) * A.kpitch) + (size_t)(tid >> 3) * A.kpitch + 8 * (tid & 7); \
        _Pragma("unroll") for (int c_ = 0; c_ < NKC; ++c_) kreg[c_] = *(const u32x4*)(kb_ + 64 * c_); \
        if (PV8) { if (DV == 128 || tid < 4 * DV) vreg[0] = *(const u32x4*)((const unsigned char*)A.Vt + (size_t)(tid >> 2) * KEYS + k0_ + 16 * (tid & 3)); } else { \
        const bf16* vb_ = A.Vt + (size_t)(tid >> 3) * KEYS + k0_ + 8 * (tid & 7); \
        _Pragma("unroll") for (int p_ = 0; p_ < NVC; ++p_) vreg[p_] = *(const u32x4*)(vb_ + (size_t)(64 * p_) * KEYS); } } while (0)
#define ATT_WRITE(boff) do { LAS unsigned char* kw_ = lds + (boff) + (tid >> 3) * KS + (tid & 7) * 16; \
        _Pragma("unroll") for (int c_ = 0; c_ < NKC; ++c_) *(LAS u32x4*)(kw_ + 128 * c_) = kreg[c_]; \
        if (PV8) { if (DV == 128 || tid < 4 * DV) { LAS unsigned char* vw8_ = lds + (boff) + V_OFF + (tid >> 2) * VS + 8 * (tid & 3); u32x2 lo_, hi_; lo_.x = vreg[0].x; lo_.y = vreg[0].z; hi_.x = vreg[0].y; hi_.y = vreg[0].w;     \
            *(LAS u32x2*)vw8_ = lo_; *(LAS u32x2*)(vw8_ + 32) = hi_; } } else { \
        LAS unsigned char* vw_ = lds + (boff) + V_OFF + (tid >> 3) * VS + ((tid & 7) >> 1) * 32 + (tid & 1) * 8;     \
        _Pragma("unroll") for (int p_ = 0; p_ < NVC; ++p_) { u32x2 lo_, hi_; lo_.x = vreg[p_].x; lo_.y = vreg[p_].y; hi_.x = vreg[p_].z; hi_.y = vreg[p_].w; \
            *(LAS u32x2*)(vw_ + 64 * p_ * VS) = lo_; *(LAS u32x2*)(vw_ + 64 * p_ * VS + 16) = hi_; } } } while (0)
#define ATT_VLD(m) (*(const LAS bf16x8*)(vb + ((m) % NDT) * 32 * VS + (32 * ((m) / (2 * NDT)) + 16 * (((m) / NDT) & 1)) * 2))
    constexpr float THR = 8.f;
    constexpr int NM = 4 * NDT;
    constexpr int KD = (MODE == 0) ? 3 : 4, VD = 4;
    ATT_LOAD(0);
    __syncthreads();
    ATT_WRITE(0);
    __syncthreads();
    int b_cur = 0;
#pragma unroll 1
    for (int it = 0; it < A.ntile; ++it) {
        const bool more = it + 1 < A.ntile;
        if (more) ATT_LOAD(it + 1);
        f32x16 sc0, sc1;
        {
            const LAS unsigned char* kb = lds + b_cur + r * KS + 16 * h;
            bf16x8 kfr[KD][2];
#pragma unroll
            for (int d_ = 0; d_ < KD; ++d_) { kfr[d_][0] = *(const LAS bf16x8*)(kb + 32 * d_); kfr[d_][1] = *(const LAS bf16x8*)(kb + 32 * KS + 32 * d_); }
            __builtin_amdgcn_s_setprio(1);
#pragma unroll
            for (int s = 0; s < NS; ++s) {
                if (s == 0) { sc0 = __builtin_amdgcn_mfma_f32_32x32x16_bf16(kfr[0][0], qf[0], negm, 0, 0, 0); sc1 = __builtin_amdgcn_mfma_f32_32x32x16_bf16(kfr[0][1], qf[0], negm, 0, 0, 0); }
                else { sc0 = __builtin_amdgcn_mfma_f32_32x32x16_bf16(kfr[s % KD][0], qf[s], sc0, 0, 0, 0); sc1 = __builtin_amdgcn_mfma_f32_32x32x16_bf16(kfr[s % KD][1], qf[s], sc1, 0, 0, 0); }
                if (s + KD < NS) { kfr[s % KD][0] = *(const LAS bf16x8*)(kb + 32 * (s + KD)); kfr[s % KD][1] = *(const LAS bf16x8*)(kb + 32 * KS + 32 * (s + KD)); }
            }
            __builtin_amdgcn_s_setprio(0);
        }
        if (MODE == 1 && lat && it >= 4) { const int qpos = qlo + r, kb0 = A.band_first + 64 * (it - 4) + 4 * h;
#pragma unroll
            for (int i = 0; i < 16; ++i) { const int kpos = kb0 + (i & 3) + 8 * (i >> 2); const int d0 = qpos - kpos, d1 = d0 - 32;
                if (d0 > 128 || d0 < -128) sc0[i] = -INFINITY;
                if (d1 > 128 || d1 < -128) sc1[i] = -INFINITY; } }
        float mt = max3f(sc0[0], sc1[0], sc0[1]);
        mt = max3f(mt, sc1[1], sc0[2]);
#pragma unroll
        for (int i = 2; i < 15; ++i) mt = max3f(mt, sc1[i], sc0[i + 1]);
        mt = fmaxf(mt, sc1[15]);
        mt = fmaxf(mt, SHFLX(mt, 32));
        if (it == 0 || !__all(mt <= THR)) {
            const float dl = it == 0 ? mt : fmaxf(mt, 0.f);
            m_run += dl;
#pragma unroll
            for (int i = 0; i < 16; ++i) { sc0[i] -= dl; sc1[i] -= dl; negm[i] = -m_run; }
            if (it > 0) { const float alpha = __builtin_amdgcn_exp2f(-dl); l2 *= alpha;
#pragma unroll
                for (int d = 0; d < NDT; ++d)
#pragma unroll
                    for (int i = 0; i < 16; ++i) acc[d][i] *= alpha; }
        }
#pragma unroll
        for (int i = 0; i < 16; i += 2) {
            f32x2_t p0 = {__builtin_amdgcn_exp2f(sc0[i]), __builtin_amdgcn_exp2f(sc0[i + 1])}, p1 = {__builtin_amdgcn_exp2f(sc1[i]), __builtin_amdgcn_exp2f(sc1[i + 1])};
            l2 += p0; l2 += p1; sc0[i] = p0[0]; sc0[i + 1] = p0[1]; sc1[i] = p1[0]; sc1[i + 1] = p1[1]; }
        if (PV8) {
            typedef int av8i_t __attribute__((ext_vector_type(8)));
            av8i_t pf8;
#pragma unroll
            for (int j = 0; j < 4; ++j) { pf8[j] = (int)pk4_fp8(sc0[4 * j], sc0[4 * j + 1], sc0[4 * j + 2], sc0[4 * j + 3]); pf8[4 + j] = (int)pk4_fp8(sc1[4 * j], sc1[4 * j + 1], sc1[4 * j + 2], sc1[4 * j + 3]); }
            const LAS unsigned char* vb = lds + b_cur + V_OFF + r * VS + 32 * h;
#define ATT_VLD8(d) ({ const u32x4 lo_ = *(const LAS u32x4*)(vb + (d) * 32 * VS), hi_ = *(const LAS u32x4*)(vb + (d) * 32 * VS + 16); (av8i_t){(int)lo_.x, (int)lo_.y, (int)lo_.z, (int)lo_.w, (int)hi_.x, (int)hi_.y, (int)hi_.z, (int)hi_.w}; })
            av8i_t vf[NDT];
#pragma unroll
            for (int d = 0; d < NDT; ++d) vf[d] = ATT_VLD8(d);
            __builtin_amdgcn_s_setprio(1);
#pragma unroll
            for (int d = 0; d < NDT; ++d) acc[d] = __builtin_amdgcn_mfma_scale_f32_32x32x64_f8f6f4(vf[d], pf8, acc[d], 0, 0, 0, 0, 0, 0);
#undef ATT_VLD8
            __builtin_amdgcn_s_setprio(0);
        } else {
        bf16x8 pf[2][2];
#pragma unroll
        for (int u = 0; u < 2; ++u) {
            u32x4 w0, w1;
            w0.x = pk2(sc0[8 * u + 0], sc0[8 * u + 1]); w0.y = pk2(sc0[8 * u + 2], sc0[8 * u + 3]); w0.z = pk2(sc0[8 * u + 4], sc0[8 * u + 5]); w0.w = pk2(sc0[8 * u + 6], sc0[8 * u + 7]);
            w1.x = pk2(sc1[8 * u + 0], sc1[8 * u + 1]); w1.y = pk2(sc1[8 * u + 2], sc1[8 * u + 3]); w1.z = pk2(sc1[8 * u + 4], sc1[8 * u + 5]); w1.w = pk2(sc1[8 * u + 6], sc1[8 * u + 7]);
            pf[0][u] = __builtin_bit_cast(bf16x8, w0); pf[1][u] = __builtin_bit_cast(bf16x8, w1);
        }
        {
            const LAS unsigned char* vb = lds + b_cur + V_OFF + r * VS + 16 * h;
            bf16x8 vfr[VD];
#pragma unroll
            for (int d_ = 0; d_ < VD; ++d_) vfr[d_] = ATT_VLD(d_);
            __builtin_amdgcn_s_setprio(1);
#pragma unroll
            for (int m = 0; m < NM; ++m) {
                acc[m % NDT] = __builtin_amdgcn_mfma_f32_32x32x16_bf16(vfr[m % VD], pf[m / (2 * NDT)][(m / NDT) & 1], acc[m % NDT], 0, 0, 0);
                if (m + VD < NM) vfr[m % VD] = ATT_VLD(m + VD);
            }
            __builtin_amdgcn_s_setprio(0);
        }
        }
        if (more) ATT_WRITE(b_cur ^ BUFSZ);
        __syncthreads();
        b_cur ^= BUFSZ;
    }
#undef ATT_LOAD
#undef ATT_WRITE
#undef ATT_K0
#undef ATT_VLD
    float l_run = l2[0] + l2[1];
    l_run += SHFLX(l_run, 32);
    if (MODE == 1) l_run += __builtin_amdgcn_exp2f(A.sink_l2 - m_run);
    const float inv = 16.f / l_run;
    unsigned char* orow = A.O + (size_t)(32 * wave + r) * A.opitch + 8 * h;
#pragma unroll
    for (int d = 0; d < NDT; ++d)
#pragma unroll
        for (int kp = 0; kp < 2; ++kp) {
            const int i0 = 8 * kp, i1 = 8 * kp + 4;
            const unsigned ga = pk4_fp8(acc[d][i0] * inv, acc[d][i0 + 1] * inv, acc[d][i0 + 2] * inv, acc[d][i0 + 3] * inv), gb = pk4_fp8(acc[d][i1] * inv, acc[d][i1 + 1] * inv, acc[d][i1 + 2] * inv, acc[d][i1 + 3] * inv);
            const auto sw = __builtin_amdgcn_permlane32_swap(ga, gb, false, false);
            u32x2 o; o.x = sw[0]; o.y = sw[1];
            *(u32x2*)(orow + 32 * d + 16 * kp) = o;
        }
}

constexpr size_t WS_GU = WS_MG;
constexpr size_t WS_GDL = WS_MOD + 512 * 1024;
constexpr int CW_GLA = 8192;
__device__ __forceinline__ float logsigmoidf_(float x) { return fminf(x, 0.f) - __logf(1.f + __expf(-fabsf(x))); }
struct GlaArgs { const bf16* P; const bf16* VtC; bf16* Y; bf16* GU; float* GDL; unsigned* cnt; const float* wd; const float* bd; const float* gnw; int need_ctx; };
__device__ __forceinline__ void gla_rows(int c, int dir, int bl, int& row0, int& kap0) {
    if (c < 4) { const int ch = dir ? 3 - c : c; row0 = LAT_ROWS + bl * CTXL + 64 * ch; kap0 = 64 * ch; }
    else { const int ch = dir ? 35 - c : c - 4; row0 = bl * SEQ + 64 * ch; kap0 = CTXL + 64 * ch; }
}
constexpr int GL_RS = 144;
constexpr int GO_RQ = 0, GO_RK = 9216, GO_VT = 18432, GO_LR = 36864  , GO_WD = 40960  , GO_BD = 49152  , GO_GT = 49664, GO_DL = 51712, GO_QT = 51968, GO_KT = 61184,
              GO_KH = 70400, GO_AT = 79616, GO_ST = 88832, GO_RED = 107264  , GO_END = 108288;
__device__ __forceinline__ void gla_decay(LAS unsigned char* lds, int dsel, int dir, int wave, int d, float (&cum)[8], float& tot) {
    float la[8];
    {
        float wdv[16];
#pragma unroll
        for (int q = 0; q < 16; ++q) wdv[q] = ((const LAS float*)(lds + GO_WD + dsel * 4096))[q * 64 + d];
        const float bdv = ((const LAS float*)(lds + GO_BD + dsel * 256))[d];
#pragma unroll
        for (int i = 0; i < 8; ++i) { const LAS unsigned* lr = (const LAS unsigned*)(lds + GO_LR + dsel * 2048 + (8 * wave + i) * 32); float x = bdv;
#pragma unroll
            for (int q = 0; q < 8; ++q) { const unsigned w = lr[q]; x += bflo(w) * wdv[2 * q] + bfhi(w) * wdv[2 * q + 1]; }
            la[i] = logsigmoidf_(x) * (1.f / 16.f); }
    }
    float s = 0.f;
    if (dir == 0) {
#pragma unroll
        for (int i = 0; i < 8; ++i) { s += la[i]; cum[i] = s; } }
    else {
#pragma unroll
        for (int i = 7; i >= 0; --i) { s += la[i]; cum[i] = s; } }
    ((LAS float*)(lds + GO_GT))[wave * 64 + d] = s;
    __syncthreads();
    float pre = 0.f; tot = 0.f;
#pragma unroll
    for (int w8 = 0; w8 < 8; ++w8) { const float gt = ((const LAS float*)(lds + GO_GT))[w8 * 64 + d]; tot += gt; if (dir == 0 ? (w8 < wave) : (w8 > wave)) pre += gt; }
#pragma unroll
    for (int i = 0; i < 8; ++i) cum[i] += pre;
}
__device__ __forceinline__ void gla_signal(unsigned* word, unsigned v, int tid) {
    asm volatile("s_waitcnt vmcnt(0)" ::: "memory");
    __syncthreads();
    if (tid == 0) { __builtin_amdgcn_fence(__ATOMIC_RELEASE, "agent"); asm volatile("s_waitcnt vmcnt(0)" ::: "memory"); __hip_atomic_fetch_add(word, v, __ATOMIC_RELAXED, __HIP_MEMORY_SCOPE_AGENT); }
}
__device__ __forceinline__ void gla_wait(unsigned* w0, unsigned* w1, unsigned need, int tid) {
    if (tid == 0) {
        unsigned sp = 0;
        while (__hip_atomic_load(w0, __ATOMIC_RELAXED, __HIP_MEMORY_SCOPE_AGENT) < need || __hip_atomic_load(w1, __ATOMIC_RELAXED, __HIP_MEMORY_SCOPE_AGENT) < need) { __builtin_amdgcn_s_sleep(2); if (++sp > (1u << 22)) break; }
        __builtin_amdgcn_fence(__ATOMIC_ACQUIRE, "agent");
        asm volatile("s_waitcnt vmcnt(0)" ::: "memory");
    }
    __syncthreads();
}
__device__ __forceinline__ void gla_local(LAS unsigned char* lds, const GlaArgs& G, int chain, int c) {
    const int tid = tidx(), lane = tid & 63, wave = __builtin_amdgcn_readfirstlane(tid >> 6), r = lane & 31, hh = lane >> 5;
    const int dir = chain & 1, h = (chain >> 1) & 3, bl = chain >> 3;
    int row0, kap0; gla_rows(c, dir, bl, row0, kap0);
    const bf16* pr = G.P + (size_t)(row0 + (tid >> 3)) * PC + 8 * (tid & 7);
    const u32x4 rk = *(const u32x4*)(pr + PC_KC + 64 * h);
    const bf16* vp = G.VtC + ((size_t)(bl * 4 + h) * 128 + (tid >> 3)) * KEYS + kap0 + 8 * (tid & 7);
    const u32x4 rv0 = *(const u32x4*)vp, rv1 = *(const u32x4*)(vp + (size_t)64 * KEYS);
    u32x4 rl = {0u, 0u, 0u, 0u};
    if (tid < 128) rl = *(const u32x4*)(G.P + (size_t)(row0 + (tid >> 1)) * PC + PC_LRF + 16 * dir + 8 * (tid & 1));
    __syncthreads();
    for (int i = tid; i < 1024; i += 512) ((LAS float*)(lds + GO_WD))[i] = G.wd[(size_t)dir * 4096 + (size_t)(i >> 6) * 256 + 64 * h + (i & 63)];
    if (tid < 64) ((LAS float*)(lds + GO_BD))[tid] = G.bd[dir * 256 + 64 * h + tid];
    *(LAS u32x4*)(lds + GO_RK + (tid >> 3) * GL_RS + (tid & 7) * 16) = rk;
    *(LAS u32x4*)(lds + GO_VT + (tid >> 3) * GL_RS + (tid & 7) * 16) = rv0; *(LAS u32x4*)(lds + GO_VT + (64 + (tid >> 3)) * GL_RS + (tid & 7) * 16) = rv1;
    if (tid < 128) *(LAS u32x4*)(lds + GO_LR + (tid >> 1) * 32 + (tid & 1) * 16) = rl;
    __syncthreads();
    const int d = lane; float cum[8], tot;
    gla_decay(lds, 0, dir, wave, d, cum, tot);
    if (wave == 0) G.GDL[((size_t)chain * 36 + c) * 64 + d] = __expf(tot);
    {
        unsigned kh[4];
#pragma unroll
        for (int i = 0; i < 8; ++i) { const int s = 8 * wave + i; const float kv = bf2f(*(const LAS bf16*)(lds + GO_RK + s * GL_RS + 2 * d));
            const unsigned khv = f2bf(kv * __expf(tot - cum[i]));
            if (i & 1) kh[i >> 1] |= khv << 16; else kh[i >> 1] = khv; }
        u32x4 w; w.x = kh[0]; w.y = kh[1]; w.z = kh[2]; w.w = kh[3];
        *(LAS u32x4*)(lds + GO_KH + d * GL_RS + 16 * wave) = w;
    }
    __syncthreads();
    const int et = wave >> 1, dt = wave & 1;
    f32x16 u;
#pragma unroll
    for (int i = 0; i < 16; ++i) u[i] = 0.f;
#pragma unroll
    for (int kk = 0; kk < 4; ++kk) { const bf16x8 af = *(const LAS bf16x8*)(lds + GO_VT + (32 * et + r) * GL_RS + (16 * kk + 8 * hh) * 2), bfr = *(const LAS bf16x8*)(lds + GO_KH + (32 * dt + r) * GL_RS + (16 * kk + 8 * hh) * 2);
        u = __builtin_amdgcn_mfma_f32_32x32x16_bf16(af, bfr, u, 0, 0, 0); }
    bf16* up = G.GU + ((size_t)chain * 36 + c) * 8192 + 32 * dt + r;
#pragma unroll
    for (int i = 0; i < 16; ++i) { const int e = 32 * et + (i & 3) + 8 * (i >> 2) + 4 * hh; up[e * 64] = (bf16)f2bf(u[i]); }
}
__device__ __forceinline__ void gla_scan(const GlaArgs& G, int chain, int quarter) {
    const int tid = tidx();
    const int e = 32 * quarter + (tid >> 4), d0 = 4 * (tid & 15);
    bf16* up = G.GU + (size_t)chain * 36 * 8192 + e * 64 + d0; const float* dlp = G.GDL + (size_t)chain * 36 * 64 + d0;
    float S[4] = {0.f, 0.f, 0.f, 0.f};
#pragma unroll 1
    for (int c0 = 0; c0 < 36; c0 += 12) {
        u32x2 uu[12]; f32x4 dl[12];
#pragma unroll
        for (int j = 0; j < 12; ++j) { uu[j] = *(const u32x2*)(up + (size_t)(c0 + j) * 8192); dl[j] = *(const f32x4*)(dlp + (c0 + j) * 64); }
#pragma unroll
        for (int j = 0; j < 12; ++j) {
            S[0] = dl[j][0] * S[0] + bflo(uu[j].x); S[1] = dl[j][1] * S[1] + bfhi(uu[j].x); S[2] = dl[j][2] * S[2] + bflo(uu[j].y); S[3] = dl[j][3] * S[3] + bfhi(uu[j].y);
            const unsigned long long w = (unsigned long long)pk2(S[0], S[1]) | ((unsigned long long)pk2(S[2], S[3]) << 32);
            __hip_atomic_store((unsigned long long*)(up + (size_t)(c0 + j) * 8192), w, __ATOMIC_RELAXED, __HIP_MEMORY_SCOPE_AGENT); }
    }
    asm volatile("s_waitcnt vmcnt(0)" ::: "memory");
    __syncthreads();
    if (tid == 0) __hip_atomic_fetch_add(G.cnt + chain * 16, 100u, __ATOMIC_RELAXED, __HIP_MEMORY_SCOPE_AGENT);
}
__device__ __forceinline__ void gla_out(LAS unsigned char* lds, const GlaArgs& G, int bh, int j) {
    const int tid = tidx(), lane = tid & 63, wave = __builtin_amdgcn_readfirstlane(tid >> 6), r = lane & 31, hh = lane >> 5;
    const int h = bh & 3, bl = bh >> 2;
    const bool isctx = j >= 32; const int ch = isctx ? j - 32 : j;
    const int row0 = isctx ? LAT_ROWS + bl * CTXL + 64 * ch : bl * SEQ + 64 * ch, kap0 = isctx ? 64 * ch : CTXL + 64 * ch;
    const bf16* pr = G.P + (size_t)(row0 + (tid >> 3)) * PC + 8 * (tid & 7);
    const u32x4 rq = *(const u32x4*)(pr + PC_QC + 64 * h), rk = *(const u32x4*)(pr + PC_KC + 64 * h);
    const bf16* vp = G.VtC + ((size_t)(bl * 4 + h) * 128 + (tid >> 3)) * KEYS + kap0 + 8 * (tid & 7);
    const u32x4 rv0 = *(const u32x4*)vp, rv1 = *(const u32x4*)(vp + (size_t)64 * KEYS);
    u32x4 rl = {0u, 0u, 0u, 0u};
    if (tid < 256) rl = *(const u32x4*)(G.P + (size_t)(row0 + ((tid & 127) >> 1)) * PC + PC_LRF + 16 * (tid >> 7) + 8 * (tid & 1));
    __syncthreads();
    for (int i = tid; i < 2048; i += 512) { const int dsel = i >> 10, q = (i >> 6) & 15, dd = i & 63; ((LAS float*)(lds + GO_WD))[i] = G.wd[(size_t)dsel * 4096 + (size_t)q * 256 + 64 * h + dd]; }
    if (tid < 128) ((LAS float*)(lds + GO_BD))[tid] = G.bd[(tid >> 6) * 256 + 64 * h + (tid & 63)];
    *(LAS u32x4*)(lds + GO_RQ + (tid >> 3) * GL_RS + (tid & 7) * 16) = rq; *(LAS u32x4*)(lds + GO_RK + (tid >> 3) * GL_RS + (tid & 7) * 16) = rk;
    *(LAS u32x4*)(lds + GO_VT + (tid >> 3) * GL_RS + (tid & 7) * 16) = rv0; *(LAS u32x4*)(lds + GO_VT + (64 + (tid >> 3)) * GL_RS + (tid & 7) * 16) = rv1;
    if (tid < 256) *(LAS u32x4*)(lds + GO_LR + (tid >> 7) * 2048 + ((tid & 127) >> 1) * 32 + (tid & 1) * 16) = rl;
    const int chain0 = bh * 2;
    gla_wait(G.cnt + chain0 * 16, G.cnt + (chain0 + 1) * 16, 400u, tid);
    const int et = wave >> 1, tt = wave & 1, d = lane;
    f32x16 oc;
#pragma unroll
    for (int i = 0; i < 16; ++i) oc[i] = 0.f;
#pragma unroll 1
    for (int dir = 0; dir < 2; ++dir) {
        if (dir) __syncthreads();
        const int pos = dir == 0 ? (isctx ? ch : 4 + ch) : (isctx ? 3 - ch : 35 - ch);
        {
            u32x4 s0 = {0u, 0u, 0u, 0u}, s1 = {0u, 0u, 0u, 0u};
            if (pos > 0) { const bf16* sp = G.GU + ((size_t)(chain0 + dir) * 36 + pos - 1) * 8192 + (tid >> 3) * 64 + 8 * (tid & 7); s0 = *(const u32x4*)sp; s1 = *(const u32x4*)(sp + 64 * 64); }
            *(LAS u32x4*)(lds + GO_ST + (tid >> 3) * GL_RS + (tid & 7) * 16) = s0; *(LAS u32x4*)(lds + GO_ST + (64 + (tid >> 3)) * GL_RS + (tid & 7) * 16) = s1;
        }
        float cum[8], tot;
        gla_decay(lds, dir, dir, wave, d, cum, tot);
#pragma unroll
        for (int i = 0; i < 8; ++i) { const int s = 8 * wave + i;
            const float qv = bf2f(*(const LAS bf16*)(lds + GO_RQ + s * GL_RS + 2 * d)), kv = bf2f(*(const LAS bf16*)(lds + GO_RK + s * GL_RS + 2 * d));
            *(LAS bf16*)(lds + GO_QT + s * GL_RS + 2 * d) = (bf16)f2bf(qv * 0.125f * __expf(cum[i]));
            *(LAS bf16*)(lds + GO_KT + s * GL_RS + 2 * d) = (bf16)f2bf(kv * __expf(-cum[i])); }
        __syncthreads();
        if (wave < 4) {
            const int ss = wave & 1, t2 = wave >> 1;
            f32x16 sc;
#pragma unroll
            for (int i = 0; i < 16; ++i) sc[i] = 0.f;
#pragma unroll
            for (int kk = 0; kk < 4; ++kk) { const bf16x8 af = *(const LAS bf16x8*)(lds + GO_KT + (32 * ss + r) * GL_RS + (16 * kk + 8 * hh) * 2), bfr = *(const LAS bf16x8*)(lds + GO_QT + (32 * t2 + r) * GL_RS + (16 * kk + 8 * hh) * 2);
                sc = __builtin_amdgcn_mfma_f32_32x32x16_bf16(af, bfr, sc, 0, 0, 0); }
            const int t = 32 * t2 + r;
#pragma unroll
            for (int i4 = 0; i4 < 4; ++i4) { float v[4];
#pragma unroll
                for (int jj = 0; jj < 4; ++jj) { const int s = 32 * ss + 8 * i4 + 4 * hh + jj; const bool keep = dir == 0 ? (s <= t) : (s >= t); v[jj] = keep ? sc[4 * i4 + jj] : 0.f; }
                u32x2 w; w.x = pk2(v[0], v[1]); w.y = pk2(v[2], v[3]); *(LAS u32x2*)(lds + GO_AT + t * GL_RS + (32 * ss + 8 * i4 + 4 * hh) * 2) = w; }
        }
        __syncthreads();
#pragma unroll
        for (int kk = 0; kk < 4; ++kk) { const bf16x8 af = *(const LAS bf16x8*)(lds + GO_ST + (32 * et + r) * GL_RS + (16 * kk + 8 * hh) * 2), bfr = *(const LAS bf16x8*)(lds + GO_QT + (32 * tt + r) * GL_RS + (16 * kk + 8 * hh) * 2);
            oc = __builtin_amdgcn_mfma_f32_32x32x16_bf16(af, bfr, oc, 0, 0, 0); }
#pragma unroll
        for (int kk = 0; kk < 4; ++kk) { const bf16x8 af = *(const LAS bf16x8*)(lds + GO_VT + (32 * et + r) * GL_RS + (16 * kk + 8 * hh) * 2), bfr = *(const LAS bf16x8*)(lds + GO_AT + (32 * tt + r) * GL_RS + (16 * kk + 8 * hh) * 2);
            oc = __builtin_amdgcn_mfma_f32_32x32x16_bf16(af, bfr, oc, 0, 0, 0); }
    }
    float ss = 0.f;
#pragma unroll
    for (int i = 0; i < 16; ++i) ss += oc[i] * oc[i];
    ss += SHFLX(ss, 32);
    if (hh == 0) ((LAS float*)(lds + GO_RED))[et * 64 + 32 * tt + r] = ss;
    __syncthreads();
    const int t = 32 * tt + r;
    const float tot2 = ((const LAS float*)(lds + GO_RED))[t] + ((const LAS float*)(lds + GO_RED))[64 + t] + ((const LAS float*)(lds + GO_RED))[128 + t] + ((const LAS float*)(lds + GO_RED))[192 + t];
    const float rstd = rsqrtf(tot2 * (1.f / 128.f) + EPS);
    const int row = row0 + t;
    const bf16* rp = G.P + (size_t)row * PC + PC_RC + 128 * h + 32 * et + 4 * hh; unsigned char* yp = (unsigned char*)G.Y + (size_t)row * 2048 + 1024 + 128 * h + 32 * et + 4 * hh; const float* gw = G.gnw + 32 * et + 4 * hh;
#pragma unroll
    for (int i4 = 0; i4 < 4; ++i4) { const u32x2 rr = *(const u32x2*)(rp + 8 * i4); const f32x4 w = *(const f32x4*)(gw + 8 * i4);
        const float y0 = oc[4 * i4] * rstd * w[0] * siluf_(bflo(rr.x)), y1 = oc[4 * i4 + 1] * rstd * w[1] * siluf_(bfhi(rr.x)), y2 = oc[4 * i4 + 2] * rstd * w[2] * siluf_(bflo(rr.y)), y3 = oc[4 * i4 + 3] * rstd * w[3] * siluf_(bfhi(rr.y));
        *(unsigned*)(yp + 8 * i4) = pk4_fp8(16.f * y0, 16.f * y1, 16.f * y2, 16.f * y3); }
}

__device__ __forceinline__ GlaArgs make_gla(const Args& a, int l, int g) {
    unsigned char* ws = a.ws; GlaArgs G; G.P = (const bf16*)(ws + WS_P); G.VtC = (const bf16*)(ws + WS_VTC); G.Y = (bf16*)(ws + WS_Y); G.GU = (bf16*)(ws + WS_GU); G.GDL = (float*)(ws + WS_GDL);
    G.cnt = (unsigned*)(ws + WS_CTL) + CW_GLA + (l * 2 + g) * 32 * 16; G.wd = a.in[I_GWD] + (size_t)l * 2 * 16 * 256; G.bd = a.in[I_GBD] + (size_t)l * 2 * 256; G.gnw = a.in[I_GNW] + l * 128; G.need_ctx = (l == 0);
    return G;
}
__device__ __forceinline__ void attn_phase(const Args& a, int l, int g, LAS unsigned char* lds) {
    unsigned char* ws = a.ws;
    const bf16* P = (const bf16*)(ws + WS_P); const bf16* QA = (const bf16*)(ws + WS_QA); const bf16* KA = (const bf16*)(ws + WS_KA);
    unsigned char* Y = ws + WS_Y;
    const int need_ctx = (l == 0);
    const int NCH = need_ctx ? 36 : 32;
    const int C_SCAN = 16, C_A = 16, C_D = 16, C_B = 32, C_AC = need_ctx ? 2 : 0, C_DC = C_AC, C_BC = need_ctx ? 4 : 0, C_OUT = 2 * NCH;
    const int qtotal = C_SCAN + C_A + C_D + C_B + C_AC + C_DC + C_BC + C_OUT;
    unsigned* ctr0 = (unsigned*)(ws + WS_CTL) + (l * 2 + g) * 8 * 16;
    volatile LAS int* slot = (volatile LAS int*)(lds + LDS_BYTES - 16);
    const GlaArgs G = make_gla(a, l, g);
    const int x0 = (int)(__builtin_amdgcn_s_getreg((3 << 11) | 20) & 7);
    for (int qi = 0; qi < 8; ++qi) {
        const int x = (x0 + qi) & 7;
        for (;;) {
            __syncthreads();
            if (tidx() == 0) *slot = (int)__hip_atomic_fetch_add(ctr0 + x * 16, 1u, __ATOMIC_RELAXED, __HIP_MEMORY_SCOPE_AGENT);
            __syncthreads();
            int idx = *slot;
            idx = __builtin_amdgcn_readfirstlane(idx);
            if (idx >= qtotal) break;
            if (idx < C_SCAN) { const int bh = x + 8 * (idx >> 3); gla_scan(G, bh * 2 + ((idx >> 2) & 1), idx & 3); continue; }
            idx -= C_SCAN;
            if (idx >= qtotal - C_SCAN - C_OUT) { idx -= qtotal - C_SCAN - C_OUT; const int bh = x + 8 * (idx / NCH); gla_out(lds, G, bh, idx - (idx / NCH) * NCH); continue; }
            AttnArgs A; A.sink_l2 = 0.f; A.qnw = nullptr; A.band_first = 0;
            int kind, bl, h, qb = 0, ctxq = 0;
            if (idx < C_A) { kind = 0; const int bh = x + 8 * (idx >> 3); bl = bh >> 2; h = bh & 3; qb = idx & 7; }
            else if (idx < C_A + C_D) { const int i = idx - C_A; kind = 2; bl = x >> 1; h = 2 * (x & 1) + (i >> 3); qb = i & 7; }
            else if (idx < C_A + C_D + C_B) { const int i = idx - C_A - C_D; kind = 1; bl = x >> 1; h = 4 * (x & 1) + (i >> 3); qb = i & 7; }
            else if (idx < C_A + C_D + C_B + C_AC) { const int i = idx - (C_A + C_D + C_B); kind = 0; const int bh = x + 8 * i; bl = bh >> 2; h = bh & 3; ctxq = 1; }
            else if (idx < C_A + C_D + C_B + C_AC + C_DC) { const int i = idx - (C_A + C_D + C_B + C_AC); kind = 2; bl = x >> 1; h = 2 * (x & 1) + i; ctxq = 1; }
            else { const int i = idx - (C_A + C_D + C_B + C_AC + C_DC); kind = 1; bl = x >> 1; h = 4 * (x & 1) + i; ctxq = 1; }
            int row;
            if (!ctxq) { row = bl * SEQ + 256 * qb; A.qpos0 = 256 * qb; A.ntile = 36; }
            else { row = LAT_ROWS + bl * CTXL; A.qpos0 = -1; A.ntile = 4; }
            A.opitch = 2048;
            if (kind == 0) {
                A.Q = QA + (size_t)row * 768 + 192 * h; A.qpitch = 768;
                A.Kc = KA + (size_t)(bl * 4 + h) * KEYS * 192; A.Kl = A.Kc + (size_t)CTXL * 192; A.kpitch = 192;
                A.Vt = (const bf16*)(ws + WS_VTA + (size_t)(bl * 4 + h) * 128 * KEYS);
                A.O = Y + (size_t)row * 2048 + 128 * h;
                attn_unit<192, 128, 0>(lds, A);
            } else if (kind == 2) {
                const int kvh = h >> 1;
                A.Q = P + (size_t)row * PC + PC_QD + 128 * h; A.qpitch = PC;
                A.Kc = P + (size_t)(LAT_ROWS + bl * CTXL) * PC + PC_KD + 128 * kvh; A.Kl = P + (size_t)(bl * SEQ) * PC + PC_KD + 128 * kvh; A.kpitch = PC;
                A.Vt = (const bf16*)(ws + WS_VTD + (size_t)(bl * 2 + kvh) * 128 * KEYS);
                A.O = Y + (size_t)row * 2048 + 1536 + 128 * h; A.qnw = a.in[I_QNW] + l * 128;
                attn_unit<128, 128, 2>(lds, A);
            } else {
                const int kvh = h >> 2;
                if (!ctxq) { const int first = 256 * qb - 128 < 0 ? 0 : 256 * qb - 128, last = 256 * qb + 383 > SEQ - 1 ? SEQ - 1 : 256 * qb + 383; A.band_first = first; A.ntile = 4 + (last - first + 1) / 64; }
                A.Q = P + (size_t)row * PC + PC_QB + 64 * h; A.qpitch = PC;
                A.Kc = P + (size_t)(LAT_ROWS + bl * CTXL) * PC + PC_KB + 64 * kvh; A.Kl = P + (size_t)(bl * SEQ) * PC + PC_KB + 64 * kvh; A.kpitch = PC;
                A.Vt = (const bf16*)(ws + WS_VTB + (size_t)(bl * 2 + kvh) * 64 * KEYS);
                A.O = Y + (size_t)row * 2048 + 512 + 64 * h; A.sink_l2 = a.in[I_SINK][l * 8 + h] * 1.4426950408889634f;
                attn_unit<64, 64, 1>(lds, A);
            }
        }
    }
}

#define XB_TMO      128
#define XB_XCNT(j)  (256  + 64 * (j))
#define XB_XSUB(j)  (1280 + 64 * (j))
#define XB_XGEN(j)  (2304 + 64 * (j))
#define XB_TOP      3328
#define XB_TOPGEN   3392
#define XCD_BAR_WORDS 3456
#define XB_SPIN_CAP (1u << 22)
__device__ __forceinline__ unsigned xb_ld(unsigned* p)              { return __hip_atomic_load(p, __ATOMIC_RELAXED, __HIP_MEMORY_SCOPE_AGENT); }
__device__ __forceinline__ unsigned xb_add(unsigned* p, unsigned v) { return __hip_atomic_fetch_add(p, v, __ATOMIC_RELAXED, __HIP_MEMORY_SCOPE_AGENT); }
__device__ __forceinline__ unsigned xb_xcc_id() { return (unsigned)__builtin_amdgcn_s_getreg((3 << 11) | 20) & 0xFu; }
#define XB_SPIN(cond, bar) do { unsigned _sp = 0; while (cond) { __builtin_amdgcn_s_sleep(1); \
    if ((++_sp & 255u) == 0u) { if (xb_ld(&(bar)[XB_TMO])) break; if (_sp > XB_SPIN_CAP) { atomicAdd(&(bar)[XB_TMO], 1u); break; } } } } while (0)
struct XcdBarrier { unsigned* bar; unsigned x; volatile LAS unsigned* st; };
__device__ __forceinline__ XcdBarrier xcd_barrier_post(unsigned* bar, volatile LAS unsigned* st) {
    XcdBarrier b; b.bar = bar; b.x = xb_xcc_id(); b.st = st;
    if (tidx() == 0) (void)xb_add(&bar[XB_XCNT(b.x)], 1u);
    return b;
}
__device__ __forceinline__ void xcd_barrier_complete(unsigned* bar, unsigned x, unsigned& nloc, unsigned& nx) {
    const unsigned G = gridDim.x * gridDim.y * gridDim.z;
    unsigned sum, cnt, mine, sp = 0u;
    for (;;) {
        sum = 0u; cnt = 0u; mine = 0u;
#pragma unroll
        for (unsigned j = 0; j < 16; ++j) { const unsigned c = xb_ld(&bar[XB_XCNT(j)]); sum += c; cnt += (c > 0u) ? 1u : 0u; mine = (j == x) ? c : mine; }
        if (sum == G) break;
        __builtin_amdgcn_s_sleep(1);
        if ((++sp & 255u) == 0u) { if (xb_ld(&bar[XB_TMO])) break; if (sp > XB_SPIN_CAP) { atomicAdd(&bar[XB_TMO], 1u); break; } }
    }
    nloc = mine > 0u ? mine : 1u; nx = cnt > 0u ? cnt : 1u;
}
__device__ __forceinline__ void xcd_barrier(const XcdBarrier& b, const bool rel = true) {
    asm volatile("s_waitcnt vmcnt(0)" ::: "memory");
    __syncthreads();
    if (tidx() == 0) {
        unsigned* bar = b.bar;
        __builtin_amdgcn_s_waitcnt(0);
        unsigned nloc = b.st[0], nx = b.st[1];
        if (nloc == 0u) { xcd_barrier_complete(bar, b.x, nloc, nx); b.st[0] = nloc; b.st[1] = nx; }
        const unsigned gen = b.st[2]; b.st[2] = gen + 1u;
        const unsigned old = xb_add(&bar[XB_XSUB(b.x)], 1u);
        if (old + 1u == (gen + 1u) * nloc) {
            if (rel) __builtin_amdgcn_fence(__ATOMIC_RELEASE, "agent");
            asm volatile("s_waitcnt vmcnt(0)" ::: "memory");
            (void)xb_add(&bar[XB_TOP], 1u);
        }
        const unsigned tgt = (gen + 1u) * nx;
        asm volatile("buffer_inv sc1" ::: "memory");
        XB_SPIN(xb_ld(&bar[XB_TOP]) < tgt, bar);
        asm volatile("s_waitcnt vmcnt(0)" ::: "memory");
    }
    __syncthreads();
}
__device__ __forceinline__ bool phase_plain_stores(int q) {
    if (q == 0 || q == 17) return false;
    const int l = q > 17, rr = l ? q - 18 : q - 1;
    if (rr >= 12) return rr - 12 == 0 || rr - 12 == 3;
    const int k0 = rr % 6; return !(k0 == 4 || k0 == 0);
}
constexpr int CW_BAR = 4096;

#ifndef MK_CG_FIRST
#define MK_CG_FIRST 0
#endif
constexpr int N_PHASES = 35;
template <bool COOP>
__global__ void __launch_bounds__(512, 2) mk_fwd(Args args) {
    extern __shared__ __attribute__((aligned(16))) unsigned char lds_raw[];
    LAS unsigned char* lds = (LAS unsigned char*)lds_raw;
    unsigned char* ws = args.ws; unsigned char* wt = ws + WS_WT;
    const int G = gridDim.x, bx = blockIdx.x;
    volatile LAS unsigned* misc = (volatile LAS unsigned*)(lds + LDS_BYTES - 32);
    XcdBarrier bar; bar.bar = nullptr; bar.x = 0; bar.st = misc;
    if ((threadIdx.x & 63u) == 0u) *(volatile LAS int*)(size_t)(LDS_WTAB + 4 * hw_wave_slot()) = (int)(threadIdx.x >> 6);
    if (COOP) { if (threadIdx.x < 4) misc[threadIdx.x] = 0u; __syncthreads(); bar = xcd_barrier_post((unsigned*)(ws + WS_CTL) + CW_BAR, misc); }
#ifdef PROBE_PHASE
    volatile LAS unsigned long long* tp = (volatile LAS unsigned long long*)(lds + LDS_BYTES - 64);
    if (threadIdx.x == 0) { tp[0] = 0; tp[1] = __builtin_amdgcn_s_memrealtime(); }
    int prev_kind = 100;
#endif
    for (int p = args.ph_lo; p < args.ph_hi; ++p) {
        if (COOP) { if (p == args.ph_lo + 1 && MK_CG_FIRST) cg::this_grid().sync(); else if (p > args.ph_lo) xcd_barrier(bar, phase_plain_stores(p - 1)); }
#ifdef PROBE_PHASE
        { if (bx == 0 && threadIdx.x == 0) { const unsigned long long t = __builtin_amdgcn_s_memrealtime(); if (prev_kind == PROBE_PHASE) tp[0] += t - tp[1]; tp[1] = t; }
          int kind_; if (p == 0) kind_ = 12; else if (p == 19) kind_ = 13; else if (p == N_PHASES - 1) kind_ = 14; else { const int l_ = p > 19, rr_ = l_ ? p - 20 : p - 1, g_ = rr_ < 14 ? rr_ / 7 : 0, k0_ = rr_ < 14 ? rr_ - 7 * g_ : rr_ - 14; kind_ = rr_ < 14 ? (k0_ >= 5 ? k0_ + 1 : k0_) : 8 + k0_; }
          prev_kind = kind_; }
#endif
        if (p == 0) { if (bx < 48) prep_mods(args, lds, bx); prep_weights_dyn(args, 0, lds, 0, PREP_EARLY_ITEMS + 64 * (1024 / 32), (unsigned*)(ws + WS_CTL) + 2176); continue; }
        if (p == N_PHASES - 1) { final_norm_rows(args); continue; }
        if (p == 17) { xc_reduce_rows(args); continue; }
        const int l = p > 17, rr = l ? p - 18 : p - 1, g = rr < 12 ? rr / 6 : 0, k0 = rr < 12 ? rr - 6 * g : rr - 12, k = rr < 12 ? (k0 >= 3 ? k0 + 1 : k0) + (k0 >= 4 ? 1 : 0) : 8 + k0;
        const int nM = (l == 1) ? 32 : 36;
        pg8::StaticOrder S;
        switch (k) {
        case 0: if (l == 1 && g == 0) prep_weights(args, 1, lds, PREP_EARLY_ITEMS); norm_mod_rows(args, l, g, MG_ROWS, 0); break;
        case 1: { pg8::Gemm gm{(const bf16*)(ws + WS_H), (const bf16*)(wt + WT_WIN), 1024, 1024, 1024, 0, 0, 0, nullptr, 0};
            EpiInProj E{(bf16*)(ws + WS_P), (bf16*)(ws + WS_VTB), (bf16*)(ws + WS_VTC), (bf16*)(ws + WS_VTD), (float*)(ws + WS_RS) + (size_t)(l * 2 + g) * MG_ROWS * 2};
            if (l == 0) { S.init(36, 15, G, bx); pg8::gemm_phase(lds, gm, S, E);
                if (g == 1) {
                    pg8::Gemm go{(const bf16*)(ws + WS_MG0), (const bf16*)(wt + WT_WO), 1024, 1024, 1024, 0, 0, 0, nullptr, 0}; S.init(36, 4, G, (bx + G - 28) % G);
                    EpiResid Eo{&args, l, 0, 2, false, 36}; pg8::gemm_phase(lds, go, S, Eo); } }
            else {
                S.init(32, 15, G, bx); pg8::gemm_phase(lds, gm, S, E);
                S.init(4, 7, G, (bx + 32) % G, 3); pg8::gemm_phase(lds, gm, S, E); }
            break; }
        case 2: {
            { pg8::Gemm gm{(const bf16*)(ws + WS_P) + PC_CKV, (const bf16*)(wt + WT_WMLA), PC, 384, 384, 0, 0, 0, nullptr, 0}; S.init(36, 7, G, bx);
              EpiMla E{(bf16*)(ws + WS_QA), (bf16*)(ws + WS_KA), (bf16*)(ws + WS_VTA), (const float*)(ws + WS_RS) + (size_t)(l * 2 + g) * MG_ROWS * 2}; pg8::gemm_phase(lds, gm, S, E); }
            const GlaArgs GG = make_gla(args, l, g); for (int it = bx; it < 1152; it += G) gla_local(lds, GG, it & 31, it >> 5); post_rows(args, l); break; }
        case 4: attn_phase(args, l, g, lds); break;
        case 6: { pg8::Gemm gm{(const bf16*)(ws + WS_Y), (const bf16*)(wt + WT_WB), 1024, 256, 256, 4, 256, 0, nullptr, 0}; S.init(nM, 16, G, bx);
            EpiStore<0> E{(bf16*)(ws + WS_Z), 4096, 1.f / 512.f}; pg8::gemm_phase<EpiStore<0>, true>(lds, gm, S, E); break; }
        case 7: { pg8::Gemm gm{(const bf16*)(ws + WS_H8A), (const bf16*)(wt + WT_WG8), 512, 512, 512, 0, 0, 0, (const bf16*)(ws + WS_H8B), H8_SPLIT}; S.init(nM, 16, G, bx);
            EpiMerge E{(const bf16*)(ws + WS_Z), (bf16*)(ws + (g == 0 ? WS_MG0 : WS_MG))}; pg8::gemm_phase<EpiMerge, true>(lds, gm, S, E);
            if (l == 0 && g == 1) norm_mod_rows(args, l, 0, 36 * 256, 1, 0, 64, G - 64, (bf16*)(ws + WS_MG0));
            break; }
        case 8: { pg8::Gemm gm{(const bf16*)(ws + WS_MG0), (const bf16*)(wt + WT_WO), 1024, 1024, 1024, 0, 0, 0, (const bf16*)(ws + WS_MG), nM};
            if (l == 0) S.init(36, 4, G, bx, 4); else S.init(2 * nM, 4, G, bx);
            EpiResid E{&args, l, 0, 2, false, nM}; pg8::gemm_phase(lds, gm, S, E); break; }
        case 9: norm_mod_rows(args, l, 0, 2 * nM * 256, 1, l == 0 ? 36 * 256 : 0); break;
        case 10: { pg8::Gemm gm{(const bf16*)(ws + (l == 0 ? WS_MG0 : WS_H2)), (const bf16*)(wt + WT_W1), 1024, 1024, 1024, 0, 0, 0, l == 0 ? (const bf16*)(ws + WS_H2) + (size_t)36 * 256 * 1024 : nullptr, l == 0 ? 36 : 0}; S.init(2 * nM, 16, G, bx);
            EpiStore<1> E{(bf16*)(ws + WS_HID), 4096}; pg8::gemm_phase(lds, gm, S, E); break; }
        default:
            if (l == 1) { pg8::Gemm gm{(const bf16*)(ws + WS_HID), (const bf16*)(wt + WT_W2), 4096, 4096, 4096, 0, 0, 0, nullptr, 0}; S.init(2 * nM, 4, G, bx);
                EpiResid E{&args, l, 0, 5, true, nM}; pg8::gemm_phase(lds, gm, S, E); }
            else {
                { pg8::Gemm gm{(const bf16*)(ws + WS_HID), (const bf16*)(wt + WT_W2), 4096, 4096, 4096, 0, 0, 0, nullptr, 0}; S.init(64, 4, G, bx, 1);
                  EpiResid E{&args, l, 0, 5, true, nM}; pg8::gemm_phase(lds, gm, S, E); }
                { pg8::Gemm gm{(const bf16*)(ws + WS_HID), (const bf16*)(wt + WT_W2), 4096, 4096, 1024, 0, 0, 4, nullptr, 0}; S.init(8, 16, G, (bx + 128) % G, 2);
                  EpiPartial E{(float*)(ws + WS_H2)}; pg8::gemm_phase(lds, gm, S, E); }
                prep_weights_dyn(args, 1, lds, 0, PREP_EARLY_ITEMS, (unsigned*)(ws + WS_CTL) + 2048);
            }
            break;
        }
    }
#ifdef PROBE_PHASE
    xcd_barrier(bar);
    if (bx == 0) { const unsigned long long t = __builtin_amdgcn_s_memrealtime(); if (threadIdx.x == 0 && prev_kind == PROBE_PHASE) tp[0] += t - tp[1]; __syncthreads();
        const float v = (float)tp[0] * PROBE_SCALE; for (int i = tidx(); i < 128; i += 512) args.out[i] = v; }
#endif
}

#ifndef MK_PER_PHASE
#define MK_PER_PHASE 0
#endif
extern "C" void kernel_launch(void* const* d_in, const int* in_sizes, int n_in, void* d_out, int out_size, void* d_ws, size_t ws_size, hipStream_t stream) {
    static int grid = 0;
    if (grid == 0) {
        if (n_in != 24 || out_size != NB * SEQ * DM || ws_size < WS_TOTAL) { fprintf(stderr, "kernel_launch: unexpected shapes (n_in %d out %d ws %zu)\n", n_in, out_size, ws_size); grid = -1; return; }
        int dev = 0, cus = 0, per_cu = 0;
        hipGetDevice(&dev); hipDeviceGetAttribute(&cus, hipDeviceAttributeMultiprocessorCount, dev);
        hipFuncSetAttribute((const void*)mk_fwd<!MK_PER_PHASE>, hipFuncAttributeMaxDynamicSharedMemorySize, LDS_BYTES);
        hipOccupancyMaxActiveBlocksPerMultiprocessor(&per_cu, (const void*)mk_fwd<!MK_PER_PHASE>, 512, LDS_BYTES);
        if (per_cu < 1) { fprintf(stderr, "kernel_launch: occupancy query says %d blocks per CU\n", per_cu); per_cu = 1; }
        (void)hipGetLastError();
        grid = cus;
    }
    if (grid < 0) return;
    hipMemsetAsync((char*)d_ws + WS_CTL, 0, 524288, stream);
    Args a{};
    for (int i = 0; i < 24; ++i) a.in[i] = (const float*)d_in[i];
    a.out = (float*)d_out; a.ws = (unsigned char*)d_ws;
#if MK_PER_PHASE
    for (int p = 0; p < N_PHASES; ++p) { a.ph_lo = p; a.ph_hi = p + 1; hipLaunchKernelGGL(mk_fwd<false>, dim3(grid), dim3(512), LDS_BYTES, stream, a); }
#else
    a.ph_lo = 0; a.ph_hi = N_PHASES;
    void* kargs[] = {&a};
    hipError_t e = hipLaunchCooperativeKernel((const void*)mk_fwd<true>, dim3(grid), dim3(512), kargs, LDS_BYTES, stream);
    if (e != hipSuccess) fprintf(stderr, "cooperative launch failed: %s (grid %d)\n", hipGetErrorString(e), grid);
#endif
}
```
